# Optimizing an MI355X kernel written in HIP

```python
import jax, jax.numpy as jnp
from jax import lax
import numpy as np

D_MODEL = 1024
BATCH = 16
SEQ = 2048
DEPTH = 2

HEAD_DIM = 64
ROPE_THETA = 10000.0
EPS = 1e-6
SWA_Q_HEADS = 8
SWA_KV_HEADS = 2
SWA_WINDOW = 128
SWA_BLOCK = 128
MOBA_HEADS = 8
MOBA_BLOCK = 256
MOBA_TOPK = 3
MOBA_Q_CHUNK = 16
GLA_HEADS = 4
GLA_DK = 64
GLA_DV = 128
GLA_GATE_RANK = 16
GLA_TAU = 16.0
GLA_CHUNK = 64
N_BRANCH = 3
SWA_WIDTH = SWA_Q_HEADS * HEAD_DIM
MOBA_WIDTH = MOBA_HEADS * HEAD_DIM
GLA_WIDTH = GLA_HEADS * GLA_DV
D_FF = -(-8 * D_MODEL // (3 * 256)) * 256
IN_SIZES = (
    SWA_Q_HEADS * HEAD_DIM, SWA_KV_HEADS * HEAD_DIM, SWA_KV_HEADS * HEAD_DIM,
    MOBA_HEADS * HEAD_DIM, MOBA_HEADS * HEAD_DIM, MOBA_HEADS * HEAD_DIM,
    GLA_HEADS * GLA_DK, GLA_HEADS * GLA_DK, GLA_HEADS * GLA_DV,
    GLA_GATE_RANK, GLA_HEADS * GLA_DV,
    N_BRANCH * D_MODEL,
)
D_IN = sum(IN_SIZES)

kernel_name = "hybrid_swa_moba_gla_block"


def rms_norm(x, g):
    xf = x.astype(jnp.float32)
    y = xf * lax.rsqrt(jnp.mean(xf * xf, axis=-1, keepdims=True) + EPS)
    return (y * g.astype(jnp.float32)).astype(x.dtype)


def rope_tables(positions, dim, dtype):
    inv_freq = ROPE_THETA ** (-jnp.arange(0, dim, 2, dtype=jnp.float32) / dim)
    ang = positions.astype(jnp.float32)[..., None] * inv_freq
    return jnp.cos(ang)[:, :, None, :].astype(dtype), jnp.sin(ang)[:, :, None, :].astype(dtype)


def apply_rope(x, cos, sin):
    x1, x2 = jnp.split(x, 2, axis=-1)
    return jnp.concatenate([x1 * cos - x2 * sin, x2 * cos + x1 * sin], axis=-1)


def sliding_window_attention(q, k, v, sinks):
    B, S, Hq, d = q.shape
    Hkv = k.shape[2]
    G = Hq // Hkv
    L = SWA_BLOCK
    nb = S // L
    qb = q.reshape(B, nb, L, Hkv, G, d)
    pad = lambda t: jnp.pad(t, ((0, 0), (L, 0), (0, 0), (0, 0))).reshape(B, nb + 1, L, Hkv, d)
    kp, vp = pad(k), pad(v)
    kb = jnp.concatenate([kp[:, :-1], kp[:, 1:]], axis=2)
    vb = jnp.concatenate([vp[:, :-1], vp[:, 1:]], axis=2)
    s = jnp.einsum('bnqhgd,bnkhd->bnhgqk', qb, kb).astype(jnp.float32) * (d ** -0.5)
    qi = jnp.arange(L)[:, None]
    ki = jnp.arange(2 * L)[None, :]
    rel = qi + L - ki
    kpos = jnp.arange(nb)[:, None, None] * L + ki - L
    allowed = (rel >= 0) & (rel < SWA_WINDOW) & (kpos >= 0)
    s = jnp.where(allowed[None, :, None, None], s, -jnp.inf)
    sink = sinks.astype(jnp.float32).reshape(1, 1, Hkv, G, 1, 1)
    m = jnp.maximum(jnp.max(s, axis=-1, keepdims=True), sink)
    p = jnp.exp(s - m)
    p = (p / (jnp.sum(p, axis=-1, keepdims=True) + jnp.exp(sink - m))).astype(v.dtype)
    o = jnp.einsum('bnhgqk,bnkhd->bnqhgd', p, vb)
    return o.reshape(B, S, Hq * d)


def moba_attention(q, k, v):
    B, S, H, d = q.shape
    L = MOBA_BLOCK
    nb = -(-S // L)
    Sp = nb * L
    scale = d ** -0.5
    padS = lambda t: jnp.pad(t, ((0, 0), (0, Sp - S), (0, 0), (0, 0))).transpose(0, 2, 1, 3)
    qh, kh, vh = padS(q), padS(k), padS(v)
    kblk = kh.reshape(B, H, nb, L, d)
    vblk = vh.reshape(B, H, nb, L, d)
    kmean = jnp.mean(kblk.astype(jnp.float32), axis=3)
    gate = jnp.einsum('bhtd,bhnd->bhtn', qh.astype(jnp.float32), kmean)
    past = jnp.arange(nb)[None, :] < (jnp.arange(Sp) // L)[:, None]
    gate = jnp.where(past, gate, -jnp.inf)
    topk = min(MOBA_TOPK, nb)
    gval, gidx = lax.top_k(gate, topk)
    gvalid = jnp.isfinite(gval)

    C = MOBA_Q_CHUNK
    nc = Sp // C
    to_chunks = lambda t: jnp.moveaxis(t.reshape(B, H, nc, C, t.shape[-1]), 2, 0)
    bi = jnp.arange(B)[:, None, None, None]
    hi = jnp.arange(H)[None, :, None, None]

    def one_chunk(args):
        qc, ic, vc_ok, c = args
        ksel = kblk[bi, hi, ic]
        vsel = vblk[bi, hi, ic]
        s_sel = jnp.einsum('bhqd,bhqnkd->bhqnk', qc, ksel).astype(jnp.float32) * scale
        s_sel = jnp.where(vc_ok[..., None], s_sel, -jnp.inf).reshape(B, H, C, topk * L)
        own = (c * C) // L
        kown = lax.dynamic_index_in_dim(kblk, own, axis=2, keepdims=False)
        vown = lax.dynamic_index_in_dim(vblk, own, axis=2, keepdims=False)
        s_own = jnp.einsum('bhqd,bhkd->bhqk', qc, kown).astype(jnp.float32) * scale
        qpos = c * C + jnp.arange(C)
        kpos = own * L + jnp.arange(L)
        s_own = jnp.where(kpos[None, :] <= qpos[:, None], s_own, -jnp.inf)
        p = jax.nn.softmax(jnp.concatenate([s_sel, s_own], axis=-1), axis=-1).astype(vh.dtype)
        p_sel = p[..., :topk * L].reshape(B, H, C, topk, L)
        p_own = p[..., topk * L:]
        return (jnp.einsum('bhqnk,bhqnkd->bhqd', p_sel, vsel)
                + jnp.einsum('bhqk,bhkd->bhqd', p_own, vown))

    out = lax.map(one_chunk, (to_chunks(qh), to_chunks(gidx), to_chunks(gvalid),
                              jnp.arange(nc, dtype=jnp.int32)))
    out = jnp.moveaxis(out, 0, 2).reshape(B, H, Sp, d)[:, :, :S]
    return out.transpose(0, 2, 1, 3).reshape(B, S, H * d)


def gla_attention(q, k, v, log_alpha):
    B, S, H, dk = q.shape
    dv = v.shape[-1]
    C = GLA_CHUNK
    nc = S // C
    f32 = jnp.float32
    rs = lambda t: t.astype(f32).reshape(B, nc, C, H, t.shape[-1]).transpose(0, 3, 1, 2, 4)
    qc = rs(q) * (dk ** -0.5)
    kc, vc = rs(k), rs(v)
    b = jnp.cumsum(rs(log_alpha), axis=3)
    b_last = b[..., -1:, :]
    q_dec = qc * jnp.exp(b)
    k_dec = kc * jnp.exp(-b)
    k_tail = kc * jnp.exp(b_last - b)
    A = jnp.einsum('bhnid,bhnjd->bhnij', q_dec, k_dec)
    A = jnp.where(jnp.tril(jnp.ones((C, C), dtype=bool)), A, 0.0)
    o_intra = jnp.einsum('bhnij,bhnjv->bhniv', A, vc)
    dS = jnp.einsum('bhnjd,bhnjv->bhndv', k_tail, vc)
    decay = jnp.exp(b_last[..., 0, :])

    def step(state, inp):
        dec, ds = inp
        return dec[..., None] * state + ds, state

    _, s_before = lax.scan(step, jnp.zeros((B, H, dk, dv), f32),
                           (jnp.moveaxis(decay, 2, 0), jnp.moveaxis(dS, 2, 0)))
    o_inter = jnp.einsum('bhnid,bhndv->bhniv', q_dec, jnp.moveaxis(s_before, 0, 2))
    o = o_intra + o_inter
    return o.transpose(0, 2, 3, 1, 4).reshape(B, S, H, dv).astype(v.dtype)


def hybrid_mixer(h, cos, sin, w_in, swa_q_norm, swa_k_norm, swa_sinks, moba_q_norm, moba_k_norm,
                 gla_w_alpha, gla_b_alpha, gla_out_norm, w_branch_swa, w_branch_moba, w_branch_gla, w_out):
    B, S, D = h.shape
    proj = h @ w_in
    points = np.cumsum(IN_SIZES)[:-1].tolist()
    (qa, ka, va, qb, kb, vb, qg, kg, vg, a_low, r_gate, gates) = jnp.split(proj, points, axis=-1)
    heads = lambda t, n: t.reshape(B, S, n, -1)
    qa = apply_rope(rms_norm(heads(qa, SWA_Q_HEADS), swa_q_norm), cos, sin)
    ka = apply_rope(rms_norm(heads(ka, SWA_KV_HEADS), swa_k_norm), cos, sin)
    y_a = sliding_window_attention(qa, ka, heads(va, SWA_KV_HEADS), swa_sinks)
    qb = apply_rope(rms_norm(heads(qb, MOBA_HEADS), moba_q_norm), cos, sin)
    kb = apply_rope(rms_norm(heads(kb, MOBA_HEADS), moba_k_norm), cos, sin)
    y_b = moba_attention(qb, kb, heads(vb, MOBA_HEADS))
    log_alpha = jax.nn.log_sigmoid((a_low @ gla_w_alpha + gla_b_alpha).astype(jnp.float32)) / GLA_TAU
    o_c = gla_attention(heads(qg, GLA_HEADS), heads(kg, GLA_HEADS), heads(vg, GLA_HEADS),
                        log_alpha.reshape(B, S, GLA_HEADS, GLA_DK))
    y_c = rms_norm(o_c, gla_out_norm).reshape(B, S, GLA_WIDTH) * jax.nn.silu(r_gate)
    g = jax.nn.sigmoid(gates.reshape(B, S, N_BRANCH, D))
    merged = (g[:, :, 0] * (y_a @ w_branch_swa)
              + g[:, :, 1] * (y_b @ w_branch_moba)
              + g[:, :, 2] * (y_c @ w_branch_gla))
    return merged @ w_out


def swiglu(h, w_gate, w_up, w_down):
    return (jax.nn.silu(h @ w_gate) * (h @ w_up)) @ w_down


def setup_inputs(seed: int = 0) -> dict:
    key = jax.random.key(seed)
    ks = jax.random.split(key, 24)
    f32 = jnp.float32
    nrm = lambda k, shape, scale: jax.random.normal(k, shape, f32) * scale
    gain = lambda k, shape: 1.0 + 0.05 * jax.random.normal(k, shape, f32)
    return {
        "x": nrm(ks[0], (BATCH, SEQ, D_MODEL), 1.0),
        "positions": jnp.broadcast_to(jnp.arange(SEQ, dtype=jnp.int32), (BATCH, SEQ)),
        "attn_norm": gain(ks[1], (DEPTH, D_MODEL)),
        "w_in": nrm(ks[2], (DEPTH, D_MODEL, D_IN), D_MODEL ** -0.5),
        "swa_q_norm": gain(ks[3], (DEPTH, HEAD_DIM)),
        "swa_k_norm": gain(ks[4], (DEPTH, HEAD_DIM)),
        "swa_sinks": nrm(ks[5], (DEPTH, SWA_Q_HEADS), 0.5),
        "moba_q_norm": gain(ks[6], (DEPTH, HEAD_DIM)),
        "moba_k_norm": gain(ks[7], (DEPTH, HEAD_DIM)),
        "gla_w_alpha": nrm(ks[8], (DEPTH, GLA_GATE_RANK, GLA_HEADS * GLA_DK), GLA_GATE_RANK ** -0.5),
        "gla_b_alpha": nrm(ks[9], (DEPTH, GLA_HEADS * GLA_DK), 0.1),
        "gla_out_norm": gain(ks[10], (DEPTH, GLA_DV)),
        "w_branch_swa": nrm(ks[11], (DEPTH, SWA_WIDTH, D_MODEL), SWA_WIDTH ** -0.5),
        "w_branch_moba": nrm(ks[12], (DEPTH, MOBA_WIDTH, D_MODEL), MOBA_WIDTH ** -0.5),
        "w_branch_gla": nrm(ks[13], (DEPTH, GLA_WIDTH, D_MODEL), GLA_WIDTH ** -0.5),
        "w_out": nrm(ks[14], (DEPTH, D_MODEL, D_MODEL), D_MODEL ** -0.5),
        "ffn_norm": gain(ks[15], (DEPTH, D_MODEL)),
        "w_ffn_gate": nrm(ks[16], (DEPTH, D_MODEL, D_FF), D_MODEL ** -0.5),
        "w_ffn_up": nrm(ks[17], (DEPTH, D_MODEL, D_FF), D_MODEL ** -0.5),
        "w_ffn_down": nrm(ks[18], (DEPTH, D_FF, D_MODEL), D_FF ** -0.5),
    }


def reference(x, positions, attn_norm, w_in, swa_q_norm, swa_k_norm, swa_sinks, moba_q_norm, moba_k_norm,
              gla_w_alpha, gla_b_alpha, gla_out_norm, w_branch_swa, w_branch_moba, w_branch_gla, w_out,
              ffn_norm, w_ffn_gate, w_ffn_up, w_ffn_down):
    cos, sin = rope_tables(positions, HEAD_DIM, x.dtype)
    for l in range(DEPTH):
        h = rms_norm(x, attn_norm[l])
        x = x + hybrid_mixer(h, cos, sin, w_in[l], swa_q_norm[l], swa_k_norm[l], swa_sinks[l],
                             moba_q_norm[l], moba_k_norm[l], gla_w_alpha[l], gla_b_alpha[l],
                             gla_out_norm[l], w_branch_swa[l], w_branch_moba[l], w_branch_gla[l], w_out[l])
        h = rms_norm(x, ffn_norm[l])
        x = x + swiglu(h, w_ffn_gate[l], w_ffn_up[l], w_ffn_down[l])
    return x
```

```cpp
#include <hip/hip_runtime.h>
#include <cstdint>
#include <cstdio>
#include <cmath>

#ifndef MK_PER_PHASE
#define MK_PER_PHASE 0
#endif

#ifndef DBG_DUP
#define DBG_DUP 0
#endif
#ifndef STG_B
#define STG_B 0
#endif
#ifndef STG_F
#define STG_F 0
#endif
#define GAS __attribute__((address_space(1)))
#define LAS __attribute__((address_space(3)))
typedef unsigned short bf16_t;
typedef short bf16x8 __attribute__((ext_vector_type(8)));
typedef short s16x4 __attribute__((ext_vector_type(4)));
typedef short v4i16_t __attribute__((ext_vector_type(4)));
typedef float f32x2 __attribute__((ext_vector_type(2)));
typedef float f32x4 __attribute__((ext_vector_type(4)));
typedef float f32x16 __attribute__((ext_vector_type(16)));
typedef unsigned u32x2 __attribute__((ext_vector_type(2)));
typedef unsigned u32x4 __attribute__((ext_vector_type(4)));
typedef __bf16 bf16x2_t __attribute__((ext_vector_type(2)));
typedef int v8i_t __attribute__((ext_vector_type(8)));

constexpr int T = 32768, SEQ = 2048, NBATCH = 16, D = 1024, DEPTH = 2;
constexpr int PP = 4096 + 64;
constexpr int PW = 4096;
constexpr int GW = 3072;
constexpr int YW = 1536;
constexpr int FF = 2816, FFP = 5632;
constexpr int DIN = 6928;
constexpr float EPS = 1e-6f;
constexpr float LOG2E = 1.4426950408889634f;
constexpr float C2 = 0.125f * LOG2E;

constexpr size_t MiB = 1u << 20;
constexpr size_t WS_CTL = 0, CTL_ZERO_BYTES = 1 * MiB;
constexpr size_t OFF_WIN = 0, OFF_WG = OFF_WIN + (size_t)PW * D * 2  , OFF_WB = OFF_WG + (size_t)GW * D, OFF_WO = OFF_WB + (size_t)3 * D * 512 * 2,
                 OFF_F1 = OFF_WO + (size_t)D * D * 2, OFF_F2 = OFF_F1 + (size_t)FFP * D * 2, LW_BYTES = OFF_F2 + (size_t)D * FF * 2;
constexpr size_t WS_W = 1 * MiB;
constexpr size_t WS_ROPE = WS_W + 2 * LW_BYTES;
constexpr size_t WS_KM = WS_ROPE + (size_t)T * 64 * 4;
constexpr size_t WS_SS = WS_KM + 512 * 1024;
constexpr size_t WS_H = WS_KM + 1 * MiB;
constexpr size_t WS_PROJ = WS_H + (size_t)T * YW * 2;
constexpr size_t WS_MERGED = WS_PROJ + (size_t)T * GW * 2;
constexpr size_t WS_Y = WS_H;
constexpr size_t WS_XB8 = WS_PROJ + (size_t)T * PP * 2;
constexpr size_t WS_END = WS_XB8 + (size_t)T * D;
static_assert(WS_ROPE % 256 == 0 && WS_END <= 512 * MiB, "workspace map");
constexpr int CW_TMO = 0, CW_BAR = 4096, CW_Q = 16384;

__device__ __forceinline__ unsigned cvt_pk_bf16(float lo, float hi) { f32x2 v = {lo, hi}; bf16x2_t b = __builtin_convertvector(v, bf16x2_t); return __builtin_bit_cast(unsigned, b); }
__device__ __forceinline__ float bf_lo(unsigned w) { return __uint_as_float(w << 16); }
__device__ __forceinline__ float bf_hi(unsigned w) { return __uint_as_float(w & 0xffff0000u); }
__device__ __forceinline__ float bf1(bf16_t x) { return __uint_as_float(((unsigned)x) << 16); }
__device__ __forceinline__ bf16_t f2bf(float f) { return (bf16_t)(cvt_pk_bf16(f, 0.f) & 0xffffu); }
__device__ __forceinline__ unsigned cvt4_fp8(float a, float b, float c, float d) { unsigned w = 0; w = __builtin_amdgcn_cvt_pk_fp8_f32(a, b, w, false); w = __builtin_amdgcn_cvt_pk_fp8_f32(c, d, w, true); return w; }
constexpr float XS8 = 16.0f, WS8 = 64.0f;
__device__ __forceinline__ float fexp2(float x) { return __builtin_amdgcn_exp2f(x); }
__device__ __forceinline__ float fexp(float x) { return __builtin_amdgcn_exp2f(x * LOG2E); }
__device__ __forceinline__ float frcp(float x) { return __builtin_amdgcn_rcpf(x); }
__device__ __forceinline__ float frsq(float x) { return __builtin_amdgcn_rsqf(x); }
__device__ __forceinline__ float sigmoidf_(float x) { return frcp(1.f + fexp(-x)); }
template <int CTRL> __device__ __forceinline__ float dpp_f(float v) { return __builtin_bit_cast(float, __builtin_amdgcn_update_dpp(0, __builtin_bit_cast(int, v), CTRL, 0xf, 0xf, true)); }
__device__ __forceinline__ float sum16(float v) { v += dpp_f<0xB1>(v); v += dpp_f<0x4E>(v); v += dpp_f<0x141>(v); v += dpp_f<0x140>(v); return v; }
__device__ __forceinline__ float addx16(float v) { auto r = __builtin_amdgcn_permlane16_swap(__float_as_uint(v), __float_as_uint(v), false, false); return __uint_as_float(r[0]) + __uint_as_float(r[1]); }
__device__ __forceinline__ float addx32(float v) { auto r = __builtin_amdgcn_permlane32_swap(__float_as_uint(v), __float_as_uint(v), false, false); return __uint_as_float(r[0]) + __uint_as_float(r[1]); }
__device__ __forceinline__ float maxx32(float v) { auto r = __builtin_amdgcn_permlane32_swap(__float_as_uint(v), __float_as_uint(v), false, false); return fmaxf(__uint_as_float(r[0]), __uint_as_float(r[1])); }
__device__ __forceinline__ float wave_sum(float v) { return addx32(addx16(sum16(v))); }
#define LDS_WAIT() asm volatile("s_waitcnt lgkmcnt(0)" ::: "memory")
#define VM_WAIT() asm volatile("s_waitcnt vmcnt(0)" ::: "memory")

#define XB_TMO      128
#define XB_XCNT(j)  (256  + 64 * (j))
#define XB_XSUB(j)  (1280 + 64 * (j))
#define XB_XGEN(j)  (2304 + 64 * (j))
#define XB_TOP      3328
#define XB_TOPGEN   3392
#define XCD_BAR_WORDS 3456
#define XB_SPIN_CAP (1u << 18)
__device__ __forceinline__ unsigned xb_ld(unsigned* p)              { return __hip_atomic_load(p, __ATOMIC_RELAXED, __HIP_MEMORY_SCOPE_AGENT); }
__device__ __forceinline__ unsigned xb_add(unsigned* p, unsigned v) { return __hip_atomic_fetch_add(p, v, __ATOMIC_RELAXED, __HIP_MEMORY_SCOPE_AGENT); }
__device__ __forceinline__ unsigned xb_xcc_id() { return (unsigned)__builtin_amdgcn_s_getreg((3 << 11) | 20) & 0xFu; }
#define XB_SPIN(cond, bar) do { unsigned _sp = 0; while (cond) { __builtin_amdgcn_s_sleep(1); \
    if ((++_sp & 255u) == 0u) { if (xb_ld(&(bar)[XB_TMO])) break; if (_sp > XB_SPIN_CAP) { atomicAdd(&(bar)[XB_TMO], 1u); break; } } } } while (0)
struct XcdBarrier { unsigned* bar; unsigned x; volatile LAS unsigned* st; };
__device__ __forceinline__ XcdBarrier xcd_barrier_post(unsigned* bar, volatile LAS unsigned* st) {
    XcdBarrier b; b.bar = bar; b.x = xb_xcc_id(); b.st = st;
    if (threadIdx.x == 0) (void)xb_add(&bar[XB_XCNT(b.x)], 1u);
    return b;
}
__device__ __forceinline__ void xcd_barrier_complete(unsigned* bar, unsigned x, unsigned& nloc, unsigned& nx) {
    const unsigned G = gridDim.x * gridDim.y * gridDim.z;
    unsigned sum, cnt, mine, sp = 0u;
    for (;;) {
        sum = 0u; cnt = 0u; mine = 0u;
#pragma unroll
        for (unsigned j = 0; j < 16; ++j) { const unsigned c = xb_ld(&bar[XB_XCNT(j)]); sum += c; cnt += (c > 0u) ? 1u : 0u; mine = (j == x) ? c : mine; }
        if (sum == G) break;
        __builtin_amdgcn_s_sleep(1);
        if ((++sp & 255u) == 0u) { if (xb_ld(&bar[XB_TMO])) break; if (sp > XB_SPIN_CAP) { atomicAdd(&bar[XB_TMO], 1u); break; } }
    }
    nloc = mine > 0u ? mine : 1u; nx = cnt > 0u ? cnt : 1u;
}
__device__ __forceinline__ void xcd_barrier(const XcdBarrier& b) {
    asm volatile("s_waitcnt vmcnt(0)" ::: "memory");
    __syncthreads();
    if (threadIdx.x == 0) {
        unsigned* bar = b.bar;
        __builtin_amdgcn_s_waitcnt(0);
        unsigned nloc = b.st[0], nx = b.st[1];
        if (nloc == 0u) { xcd_barrier_complete(bar, b.x, nloc, nx); b.st[0] = nloc; b.st[1] = nx; }
        const unsigned old = xb_add(&bar[XB_XSUB(b.x)], 1u);
        const unsigned gen = old / nloc;
        if (old + 1u == (gen + 1u) * nloc) {
            __builtin_amdgcn_fence(__ATOMIC_RELEASE, "agent");
            asm volatile("s_waitcnt vmcnt(0)" ::: "memory");
            const unsigned og = xb_add(&bar[XB_TOP], 1u);
            const unsigned tg = og / nx;
            if (og + 1u == (tg + 1u) * nx) xb_add(&bar[XB_TOPGEN], 1u);
            else XB_SPIN(xb_ld(&bar[XB_TOPGEN]) == tg, bar);
            __builtin_amdgcn_fence(__ATOMIC_ACQUIRE, "agent");
            xb_add(&bar[XB_XGEN(b.x)], 1u);
            asm volatile("s_waitcnt vmcnt(0)" ::: "memory");
        } else {
            XB_SPIN(xb_ld(&bar[XB_XGEN(b.x)]) == gen, bar);
            __builtin_amdgcn_fence(__ATOMIC_ACQUIRE, "agent");
            asm volatile("s_waitcnt vmcnt(0)" ::: "memory");
        }
    }
    __syncthreads();
}

namespace pg8 {
constexpr int BM = 256, BK = 64, HALF = 128, HTB = HALF * BK * 2, STAGE_BYTES = 8 * HTB, NXCD = 8, WGM = 8;
__host__ __device__ __forceinline__ int lds_byte(int r, int c) { const int st = (r >> 4) * 2 + (c >> 5), rr = r & 15, cc = c & 31, ob = rr * 64 + cc * 2; return st * 1024 + (ob ^ (((ob >> 9) & 1) << 5)); }
__host__ __device__ __forceinline__ void stage_rc(int b, int& R, int& C) { const int st = b / 1024, sb = b % 1024, swz = sb ^ (((sb >> 9) & 1) << 5); R = (st >> 1) * 16 + swz / 64; C = (st & 1) * 32 + (swz % 64) / 2; }
__host__ __device__ __forceinline__ int perm32(int rho) { const int n = rho >> 4, i = rho & 15; return 8 * (i >> 2) + 4 * n + (i & 3); }

struct Unit { int pm, pn, sub; };
struct Gemm { const bf16_t* A; const bf16_t* Bt; int K, lda, ldb; long a_sub, b_sub;
              const bf16_t* A1; const bf16_t* Bt1; int K1, lda1, ldb1; long a_sub1, b_sub1; int sub1; };

struct TileOrder {
    int nM, nN, nwg, G, c, nsub;
    __device__ __forceinline__ void init(int M, int N, int G_, int c_, int nsub_) { nM = M / BM; nN = N / BM; nwg = nM * nN; G = G_; c = c_; nsub = nsub_; }
    __device__ __forceinline__ bool next(int i, Unit& u) const {
        const int ti = i / nsub; u.sub = i - ti * nsub;
        const long L = (long)ti * G + c; if (L >= nwg) return false;
        int wgid = (int)L; { const int q = nwg / NXCD, r = nwg % NXCD, xcd = wgid % NXCD, off = wgid / NXCD; wgid = (xcd < r ? xcd * (q + 1) : r * (q + 1) + (xcd - r) * q) + off; }
        const int nig = WGM * nN, gid = wgid / nig, fm = gid * WGM, gsz = (nM - fm) < WGM ? (nM - fm) : WGM;
        u.pm = fm + ((wgid % nig) % gsz); u.pn = (wgid % nig) / gsz; return true;
    }
};

struct TileOrderBal : TileOrder {
    __device__ __forceinline__ bool next(int i, Unit& u) const { if (!TileOrder::next(i, u)) return false;
        const unsigned long long tab = 0xCBA8FD97E2654310ull;
        u.pn = (int)((tab >> (4 * u.pn)) & 15ull); return true; } };
struct GateTriple { int pm, pn; __device__ __forceinline__ bool next(int i, Unit& u) const { if (i >= 3) return false; u.pm = pm; u.pn = 4 * i + pn; u.sub = 0; return true; } };
struct SubTriple { int pm, pn; __device__ __forceinline__ bool next(int i, Unit& u) const { if (i >= 3) return false; u.pm = pm; u.pn = pn; u.sub = i; return true; } };

typedef f32x4 Acc[2][2][4][2];

template <class Epi, bool DUAL = false, class Sched = TileOrder, bool F8 = false>
__device__ __forceinline__ void gemm_phase(LAS unsigned char* lds, const Gemm g, const Sched& S, const Epi& E, int stagger = 0) {
    for (int i_ = 0; i_ < stagger; ++i_) __builtin_amdgcn_s_sleep(32);
    int tid_ = threadIdx.x; asm volatile("" : "+v"(tid_));
    const int tid = tid_, wid = __builtin_amdgcn_readfirstlane(tid >> 6), lane = tid & 63, wr = wid >> 2, wc = wid & 3, fr = lane & 15, fq = lane >> 4;
    const size_t kstep = (size_t)(BK * 2);
    const unsigned ldsw = (unsigned)wid * 1024u;
    const int aoff = F8 ? lds_byte(wr * 64 + fr, fq * 16) : lds_byte(wr * 64 + fr, fq * 8), boff = F8 ? lds_byte(wc * 32 + fr, fq * 16) : lds_byte(wc * 32 + fr, fq * 8);
#define PG8_SA(b, h) (((b) * 2 + (h)) * HTB)
#define PG8_SB(b, h) ((4 + (b) * 2 + (h)) * HTB)
#define PG8_STAGE(bufoff, gbase, voff, hs) do { _Pragma("unroll") for (int _i = 0; _i < 2; ++_i) \
        __builtin_amdgcn_global_load_lds((const unsigned*)((const char*)(gbase) + (size_t)_i * (hs) + (voff)), (LAS unsigned*)(lds + (bufoff) + ldsw + _i * 8192), 16, 0, 0); } while (0)
#define PG8_LD32(p) __builtin_bit_cast(v8i_t, __builtin_shufflevector(*(const LAS bf16x8*)(p), *(const LAS bf16x8*)((p) + 16), 0, 1, 2, 3, 4, 5, 6, 7, 8, 9, 10, 11, 12, 13, 14, 15))
#define PG8_LDA(dst, b, h) do { if constexpr (F8) { _Pragma("unroll") for (int m = 0; m < 4; ++m) dst##8[m] = PG8_LD32(lds + PG8_SA(b, h) + aoff + m * 2048); } \
        else { _Pragma("unroll") for (int m = 0; m < 4; ++m) _Pragma("unroll") for (int k = 0; k < 2; ++k) dst[m][k] = *(const LAS bf16x8*)(lds + PG8_SA(b, h) + aoff + m * 2048 + k * 1024); } } while (0)
#define PG8_LDB(dst, b, h) do { if constexpr (F8) { _Pragma("unroll") for (int n = 0; n < 2; ++n) dst##8[n] = PG8_LD32(lds + PG8_SB(b, h) + boff + n * 2048); } \
        else { _Pragma("unroll") for (int n = 0; n < 2; ++n) _Pragma("unroll") for (int k = 0; k < 2; ++k) dst[n][k] = *(const LAS bf16x8*)(lds + PG8_SB(b, h) + boff + n * 2048 + k * 1024); } } while (0)
#define PG8_MMA(ai, bj, At, Bt) do { __builtin_amdgcn_s_setprio(1); _Pragma("unroll") for (int m = 0; m < 4; ++m) _Pragma("unroll") for (int n = 0; n < 2; ++n) { \
        if constexpr (F8) asm volatile("v_mfma_scale_f32_16x16x128_f8f6f4 %0, %1, %2, %0, %3, %3 op_sel_hi:[0,0,0]" : "+v"(acc[ai][bj][m][n]) : "v"(Bt##8[n]), "v"(At##8[m]), "v"(sc8));   \
        else { _Pragma("unroll") for (int k = 0; k < 2; ++k) acc[ai][bj][m][n] = __builtin_amdgcn_mfma_f32_16x16x32_bf16(Bt[n][k], At[m][k], acc[ai][bj][m][n], 0, 0, 0); } } \
        __builtin_amdgcn_s_setprio(0); } while (0)
#define PG8_WAIT_V(n) asm volatile("s_waitcnt vmcnt(" #n ")" ::: "memory")
#define PG8_WAIT_L(n) asm volatile("s_waitcnt lgkmcnt(" #n ")" ::: "memory")
#define PG8_WAIT_VX(flag) do { if constexpr (Epi::NST == 8) asm volatile("s_cmp_eq_u32 %0, 0\n\ts_cbranch_scc1 1f\n\ts_waitcnt vmcnt(16)\n\ts_branch 2f\n1:\n\ts_waitcnt vmcnt(8)\n2:" :: "s"(flag) : "memory", "scc"); \
        else if constexpr (Epi::NST == 16) asm volatile("s_cmp_eq_u32 %0, 0\n\ts_cbranch_scc1 1f\n\ts_waitcnt vmcnt(24)\n\ts_branch 2f\n1:\n\ts_waitcnt vmcnt(8)\n2:" :: "s"(flag) : "memory", "scc"); \
        else if constexpr (Epi::NST == 32) asm volatile("s_cmp_eq_u32 %0, 0\n\ts_cbranch_scc1 1f\n\ts_waitcnt vmcnt(40)\n\ts_branch 2f\n1:\n\ts_waitcnt vmcnt(8)\n2:" :: "s"(flag) : "memory", "scc"); \
        else asm volatile("s_waitcnt vmcnt(8)" ::: "memory"); } while (0)
#define PG8_BAR __builtin_amdgcn_s_barrier()
#define PG8_SCHED __builtin_amdgcn_sched_barrier(0)
#define PG8_KIND(u) (DUAL && (u).sub >= g.sub1)
#define PG8_ABASE(u) (PG8_KIND(u) ? (const char*)g.A1 + ((size_t)(u).pm * BM * g.lda1 + (size_t)((u).sub - g.sub1) * g.a_sub1) * 2 : (const char*)g.A + ((size_t)(u).pm * BM * g.lda + (size_t)(u).sub * g.a_sub) * 2)
#define PG8_BBASE(u) (PG8_KIND(u) ? (const char*)g.Bt1 + ((size_t)(u).pn * BM * g.ldb1 + (size_t)((u).sub - g.sub1) * g.b_sub1) * 2 : (const char*)g.Bt + ((size_t)(u).pn * BM * g.ldb + (size_t)(u).sub * g.b_sub) * 2)
#define PG8_VOFF(kd, vA, vB) do { const bool k_ = (kd); const int la_ = k_ ? g.lda1 : g.lda, lb_ = k_ ? g.ldb1 : g.ldb; \
        vA = (unsigned)(sR * la_ + sC) * 2u; vB = (unsigned)(sRb * lb_ + sC) * 2u; } while (0)
#define PG8_SETCFG(kd, hA, hB, ntv) do { const bool k_ = (kd); hA = (size_t)HALF * (k_ ? g.lda1 : g.lda) * 2; hB = (size_t)HALF * (k_ ? g.ldb1 : g.ldb) * 2; ntv = (k_ ? g.K1 : g.K) / BK; } while (0)
    Unit cur, nxt; int ui = 0;
    if (!S.next(0, cur)) return;
    Acc acc;
#pragma unroll
    for (int a = 0; a < 2; ++a)
#pragma unroll
        for (int b = 0; b < 2; ++b)
#pragma unroll
            for (int m = 0; m < 4; ++m)
#pragma unroll
                for (int n = 0; n < 2; ++n) acc[a][b][m][n] = (f32x4){0.f, 0.f, 0.f, 0.f};
    bf16x8 At[4][2], B0[2][2], B1[2][2];
    v8i_t At8[4], B08[2], B18[2];
    const int sc8 = 0x7f7f7f7f;
    float pre[8];
#pragma unroll
    for (int i = 0; i < 8; ++i) pre[i] = 0.f;
    const char* cA = PG8_ABASE(cur); const char* cB = PG8_BBASE(cur);
    int sR, sC; stage_rc(tid * 16, sR, sC); const int sRb = Epi::PERM ? ((sR & ~31) + perm32(sR & 31)) : sR;
    unsigned voffA, voffB; size_t hstepA, hstepB, xhA, xhB; int nt, xnt; bool xkind;
    PG8_VOFF(PG8_KIND(cur), voffA, voffB); PG8_SETCFG(PG8_KIND(cur), hstepA, hstepB, nt);
    PG8_STAGE(PG8_SB(0, 0), cB, voffB, hstepB >> 1); PG8_STAGE(PG8_SB(0, 1), cB + hstepB, voffB, hstepB >> 1); PG8_STAGE(PG8_SA(0, 0), cA, voffA, hstepA >> 1); PG8_STAGE(PG8_SA(0, 1), cA + hstepA, voffA, hstepA >> 1);
    if (wr == 1) PG8_BAR;
    PG8_WAIT_V(2); PG8_BAR;
    PG8_STAGE(PG8_SB(1, 0), cB + kstep, voffB, hstepB >> 1); PG8_STAGE(PG8_SA(1, 0), cA + kstep, voffA, hstepA >> 1); PG8_STAGE(PG8_SB(1, 1), cB + hstepB + kstep, voffB, hstepB >> 1);
    PG8_WAIT_V(6); PG8_BAR;
    for (;;) {
        const bool has_next = S.next(ui + 1, nxt);
        const char* nA = has_next ? PG8_ABASE(nxt) : cA; const char* nB = has_next ? PG8_BBASE(nxt) : cB;
        xkind = has_next ? PG8_KIND(nxt) : PG8_KIND(cur); PG8_SETCFG(xkind, xhA, xhB, xnt);
        for (int t = 0; t < nt; t += 2) {
            const bool last = (t == nt - 2);
            const char* a1 = cA + (size_t)(t + 1) * kstep;
            const char* a2 = last ? nA : cA + (size_t)(t + 2) * kstep; const char* b2 = last ? nB : cB + (size_t)(t + 2) * kstep;
            const char* a3 = a2 + kstep; const char* b3 = b2 + kstep;
            unsigned vA2 = voffA, vB2 = voffB;
            if (DUAL && last) PG8_VOFF(xkind, vA2, vB2);
            const size_t hA2 = last ? xhA : hstepA, hB2 = last ? xhB : hstepB;
            if (last) E.prefetch(cur, pre);
            const int rxi = __builtin_amdgcn_readfirstlane(((Epi::NST > 0) && (t == 0) && (ui > 0)) ? 1 : 0);
            PG8_LDB(B0, 0, 0); PG8_LDB(B1, 0, 1); PG8_SCHED; PG8_LDA(At, 0, 0); PG8_STAGE(PG8_SA(1, 1), a1 + hstepA, voffA, hstepA >> 1);
            PG8_WAIT_VX(rxi);
            PG8_WAIT_L(0); PG8_BAR; PG8_MMA(0, 0, At, B0); PG8_MMA(0, 1, At, B1); PG8_BAR; PG8_SCHED;
            PG8_LDA(At, 0, 1); PG8_STAGE(PG8_SB(0, 0), b2, vB2, hB2 >> 1); PG8_STAGE(PG8_SB(0, 1), b2 + hB2, vB2, hB2 >> 1); PG8_STAGE(PG8_SA(0, 0), a2, vA2, hA2 >> 1);
            PG8_WAIT_VX(rxi);
            PG8_WAIT_L(0); PG8_BAR; PG8_MMA(1, 0, At, B0); PG8_MMA(1, 1, At, B1); PG8_BAR; PG8_SCHED;
            PG8_LDB(B0, 1, 0); PG8_LDB(B1, 1, 1); PG8_SCHED; PG8_LDA(At, 1, 0); PG8_STAGE(PG8_SA(0, 1), a2 + hA2, vA2, hA2 >> 1);
            PG8_WAIT_V(8); PG8_WAIT_L(0); PG8_BAR; PG8_MMA(0, 0, At, B0); PG8_MMA(0, 1, At, B1); PG8_BAR; PG8_SCHED;
            PG8_LDA(At, 1, 1); PG8_STAGE(PG8_SB(1, 0), b3, vB2, hB2 >> 1); PG8_STAGE(PG8_SB(1, 1), b3 + hB2, vB2, hB2 >> 1); PG8_STAGE(PG8_SA(1, 0), a3, vA2, hA2 >> 1);
            PG8_WAIT_V(8); PG8_WAIT_L(0); PG8_BAR; PG8_MMA(1, 0, At, B0); PG8_MMA(1, 1, At, B1); PG8_BAR; PG8_SCHED;
        }
        if (wr == 0) PG8_BAR;
        if constexpr (F8) asm volatile("s_nop 15\n\ts_nop 7" ::: "memory");
        const bool keep = E(acc, cur, pre);
        if (!has_next) break;
        if (!keep) {
#pragma unroll
            for (int a = 0; a < 2; ++a)
#pragma unroll
                for (int b = 0; b < 2; ++b)
#pragma unroll
                    for (int m = 0; m < 4; ++m)
#pragma unroll
                        for (int n = 0; n < 2; ++n) acc[a][b][m][n] = (f32x4){0.f, 0.f, 0.f, 0.f};
        }
        cur = nxt; cA = nA; cB = nB; ++ui;
        if (DUAL) PG8_VOFF(xkind, voffA, voffB);
        hstepA = xhA; hstepB = xhB; nt = xnt;
        if (wr == 1) PG8_BAR;
    }
    PG8_WAIT_V(0);
    PG8_BAR;
#undef PG8_SA
#undef PG8_SB
#undef PG8_STAGE
#undef PG8_LDA
#undef PG8_LD32
#undef PG8_LDB
#undef PG8_MMA
#undef PG8_WAIT_V
#undef PG8_WAIT_L
#undef PG8_WAIT_VX
#undef PG8_BAR
#undef PG8_SCHED
#undef PG8_ABASE
#undef PG8_BBASE
#undef PG8_KIND
#undef PG8_SETCFG
#undef PG8_VOFF
}

__device__ __forceinline__ void lane_ids(int& wr, int& wc, int& fr, int& fq) { int t = threadIdx.x; asm volatile("" : "+v"(t)); const int wid = __builtin_amdgcn_readfirstlane(t >> 6); wr = wid >> 2; wc = wid & 3; fr = t & 15; fq = (t >> 4) & 3; }
__device__ __forceinline__ u32x4 pack8(const f32x4 a, const f32x4 b) { u32x4 w; w.x = cvt_pk_bf16(a[0], a[1]); w.y = cvt_pk_bf16(a[2], a[3]); w.z = cvt_pk_bf16(b[0], b[1]); w.w = cvt_pk_bf16(b[2], b[3]); return w; }

struct EpiInProj {
    static constexpr bool PERM = true; static constexpr int NST = 16;
    bf16_t* O;
    const bf16_t* rope;
    const float* g_qa; const float* g_ka; const float* g_qb; const float* g_kb;
    const float* b_alpha;
    float* kmp;
    const float* ssq;
    __device__ __forceinline__ void prefetch(const Unit& u, float (&pre)[8]) const {
        int t = threadIdx.x; asm volatile("" : "+v"(t)); const int row0 = u.pm * BM + ((t >> 8) & 1) * 64 + (t & 15);
#pragma unroll
        for (int st = 0; st < 8; ++st) pre[st] = ssq[row0 + (st >> 2) * HALF + (st & 3) * 16];
    }
    __device__ __forceinline__ bool operator()(Acc& acc, const Unit& u, const float (&pre)[8]) const {
        int wr, wc, fr, fq; lane_ids(wr, wc, fr, fq);
        const int G = 4 * u.pn + wc;
        const int row0 = u.pm * BM + wr * 64 + fr;
        {
#pragma unroll
            for (int st = 0; st < 8; ++st) { const float rs = frsq(pre[st] * (1.0f / D) + EPS);
#pragma unroll
                for (int bj = 0; bj < 2; ++bj)
#pragma unroll
                    for (int n = 0; n < 2; ++n) acc[st >> 2][bj][st & 3][n] *= rs; }
        }
        bf16_t* obase = O + (size_t)row0 * PP + 64 * G + 8 * fq;
        const float* gain = nullptr; float qs = 1.f; bool mean = false;
        if (G < 8) { gain = g_qa; qs = C2; } else if (G < 10) gain = g_ka; else if (G >= 12 && G < 20) { gain = g_qb; qs = C2; } else if (G >= 20 && G < 28) { gain = g_kb; mean = true; }
        if (gain) {
            f32x4 gn[2][2];
#pragma unroll
            for (int bj = 0; bj < 2; ++bj)
#pragma unroll
                for (int n = 0; n < 2; ++n) gn[bj][n] = *(const f32x4*)(gain + 32 * bj + 8 * fq + 4 * n);
            f32x4 ks[2][2];
#pragma unroll
            for (int bj = 0; bj < 2; ++bj)
#pragma unroll
                for (int n = 0; n < 2; ++n) ks[bj][n] = (f32x4){0.f, 0.f, 0.f, 0.f};
            u32x4 cw[8], sw[8];
#define INP_ROPE_LD(g_) do { const int rn_ = ((g_) >> 2) * HALF + ((g_) & 3) * 16; const bf16_t* cs_ = rope + (size_t)(row0 + rn_) * 64 + 8 * fq; cw[g_] = *(const u32x4*)cs_; sw[g_] = *(const u32x4*)(cs_ + 32); } while (0)
            INP_ROPE_LD(0); INP_ROPE_LD(1);
#pragma unroll
            for (int st = 0; st < 8; ++st) {
                const int ai = st >> 2, m = st & 3, rr = ai * HALF + m * 16;
                if (st + 2 < 8) INP_ROPE_LD(st + 2);
                const u32x4 cq_ = cw[st], sq_ = sw[st];
                const f32x4 c0 = {bf_lo(cq_.x), bf_hi(cq_.x), bf_lo(cq_.y), bf_hi(cq_.y)}, c1 = {bf_lo(cq_.z), bf_hi(cq_.z), bf_lo(cq_.w), bf_hi(cq_.w)};
                const f32x4 s0 = {bf_lo(sq_.x), bf_hi(sq_.x), bf_lo(sq_.y), bf_hi(sq_.y)}, s1 = {bf_lo(sq_.z), bf_hi(sq_.z), bf_lo(sq_.w), bf_hi(sq_.w)};
                float ss = 0.f;
#pragma unroll
                for (int bj = 0; bj < 2; ++bj)
#pragma unroll
                    for (int n = 0; n < 2; ++n) { const f32x4 v = acc[ai][bj][m][n]; ss += (v[0] * v[0] + v[1] * v[1]) + (v[2] * v[2] + v[3] * v[3]); }
                ss = addx32(addx16(ss));
                const float rs = frsq(ss * (1.0f / 64.0f) + EPS);
                f32x4 o0[2], o1[2];
#pragma unroll
                for (int n = 0; n < 2; ++n) {
                    const f32x4 c = n ? c1 : c0, sx = n ? s1 : s0;
                    const f32x4 y0 = acc[ai][0][m][n] * rs * gn[0][n], y1 = acc[ai][1][m][n] * rs * gn[1][n];
                    o0[n] = y0 * c - y1 * sx; o1[n] = y1 * c + y0 * sx;
                    ks[0][n] += o0[n]; ks[1][n] += o1[n];
                    o0[n] *= qs; o1[n] *= qs;
                }
                *(u32x4*)(obase + (size_t)rr * PP) = pack8(o0[0], o0[1]);
                *(u32x4*)(obase + (size_t)rr * PP + 32) = pack8(o1[0], o1[1]);
                asm volatile("" : "+v"(ks[0][0]), "+v"(ks[0][1]), "+v"(ks[1][0]), "+v"(ks[1][1]) :: "memory");
            }
#undef INP_ROPE_LD
            if (mean) {
#pragma unroll
                for (int bj = 0; bj < 2; ++bj)
#pragma unroll
                    for (int n = 0; n < 2; ++n)
#pragma unroll
                        for (int j = 0; j < 4; ++j) ks[bj][n][j] = sum16(ks[bj][n][j]);
                if (fr == 0) {
                    float* kp = kmp + ((size_t)((u.pm * 8 + (G - 20)) * 2 + wr)) * 64 + 8 * fq;
#pragma unroll
                    for (int bj = 0; bj < 2; ++bj)
#pragma unroll
                        for (int n = 0; n < 2; ++n) *(f32x4*)(kp + 32 * bj + 4 * n) = ks[bj][n];
                }
            }
        } else {
            const int mode = (G >= 36 && G < 40) ? 1 : (G >= 52 && G < 56) ? 2 : (G >= 56) ? 3 : 0;
            f32x4 bb[2][2];
#pragma unroll
            for (int bj = 0; bj < 2; ++bj)
#pragma unroll
                for (int n = 0; n < 2; ++n) bb[bj][n] = (mode == 2) ? *(const f32x4*)(b_alpha + 64 * (G - 52) + 32 * bj + 8 * fq + 4 * n) : (f32x4){0.f, 0.f, 0.f, 0.f};
#pragma unroll
            for (int ai = 0; ai < 2; ++ai)
#pragma unroll
                for (int m = 0; m < 4; ++m) {
                    const int rr = ai * HALF + m * 16;
                    f32x4 o[2][2];
#pragma unroll
                    for (int bj = 0; bj < 2; ++bj)
#pragma unroll
                        for (int n = 0; n < 2; ++n) {
                            f32x4 v = acc[ai][bj][m][n];
                            if (mode == 1) v *= 0.125f;
                            else if (mode == 2) {
#pragma unroll
                                for (int j = 0; j < 4; ++j) { const float z = v[j] + bb[bj][n][j]; v[j] = (fminf(z, 0.f) - __logf(1.f + fexp(-fabsf(z)))) * (1.0f / 16.0f); }
                            } else if (mode == 3) {
#pragma unroll
                                for (int j = 0; j < 4; ++j) v[j] = v[j] * sigmoidf_(v[j]);
                            }
                            o[bj][n] = v;
                        }
                    *(u32x4*)(obase + (size_t)rr * PP) = pack8(o[0][0], o[0][1]);
                    *(u32x4*)(obase + (size_t)rr * PP + 32) = pack8(o[1][0], o[1][1]);
                    asm volatile("" ::: "memory");
                }
        }
        return false;
    }
};

template <bool LATE> struct EpiGatesT {
    static constexpr bool PERM = true; static constexpr int NST = (DBG_DUP == 11) ? 0 : 16;
    bf16_t* O; int nostore; const float* ssq; int late; float oscale;
    __device__ __forceinline__ void prefetch(const Unit& u, float (&pre)[8]) const {
        if constexpr (LATE) return;
        int t = threadIdx.x; asm volatile("" : "+v"(t)); const int row0 = u.pm * BM + ((t >> 8) & 1) * 64 + (t & 15);
#pragma unroll
        for (int st = 0; st < 8; ++st) pre[st] = ssq[row0 + (st >> 2) * HALF + (st & 3) * 16];
    }
    __device__ __forceinline__ bool operator()(Acc& acc, const Unit& u, const float (&pre)[8]) const {
        int wr, wc, fr, fq; lane_ids(wr, wc, fr, fq);
        if (nostore) {
#pragma unroll
            for (int ai = 0; ai < 2; ++ai)
#pragma unroll
                for (int bj = 0; bj < 2; ++bj)
#pragma unroll
                    for (int m = 0; m < 4; ++m) asm volatile("" :: "v"(acc[ai][bj][m][0]), "v"(acc[ai][bj][m][1]));
            return false;
        }
        const int row0 = u.pm * BM + wr * 64 + fr, col0 = u.pn * BM + wc * 32 + 8 * fq;
        float rsv[8];
#pragma unroll
        for (int st = 0; st < 8; ++st) rsv[st] = LATE ? ssq[row0 + (st >> 2) * HALF + (st & 3) * 16] : pre[st];
#pragma unroll
        for (int ai = 0; ai < 2; ++ai)
#pragma unroll
            for (int m = 0; m < 4; ++m) { unsigned char* rowp = (unsigned char*)O + (size_t)(row0 + ai * HALF + m * 16) * GW + col0;
                const float rs = frsq(rsv[ai * 4 + m] * (1.0f / D) + EPS) * oscale;
#pragma unroll
                for (int bj = 0; bj < 2; ++bj) { f32x4 v0 = acc[ai][bj][m][0] * rs, v1 = acc[ai][bj][m][1] * rs;
                    unsigned w0 = 0u, w1 = 0u;
#pragma unroll
                    for (int j = 0; j < 4; ++j) { w0 = __builtin_amdgcn_cvt_pk_u8_f32(fmaxf(sigmoidf_(v0[j]) * 255.0f, 1.0f), j, w0); w1 = __builtin_amdgcn_cvt_pk_u8_f32(fmaxf(sigmoidf_(v1[j]) * 255.0f, 1.0f), j, w1); }
                    *(u32x2*)(rowp + bj * HALF) = (u32x2){w0, w1}; } }
        return false;
    }
};

typedef EpiGatesT<false> EpiGates;
struct EpiMerge {
    static constexpr bool PERM = true; static constexpr int NST = 16;
    const bf16_t* Gt;
    bf16_t* O;
    __device__ __forceinline__ void prefetch(const Unit&, float (&)[8]) const {}
    __device__ __forceinline__ bool operator()(Acc& acc, const Unit& u, const float (&pre)[8]) const {
        int wr, wc, fr, fq; lane_ids(wr, wc, fr, fq);
        const int row0 = u.pm * BM + wr * 64 + fr, col0 = u.pn * BM + wc * 32 + 8 * fq;
        const bool last = u.sub == 2;
        const unsigned char* G8 = (const unsigned char*)Gt;
        u32x2 ga[2][4][2], gb[2][4][2];
#pragma unroll
        for (int ai = 0; ai < 2; ++ai)
#pragma unroll
            for (int m = 0; m < 4; ++m)
#pragma unroll
                for (int bj = 0; bj < 2; ++bj) {
                    const unsigned char* gp = G8 + (size_t)(row0 + ai * HALF + m * 16) * GW + (size_t)u.sub * D + col0 + bj * HALF;
                    ga[ai][m][bj] = *(const u32x2*)gp;
                    gb[ai][m][bj] = last ? (u32x2){0x01010101u, 0x01010101u} : *(const u32x2*)(gp + D);
                }
        asm volatile("" ::: "memory");
        const float fin = last ? (1.0f / 255.0f) : 1.0f;
#pragma unroll
        for (int ai = 0; ai < 2; ++ai)
#pragma unroll
            for (int m = 0; m < 4; ++m)
#pragma unroll
                for (int bj = 0; bj < 2; ++bj) {
                    const u32x2 a = ga[ai][m][bj], b = gb[ai][m][bj];
                    const f32x4 s0 = {(float)(a.x & 0xffu) * frcp((float)(b.x & 0xffu)), (float)((a.x >> 8) & 0xffu) * frcp((float)((b.x >> 8) & 0xffu)), (float)((a.x >> 16) & 0xffu) * frcp((float)((b.x >> 16) & 0xffu)), (float)(a.x >> 24) * frcp((float)(b.x >> 24))};
                    const f32x4 s1 = {(float)(a.y & 0xffu) * frcp((float)(b.y & 0xffu)), (float)((a.y >> 8) & 0xffu) * frcp((float)((b.y >> 8) & 0xffu)), (float)((a.y >> 16) & 0xffu) * frcp((float)((b.y >> 16) & 0xffu)), (float)(a.y >> 24) * frcp((float)(b.y >> 24))};
                    acc[ai][bj][m][0] *= s0 * fin; acc[ai][bj][m][1] *= s1 * fin;
                    if (last) *(u32x4*)(O + (size_t)(row0 + ai * HALF + m * 16) * D + col0 + bj * HALF) = pack8(acc[ai][bj][m][0], acc[ai][bj][m][1]);
                }
        asm volatile("" ::: "memory");
        return !last;
    }
};

struct EpiGBM {
    static constexpr bool PERM = true; static constexpr int NST = 16;
    EpiGates eg; EpiMerge em;
    __device__ __forceinline__ void prefetch(const Unit&, float (&)[8]) const {}
    __device__ __forceinline__ bool operator()(Acc& acc, const Unit& u, const float (&pre)[8]) const {
        if (u.sub < 3) { const Unit v = {u.pm, 4 * u.sub + u.pn, 0}; return eg(acc, v, pre); }
        const Unit v = {u.pm, u.pn, u.sub - 3}; return em(acc, v, pre);
    }
};

struct EpiResid {
    static constexpr bool PERM = true; static constexpr int NST = 32;
    const bf16_t* base; float* out; bf16_t* xb; float* ssq; unsigned char* xb8;
    __device__ __forceinline__ void prefetch(const Unit&, float (&)[8]) const {}
    __device__ __forceinline__ bool operator()(Acc& acc, const Unit& u, const float (&pre)[8]) const {
        int wr, wc, fr, fq; lane_ids(wr, wc, fr, fq);
        const int row0 = u.pm * BM + wr * 64 + fr, col0 = u.pn * BM + wc * 32 + 8 * fq;
        u32x4 bw[2][4][2];
#pragma unroll
        for (int ai = 0; ai < 2; ++ai)
#pragma unroll
            for (int m = 0; m < 4; ++m)
#pragma unroll
                for (int bj = 0; bj < 2; ++bj) bw[ai][m][bj] = *(const u32x4*)(base + (size_t)(row0 + ai * HALF + m * 16) * D + col0 + bj * HALF);
        asm volatile("" ::: "memory");
#pragma unroll
        for (int ai = 0; ai < 2; ++ai) {
#pragma unroll
            for (int m = 0; m < 4; ++m) { const size_t off = (size_t)(row0 + ai * HALF + m * 16) * D + col0; float ss = 0.f;
#pragma unroll
                for (int bj = 0; bj < 2; ++bj) {
                    const u32x4 w = bw[ai][m][bj];
                    const f32x4 o0 = (f32x4){bf_lo(w.x), bf_hi(w.x), bf_lo(w.y), bf_hi(w.y)} + acc[ai][bj][m][0], o1 = (f32x4){bf_lo(w.z), bf_hi(w.z), bf_lo(w.w), bf_hi(w.w)} + acc[ai][bj][m][1];
                    if (out) { *(f32x4*)(out + off + bj * HALF) = o0; *(f32x4*)(out + off + bj * HALF + 4) = o1; }
                    if (xb) { ss += ((o0[0] * o0[0] + o0[1] * o0[1]) + (o0[2] * o0[2] + o0[3] * o0[3])) + ((o1[0] * o1[0] + o1[1] * o1[1]) + (o1[2] * o1[2] + o1[3] * o1[3]));
                        *(u32x4*)(xb + off + bj * HALF) = pack8(o0, o1);
                        if (xb8) *(u32x2*)(xb8 + off + bj * HALF) = (u32x2){cvt4_fp8(o0[0] * XS8, o0[1] * XS8, o0[2] * XS8, o0[3] * XS8), cvt4_fp8(o1[0] * XS8, o1[1] * XS8, o1[2] * XS8, o1[3] * XS8)}; } }
                if (xb) { ss = addx32(addx16(ss)); if (fq == 0) atomicAdd(ssq + (row0 + ai * HALF + m * 16), ss); } }
            asm volatile("" ::: "memory");
        }
        return false;
    }
};

struct EpiFfn1 {
    static constexpr bool PERM = true; static constexpr int NST = 8;
    bf16_t* O; const float* ssq;
    __device__ __forceinline__ void prefetch(const Unit& u, float (&pre)[8]) const {
        int t = threadIdx.x; asm volatile("" : "+v"(t)); const int row0 = u.pm * BM + ((t >> 8) & 1) * 64 + (t & 15);
#pragma unroll
        for (int st = 0; st < 8; ++st) pre[st] = ssq[row0 + (st >> 2) * HALF + (st & 3) * 16];
    }
    __device__ __forceinline__ bool operator()(Acc& acc, const Unit& u, const float (&pre)[8]) const {
        int wr, wc, fr, fq; lane_ids(wr, wc, fr, fq);
        const int row0 = u.pm * BM + wr * 64 + fr, col0 = u.pn * HALF + wc * 32 + 8 * fq;
#pragma unroll
        for (int ai = 0; ai < 2; ++ai)
#pragma unroll
            for (int m = 0; m < 4; ++m) {
                const float rs = frsq(pre[ai * 4 + m] * (1.0f / D) + EPS);
                f32x4 o[2];
#pragma unroll
                for (int n = 0; n < 2; ++n) { const f32x4 gt = acc[ai][0][m][n] * rs, up = acc[ai][1][m][n] * rs;
#pragma unroll
                    for (int j = 0; j < 4; ++j) o[n][j] = gt[j] * sigmoidf_(gt[j]) * up[j]; }
                *(u32x4*)(O + (size_t)(row0 + ai * HALF + m * 16) * FF + col0) = pack8(o[0], o[1]);
            }
        return false;
    }
};
}

namespace att {
constexpr int SLOTB = 8192;
constexpr int L_K = 0, L_V = 2 * SLOTB, L_WS = 4 * SLOTB, L_OST = L_WS + 8 * 256, L_KM = L_OST + 8 * 4096, L_END = L_KM + 7 * 64 * 4;
__device__ __forceinline__ int crow(int r, int hi) { return (r & 3) + 8 * (r >> 2) + 4 * hi; }
__device__ __forceinline__ void glds16(const void* gsrc, unsigned lds_dst) { unsigned keep;
    asm volatile("s_mov_b32 %0, m0\n\ts_mov_b32 m0, %2\n\ts_nop 0\n\tglobal_load_lds_dwordx4 %1, off\n\ts_mov_b32 m0, %0" : "=&s"(keep) : "v"(gsrc), "s"(lds_dst) : "memory"); }
#define ATT_WAIT_BAR0() asm volatile("s_waitcnt vmcnt(0) lgkmcnt(0)\n\ts_barrier" ::: "memory")
#define ATT_SBAR() __builtin_amdgcn_sched_barrier(0)

__device__ __forceinline__ void qkt(f32x16& p0, f32x16& p1, LAS const unsigned char* Kslot, const bf16x8* qr, int r32, int hi) {
    LAS const unsigned char* kb = Kslot + hi * 1024 + r32 * 16;
    p0 = f32x16{}; p1 = f32x16{};
#pragma unroll
    for (int d0 = 0; d0 < 4; ++d0) {
        const bf16x8 b0 = *(LAS const bf16x8*)(kb + d0 * 2048);
        const bf16x8 b1 = *(LAS const bf16x8*)(kb + d0 * 2048 + 512);
        p0 = __builtin_amdgcn_mfma_f32_32x32x16_bf16(b0, qr[d0], p0, 0, 0, 0);
        p1 = __builtin_amdgcn_mfma_f32_32x32x16_bf16(b1, qr[d0], p1, 0, 0, 0);
    }
}
__device__ __forceinline__ float rowmax(const f32x16& p0, const f32x16& p1) {
    float a = fmaxf(p0[0], p1[0]);
#pragma unroll
    for (int r = 1; r < 16; ++r) a = fmaxf(a, fmaxf(p0[r], p1[r]));
    return maxx32(a);
}
__device__ __forceinline__ void pv(f32x16* o, int vb, bf16x8 pa0, bf16x8 pa1, bf16x8 pa2, bf16x8 pa3) {
#pragma unroll
    for (int d0 = 0; d0 < 2; ++d0) { s16x4 lo[4], hi[4];
#pragma unroll
        for (int ks = 0; ks < 4; ++ks) {
            asm volatile("ds_read_b64_tr_b16 %0,%1 offset:%c2" : "=&v"(lo[ks]) : "v"(vb), "i"(d0 * 4096 + ks * 1024) : "memory");
            asm volatile("ds_read_b64_tr_b16 %0,%1 offset:%c2" : "=&v"(hi[ks]) : "v"(vb), "i"(d0 * 4096 + ks * 1024 + 512) : "memory"); }
        asm volatile("s_waitcnt lgkmcnt(0)" ::: "memory"); ATT_SBAR();
#define ATT_PK(k) (bf16x8){lo[k][0], lo[k][1], lo[k][2], lo[k][3], hi[k][0], hi[k][1], hi[k][2], hi[k][3]}
        o[d0] = __builtin_amdgcn_mfma_f32_32x32x16_bf16(pa0, ATT_PK(0), o[d0], 0, 0, 0);
        o[d0] = __builtin_amdgcn_mfma_f32_32x32x16_bf16(pa1, ATT_PK(1), o[d0], 0, 0, 0);
        o[d0] = __builtin_amdgcn_mfma_f32_32x32x16_bf16(pa2, ATT_PK(2), o[d0], 0, 0, 0);
        o[d0] = __builtin_amdgcn_mfma_f32_32x32x16_bf16(pa3, ATT_PK(3), o[d0], 0, 0, 0);
#undef ATT_PK
    }
}

template <int MODE>
__device__ __forceinline__ void attn_unit(const bf16_t* proj, bf16_t* Y, int b, int hh, int qb, const float* sinks, const float* kmp, LAS unsigned char* shm) {
    int tid_ = threadIdx.x; asm volatile("" : "+v"(tid_));
    const int tid = tid_, lane = tid & 63, r32 = lane & 31, hi = lane >> 5; const int wid = __builtin_amdgcn_readfirstlane(tid >> 6);
    const long rowbase = (long)b * SEQ;
    int qhead, qrow0, kcol, vcol, qcol, ycol, t_first, t_last;
    if (MODE == 0) { qhead = 4 * hh + (wid >> 1); qrow0 = 64 * qb + 32 * (wid & 1); qcol = 64 * qhead; kcol = 512 + 64 * hh; vcol = 640 + 64 * hh; ycol = 64 * qhead; t_first = qb >= 2 ? qb - 2 : 0; t_last = qb; }
    else { qhead = hh; qrow0 = 256 * qb + 32 * wid; qcol = 768 + 64 * hh; kcol = 1280 + 64 * hh; vcol = 1792 + 64 * hh; ycol = 512 + 64 * hh; t_first = 0; t_last = 4 * qb + 3; }
    const bf16_t* Qw = proj + (rowbase + qrow0) * PP + qcol;
    const bf16_t* Kh = proj + rowbase * PP + kcol; const bf16_t* Vh = proj + rowbase * PP + vcol;
    const unsigned lds0 = (unsigned)(uintptr_t)shm;
    LAS float* wsf = (LAS float*)(shm + L_WS) + wid * 64;
    const bf16_t* ksrc = Kh + (long)lane * PP + wid * 8;
    const bf16_t* vsrc = Vh + (long)(16 * (wid & 3) + (lane >> 2)) * PP + (wid >> 2) * 32 + (lane & 3) * 8;
    const unsigned kdst = lds0 + L_K + wid * 1024, vdst = lds0 + L_V + wid * 1024;
#define ATT_DMA(t, slot) do { glds16(ksrc + (long)(t) * 64 * PP, (unsigned)__builtin_amdgcn_readfirstlane(kdst + (slot))); glds16(vsrc + (long)(t) * 64 * PP, (unsigned)__builtin_amdgcn_readfirstlane(vdst + (slot))); } while (0)
    const int vb0 = (int)(lds0 + L_V) + ((lane >> 4) & 1) * 32 + (lane & 3) * 8 + (4 * hi + ((lane & 15) >> 2)) * 64;
    bf16x8 qr[4];
#pragma unroll
    for (int d0 = 0; d0 < 4; ++d0) qr[d0] = *(const bf16x8*)(Qw + (long)r32 * PP + d0 * 16 + hi * 8);
    unsigned sel = 0u;
    if (MODE == 1) {
        LAS float* km = (LAS float*)(shm + L_KM);
        if (qb > 0) { for (int idx = tid; idx < qb * 64; idx += 512) { const int n = idx >> 6, d = idx & 63; const float* p = kmp + ((size_t)(((b * 8 + n) * 8 + hh) * 2)) * 64 + d; km[idx] = p[0] + p[64]; } }
        LDS_WAIT(); __syncthreads();
        if (qb <= 3) sel = (1u << qb) - 1u;
        else {
            float qf[32];
#pragma unroll
            for (int d0 = 0; d0 < 4; ++d0)
#pragma unroll
                for (int j = 0; j < 8; ++j) qf[d0 * 8 + j] = bf1((bf16_t)qr[d0][j]);
            float gsc[7];
#pragma unroll
            for (int n = 0; n < 7; ++n) {
                float a = 0.f;
                if (n < qb) {
#pragma unroll
                    for (int d0 = 0; d0 < 4; ++d0) { const f32x4 k0 = *(LAS const f32x4*)(km + n * 64 + d0 * 16 + hi * 8), k1 = *(LAS const f32x4*)(km + n * 64 + d0 * 16 + hi * 8 + 4);
                        a += qf[d0 * 8 + 0] * k0[0] + qf[d0 * 8 + 1] * k0[1] + qf[d0 * 8 + 2] * k0[2] + qf[d0 * 8 + 3] * k0[3] + qf[d0 * 8 + 4] * k1[0] + qf[d0 * 8 + 5] * k1[1] + qf[d0 * 8 + 6] * k1[2] + qf[d0 * 8 + 7] * k1[3]; }
                    a = addx32(a);
                } else a = -INFINITY;
                gsc[n] = a;
            }
#pragma unroll
            for (int n = 0; n < 7; ++n) { int cnt = 0;
#pragma unroll
                for (int m2 = 0; m2 < 7; ++m2) if (m2 != n) cnt += (gsc[m2] > gsc[n] || (gsc[m2] == gsc[n] && m2 < n)) ? 1 : 0;
                if (cnt < 3 && n < qb) sel |= 1u << n; }
        }
    }
    float mhat, l_reg; f32x16 o[2]; o[0] = f32x16{}; o[1] = f32x16{};
    if (MODE == 0) { mhat = sinks[qhead] * LOG2E; l_reg = hi == 0 ? 1.f : 0.f; } else { mhat = -1e30f; l_reg = 0.f; }
    const int qabs = qrow0 + r32;
    ATT_DMA(t_first, 0);
    int slot = 0;
    for (int t = t_first; t <= t_last; ++t) {
        ATT_WAIT_BAR0();
        if (t < t_last) ATT_DMA(t + 1, slot ^ SLOTB);
        bool active = true;
        if (MODE == 1 && t < 4 * qb) active = __any((sel >> (t >> 2)) & 1u);
        if (active) {
            f32x16 p0, p1;
            qkt(p0, p1, shm + L_K + slot, qr, r32, hi);
            if (MODE == 0) {
                const int kb = 64 * t + 4 * hi;
#pragma unroll
                for (int r = 0; r < 16; ++r) { const int kv = kb + (r & 3) + 8 * (r >> 2);
                    if (!(kv <= qabs && kv > qabs - 128)) p0[r] = -INFINITY;
                    if (!(kv + 32 <= qabs && kv + 32 > qabs - 128)) p1[r] = -INFINITY; }
            } else {
                if (t >= 4 * qb) {
                    const int kb = 64 * t + 4 * hi;
#pragma unroll
                    for (int r = 0; r < 16; ++r) { const int kv = kb + (r & 3) + 8 * (r >> 2); if (kv > qabs) p0[r] = -INFINITY; if (kv + 32 > qabs) p1[r] = -INFINITY; }
                } else if (!((sel >> (t >> 2)) & 1u)) {
#pragma unroll
                    for (int r = 0; r < 16; ++r) { p0[r] = -INFINITY; p1[r] = -INFINITY; }
                }
            }
            const float rm = rowmax(p0, p1);
            const float mnew = fmaxf(mhat, rm);
            const float f = fexp2(mhat - mnew);
            mhat = mnew;
            float sacc = 0.f;
#pragma unroll
            for (int r = 0; r < 16; ++r) { p0[r] = fexp2(p0[r] - mnew); p1[r] = fexp2(p1[r] - mnew); sacc += p0[r] + p1[r]; }
            l_reg = l_reg * f + sacc;
            if (__any(f != 1.0f)) {
                if (hi == 0) wsf[r32] = f;
                LDS_WAIT();
#pragma unroll
                for (int r = 0; r < 16; ++r) { const float fr_ = wsf[crow(r, hi)]; o[0][r] *= fr_; o[1][r] *= fr_; }
            }
            u32x4 pw0, pw1, pw2, pw3;
#define ATT_PKW(P, B) cvt_pk_bf16(P[B], P[B + 1])
            pw0 = (u32x4){ATT_PKW(p0, 0), ATT_PKW(p0, 2), ATT_PKW(p0, 4), ATT_PKW(p0, 6)}; pw1 = (u32x4){ATT_PKW(p0, 8), ATT_PKW(p0, 10), ATT_PKW(p0, 12), ATT_PKW(p0, 14)};
            pw2 = (u32x4){ATT_PKW(p1, 0), ATT_PKW(p1, 2), ATT_PKW(p1, 4), ATT_PKW(p1, 6)}; pw3 = (u32x4){ATT_PKW(p1, 8), ATT_PKW(p1, 10), ATT_PKW(p1, 12), ATT_PKW(p1, 14)};
#undef ATT_PKW
            ATT_SBAR();
            pv(o, vb0 + slot, __builtin_bit_cast(bf16x8, pw0), __builtin_bit_cast(bf16x8, pw1), __builtin_bit_cast(bf16x8, pw2), __builtin_bit_cast(bf16x8, pw3));
        }
        slot ^= SLOTB;
    }
    l_reg = addx32(l_reg);
    if (hi == 0) wsf[32 + r32] = l_reg;
    LDS_WAIT();
    float rli[16];
#pragma unroll
    for (int r = 0; r < 16; ++r) rli[r] = frcp(wsf[32 + crow(r, hi)]);
    bf16_t* Ow = Y + (rowbase + qrow0) * YW + ycol;
    { LAS bf16_t* stg = (LAS bf16_t*)(shm + L_OST) + wid * 2048;
#pragma unroll
        for (int r = 0; r < 16; ++r) { const int orow = crow(r, hi);
#pragma unroll
            for (int d0 = 0; d0 < 2; ++d0) stg[orow * 64 + d0 * 32 + r32] = f2bf(o[d0][r] * rli[r]); }
        LDS_WAIT();
#pragma unroll
        for (int i = 0; i < 4; ++i) { const int row = i * 8 + (lane >> 3), ch = lane & 7; const u32x4 v = *(LAS const u32x4*)(stg + row * 64 + ch * 8); *(u32x4*)(Ow + (long)row * YW + ch * 8) = v; } }
    asm volatile("s_waitcnt lgkmcnt(0)\n\ts_barrier" ::: "memory");
#undef ATT_DMA
}
}

namespace att2 {
#define SBAR() __builtin_amdgcn_sched_barrier(0)
__device__ __forceinline__ int crow(int r,int hi){return (r&3)+8*(r>>2)+4*hi;}
#define SBAR() __builtin_amdgcn_sched_barrier(0)
__device__ __forceinline__ void cmask(f32x16&p0,f32x16&p1,int jb,int qrel,int hi){
  const float NEG=-INFINITY; int kb=64*jb+4*hi;
  #pragma unroll
  for(int r=0;r<16;++r){int kv=kb+(r&3)+8*(r>>2); if(kv>qrel)p0[r]=NEG; if(kv+32>qrel)p1[r]=NEG;}
}

constexpr int NW=8,QBLK=32,QB=256,KVBLK=64,DM=PP;
constexpr int NSLOT=3, SLOTB=8192;
constexpr int LDS_K=0, LDS_V=NSLOT*SLOTB, LDS_WS=2*NSLOT*SLOTB, LDS_OST=LDS_WS+NW*64*4, LDS_KM=LDS_OST+NW*4096, LDS_BYTES=LDS_KM+7*64*4;
__device__ __forceinline__ void glds16(const void*gsrc,unsigned lds_dst){unsigned keep;
  asm volatile("s_mov_b32 %0, m0\n\ts_mov_b32 m0, %2\n\ts_nop 0\n\tglobal_load_lds_dwordx4 %1, off\n\ts_mov_b32 m0, %0":"=&s"(keep):"v"(gsrc),"s"(lds_dst):"memory");}
__device__ __forceinline__ float max3f(float a,float b,float c){float r;asm("v_max3_f32 %0, %1, %2, %3":"=v"(r):"v"(a),"v"(b),"v"(c));return r;}
__device__ __forceinline__ float max2f(float a,float b){float r;asm("v_max_f32_e32 %0, %1, %2":"=v"(r):"v"(a),"v"(b));return r;}
__device__ __forceinline__ float fadd_s(float a,float b){float r;asm("v_add_f32_e32 %0, %1, %2":"=v"(r):"v"(a),"v"(b));return r;}
__device__ __forceinline__ float fsub_s(float a,float b){float r;asm("v_sub_f32_e32 %0, %1, %2":"=v"(r):"v"(a),"v"(b));return r;}
typedef float f32x2_t __attribute__((ext_vector_type(2))); typedef __bf16 bf16x2_t __attribute__((ext_vector_type(2)));
typedef int v8i_t __attribute__((ext_vector_type(8)));
__device__ __forceinline__ unsigned cvtpk_s(float lo,float hi){f32x2_t v={lo,hi};bf16x2_t b=__builtin_convertvector(v,bf16x2_t);return __builtin_bit_cast(unsigned,b);}
#define WAIT_BAR(N) asm volatile("s_waitcnt vmcnt(" #N ") lgkmcnt(0)\n\ts_barrier":::"memory")

typedef __attribute__((address_space(3))) const char* lds_cptr;
__device__ __forceinline__ void qkt(f32x16&p0,f32x16&p1,lds_cptr Kslot,const bf16x8*qr,const f32x16&negm,int r32,int hi){
  lds_cptr kb=Kslot+hi*1024+r32*16;
  #pragma unroll
  for(int d0=0;d0<4;++d0){
    const bf16x8 b0=*(const __attribute__((address_space(3))) bf16x8*)(kb+d0*2048);
    const bf16x8 b1=*(const __attribute__((address_space(3))) bf16x8*)(kb+d0*2048+512);
    if(d0==0){p0=__builtin_amdgcn_mfma_f32_32x32x16_bf16(b0,qr[0],negm,0,0,0);p1=__builtin_amdgcn_mfma_f32_32x32x16_bf16(b1,qr[0],negm,0,0,0);}
    else{p0=__builtin_amdgcn_mfma_f32_32x32x16_bf16(b0,qr[d0],p0,0,0,0);p1=__builtin_amdgcn_mfma_f32_32x32x16_bf16(b1,qr[d0],p1,0,0,0);}}
}
__device__ __forceinline__ void kload8(bf16x8*kf,lds_cptr kp){
  kf[0]=*(const __attribute__((address_space(3))) bf16x8*)(kp);      kf[1]=*(const __attribute__((address_space(3))) bf16x8*)(kp+512);
  kf[2]=*(const __attribute__((address_space(3))) bf16x8*)(kp+2048); kf[3]=*(const __attribute__((address_space(3))) bf16x8*)(kp+2560);
  kf[4]=*(const __attribute__((address_space(3))) bf16x8*)(kp+4096); kf[5]=*(const __attribute__((address_space(3))) bf16x8*)(kp+4608);
  kf[6]=*(const __attribute__((address_space(3))) bf16x8*)(kp+6144); kf[7]=*(const __attribute__((address_space(3))) bf16x8*)(kp+6656);
}
__device__ __forceinline__ void kload2(bf16x8*kf,lds_cptr kp,int j){ kf[2*j]=*(const __attribute__((address_space(3))) bf16x8*)(kp+j*2048); kf[2*j+1]=*(const __attribute__((address_space(3))) bf16x8*)(kp+j*2048+512); }
__device__ __forceinline__ s16x4 vtr(lds_cptr p){ return __builtin_bit_cast(s16x4,__builtin_amdgcn_ds_read_tr16_b64_v4i16((__attribute__((address_space(3))) v4i16_t*)p)); }
__device__ __forceinline__ float rowmax(const f32x16&p0,const f32x16&p1){
  float a=max3f(p0[0],p0[1],p1[0]),b=max3f(p0[2],p0[3],p1[1]);a=max3f(a,p1[2],p1[3]);
  #pragma unroll
  for(int r=4;r<16;r+=4){a=max3f(a,p0[r],p0[r+1]);b=max3f(b,p0[r+2],p0[r+3]);a=max3f(a,p1[r],p1[r+1]);b=max3f(b,p1[r+2],p1[r+3]);}
  const float m=max2f(a,b);
  auto rr=__builtin_amdgcn_permlane32_swap(__float_as_uint(m),__float_as_uint(m),false,false);
  return max2f(__uint_as_float(rr[0]),__uint_as_float(rr[1]));
}
__device__ __forceinline__ void pv(f32x16*o,int vb,bf16x8 pa0,bf16x8 pa1,bf16x8 pa2,bf16x8 pa3){
  #pragma unroll
  for(int d0=0;d0<2;++d0){s16x4 lo[4],hi[4];
    #pragma unroll
    for(int ks=0;ks<4;++ks){
      asm volatile("ds_read_b64_tr_b16 %0,%1 offset:%c2":"=&v"(lo[ks]):"v"(vb),"i"(d0*4096+ks*1024):"memory");
      asm volatile("ds_read_b64_tr_b16 %0,%1 offset:%c2":"=&v"(hi[ks]):"v"(vb),"i"(d0*4096+ks*1024+512):"memory");}
    asm volatile("s_waitcnt lgkmcnt(0)":::"memory");SBAR();
    #define PK(k) (bf16x8){lo[k][0],lo[k][1],lo[k][2],lo[k][3],hi[k][0],hi[k][1],hi[k][2],hi[k][3]}
    o[d0]=__builtin_amdgcn_mfma_f32_32x32x16_bf16(pa0,PK(0),o[d0],0,0,0);
    o[d0]=__builtin_amdgcn_mfma_f32_32x32x16_bf16(pa1,PK(1),o[d0],0,0,0);
    o[d0]=__builtin_amdgcn_mfma_f32_32x32x16_bf16(pa2,PK(2),o[d0],0,0,0);
    o[d0]=__builtin_amdgcn_mfma_f32_32x32x16_bf16(pa3,PK(3),o[d0],0,0,0);
    #undef PK
  }
}

template<int THRL> __device__ __forceinline__ void moba_unit(int b,int h,int qb,const bf16_t*proj,bf16_t*Y,const float*kmp,LAS unsigned char*shm){
  int tid_=threadIdx.x; asm volatile("":"+v"(tid_));
  const int tid=tid_,lane=tid&63,r32=lane&31,hi=lane>>5; const int wid=__builtin_amdgcn_readfirstlane(tid>>6);
  const long rowbase=(long)b*SEQ; const int q0=qb*QB;
  const bf16_t*Qw=proj+(rowbase+q0+wid*QBLK)*DM+768+h*64;
  const bf16_t*Kh=proj+rowbase*DM+1280+h*64,*Vh=proj+rowbase*DM+1792+h*64;
  const unsigned lds0=(unsigned)(uintptr_t)shm;
  LAS float*wsf=(LAS float*)(shm+LDS_WS)+wid*64;
  const bf16_t*ksrc=Kh+(long)lane*DM+wid*8;
  const bf16_t*vsrc=Vh+(long)(16*(wid&3)+(lane>>2))*DM+(wid>>2)*32+(lane&3)*8;
  const unsigned kdst=lds0+LDS_K+wid*1024, vdst=lds0+LDS_V+wid*1024;
  #define DMA_K(t,slot) glds16(ksrc+(long)(t)*KVBLK*DM,(unsigned)__builtin_amdgcn_readfirstlane(kdst+(slot)))
  #define DMA_V(t,slot) glds16(vsrc+(long)(t)*KVBLK*DM,(unsigned)__builtin_amdgcn_readfirstlane(vdst+(slot)))
  const int vb0=(int)(lds0+LDS_V)+((lane>>4)&1)*32+(lane&3)*8+(4*hi+((lane&15)>>2))*64;
  const lds_cptr Kbase=(lds_cptr)(shm+LDS_K); bf16x8 kf[8];
  const lds_cptr shm3=(lds_cptr)shm; const lds_cptr kp0=shm3+LDS_K+hi*1024+r32*16; const lds_cptr vp0=shm3+LDS_V+((lane>>4)&1)*32+(lane&3)*8+(4*hi+((lane&15)>>2))*64;
  const int NT=(q0+QB)/KVBLK;
  bf16x8 qr[4];
  #pragma unroll
  for(int d0=0;d0<4;++d0)qr[d0]=*reinterpret_cast<const bf16x8*>(&Qw[(long)r32*DM+d0*16+hi*8]);
  LAS float*km=(LAS float*)(shm+LDS_KM);
  if(tid<qb*64){ const int n_=tid>>6,d_=tid&63; const float*p_=kmp+((size_t)(((b*8+n_)*8+h)*2))*64+d_; km[tid]=p_[0]+p_[64]; }
  DMA_K(0,0);DMA_V(0,0);DMA_K(1,SLOTB);
  asm volatile("s_waitcnt lgkmcnt(0)\n\ts_barrier":::"memory");
  unsigned sel=0u;
  if(qb<=3)sel=(1u<<qb)-1u;
  else{
    float qf[32];
    #pragma unroll
    for(int d0=0;d0<4;++d0)
      #pragma unroll
      for(int j=0;j<8;++j)qf[d0*8+j]=bf1((bf16_t)qr[d0][j]);
    float gsc[7];
    #pragma unroll
    for(int n=0;n<7;++n){
      float a=0.f;
      if(n<qb){
        #pragma unroll
        for(int d0=0;d0<4;++d0){ const f32x4 k0=*(LAS const f32x4*)(km+n*64+d0*16+hi*8),k1=*(LAS const f32x4*)(km+n*64+d0*16+hi*8+4);
          a+=qf[d0*8+0]*k0[0]+qf[d0*8+1]*k0[1]+qf[d0*8+2]*k0[2]+qf[d0*8+3]*k0[3]+qf[d0*8+4]*k1[0]+qf[d0*8+5]*k1[1]+qf[d0*8+6]*k1[2]+qf[d0*8+7]*k1[3]; }
        a=addx32(a);
      } else a=-INFINITY;
      gsc[n]=a;
    }
    #pragma unroll
    for(int n=0;n<7;++n){ int cnt=0;
      #pragma unroll
      for(int m2=0;m2<7;++m2) if(m2!=n) cnt+=(gsc[m2]>gsc[n]||(gsc[m2]==gsc[n]&&m2<n))?1:0;
      if(cnt<3&&n<qb)sel|=1u<<n; }
  }
  float mhat=0.f,l_reg=0.f;f32x16 o[2];o[0]=f32x16{};o[1]=f32x16{};f32x16 negm=f32x16{};asm volatile("":"+v"(negm));
  const int qrel=wid*QBLK+r32;
  #define BLKM(P0,P1,t) do{ const float mk_=((sel>>((t)>>2))&1u)?0.f:-INFINITY; _Pragma("unroll") for(int r=0;r<16;++r){P0[r]+=mk_;P1[r]+=mk_;} }while(0)
  #define CMASK(P0,P1,t) do{int jb_=(t)-(NT-4); if(jb_>=0)cmask(P0,P1,jb_,qrel,hi); else BLKM(P0,P1,t);}while(0)
  bool resc=false;
  #define START(P0,P1) do{ const float rm=rowmax(P0,P1); resc=false; \
    { const float dl=__builtin_fmaxf(rm,-60.f); mhat=fadd_s(mhat,dl); \
      _Pragma("unroll") for(int r=0;r<16;++r){P0[r]=fsub_s(P0[r],dl);P1[r]=fsub_s(P1[r],dl);} \
      _Pragma("unroll") for(int r=0;r<16;++r)negm[r]=-mhat; asm volatile("":"+v"(negm)); } \
    _Pragma("unroll") for(int r=0;r<16;++r)P0[r]=__builtin_amdgcn_exp2f(P0[r]); }while(0)
  #define RESC() do{ if(resc){ asm volatile("s_waitcnt lgkmcnt(0)":::"memory"); \
      _Pragma("unroll") for(int d_=0;d_<2;++d_) _Pragma("unroll") for(int r=0;r<16;++r)o[d_][r]*=wsf[crow(r,hi)]; } }while(0)
  f32x16 pA0,pA1,pB0,pB1;
  int sl_prev=0,sl_cur=0,sl_next=SLOTB;
  #define ROT() do{sl_prev=sl_cur;sl_cur=sl_next;sl_next=(sl_next==(NSLOT-1)*SLOTB)?0:sl_next+SLOTB;}while(0)
  DMA_K(2,2*SLOTB);
  WAIT_BAR(3);
  qkt(pA0,pA1,Kbase,qr,negm,r32,hi);asm volatile("s_nop 15\n\ts_nop 7":"+v"(pA0),"+v"(pA1));CMASK(pA0,pA1,0);
  START(pA0,pA1);
  _Pragma("unroll") for(int r=0;r<16;++r)pA1[r]=__builtin_amdgcn_exp2f(pA1[r]);
  WAIT_BAR(0);
  DMA_K(3,0);DMA_V(1,SLOTB);
  ROT();
  kload8(kf,kp0+sl_cur);
  WAIT_BAR(2);
  s16x4 vlo[8],vhi[8]; u32x4 pw0,pw1,pw2,pw3;
  #define PKW(P,B) cvtpk_s(P[B],P[B+1])
  #define PAF(k) __builtin_bit_cast(bf16x8,pw##k)
  #define VFR(i) (bf16x8){vlo[i][0],vlo[i][1],vlo[i][2],vlo[i][3],vhi[i][0],vhi[i][1],vhi[i][2],vhi[i][3]}
  #define PIN(x) asm volatile("":"+v"(x))
  #define MX3(a,b,c) __builtin_fmaxf(__builtin_fmaxf((a),(b)),(c))
  #define GAPA(MF,A0,A1,A2,A3,W0,W1,PW) do{ MF; sacc+=A0; sacc+=A1; sacc+=A2; sacc+=A3; PIN(sacc); W0; W1; PIN(PW); SBAR(); }while(0)
  #define EX(v) __builtin_amdgcn_exp2f(v)
  #define GAPB(MF,X,B) do{ MF; X[B]=EX(X[B]); X[B+1]=EX(X[B+1]); X[B+2]=EX(X[B+2]); X[B+3]=EX(X[B+3]); PIN(X); SBAR(); }while(0)
  #define VRD(i) do{ vlo[i]=vtr(vp_+(((i)>>2)*4096+((i)&3)*1024)); vhi[i]=vtr(vp_+(((i)>>2)*4096+((i)&3)*1024+512)); }while(0)
  #define KRD(G,j) do{ if(G){ kload2(kf,kp0+sl_next,j); SBAR(); } }while(0)
  #define STEP(C0,C1,P0,P1,t,GK,GV,GL) do{ SBAR(); \
    const lds_cptr vp_=vp0+sl_prev; \
    VRD(0); SBAR(); float sacc=(P0[0]+P0[1]); \
    GAPA(C0=__builtin_amdgcn_mfma_f32_32x32x16_bf16(kf[0],qr[0],negm,0,0,0), P0[2],P0[3],P0[4],P0[5],     pw0[0]=PKW(P0,0), pw0[1]=PKW(P0,2), pw0); \
    VRD(4); SBAR(); GAPA(C1=__builtin_amdgcn_mfma_f32_32x32x16_bf16(kf[1],qr[0],negm,0,0,0), P0[6],P0[7],P0[8],P0[9],     pw0[2]=PKW(P0,4), pw0[3]=PKW(P0,6), pw0); \
    VRD(1); SBAR(); GAPA(C0=__builtin_amdgcn_mfma_f32_32x32x16_bf16(kf[2],qr[1],C0,0,0,0),   P0[10],P0[11],P0[12],P0[13], pw1[0]=PKW(P0,8), pw1[1]=PKW(P0,10), pw1); \
    VRD(5); SBAR(); GAPA(C1=__builtin_amdgcn_mfma_f32_32x32x16_bf16(kf[3],qr[1],C1,0,0,0),   P0[14],P0[15],P1[0],P1[1],   pw1[2]=PKW(P0,12),pw1[3]=PKW(P0,14), pw1); \
    VRD(2); SBAR(); GAPA(C0=__builtin_amdgcn_mfma_f32_32x32x16_bf16(kf[4],qr[2],C0,0,0,0),   P1[2],P1[3],P1[4],P1[5],     pw2[0]=PKW(P1,0), pw2[1]=PKW(P1,2), pw2); \
    VRD(6); SBAR(); GAPA(C1=__builtin_amdgcn_mfma_f32_32x32x16_bf16(kf[5],qr[2],C1,0,0,0),   P1[6],P1[7],P1[8],P1[9],     pw2[2]=PKW(P1,4), pw2[3]=PKW(P1,6), pw2); \
    VRD(3); SBAR(); GAPA(C0=__builtin_amdgcn_mfma_f32_32x32x16_bf16(kf[6],qr[3],C0,0,0,0),   P1[10],P1[11],P1[12],P1[13], pw3[0]=PKW(P1,8), pw3[1]=PKW(P1,10), pw3); \
    VRD(7); SBAR(); GAPA(C1=__builtin_amdgcn_mfma_f32_32x32x16_bf16(kf[7],qr[3],C1,0,0,0),   P1[14],P1[15],0.f,0.f,       pw3[2]=PKW(P1,12),pw3[3]=PKW(P1,14), pw3); \
    l_reg+=sacc; \
    if(GK){DMA_K((t)+3,sl_cur);} if(GV){DMA_V((t)+1,sl_next);} \
    CMASK(C0,C1,t); \
    { float a=MX3(C0[0],C0[1],C1[0]),b=MX3(C0[2],C0[3],C1[1]); a=MX3(a,C1[2],C1[3]); \
      _Pragma("unroll") for(int r=4;r<16;r+=4){a=MX3(a,C0[r],C0[r+1]);b=MX3(b,C0[r+2],C0[r+3]);a=MX3(a,C1[r],C1[r+1]);b=MX3(b,C1[r+2],C1[r+3]);} \
      float rm=__builtin_fmaxf(a,b); { auto rr=__builtin_amdgcn_permlane32_swap(__float_as_uint(rm),__float_as_uint(rm),false,false); rm=__builtin_fmaxf(__uint_as_float(rr[0]),__uint_as_float(rr[1])); } \
      resc=false; \
      if(__builtin_expect(__any(rm>(float)THRL),0)){ const float dl=__builtin_fmaxf(rm,0.f); mhat+=dl; \
        _Pragma("unroll") for(int r=0;r<16;++r){C0[r]-=dl;C1[r]-=dl;} \
        _Pragma("unroll") for(int r=0;r<16;++r)negm[r]=-mhat; asm volatile("":"+v"(negm)); \
        const float f=__builtin_amdgcn_exp2f(-dl); l_reg*=f; if(hi==0)wsf[r32]=f; resc=true; } } \
    SBAR(); \
    GAPB(o[0]=__builtin_amdgcn_mfma_f32_32x32x16_bf16(PAF(0),VFR(0),o[0],0,0,0), C0,0); \
    GAPB(o[1]=__builtin_amdgcn_mfma_f32_32x32x16_bf16(PAF(0),VFR(4),o[1],0,0,0), C0,4); \
    KRD(GL,0); GAPB(o[0]=__builtin_amdgcn_mfma_f32_32x32x16_bf16(PAF(1),VFR(1),o[0],0,0,0), C0,8); \
    KRD(GL,1); GAPB(o[1]=__builtin_amdgcn_mfma_f32_32x32x16_bf16(PAF(1),VFR(5),o[1],0,0,0), C0,12); \
    KRD(GL,2); GAPB(o[0]=__builtin_amdgcn_mfma_f32_32x32x16_bf16(PAF(2),VFR(2),o[0],0,0,0), C1,0); \
    KRD(GL,3); GAPB(o[1]=__builtin_amdgcn_mfma_f32_32x32x16_bf16(PAF(2),VFR(6),o[1],0,0,0), C1,4); \
    GAPB(o[0]=__builtin_amdgcn_mfma_f32_32x32x16_bf16(PAF(3),VFR(3),o[0],0,0,0), C1,8); \
    GAPB(o[1]=__builtin_amdgcn_mfma_f32_32x32x16_bf16(PAF(3),VFR(7),o[1],0,0,0), C1,12); \
    }while(0)
  int t=1;
  #undef CMASK
  #define CMASK(P0,P1,t) BLKM(P0,P1,t)
  for(;t+5<NT;t+=2){
    STEP(pB0,pB1,pA0,pA1,t,true,true,true);     WAIT_BAR(2); RESC(); ROT();
    STEP(pA0,pA1,pB0,pB1,t+1,true,true,true);   WAIT_BAR(2); RESC(); ROT();
  }
  #undef CMASK
  #define CMASK(P0,P1,t) do{int jb_=(t)-(NT-4); if(jb_>=0)cmask(P0,P1,jb_,qrel,hi); else BLKM(P0,P1,t);}while(0)
  #define ENDW(tt) do{ if((tt)+3<NT){WAIT_BAR(2);} else if((tt)+2<NT){WAIT_BAR(1);} else {WAIT_BAR(0);} }while(0)
  for(;t+1<NT;t+=2){
    STEP(pB0,pB1,pA0,pA1,t,(t+3<NT),(t+1<NT),(t+1<NT));       ENDW(t);   RESC(); ROT();
    STEP(pA0,pA1,pB0,pB1,t+1,(t+4<NT),(t+2<NT),(t+2<NT));     ENDW(t+1); RESC(); ROT();
  }
  STEP(pB0,pB1,pA0,pA1,NT-1,false,false,false); RESC();
  { float sacc=pB0[0]+pB0[1]; _Pragma("unroll") for(int r=2;r<16;++r)sacc+=pB0[r]; _Pragma("unroll") for(int r=0;r<16;++r)sacc+=pB1[r]; l_reg+=sacc;
    pw0=(u32x4){PKW(pB0,0),PKW(pB0,2),PKW(pB0,4),PKW(pB0,6)};pw1=(u32x4){PKW(pB0,8),PKW(pB0,10),PKW(pB0,12),PKW(pB0,14)};pw2=(u32x4){PKW(pB1,0),PKW(pB1,2),PKW(pB1,4),PKW(pB1,6)};pw3=(u32x4){PKW(pB1,8),PKW(pB1,10),PKW(pB1,12),PKW(pB1,14)};
    SBAR(); pv(o,vb0+sl_cur,PAF(0),PAF(1),PAF(2),PAF(3)); }
  #undef PKW
  #undef PAF
  #undef VFR
  #undef PIN
  #undef MX3
  #undef GAPA
  #undef GAPB
  #undef EX
  #undef VRD
  #undef KRD
  #undef STEP
  #undef ENDW
  {auto rr=__builtin_amdgcn_permlane32_swap(__float_as_uint(l_reg),__float_as_uint(l_reg),false,false);l_reg=__uint_as_float(rr[0])+__uint_as_float(rr[1]);}
  if(hi==0)wsf[32+r32]=l_reg;asm volatile("s_waitcnt lgkmcnt(0)":::"memory");
  float rli[16];
  #pragma unroll
  for(int r=0;r<16;++r)rli[r]=__builtin_amdgcn_rcpf(wsf[32+crow(r,hi)]);
  bf16_t*Ow=Y+(rowbase+q0+wid*QBLK)*YW+512+h*64;
  { LAS bf16_t*stg=(LAS bf16_t*)(shm+LDS_OST)+wid*2048;
    #pragma unroll
    for(int r=0;r<16;++r){const int orow=crow(r,hi);
      #pragma unroll
      for(int d0=0;d0<2;++d0)stg[orow*64+d0*32+r32]=f2bf(o[d0][r]*rli[r]);}
    asm volatile("s_waitcnt lgkmcnt(0)":::"memory");
    #pragma unroll
    for(int i=0;i<4;++i){const int row=i*8+(lane>>3),ch=lane&7; const u32x4 v=*(LAS const u32x4*)(stg+row*64+ch*8); *(u32x4*)(Ow+(long)row*YW+ch*8)=v;} }
  asm volatile("s_waitcnt lgkmcnt(0)\n\ts_barrier":::"memory");
  #undef DMA_K
  #undef DMA_V
  #undef CMASK
  #undef BLKM
  #undef START
  #undef RESC
  #undef ROT
}

#undef SBAR
#undef WAIT_BAR
}

namespace gla {
constexpr int PB = 144, PV = 272;
constexpr int L_LAR = 0, L_QR = 9216, L_KR = 18432, L_VR = 27648, L_RR = 45056, L_QD = 62464, L_KD = 71680, L_KTL = 80896, L_AM = 90112, L_DEC = 99328, L_SSQ = 99584, L_Y = 101632, L_END = 119040;
__device__ __forceinline__ f32x4 mfma16(bf16x8 a, bf16x8 b, f32x4 c) { return __builtin_amdgcn_mfma_f32_16x16x32_bf16(a, b, c, 0, 0, 0); }
__device__ __forceinline__ s16x4 trd(LAS const unsigned char* p) { return __builtin_bit_cast(s16x4, __builtin_amdgcn_ds_read_tr16_b64_v4i16((LAS v4i16_t*)p)); }
__device__ __forceinline__ bf16x8 tr_frag(LAS const unsigned char* img, int pitch, int k0, int c0, int lane) {
    const int g = lane >> 4, q = (lane & 15) >> 2, p = lane & 3;
    LAS const unsigned char* a = img + (k0 + 8 * g + q) * pitch + (c0 + 4 * p) * 2;
    const s16x4 lo = trd(a), hi = trd(a + 4 * pitch);
    return (bf16x8){lo[0], lo[1], lo[2], lo[3], hi[0], hi[1], hi[2], hi[3]};
}

template <int VAR = 0> __device__ __forceinline__ void gla_unit(const bf16_t* proj, bf16_t* Y, int b, int h, const float* gnorm, LAS unsigned char* lds) {
    int tid_ = threadIdx.x; asm volatile("" : "+v"(tid_));
    const int tid = tid_, lane = tid & 63, fr = lane & 15, fq = lane >> 4; const int wid = __builtin_amdgcn_readfirstlane(tid >> 6);
    const long rowbase = (long)b * SEQ;
    const int cq = 2304 + 64 * h, ck = 2560 + 64 * h, cv = 2816 + 128 * h, cla = 3328 + 64 * h, cr = 3584 + 128 * h;
    const int lt = tid >> 3, ldc = (tid & 7) * 8;
    const int vrow0 = tid >> 4, ve0 = (tid & 15) * 8;
    f32x4 sd[4];
#pragma unroll
    for (int i = 0; i < 4; ++i) sd[i] = (f32x4){0.f, 0.f, 0.f, 0.f};
    const f32x4 gn4 = *(const f32x4*)(gnorm + 16 * wid + 4 * fq);
    u32x4 nq, nk, nla, nv0, nv1, nr0, nr1;
    {
        const bf16_t* base = proj + (rowbase + lt) * PP;
        nq = *(const u32x4*)(base + cq + ldc); nk = *(const u32x4*)(base + ck + ldc); nla = *(const u32x4*)(base + cla + ldc);
        const bf16_t* bv = proj + (rowbase + vrow0) * PP;
        nv0 = *(const u32x4*)(bv + cv + ve0); nv1 = *(const u32x4*)(bv + (size_t)32 * PP + cv + ve0);
        nr0 = *(const u32x4*)(bv + cr + ve0); nr1 = *(const u32x4*)(bv + (size_t)32 * PP + cr + ve0);
    }
    LAS float* DEC = (LAS float*)(lds + L_DEC); LAS float* SSQ = (LAS float*)(lds + L_SSQ);
    const int db = wid & 3, ibp = wid >> 2;
    for (int n = 0; n < 32; ++n) {
        *(LAS u32x4*)(lds + L_LAR + lt * PB + ldc * 2) = nla; *(LAS u32x4*)(lds + L_QR + lt * PB + ldc * 2) = nq; *(LAS u32x4*)(lds + L_KR + lt * PB + ldc * 2) = nk;
        *(LAS u32x4*)(lds + L_VR + vrow0 * PV + ve0 * 2) = nv0; *(LAS u32x4*)(lds + L_VR + (vrow0 + 32) * PV + ve0 * 2) = nv1;
        const int rro = (n & 1) ? L_Y : L_RR;
        *(LAS u32x4*)(lds + rro + vrow0 * PV + ve0 * 2) = nr0; *(LAS u32x4*)(lds + rro + (vrow0 + 32) * PV + ve0 * 2) = nr1;
        if (n + 1 < 32) {
            const long r1 = rowbase + (long)(n + 1) * 64;
            const bf16_t* base = proj + (r1 + lt) * PP;
            nq = *(const u32x4*)(base + cq + ldc); nk = *(const u32x4*)(base + ck + ldc); nla = *(const u32x4*)(base + cla + ldc);
            const bf16_t* bv = proj + (r1 + vrow0) * PP;
            nv0 = *(const u32x4*)(bv + cv + ve0); nv1 = *(const u32x4*)(bv + (size_t)32 * PP + cv + ve0);
            nr0 = *(const u32x4*)(bv + cr + ve0); nr1 = *(const u32x4*)(bv + (size_t)32 * PP + cr + ve0);
        }
        LDS_WAIT(); __builtin_amdgcn_s_barrier(); asm volatile("" ::: "memory");
        {
            bf16x8 af[2];
#pragma unroll
            for (int s = 0; s < 2; ++s) af[s] = tr_frag(lds + L_LAR, PB, 32 * s, 16 * db, lane);
            const u32x4 one4 = {0x3F803F80u, 0x3F803F80u, 0x3F803F80u, 0x3F803F80u};
            f32x4 bl = {0.f, 0.f, 0.f, 0.f};
            bl = mfma16(af[0], __builtin_bit_cast(bf16x8, one4), bl); bl = mfma16(af[1], __builtin_bit_cast(bf16x8, one4), bl);
#pragma unroll
            for (int rep = 0; rep < 2; ++rep) {
                const int ib = 2 * ibp + rep, i_ = 16 * ib + fr;
                f32x4 bc = {0.f, 0.f, 0.f, 0.f};
#pragma unroll
                for (int s = 0; s < 2; ++s) {
                    const int nones = i_ - (32 * s + 8 * fq) + 1;
                    u32x4 lw;
                    lw.x = (nones > 0 ? 0x3F80u : 0u) | (nones > 1 ? 0x3F800000u : 0u); lw.y = (nones > 2 ? 0x3F80u : 0u) | (nones > 3 ? 0x3F800000u : 0u);
                    lw.z = (nones > 4 ? 0x3F80u : 0u) | (nones > 5 ? 0x3F800000u : 0u); lw.w = (nones > 6 ? 0x3F80u : 0u) | (nones > 7 ? 0x3F800000u : 0u);
                    bc = mfma16(af[s], __builtin_bit_cast(bf16x8, lw), bc);
                }
                const int off = i_ * PB + (16 * db + 4 * fq) * 2;
                const u32x2 qw = *(LAS const u32x2*)(lds + L_QR + off), kw = *(LAS const u32x2*)(lds + L_KR + off);
                const float q4[4] = {bf_lo(qw.x), bf_hi(qw.x), bf_lo(qw.y), bf_hi(qw.y)}, k4[4] = {bf_lo(kw.x), bf_hi(kw.x), bf_lo(kw.y), bf_hi(kw.y)};
                float qd[4], kd[4], kt[4];
#pragma unroll
                for (int r = 0; r < 4; ++r) { qd[r] = q4[r] * fexp(bc[r]); kd[r] = k4[r] * fexp(-bc[r]); kt[r] = k4[r] * fexp(bl[r] - bc[r]); }
                *(LAS u32x2*)(lds + L_QD + off) = (u32x2){cvt_pk_bf16(qd[0], qd[1]), cvt_pk_bf16(qd[2], qd[3])};
                *(LAS u32x2*)(lds + L_KD + off) = (u32x2){cvt_pk_bf16(kd[0], kd[1]), cvt_pk_bf16(kd[2], kd[3])};
                *(LAS u32x2*)(lds + L_KTL + off) = (u32x2){cvt_pk_bf16(kt[0], kt[1]), cvt_pk_bf16(kt[2], kt[3])};
            }
            if (ibp == 0 && fr == 0) *(LAS f32x4*)(DEC + 16 * db + 4 * fq) = (f32x4){fexp(bl[0]), fexp(bl[1]), fexp(bl[2]), fexp(bl[3])};
        }
        LDS_WAIT(); __builtin_amdgcn_s_barrier(); asm volatile("" ::: "memory");
#pragma unroll
        for (int rep = 0; rep < 2; ++rep) {
            const int id = wid + 8 * rep, ib = id >> 2, jb = id & 3;
            u32x2 w = {0u, 0u};
            if (jb <= ib) {
                f32x4 a = {0.f, 0.f, 0.f, 0.f};
#pragma unroll
                for (int s = 0; s < 2; ++s) {
                    const bf16x8 ka = *(LAS const bf16x8*)(lds + L_KD + (16 * jb + fr) * PB + (32 * s + 8 * fq) * 2);
                    const bf16x8 qb_ = *(LAS const bf16x8*)(lds + L_QD + (16 * ib + fr) * PB + (32 * s + 8 * fq) * 2);
                    a = mfma16(ka, qb_, a);
                }
                const int i_ = 16 * ib + fr, j0 = 16 * jb + 4 * fq;
#pragma unroll
                for (int r = 0; r < 4; ++r) if (j0 + r > i_) a[r] = 0.f;
                w.x = cvt_pk_bf16(a[0], a[1]); w.y = cvt_pk_bf16(a[2], a[3]);
            }
            *(LAS u32x2*)(lds + L_AM + (16 * ib + fr) * PB + (16 * jb + 4 * fq) * 2) = w;
        }
        f32x4 ao[4];
        {
            bf16x8 sb[2];
#pragma unroll
            for (int s = 0; s < 2; ++s) { u32x4 w; w.x = cvt_pk_bf16(sd[2 * s][0], sd[2 * s][1]); w.y = cvt_pk_bf16(sd[2 * s][2], sd[2 * s][3]); w.z = cvt_pk_bf16(sd[2 * s + 1][0], sd[2 * s + 1][1]); w.w = cvt_pk_bf16(sd[2 * s + 1][2], sd[2 * s + 1][3]); sb[s] = __builtin_bit_cast(bf16x8, w); }
#pragma unroll
            for (int ib = 0; ib < 4; ++ib) {
                f32x4 a = {0.f, 0.f, 0.f, 0.f};
#pragma unroll
                for (int s = 0; s < 2; ++s) {
                    const u32x2 lo = *(LAS const u32x2*)(lds + L_QD + (16 * ib + fr) * PB + (32 * s + 4 * fq) * 2);
                    const u32x2 hi = *(LAS const u32x2*)(lds + L_QD + (16 * ib + fr) * PB + (32 * s + 16 + 4 * fq) * 2);
                    const u32x4 qa = {lo.x, lo.y, hi.x, hi.y};
                    a = mfma16(sb[s], __builtin_bit_cast(bf16x8, qa), a);
                }
                ao[ib] = a;
            }
        }
        LDS_WAIT(); __builtin_amdgcn_s_barrier(); asm volatile("" ::: "memory");
        {
            bf16x8 vf[2];
#pragma unroll
            for (int s = 0; s < 2; ++s) vf[s] = tr_frag(lds + L_VR, PV, 32 * s, 16 * wid, lane);
#pragma unroll
            for (int ib = 0; ib < 4; ++ib)
#pragma unroll
                for (int s = 0; s < 2; ++s) {
                    if (32 * s > 16 * ib + 15) continue;
                    const bf16x8 af = *(LAS const bf16x8*)(lds + L_AM + (16 * ib + fr) * PB + (32 * s + 8 * fq) * 2);
                    ao[ib] = mfma16(vf[s], af, ao[ib]);
                }
#pragma unroll
            for (int d4 = 0; d4 < 4; ++d4) {
                const f32x4 dc = *(LAS const f32x4*)(DEC + 16 * d4 + 4 * fq);
                f32x4 a = sd[d4] * dc;
#pragma unroll
                for (int s = 0; s < 2; ++s) { const bf16x8 kf = tr_frag(lds + L_KTL, PB, 32 * s, 16 * d4, lane); a = mfma16(kf, vf[s], a); }
                sd[d4] = a;
            }
        }
#pragma unroll
        for (int ib = 0; ib < 4; ++ib) { float v = (ao[ib][0] * ao[ib][0] + ao[ib][1] * ao[ib][1]) + (ao[ib][2] * ao[ib][2] + ao[ib][3] * ao[ib][3]); v = addx32(addx16(v));
            if (fq == 0) SSQ[(16 * ib + fr) * 8 + wid] = v; }
        LDS_WAIT(); __builtin_amdgcn_s_barrier(); asm volatile("" ::: "memory");
        {
            const long r0 = rowbase + (long)n * 64;
#pragma unroll
            for (int ib = 0; ib < 4; ++ib) { const int i_ = 16 * ib + fr;
                const f32x4 s0 = *(LAS const f32x4*)(SSQ + i_ * 8), s1 = *(LAS const f32x4*)(SSQ + i_ * 8 + 4);
                const float tot = ((s0[0] + s0[1]) + (s0[2] + s0[3])) + ((s1[0] + s1[1]) + (s1[2] + s1[3]));
                const float rstd = frsq(tot * (1.0f / 128.0f) + EPS);
                const u32x2 rw = *(LAS const u32x2*)(lds + rro + i_ * PV + (16 * wid + 4 * fq) * 2);
                const f32x4 y = ao[ib] * rstd * gn4 * (f32x4){bf_lo(rw.x), bf_hi(rw.x), bf_lo(rw.y), bf_hi(rw.y)};
                *(u32x2*)(Y + (r0 + i_) * YW + 1024 + 128 * h + 16 * wid + 4 * fq) = (u32x2){cvt_pk_bf16(y[0], y[1]), cvt_pk_bf16(y[2], y[3])}; }
        }
    }
    LDS_WAIT(); __builtin_amdgcn_s_barrier(); asm volatile("" ::: "memory");
}
}

constexpr int NWAVES = 8;
constexpr int RING_BYTES = 131072, MISC_OFF = RING_BYTES, LDS_BYTES = 147456;
static_assert(gla::L_END <= RING_BYTES && att::L_END <= RING_BYTES && att2::LDS_BYTES <= RING_BYTES, "LDS map");

struct Params { const float* in[20]; float* out; unsigned char* ws; double invf[32]; int ph_lo, ph_hi; };

__device__ __forceinline__ void norm_row(const float* xrow, const float* gain, bf16_t* orow, int lane) {
    const f32x4* xr = (const f32x4*)xrow + lane; const f32x4* gr = (const f32x4*)gain + lane;
    f32x4 v[4]; float s = 0.f;
#pragma unroll
    for (int j = 0; j < 4; ++j) { v[j] = xr[64 * j]; s += (v[j][0] * v[j][0] + v[j][1] * v[j][1]) + (v[j][2] * v[j][2] + v[j][3] * v[j][3]); }
    const float rstd = 1.0f / sqrtf(wave_sum(s) * (1.0f / D) + EPS);
    u32x2* o8 = (u32x2*)orow + lane;
#pragma unroll
    for (int j = 0; j < 4; ++j) { const f32x4 g = gr[64 * j]; u32x2 w; w.x = cvt_pk_bf16(v[j][0] * rstd * g[0], v[j][1] * rstd * g[1]); w.y = cvt_pk_bf16(v[j][2] * rstd * g[2], v[j][3] * rstd * g[3]); o8[64 * j] = w; }
}
__device__ __forceinline__ void norm_phase(const float* x, const float* gain, bf16_t* H, int gw, int ngw, int lane) {
    for (int m = gw; m < T; m += ngw) norm_row(x + (size_t)m * D, gain, H + (size_t)m * D, lane);
}

__device__ __forceinline__ void conv_item(const float* src, int pitch, int col, int K, bf16_t* dst, int prow, int k0, const float* kscale = nullptr) {
    const float* s = src + (size_t)k0 * pitch + col;
    bf16_t* d = dst + (size_t)prow * K + k0;
#pragma unroll 2
    for (int kk = 0; kk < 8; ++kk) {
        float v[8];
#pragma unroll
        for (int i = 0; i < 8; ++i) v[i] = s[(size_t)(kk * 8 + i) * pitch];
        if (kscale) {
#pragma unroll
            for (int i = 0; i < 8; ++i) v[i] *= kscale[k0 + kk * 8 + i]; }
        u32x4 w; w.x = cvt_pk_bf16(v[0], v[1]); w.y = cvt_pk_bf16(v[2], v[3]); w.z = cvt_pk_bf16(v[4], v[5]); w.w = cvt_pk_bf16(v[6], v[7]);
        *(u32x4*)(d + kk * 8) = w;
    }
}
constexpr int IT_WIN = (PW / 64) * (D / 64), IT_WG = (GW / 64) * (D / 64), IT_WB = 3 * (D / 64) * (512 / 64), IT_WO = (D / 64) * (D / 64), IT_F1 = (FFP / 64) * (D / 64), IT_F2 = (D / 64) * (FF / 64);
constexpr int IT_LAYER = IT_WIN + IT_WG + IT_WB + IT_WO + IT_F1 + IT_F2;

__device__ __forceinline__ void sincos_d(double a, float& c, float& s) {
    const double kq = rint(a * 0.63661977236758134308);
    double r = fma(-kq, 1.57079632679489655800e+00, a); r = fma(-kq, 6.12323399573676603587e-17, r);
    const double r2 = r * r;
    const double sp = r * (1.0 + r2 * (-1.0 / 6 + r2 * (1.0 / 120 + r2 * (-1.0 / 5040 + r2 * (1.0 / 362880 + r2 * (-1.0 / 39916800 + r2 * (1.0 / 6227020800.0)))))));
    const double cp = 1.0 + r2 * (-0.5 + r2 * (1.0 / 24 + r2 * (-1.0 / 720 + r2 * (1.0 / 40320 + r2 * (-1.0 / 3628800 + r2 * (1.0 / 479001600 + r2 * (-1.0 / 87178291200.0)))))));
    const int q = ((int)kq) & 3;
    const double ss = (q == 0) ? sp : (q == 1) ? cp : (q == 2) ? -sp : -cp;
    const double cc = (q == 0) ? cp : (q == 1) ? -sp : (q == 2) ? -cp : sp;
    c = (float)cc; s = (float)ss;
}

__device__ __forceinline__ void prologue(const Params& P, int gw, int ngw, int lane) {
    unsigned char* ws = P.ws;
    for (int rep = 0; rep < (DBG_DUP == 4 ? 2 : 1); ++rep)
    for (int it = gw; it < 2 * IT_LAYER; it += ngw) {
        const int l = it / IT_LAYER; int r = it - l * IT_LAYER;
        unsigned char* wl = ws + WS_W + (size_t)l * LW_BYTES;
        if (r < IT_WIN) {
            const int rb = r / (D / 64), kb = r % (D / 64), p = rb * 64 + lane, k0 = kb * 64;
            const int pn = p >> 8, bj = (p >> 7) & 1, wc = (p >> 5) & 3, rem = p & 31, c = 256 * pn + 64 * wc + 32 * bj + rem;
            const float* win = P.in[3] + (size_t)l * D * DIN;
            bf16_t* dst = (bf16_t*)(wl + OFF_WIN);
            const float* ga = P.in[2] + (size_t)l * D;
            if (c < 3328) conv_item(win, DIN, c, D, dst, p, k0, ga);
            else if (c >= 3584) conv_item(win, DIN, 3344 + (c - 3584), D, dst, p, k0, ga);
            else {
                const float* wa = P.in[9] + (size_t)l * 16 * 256 + (c - 3328);
                float a[16];
#pragma unroll
                for (int q = 0; q < 16; ++q) a[q] = wa[q * 256];
                for (int kk = 0; kk < 8; ++kk) {
                    float v[8];
#pragma unroll
                    for (int i = 0; i < 8; ++i) { const float* wr_ = win + (size_t)(k0 + kk * 8 + i) * DIN + 3328; float acc = 0.f;
#pragma unroll
                        for (int q = 0; q < 16; ++q) acc += wr_[q] * a[q];
                        v[i] = acc * ga[k0 + kk * 8 + i]; }
                    u32x4 w; w.x = cvt_pk_bf16(v[0], v[1]); w.y = cvt_pk_bf16(v[2], v[3]); w.z = cvt_pk_bf16(v[4], v[5]); w.w = cvt_pk_bf16(v[6], v[7]);
                    *(u32x4*)(dst + (size_t)p * D + k0 + kk * 8) = w;
                }
            }
            continue;
        }
        r -= IT_WIN;
        if (r < IT_WG) {
            const int rb = r / (D / 64), kb = r % (D / 64), p = rb * 64 + lane, k0 = kb * 64;
            const float* sp = P.in[3] + (size_t)l * D * DIN + (size_t)k0 * DIN + 3856 + p; const float* ga = P.in[2] + (size_t)l * D + k0;
            unsigned char* d8 = wl + OFF_WG + (size_t)p * D + k0;
#pragma unroll 2
            for (int kk = 0; kk < 4; ++kk) { float v[16];
#pragma unroll
                for (int i = 0; i < 16; ++i) v[i] = sp[(size_t)(kk * 16 + i) * DIN] * ga[kk * 16 + i] * WS8;
                *(u32x4*)(d8 + kk * 16) = (u32x4){cvt4_fp8(v[0], v[1], v[2], v[3]), cvt4_fp8(v[4], v[5], v[6], v[7]), cvt4_fp8(v[8], v[9], v[10], v[11]), cvt4_fp8(v[12], v[13], v[14], v[15])}; }
            continue; }
        r -= IT_WG;
        if (r < IT_WB) { const int j = r / ((D / 64) * 8), r2 = r % ((D / 64) * 8), rb = r2 / 8, kb = r2 % 8, p = rb * 64 + lane;
            conv_item(P.in[12 + j] + (size_t)l * 512 * D, D, p, 512, (bf16_t*)(wl + OFF_WB) + (size_t)j * D * 512, p, kb * 64); continue; }
        r -= IT_WB;
        if (r < IT_WO) { const int rb = r / (D / 64), kb = r % (D / 64), p = rb * 64 + lane; conv_item(P.in[15] + (size_t)l * D * D, D, p, D, (bf16_t*)(wl + OFF_WO), p, kb * 64); continue; }
        r -= IT_WO;
        if (r < IT_F1) { const int rb = r / (D / 64), kb = r % (D / 64), p = rb * 64 + lane; const int pn = p >> 8, bj = (p >> 7) & 1, c = 128 * pn + (p & 127);
            conv_item(P.in[bj ? 18 : 17] + (size_t)l * D * FF, FF, c, D, (bf16_t*)(wl + OFF_F1), p, kb * 64, P.in[16] + (size_t)l * D); continue; }
        r -= IT_F1;
        { const int rb = r / (FF / 64), kb = r % (FF / 64), p = rb * 64 + lane; conv_item(P.in[19] + (size_t)l * FF * D, D, p, FF, (bf16_t*)(wl + OFF_F2), p, kb * 64); }
    }
    {
        bf16_t* rope = (bf16_t*)(ws + WS_ROPE); const int* pos = (const int*)P.in[1];
        for (int idx = gw * 64 + lane; idx < T * 32; idx += ngw * 64) { const int t = idx >> 5, i = idx & 31; float c, s; sincos_d((double)pos[t] * P.invf[i], c, s); rope[(size_t)t * 64 + i] = f2bf(c); rope[(size_t)t * 64 + 32 + i] = f2bf(s); }
    }
    {
        float* SS = (float*)(ws + WS_SS); bf16_t* XB = (bf16_t*)P.out;
        for (int m = gw; m < T; m += ngw) {
            const f32x4* xr = (const f32x4*)(P.in[0] + (size_t)m * D) + lane; u32x2* o8 = (u32x2*)(XB + (size_t)m * D) + lane; float s2 = 0.f;
#pragma unroll
            for (int j = 0; j < 4; ++j) { const f32x4 v = xr[64 * j]; s2 += (v[0] * v[0] + v[1] * v[1]) + (v[2] * v[2] + v[3] * v[3]); u32x2 w; w.x = cvt_pk_bf16(v[0], v[1]); w.y = cvt_pk_bf16(v[2], v[3]); o8[64 * j] = w;
                ((unsigned*)(ws + WS_XB8 + (size_t)m * D))[lane + 64 * j] = cvt4_fp8(v[0] * XS8, v[1] * XS8, v[2] * XS8, v[3] * XS8); }
            s2 = wave_sum(s2);
            if (lane == 0) SS[m] = s2;
        }
        for (int idx = gw * 64 + lane; idx < 3 * T; idx += ngw * 64) SS[T + idx] = 0.f;
    }
}

constexpr int Q_GLA = 64, Q_MOBA = 1024, Q_SWA = 1024, Q_TOTAL = Q_GLA + Q_MOBA + Q_SWA;

__global__ void __launch_bounds__(NWAVES * 64, 2) mk_fwd(Params P) {
    extern __shared__ __attribute__((aligned(16))) unsigned char lds_raw[];
    LAS unsigned char* lds = (LAS unsigned char*)lds_raw;
    volatile LAS unsigned* MISC = (volatile LAS unsigned*)(lds + MISC_OFF);
    const int tid = threadIdx.x, lane = tid & 63, wave = __builtin_amdgcn_readfirstlane(tid >> 6);
    const int G = gridDim.x, bx = blockIdx.x;
    const int vcu = (G % 8 == 0) ? (bx % 8) * (G / 8) + bx / 8 : bx;
    const int gw = vcu * NWAVES + wave, ngw = G * NWAVES;
    unsigned char* ws = P.ws;
    unsigned* ctl = (unsigned*)(ws + WS_CTL);
    for (int u = tid; u < 64; u += NWAVES * 64) MISC[u] = 0u;
    __syncthreads();
    XcdBarrier bar; bar.bar = ctl + CW_BAR; bar.x = 0; bar.st = nullptr;
    if (!MK_PER_PHASE) bar = xcd_barrier_post(ctl + CW_BAR, MISC + 8);
    const int lo = P.ph_lo, hi = P.ph_hi;
#define IN(k) (lo <= (k) && (k) < hi)
#define SEAM(k) do { if (IN(k) && IN((k) + 1)) xcd_barrier(bar); } while (0)

#define Hb ((bf16_t*)(ws + WS_H))
#define PROJ ((bf16_t*)(ws + WS_PROJ))
#define GATES PROJ
#define MERGED ((bf16_t*)(ws + WS_MERGED))
#define ACT PROJ
#define Yb ((bf16_t*)(ws + WS_Y))
#define rope ((bf16_t*)(ws + WS_ROPE))
#define kmp ((float*)(ws + WS_KM))
#define SS ((float*)(ws + WS_SS))

    #ifndef DBG_NO_PRO
    if (IN(1)) { prologue(P, gw, ngw, lane); }
#endif
    SEAM(1);
    for (int l = 0; l < DEPTH; ++l) {
        const int pb = 9 * l;
        unsigned char* ws = P.ws; asm volatile("" : "+s"(ws));
        int lane_l = lane; asm volatile("" : "+v"(lane_l));
        int bxl = blockIdx.x; asm volatile("" : "+s"(bxl));
        const float* xin = (l == 0) ? P.in[0] : P.out;
        unsigned char* wl = ws + WS_W + (size_t)l * LW_BYTES;
        if (IN(2 + pb)) for (int rep = 0; rep < (DBG_DUP == 2 ? 2 : 1); ++rep) {
            if (rep) xcd_barrier(bar);
            pg8::Gemm g{(const bf16_t*)P.out, (const bf16_t*)(wl + OFF_WIN), D, D, D, 0, 0, nullptr, nullptr, 0, 0, 0, 0, 0, 1 << 30}; pg8::TileOrderBal S; S.init(T, PW, G, bxl, 1);
            pg8::EpiInProj E{PROJ, rope, P.in[4] + l * 64, P.in[5] + l * 64, P.in[7] + l * 64, P.in[8] + l * 64, P.in[10] + l * 256, kmp, SS + (size_t)(2 * l) * T};
#ifndef DBG_NO_EPIINPROJ
            pg8::gemm_phase<pg8::EpiInProj, false, pg8::TileOrderBal>(lds, g, S, E, 0);
#endif
        }
        SEAM(2 + pb);
        if (IN(3 + pb)) for (int rep = 0; rep < (DBG_DUP == 1 ? 2 : 1); ++rep) {
            if (rep) xcd_barrier(bar);
            unsigned* qctr = ctl + CW_Q + 256 * l + 512 * rep;
            int it = 0;
#ifndef DBG_NO_GLA
            for (int r2 = 0; r2 < (DBG_DUP == 8 ? 2 : 1); ++r2, ++it)
            for (;; ++it) {
                if (tid == 0) MISC[16 + (it & 1)] = __hip_atomic_fetch_add(qctr + 16 * r2, 1u, __ATOMIC_RELAXED, __HIP_MEMORY_SCOPE_AGENT);
                __syncthreads();
                const int id = (int)MISC[16 + (it & 1)];
                if (id >= Q_GLA) break;
                gla::gla_unit(PROJ, Yb, id >> 2, id & 3, P.in[11] + l * 128, lds);
            }
            ++it;
#endif
#ifndef DBG_NO_MOBA
            for (int r2 = 0; r2 < (DBG_DUP == 9 ? 2 : 1); ++r2, ++it)
            for (;; ++it) {
                if (tid == 0) MISC[16 + (it & 1)] = __hip_atomic_fetch_add(qctr + 64 + 16 * r2, 1u, __ATOMIC_RELAXED, __HIP_MEMORY_SCOPE_AGENT);
                __syncthreads();
                const int m = (int)MISC[16 + (it & 1)];
                if (m >= Q_MOBA) break;
                att2::moba_unit<8>((m & 127) >> 3, m & 7, 7 - (m >> 7), PROJ, Yb, kmp, lds);
            }
            ++it;
#endif
#ifndef DBG_NO_SWA
            for (int r2 = 0; r2 < (DBG_DUP == 10 ? 2 : 1); ++r2, ++it)
            for (;; ++it) {
                if (tid == 0) MISC[16 + (it & 1)] = __hip_atomic_fetch_add(qctr + 128 + 16 * r2, 1u, __ATOMIC_RELAXED, __HIP_MEMORY_SCOPE_AGENT);
                __syncthreads();
                const int sidx = (int)MISC[16 + (it & 1)];
                if (sidx >= Q_SWA) break;
                att::attn_unit<0>(PROJ, Yb, sidx >> 6, (sidx >> 5) & 1, sidx & 31, P.in[6] + l * 8, nullptr, lds);
            }
#endif
        }
        SEAM(3 + pb);
        if (IN(4 + pb)) {
            pg8::TileOrder S0; S0.init(T, D, G, bxl, 1);
            for (int ti = 0;; ++ti) {
                pg8::Unit u0; if (!S0.next(ti, u0)) break;
                { pg8::Gemm g{(const bf16_t*)(ws + WS_XB8), (const bf16_t*)(wl + OFF_WG), D / 2, D / 2, D / 2, 0, 0, nullptr, nullptr, 0, 0, 0, 0, 0, 1 << 30}; pg8::GateTriple S{u0.pm, u0.pn};
                  pg8::EpiGatesT<false> E{GATES, 0, SS + (size_t)(2 * l) * T, 0, 1.0f / (XS8 * WS8)};
                  pg8::gemm_phase<pg8::EpiGatesT<false>, false, pg8::GateTriple, true>(lds, g, S, E, 0); }
                { pg8::Gemm g{Yb, (const bf16_t*)(wl + OFF_WB), 512, YW, 512, 512, (long)D * 512, nullptr, nullptr, 0, 0, 0, 0, 0, 1 << 30}; pg8::SubTriple S{u0.pm, u0.pn};
                  pg8::EpiMerge E{GATES, MERGED};
                  pg8::gemm_phase<pg8::EpiMerge, false, pg8::SubTriple>(lds, g, S, E, 0); }
            }
        }
        SEAM(4 + pb);
        if (IN(6 + pb)) for (int rep = 0; rep < ((DBG_DUP == 13 && l == 0) ? 2 : 1); ++rep) {
            if (rep) xcd_barrier(bar);
            pg8::Gemm g{MERGED, (const bf16_t*)(wl + OFF_WO), D, D, D, 0, 0, nullptr, nullptr, 0, 0, 0, 0, 0, 1 << 30}; pg8::TileOrder S; S.init(T, D, G, bxl, 1);
            pg8::EpiResid E{(const bf16_t*)P.out, nullptr, Hb, SS + (size_t)(2 * l + 1) * T, nullptr};
#ifndef DBG_NO_RESID
            pg8::gemm_phase<pg8::EpiResid>(lds, g, S, E, ((bxl >> 3) & 3) * STG_F);
#endif
        }
        SEAM(6 + pb);
        if (DBG_DUP == 5) { for (int rep = 0; rep < 8; ++rep) xcd_barrier(bar); }
        if (IN(8 + pb)) for (int rep = 0; rep < (DBG_DUP == 6 ? 2 : 1); ++rep) {
            if (rep) xcd_barrier(bar);
            pg8::Gemm g{Hb, (const bf16_t*)(wl + OFF_F1), D, D, D, 0, 0, nullptr, nullptr, 0, 0, 0, 0, 0, 1 << 30}; pg8::TileOrder S; S.init(T, FFP, G, bxl, 1);
            pg8::EpiFfn1 E{ACT, SS + (size_t)(2 * l + 1) * T};
#ifndef DBG_NO_EPIFFN1
            pg8::gemm_phase<pg8::EpiFfn1>(lds, g, S, E, ((bxl >> 3) & 3) * STG_B);
#endif
        }
        SEAM(8 + pb);
        if (IN(9 + pb)) {
            pg8::Gemm g{ACT, (const bf16_t*)(wl + OFF_F2), FF, FF, FF, 0, 0, nullptr, nullptr, 0, 0, 0, 0, 0, 1 << 30}; pg8::TileOrder S; S.init(T, D, G, bxl, 1);
            pg8::EpiResid E{(const bf16_t*)Hb, (l + 1 < DEPTH) ? nullptr : P.out, (l + 1 < DEPTH) ? (bf16_t*)P.out : nullptr, (l + 1 < DEPTH) ? SS + (size_t)(2 * l + 2) * T : nullptr, (l + 1 < DEPTH) ? ws + WS_XB8 : nullptr};
#ifndef DBG_NO_RESID
            pg8::gemm_phase<pg8::EpiResid>(lds, g, S, E, ((bxl >> 3) & 3) * STG_F);
#endif
        }
        SEAM(9 + pb);
    }
#undef IN
#undef SEAM
#undef Hb
#undef PROJ
#undef GATES
#undef MERGED
#undef ACT
#undef Yb
#undef rope
#undef kmp
#undef SS
}

extern "C" void kernel_launch(void* const* d_in, const int* in_sizes, int n_in, void* d_out, int out_size, void* d_ws, size_t ws_size, hipStream_t stream) {
    static int grid = 0;
    if (grid == 0) {
        if (n_in != 20 || out_size != T * D || ws_size < WS_END) { fprintf(stderr, "kernel_launch: unexpected problem (n_in %d, out %d, ws %zu < %zu)\n", n_in, out_size, ws_size, (size_t)WS_END); grid = -1; return; }
        int dev = 0, cus = 0;
        if (hipGetDevice(&dev) != hipSuccess || hipDeviceGetAttribute(&cus, hipDeviceAttributeMultiprocessorCount, dev) != hipSuccess) { grid = -1; return; }
        if (hipFuncSetAttribute((const void*)mk_fwd, hipFuncAttributeMaxDynamicSharedMemorySize, LDS_BYTES) != hipSuccess) { fprintf(stderr, "kernel_launch: hipFuncSetAttribute failed\n"); grid = -1; return; }
        int per_cu = 0;
        if (hipOccupancyMaxActiveBlocksPerMultiprocessor(&per_cu, (const void*)mk_fwd, NWAVES * 64, LDS_BYTES) != hipSuccess || per_cu < 1) fprintf(stderr, "kernel_launch: occupancy query says %d\n", per_cu);
        (void)hipGetLastError();
        grid = cus;
    }
    if (grid < 0) return;
    (void)hipMemsetAsync((char*)d_ws + WS_CTL, 0, CTL_ZERO_BYTES, stream);
    Params p{};
    for (int i = 0; i < 20; ++i) p.in[i] = (const float*)d_in[i];
    p.out = (float*)d_out; p.ws = (unsigned char*)d_ws;
    for (int i = 0; i < 32; ++i) p.invf[i] = std::pow(10000.0, -(double)i / 32.0);
#if MK_PER_PHASE
    for (int k = 1; k <= 18; ++k) { p.ph_lo = k; p.ph_hi = k + 1; hipLaunchKernelGGL(mk_fwd, dim3(grid), dim3(NWAVES * 64), LDS_BYTES, stream, p); }
#else
    p.ph_lo = 1; p.ph_hi = 19;
    hipLaunchKernelGGL(mk_fwd, dim3(grid), dim3(NWAVES * 64), LDS_BYTES, stream, p);
#endif
}
```

```cpp
#include <hip/hip_runtime.h>
#include <cstdint>
#include <cstdio>
#include <cmath>

#ifndef MK_PER_PHASE
#define MK_PER_PHASE 0
#endif

#ifndef DBG_DUP
#define DBG_DUP 0
#endif
#ifndef STG_B
#define STG_B 0
#endif
#ifndef STG_F
#define STG_F 0
#endif
#define GAS __attribute__((address_space(1)))
#define LAS __attribute__((address_space(3)))
typedef unsigned short bf16_t;
typedef short bf16x8 __attribute__((ext_vector_type(8)));
typedef short s16x4 __attribute__((ext_vector_type(4)));
typedef short v4i16_t __attribute__((ext_vector_type(4)));
typedef float f32x2 __attribute__((ext_vector_type(2)));
typedef float f32x4 __attribute__((ext_vector_type(4)));
typedef float f32x16 __attribute__((ext_vector_type(16)));
typedef unsigned u32x2 __attribute__((ext_vector_type(2)));
typedef unsigned u32x4 __attribute__((ext_vector_type(4)));
typedef __bf16 bf16x2_t __attribute__((ext_vector_type(2)));
typedef int v8i_t __attribute__((ext_vector_type(8)));

constexpr int T = 32768, SEQ = 2048, NBATCH = 16, D = 1024, DEPTH = 2;
constexpr int PP = 4096 + 64;
constexpr int PW = 4096;
constexpr int GW = 3072;
constexpr int YW = 1536;
constexpr int FF = 2816, FFP = 5632;
constexpr int DIN = 6928;
constexpr float EPS = 1e-6f;
constexpr float LOG2E = 1.4426950408889634f;
constexpr float C2 = 0.125f * LOG2E;

constexpr size_t MiB = 1u << 20;
constexpr size_t WS_CTL = 0, CTL_ZERO_BYTES = 1 * MiB;
constexpr size_t OFF_WIN = 0, OFF_WG = OFF_WIN + (size_t)PW * D * 2  , OFF_WB = OFF_WG + (size_t)GW * D, OFF_WO = OFF_WB + (size_t)3 * D * 512 * 2,
                 OFF_F1 = OFF_WO + (size_t)D * D * 2, OFF_F2 = OFF_F1 + (size_t)FFP * D * 2, LW_BYTES = OFF_F2 + (size_t)D * FF * 2;
constexpr size_t WS_W = 1 * MiB;
constexpr size_t WS_ROPE = WS_W + 2 * LW_BYTES;
constexpr size_t WS_KM = WS_ROPE + (size_t)T * 64 * 4;
constexpr size_t WS_SS = WS_KM + 512 * 1024;
constexpr size_t WS_H = WS_KM + 1 * MiB;
constexpr size_t WS_PROJ = WS_H + (size_t)T * YW * 2;
constexpr size_t WS_MERGED = WS_PROJ + (size_t)T * GW * 2;
constexpr size_t WS_Y = WS_H;
constexpr size_t WS_XB8 = WS_PROJ + (size_t)T * PP * 2;
constexpr size_t WS_END = WS_XB8 + (size_t)T * D;
static_assert(WS_ROPE % 256 == 0 && WS_END <= 512 * MiB, "workspace map");
constexpr int CW_TMO = 0, CW_BAR = 4096, CW_Q = 16384;
constexpr int CW_GRP = 8192, CW_GMASK = 9216;
constexpr int RPG = T / 8;
constexpr size_t SLAB = (size_t)RPG * PP * 2;
constexpr size_t SH_H = (size_t)RPG * (YW - D) * 2, SH_GATES = SLAB - (size_t)RPG * GW, SH_MERGED = SLAB - (size_t)RPG * D * 2, SH_ACT = SLAB - (size_t)RPG * FF * 2;
constexpr size_t OFF_MERGED_IN_SLAB = (size_t)RPG * GW;
static_assert(OFF_MERGED_IN_SLAB + (size_t)RPG * D * 2 <= SLAB && (size_t)RPG * FF * 2 <= SLAB, "group slabs");

__device__ __forceinline__ unsigned cvt_pk_bf16(float lo, float hi) { f32x2 v = {lo, hi}; bf16x2_t b = __builtin_convertvector(v, bf16x2_t); return __builtin_bit_cast(unsigned, b); }
__device__ __forceinline__ float bf_lo(unsigned w) { return __uint_as_float(w << 16); }
__device__ __forceinline__ float bf_hi(unsigned w) { return __uint_as_float(w & 0xffff0000u); }
__device__ __forceinline__ float bf1(bf16_t x) { return __uint_as_float(((unsigned)x) << 16); }
__device__ __forceinline__ bf16_t f2bf(float f) { return (bf16_t)(cvt_pk_bf16(f, 0.f) & 0xffffu); }
__device__ __forceinline__ unsigned cvt4_fp8(float a, float b, float c, float d) { unsigned w = 0; w = __builtin_amdgcn_cvt_pk_fp8_f32(a, b, w, false); w = __builtin_amdgcn_cvt_pk_fp8_f32(c, d, w, true); return w; }
constexpr float XS8 = 16.0f, WS8 = 64.0f;
__device__ __forceinline__ float fexp2(float x) { return __builtin_amdgcn_exp2f(x); }
__device__ __forceinline__ float fexp(float x) { return __builtin_amdgcn_exp2f(x * LOG2E); }
__device__ __forceinline__ float frcp(float x) { return __builtin_amdgcn_rcpf(x); }
__device__ __forceinline__ float frsq(float x) { return __builtin_amdgcn_rsqf(x); }
__device__ __forceinline__ float sigmoidf_(float x) { return frcp(1.f + fexp(-x)); }
template <int CTRL> __device__ __forceinline__ float dpp_f(float v) { return __builtin_bit_cast(float, __builtin_amdgcn_update_dpp(0, __builtin_bit_cast(int, v), CTRL, 0xf, 0xf, true)); }
__device__ __forceinline__ float sum16(float v) { v += dpp_f<0xB1>(v); v += dpp_f<0x4E>(v); v += dpp_f<0x141>(v); v += dpp_f<0x140>(v); return v; }
__device__ __forceinline__ float addx16(float v) { auto r = __builtin_amdgcn_permlane16_swap(__float_as_uint(v), __float_as_uint(v), false, false); return __uint_as_float(r[0]) + __uint_as_float(r[1]); }
__device__ __forceinline__ float addx32(float v) { auto r = __builtin_amdgcn_permlane32_swap(__float_as_uint(v), __float_as_uint(v), false, false); return __uint_as_float(r[0]) + __uint_as_float(r[1]); }
__device__ __forceinline__ float maxx32(float v) { auto r = __builtin_amdgcn_permlane32_swap(__float_as_uint(v), __float_as_uint(v), false, false); return fmaxf(__uint_as_float(r[0]), __uint_as_float(r[1])); }
__device__ __forceinline__ float wave_sum(float v) { return addx32(addx16(sum16(v))); }
#define LDS_WAIT() asm volatile("s_waitcnt lgkmcnt(0)" ::: "memory")
#define VM_WAIT() asm volatile("s_waitcnt vmcnt(0)" ::: "memory")

#define XB_TMO      128
#define XB_XCNT(j)  (256  + 64 * (j))
#define XB_XSUB(j)  (1280 + 64 * (j))
#define XB_XGEN(j)  (2304 + 64 * (j))
#define XB_TOP      3328
#define XB_TOPGEN   3392
#define XCD_BAR_WORDS 3456
#define XB_SPIN_CAP (1u << 18)
__device__ __forceinline__ unsigned xb_ld(unsigned* p)              { return __hip_atomic_load(p, __ATOMIC_RELAXED, __HIP_MEMORY_SCOPE_AGENT); }
__device__ __forceinline__ unsigned xb_add(unsigned* p, unsigned v) { return __hip_atomic_fetch_add(p, v, __ATOMIC_RELAXED, __HIP_MEMORY_SCOPE_AGENT); }
__device__ __forceinline__ unsigned xb_xcc_id() { return (unsigned)__builtin_amdgcn_s_getreg((3 << 11) | 20) & 0xFu; }
#define XB_SPIN(cond, bar) do { unsigned _sp = 0; while (cond) { __builtin_amdgcn_s_sleep(1); \
    if ((++_sp & 255u) == 0u) { if (xb_ld(&(bar)[XB_TMO])) break; if (_sp > XB_SPIN_CAP) { atomicAdd(&(bar)[XB_TMO], 1u); break; } } } } while (0)
struct XcdBarrier { unsigned* bar; unsigned x; volatile LAS unsigned* st; };
__device__ __forceinline__ XcdBarrier xcd_barrier_post(unsigned* bar, volatile LAS unsigned* st) {
    XcdBarrier b; b.bar = bar; b.x = xb_xcc_id(); b.st = st;
    if (threadIdx.x == 0) (void)xb_add(&bar[XB_XCNT(b.x)], 1u);
    return b;
}
__device__ __forceinline__ void xcd_barrier_complete(unsigned* bar, unsigned x, unsigned& nloc, unsigned& nx) {
    const unsigned G = gridDim.x * gridDim.y * gridDim.z;
    unsigned sum, cnt, mine, sp = 0u;
    for (;;) {
        sum = 0u; cnt = 0u; mine = 0u;
#pragma unroll
        for (unsigned j = 0; j < 16; ++j) { const unsigned c = xb_ld(&bar[XB_XCNT(j)]); sum += c; cnt += (c > 0u) ? 1u : 0u; mine = (j == x) ? c : mine; }
        if (sum == G) break;
        __builtin_amdgcn_s_sleep(1);
        if ((++sp & 255u) == 0u) { if (xb_ld(&bar[XB_TMO])) break; if (sp > XB_SPIN_CAP) { atomicAdd(&bar[XB_TMO], 1u); break; } }
    }
    nloc = mine > 0u ? mine : 1u; nx = cnt > 0u ? cnt : 1u;
}
__device__ __forceinline__ void xcd_barrier(const XcdBarrier& b) {
    asm volatile("s_waitcnt vmcnt(0)" ::: "memory");
    __syncthreads();
    if (threadIdx.x == 0) {
        unsigned* bar = b.bar;
        __builtin_amdgcn_s_waitcnt(0);
        unsigned nloc = b.st[0], nx = b.st[1];
        if (nloc == 0u) { xcd_barrier_complete(bar, b.x, nloc, nx); b.st[0] = nloc; b.st[1] = nx; }
        const unsigned old = xb_add(&bar[XB_XSUB(b.x)], 1u);
        const unsigned gen = old / nloc;
        if (old + 1u == (gen + 1u) * nloc) {
            __builtin_amdgcn_fence(__ATOMIC_RELEASE, "agent");
            asm volatile("s_waitcnt vmcnt(0)" ::: "memory");
            const unsigned og = xb_add(&bar[XB_TOP], 1u);
            const unsigned tg = og / nx;
            if (og + 1u == (tg + 1u) * nx) xb_add(&bar[XB_TOPGEN], 1u);
            else XB_SPIN(xb_ld(&bar[XB_TOPGEN]) == tg, bar);
            __builtin_amdgcn_fence(__ATOMIC_ACQUIRE, "agent");
            xb_add(&bar[XB_XGEN(b.x)], 1u);
            asm volatile("s_waitcnt vmcnt(0)" ::: "memory");
        } else {
            XB_SPIN(xb_ld(&bar[XB_XGEN(b.x)]) == gen, bar);
            __builtin_amdgcn_fence(__ATOMIC_ACQUIRE, "agent");
            asm volatile("s_waitcnt vmcnt(0)" ::: "memory");
        }
    }
    __syncthreads();
}

__device__ __forceinline__ void grp_barrier(unsigned* gword, unsigned target, unsigned* bar) {
    asm volatile("s_waitcnt vmcnt(0)" ::: "memory");
    __syncthreads();
    if (threadIdx.x == 0) {
        __builtin_amdgcn_s_waitcnt(0);
        (void)xb_add(gword, 1u);
        XB_SPIN(xb_ld(gword) < target, bar);
        __builtin_amdgcn_fence(__ATOMIC_ACQUIRE, "agent");
        asm volatile("s_waitcnt vmcnt(0)" ::: "memory");
    }
    __syncthreads();
}

namespace pg8 {
constexpr int BM = 256, BK = 64, HALF = 128, HTB = HALF * BK * 2, STAGE_BYTES = 8 * HTB, NXCD = 8, WGM = 8;
__host__ __device__ __forceinline__ int lds_byte(int r, int c) { const int st = (r >> 4) * 2 + (c >> 5), rr = r & 15, cc = c & 31, ob = rr * 64 + cc * 2; return st * 1024 + (ob ^ (((ob >> 9) & 1) << 5)); }
__host__ __device__ __forceinline__ void stage_rc(int b, int& R, int& C) { const int st = b / 1024, sb = b % 1024, swz = sb ^ (((sb >> 9) & 1) << 5); R = (st >> 1) * 16 + swz / 64; C = (st & 1) * 32 + (swz % 64) / 2; }
__host__ __device__ __forceinline__ int perm32(int rho) { const int n = rho >> 4, i = rho & 15; return 8 * (i >> 2) + 4 * n + (i & 3); }

struct Unit { int pm, pn, sub; };
struct Gemm { const bf16_t* A; const bf16_t* Bt; int K, lda, ldb; long a_sub, b_sub;
              const bf16_t* A1; const bf16_t* Bt1; int K1, lda1, ldb1; long a_sub1, b_sub1; int sub1; };

struct TileOrder {
    int nM, nN, nwg, G, c, nsub;
    __device__ __forceinline__ void init(int M, int N, int G_, int c_, int nsub_) { nM = M / BM; nN = N / BM; nwg = nM * nN; G = G_; c = c_; nsub = nsub_; }
    __device__ __forceinline__ bool next(int i, Unit& u) const {
        const int ti = i / nsub; u.sub = i - ti * nsub;
        const long L = (long)ti * G + c; if (L >= nwg) return false;
        int wgid = (int)L; { const int q = nwg / NXCD, r = nwg % NXCD, xcd = wgid % NXCD, off = wgid / NXCD; wgid = (xcd < r ? xcd * (q + 1) : r * (q + 1) + (xcd - r) * q) + off; }
        const int nig = WGM * nN, gid = wgid / nig, fm = gid * WGM, gsz = (nM - fm) < WGM ? (nM - fm) : WGM;
        u.pm = fm + ((wgid % nig) % gsz); u.pn = (wgid % nig) / gsz; return true;
    }
};

struct TileOrderBal : TileOrder {
    __device__ __forceinline__ bool next(int i, Unit& u) const { if (!TileOrder::next(i, u)) return false;
        const unsigned long long tab = 0xCBA8FD97E2654310ull;
        u.pn = (int)((tab >> (4 * u.pn)) & 15ull); return true; } };
struct GateTriple { int pm, pn; __device__ __forceinline__ bool next(int i, Unit& u) const { if (i >= 3) return false; u.pm = pm; u.pn = 4 * i + pn; u.sub = 0; return true; } };
struct SubTriple { int pm, pn; __device__ __forceinline__ bool next(int i, Unit& u) const { if (i >= 3) return false; u.pm = pm; u.pn = pn; u.sub = i; return true; } };

typedef f32x4 Acc[2][2][4][2];

template <class Epi, bool DUAL = false, class Sched = TileOrder, bool F8 = false>
__device__ __forceinline__ void gemm_phase(LAS unsigned char* lds, const Gemm g, const Sched& S, const Epi& E, int stagger = 0) {
    for (int i_ = 0; i_ < stagger; ++i_) __builtin_amdgcn_s_sleep(32);
    int tid_ = threadIdx.x; asm volatile("" : "+v"(tid_));
    const int tid = tid_, wid = __builtin_amdgcn_readfirstlane(tid >> 6), lane = tid & 63, wr = wid >> 2, wc = wid & 3, fr = lane & 15, fq = lane >> 4;
    const size_t kstep = (size_t)(BK * 2);
    const unsigned ldsw = (unsigned)wid * 1024u;
    const int aoff = F8 ? lds_byte(wr * 64 + fr, fq * 16) : lds_byte(wr * 64 + fr, fq * 8), boff = F8 ? lds_byte(wc * 32 + fr, fq * 16) : lds_byte(wc * 32 + fr, fq * 8);
#define PG8_SA(b, h) (((b) * 2 + (h)) * HTB)
#define PG8_SB(b, h) ((4 + (b) * 2 + (h)) * HTB)
#define PG8_STAGE(bufoff, gbase, voff, hs) do { _Pragma("unroll") for (int _i = 0; _i < 2; ++_i) \
        __builtin_amdgcn_global_load_lds((const unsigned*)((const char*)(gbase) + (size_t)_i * (hs) + (voff)), (LAS unsigned*)(lds + (bufoff) + ldsw + _i * 8192), 16, 0, 0); } while (0)
#define PG8_LD32(p) __builtin_bit_cast(v8i_t, __builtin_shufflevector(*(const LAS bf16x8*)(p), *(const LAS bf16x8*)((p) + 16), 0, 1, 2, 3, 4, 5, 6, 7, 8, 9, 10, 11, 12, 13, 14, 15))
#define PG8_LDA(dst, b, h) do { if constexpr (F8) { _Pragma("unroll") for (int m = 0; m < 4; ++m) dst##8[m] = PG8_LD32(lds + PG8_SA(b, h) + aoff + m * 2048); } \
        else { _Pragma("unroll") for (int m = 0; m < 4; ++m) _Pragma("unroll") for (int k = 0; k < 2; ++k) dst[m][k] = *(const LAS bf16x8*)(lds + PG8_SA(b, h) + aoff + m * 2048 + k * 1024); } } while (0)
#define PG8_LDB(dst, b, h) do { if constexpr (F8) { _Pragma("unroll") for (int n = 0; n < 2; ++n) dst##8[n] = PG8_LD32(lds + PG8_SB(b, h) + boff + n * 2048); } \
        else { _Pragma("unroll") for (int n = 0; n < 2; ++n) _Pragma("unroll") for (int k = 0; k < 2; ++k) dst[n][k] = *(const LAS bf16x8*)(lds + PG8_SB(b, h) + boff + n * 2048 + k * 1024); } } while (0)
#define PG8_MMA(ai, bj, At, Bt) do { __builtin_amdgcn_s_setprio(1); _Pragma("unroll") for (int m = 0; m < 4; ++m) _Pragma("unroll") for (int n = 0; n < 2; ++n) { \
        if constexpr (F8) asm volatile("v_mfma_scale_f32_16x16x128_f8f6f4 %0, %1, %2, %0, %3, %3 op_sel_hi:[0,0,0]" : "+v"(acc[ai][bj][m][n]) : "v"(Bt##8[n]), "v"(At##8[m]), "v"(sc8));   \
        else { _Pragma("unroll") for (int k = 0; k < 2; ++k) acc[ai][bj][m][n] = __builtin_amdgcn_mfma_f32_16x16x32_bf16(Bt[n][k], At[m][k], acc[ai][bj][m][n], 0, 0, 0); } } \
        __builtin_amdgcn_s_setprio(0); } while (0)
#define PG8_WAIT_V(n) asm volatile("s_waitcnt vmcnt(" #n ")" ::: "memory")
#define PG8_WAIT_L(n) asm volatile("s_waitcnt lgkmcnt(" #n ")" ::: "memory")
#define PG8_WAIT_VX(flag) do { if constexpr (Epi::NST == 8) asm volatile("s_cmp_eq_u32 %0, 0\n\ts_cbranch_scc1 1f\n\ts_waitcnt vmcnt(16)\n\ts_branch 2f\n1:\n\ts_waitcnt vmcnt(8)\n2:" :: "s"(flag) : "memory", "scc"); \
        else if constexpr (Epi::NST == 16) asm volatile("s_cmp_eq_u32 %0, 0\n\ts_cbranch_scc1 1f\n\ts_waitcnt vmcnt(24)\n\ts_branch 2f\n1:\n\ts_waitcnt vmcnt(8)\n2:" :: "s"(flag) : "memory", "scc"); \
        else if constexpr (Epi::NST == 32) asm volatile("s_cmp_eq_u32 %0, 0\n\ts_cbranch_scc1 1f\n\ts_waitcnt vmcnt(40)\n\ts_branch 2f\n1:\n\ts_waitcnt vmcnt(8)\n2:" :: "s"(flag) : "memory", "scc"); \
        else asm volatile("s_waitcnt vmcnt(8)" ::: "memory"); } while (0)
#define PG8_BAR __builtin_amdgcn_s_barrier()
#define PG8_SCHED __builtin_amdgcn_sched_barrier(0)
#define PG8_KIND(u) (DUAL && (u).sub >= g.sub1)
#define PG8_ABASE(u) (PG8_KIND(u) ? (const char*)g.A1 + ((size_t)(u).pm * BM * g.lda1 + (size_t)((u).sub - g.sub1) * g.a_sub1) * 2 : (const char*)g.A + ((size_t)(u).pm * BM * g.lda + (size_t)(u).sub * g.a_sub) * 2)
#define PG8_BBASE(u) (PG8_KIND(u) ? (const char*)g.Bt1 + ((size_t)(u).pn * BM * g.ldb1 + (size_t)((u).sub - g.sub1) * g.b_sub1) * 2 : (const char*)g.Bt + ((size_t)(u).pn * BM * g.ldb + (size_t)(u).sub * g.b_sub) * 2)
#define PG8_VOFF(kd, vA, vB) do { const bool k_ = (kd); const int la_ = k_ ? g.lda1 : g.lda, lb_ = k_ ? g.ldb1 : g.ldb; \
        vA = (unsigned)(sR * la_ + sC) * 2u; vB = (unsigned)(sRb * lb_ + sC) * 2u; } while (0)
#define PG8_SETCFG(kd, hA, hB, ntv) do { const bool k_ = (kd); hA = (size_t)HALF * (k_ ? g.lda1 : g.lda) * 2; hB = (size_t)HALF * (k_ ? g.ldb1 : g.ldb) * 2; ntv = (k_ ? g.K1 : g.K) / BK; } while (0)
    Unit cur, nxt; int ui = 0;
    if (!S.next(0, cur)) return;
    Acc acc;
#pragma unroll
    for (int a = 0; a < 2; ++a)
#pragma unroll
        for (int b = 0; b < 2; ++b)
#pragma unroll
            for (int m = 0; m < 4; ++m)
#pragma unroll
                for (int n = 0; n < 2; ++n) acc[a][b][m][n] = (f32x4){0.f, 0.f, 0.f, 0.f};
    bf16x8 At[4][2], B0[2][2], B1[2][2];
    v8i_t At8[4], B08[2], B18[2];
    const int sc8 = 0x7f7f7f7f;
    float pre[8];
#pragma unroll
    for (int i = 0; i < 8; ++i) pre[i] = 0.f;
    const char* cA = PG8_ABASE(cur); const char* cB = PG8_BBASE(cur);
    int sR, sC; stage_rc(tid * 16, sR, sC); const int sRb = Epi::PERM ? ((sR & ~31) + perm32(sR & 31)) : sR;
    unsigned voffA, voffB; size_t hstepA, hstepB, xhA, xhB; int nt, xnt; bool xkind;
    PG8_VOFF(PG8_KIND(cur), voffA, voffB); PG8_SETCFG(PG8_KIND(cur), hstepA, hstepB, nt);
    PG8_STAGE(PG8_SB(0, 0), cB, voffB, hstepB >> 1); PG8_STAGE(PG8_SB(0, 1), cB + hstepB, voffB, hstepB >> 1); PG8_STAGE(PG8_SA(0, 0), cA, voffA, hstepA >> 1); PG8_STAGE(PG8_SA(0, 1), cA + hstepA, voffA, hstepA >> 1);
    if (wr == 1) PG8_BAR;
    PG8_WAIT_V(2); PG8_BAR;
    PG8_STAGE(PG8_SB(1, 0), cB + kstep, voffB, hstepB >> 1); PG8_STAGE(PG8_SA(1, 0), cA + kstep, voffA, hstepA >> 1); PG8_STAGE(PG8_SB(1, 1), cB + hstepB + kstep, voffB, hstepB >> 1);
    PG8_WAIT_V(6); PG8_BAR;
    for (;;) {
        const bool has_next = S.next(ui + 1, nxt);
        const char* nA = has_next ? PG8_ABASE(nxt) : cA; const char* nB = has_next ? PG8_BBASE(nxt) : cB;
        xkind = has_next ? PG8_KIND(nxt) : PG8_KIND(cur); PG8_SETCFG(xkind, xhA, xhB, xnt);
        for (int t = 0; t < nt; t += 2) {
            const bool last = (t == nt - 2);
            const char* a1 = cA + (size_t)(t + 1) * kstep;
            const char* a2 = last ? nA : cA + (size_t)(t + 2) * kstep; const char* b2 = last ? nB : cB + (size_t)(t + 2) * kstep;
            const char* a3 = a2 + kstep; const char* b3 = b2 + kstep;
            unsigned vA2 = voffA, vB2 = voffB;
            if (DUAL && last) PG8_VOFF(xkind, vA2, vB2);
            const size_t hA2 = last ? xhA : hstepA, hB2 = last ? xhB : hstepB;
            if (last) E.prefetch(cur, pre);
            const int rxi = __builtin_amdgcn_readfirstlane(((Epi::NST > 0) && (t == 0) && (ui > 0)) ? 1 : 0);
            PG8_LDB(B0, 0, 0); PG8_LDB(B1, 0, 1); PG8_SCHED; PG8_LDA(At, 0, 0); PG8_STAGE(PG8_SA(1, 1), a1 + hstepA, voffA, hstepA >> 1);
            PG8_WAIT_VX(rxi);
            PG8_WAIT_L(0); PG8_BAR; PG8_MMA(0, 0, At, B0); PG8_MMA(0, 1, At, B1); PG8_BAR; PG8_SCHED;
            PG8_LDA(At, 0, 1); PG8_STAGE(PG8_SB(0, 0), b2, vB2, hB2 >> 1); PG8_STAGE(PG8_SB(0, 1), b2 + hB2, vB2, hB2 >> 1); PG8_STAGE(PG8_SA(0, 0), a2, vA2, hA2 >> 1);
            PG8_WAIT_VX(rxi);
            PG8_WAIT_L(0); PG8_BAR; PG8_MMA(1, 0, At, B0); PG8_MMA(1, 1, At, B1); PG8_BAR; PG8_SCHED;
            PG8_LDB(B0, 1, 0); PG8_LDB(B1, 1, 1); PG8_SCHED; PG8_LDA(At, 1, 0); PG8_STAGE(PG8_SA(0, 1), a2 + hA2, vA2, hA2 >> 1);
            PG8_WAIT_V(8); PG8_WAIT_L(0); PG8_BAR; PG8_MMA(0, 0, At, B0); PG8_MMA(0, 1, At, B1); PG8_BAR; PG8_SCHED;
            PG8_LDA(At, 1, 1); PG8_STAGE(PG8_SB(1, 0), b3, vB2, hB2 >> 1); PG8_STAGE(PG8_SB(1, 1), b3 + hB2, vB2, hB2 >> 1); PG8_STAGE(PG8_SA(1, 0), a3, vA2, hA2 >> 1);
            PG8_WAIT_V(8); PG8_WAIT_L(0); PG8_BAR; PG8_MMA(1, 0, At, B0); PG8_MMA(1, 1, At, B1); PG8_BAR; PG8_SCHED;
        }
        if (wr == 0) PG8_BAR;
        if constexpr (F8) asm volatile("s_nop 15\n\ts_nop 7" ::: "memory");
        const bool keep = E(acc, cur, pre);
        if (!has_next) break;
        if (!keep) {
#pragma unroll
            for (int a = 0; a < 2; ++a)
#pragma unroll
                for (int b = 0; b < 2; ++b)
#pragma unroll
                    for (int m = 0; m < 4; ++m)
#pragma unroll
                        for (int n = 0; n < 2; ++n) acc[a][b][m][n] = (f32x4){0.f, 0.f, 0.f, 0.f};
        }
        cur = nxt; cA = nA; cB = nB; ++ui;
        if (DUAL) PG8_VOFF(xkind, voffA, voffB);
        hstepA = xhA; hstepB = xhB; nt = xnt;
        if (wr == 1) PG8_BAR;
    }
    PG8_WAIT_V(0);
    PG8_BAR;
#undef PG8_SA
#undef PG8_SB
#undef PG8_STAGE
#undef PG8_LDA
#undef PG8_LD32
#undef PG8_LDB
#undef PG8_MMA
#undef PG8_WAIT_V
#undef PG8_WAIT_L
#undef PG8_WAIT_VX
#undef PG8_BAR
#undef PG8_SCHED
#undef PG8_ABASE
#undef PG8_BBASE
#undef PG8_KIND
#undef PG8_SETCFG
#undef PG8_VOFF
}

__device__ __forceinline__ void lane_ids(int& wr, int& wc, int& fr, int& fq) { int t = threadIdx.x; asm volatile("" : "+v"(t)); const int wid = __builtin_amdgcn_readfirstlane(t >> 6); wr = wid >> 2; wc = wid & 3; fr = t & 15; fq = (t >> 4) & 3; }
__device__ __forceinline__ u32x4 pack8(const f32x4 a, const f32x4 b) { u32x4 w; w.x = cvt_pk_bf16(a[0], a[1]); w.y = cvt_pk_bf16(a[2], a[3]); w.z = cvt_pk_bf16(b[0], b[1]); w.w = cvt_pk_bf16(b[2], b[3]); return w; }

struct EpiInProj {
    static constexpr bool PERM = true; static constexpr int NST = 16;
    bf16_t* O;
    const bf16_t* rope;
    const float* g_qa; const float* g_ka; const float* g_qb; const float* g_kb;
    const float* b_alpha;
    float* kmp;
    const float* ssq;
    __device__ __forceinline__ void prefetch(const Unit& u, float (&pre)[8]) const {
        int t = threadIdx.x; asm volatile("" : "+v"(t)); const int row0 = u.pm * BM + ((t >> 8) & 1) * 64 + (t & 15);
#pragma unroll
        for (int st = 0; st < 8; ++st) pre[st] = ssq[row0 + (st >> 2) * HALF + (st & 3) * 16];
    }
    __device__ __forceinline__ bool operator()(Acc& acc, const Unit& u, const float (&pre)[8]) const {
        int wr, wc, fr, fq; lane_ids(wr, wc, fr, fq);
        const int G = 4 * u.pn + wc;
        const int row0 = u.pm * BM + wr * 64 + fr;
        {
#pragma unroll
            for (int st = 0; st < 8; ++st) { const float rs = frsq(pre[st] * (1.0f / D) + EPS);
#pragma unroll
                for (int bj = 0; bj < 2; ++bj)
#pragma unroll
                    for (int n = 0; n < 2; ++n) acc[st >> 2][bj][st & 3][n] *= rs; }
        }
        bf16_t* obase = O + (size_t)row0 * PP + 64 * G + 8 * fq;
        const float* gain = nullptr; float qs = 1.f; bool mean = false;
        if (G < 8) { gain = g_qa; qs = C2; } else if (G < 10) gain = g_ka; else if (G >= 12 && G < 20) { gain = g_qb; qs = C2; } else if (G >= 20 && G < 28) { gain = g_kb; mean = true; }
        if (gain) {
            f32x4 gn[2][2];
#pragma unroll
            for (int bj = 0; bj < 2; ++bj)
#pragma unroll
                for (int n = 0; n < 2; ++n) gn[bj][n] = *(const f32x4*)(gain + 32 * bj + 8 * fq + 4 * n);
            f32x4 ks[2][2];
#pragma unroll
            for (int bj = 0; bj < 2; ++bj)
#pragma unroll
                for (int n = 0; n < 2; ++n) ks[bj][n] = (f32x4){0.f, 0.f, 0.f, 0.f};
            u32x4 cw[8], sw[8];
#define INP_ROPE_LD(g_) do { const int rn_ = ((g_) >> 2) * HALF + ((g_) & 3) * 16; const bf16_t* cs_ = rope + (size_t)(row0 + rn_) * 64 + 8 * fq; cw[g_] = *(const u32x4*)cs_; sw[g_] = *(const u32x4*)(cs_ + 32); } while (0)
            INP_ROPE_LD(0); INP_ROPE_LD(1);
#pragma unroll
            for (int st = 0; st < 8; ++st) {
                const int ai = st >> 2, m = st & 3, rr = ai * HALF + m * 16;
                if (st + 2 < 8) INP_ROPE_LD(st + 2);
                const u32x4 cq_ = cw[st], sq_ = sw[st];
                const f32x4 c0 = {bf_lo(cq_.x), bf_hi(cq_.x), bf_lo(cq_.y), bf_hi(cq_.y)}, c1 = {bf_lo(cq_.z), bf_hi(cq_.z), bf_lo(cq_.w), bf_hi(cq_.w)};
                const f32x4 s0 = {bf_lo(sq_.x), bf_hi(sq_.x), bf_lo(sq_.y), bf_hi(sq_.y)}, s1 = {bf_lo(sq_.z), bf_hi(sq_.z), bf_lo(sq_.w), bf_hi(sq_.w)};
                float ss = 0.f;
#pragma unroll
                for (int bj = 0; bj < 2; ++bj)
#pragma unroll
                    for (int n = 0; n < 2; ++n) { const f32x4 v = acc[ai][bj][m][n]; ss += (v[0] * v[0] + v[1] * v[1]) + (v[2] * v[2] + v[3] * v[3]); }
                ss = addx32(addx16(ss));
                const float rs = frsq(ss * (1.0f / 64.0f) + EPS);
                f32x4 o0[2], o1[2];
#pragma unroll
                for (int n = 0; n < 2; ++n) {
                    const f32x4 c = n ? c1 : c0, sx = n ? s1 : s0;
                    const f32x4 y0 = acc[ai][0][m][n] * rs * gn[0][n], y1 = acc[ai][1][m][n] * rs * gn[1][n];
                    o0[n] = y0 * c - y1 * sx; o1[n] = y1 * c + y0 * sx;
                    ks[0][n] += o0[n]; ks[1][n] += o1[n];
                    o0[n] *= qs; o1[n] *= qs;
                }
                *(u32x4*)(obase + (size_t)rr * PP) = pack8(o0[0], o0[1]);
                *(u32x4*)(obase + (size_t)rr * PP + 32) = pack8(o1[0], o1[1]);
                asm volatile("" : "+v"(ks[0][0]), "+v"(ks[0][1]), "+v"(ks[1][0]), "+v"(ks[1][1]) :: "memory");
            }
#undef INP_ROPE_LD
            if (mean) {
#pragma unroll
                for (int bj = 0; bj < 2; ++bj)
#pragma unroll
                    for (int n = 0; n < 2; ++n)
#pragma unroll
                        for (int j = 0; j < 4; ++j) ks[bj][n][j] = sum16(ks[bj][n][j]);
                if (fr == 0) {
                    float* kp = kmp + ((size_t)((u.pm * 8 + (G - 20)) * 2 + wr)) * 64 + 8 * fq;
#pragma unroll
                    for (int bj = 0; bj < 2; ++bj)
#pragma unroll
                        for (int n = 0; n < 2; ++n) *(f32x4*)(kp + 32 * bj + 4 * n) = ks[bj][n];
                }
            }
        } else {
            const int mode = (G >= 36 && G < 40) ? 1 : (G >= 52 && G < 56) ? 2 : (G >= 56) ? 3 : 0;
            f32x4 bb[2][2];
#pragma unroll
            for (int bj = 0; bj < 2; ++bj)
#pragma unroll
                for (int n = 0; n < 2; ++n) bb[bj][n] = (mode == 2) ? *(const f32x4*)(b_alpha + 64 * (G - 52) + 32 * bj + 8 * fq + 4 * n) : (f32x4){0.f, 0.f, 0.f, 0.f};
#pragma unroll
            for (int ai = 0; ai < 2; ++ai)
#pragma unroll
                for (int m = 0; m < 4; ++m) {
                    const int rr = ai * HALF + m * 16;
                    f32x4 o[2][2];
#pragma unroll
                    for (int bj = 0; bj < 2; ++bj)
#pragma unroll
                        for (int n = 0; n < 2; ++n) {
                            f32x4 v = acc[ai][bj][m][n];
                            if (mode == 1) v *= 0.125f;
                            else if (mode == 2) {
#pragma unroll
                                for (int j = 0; j < 4; ++j) { const float z = v[j] + bb[bj][n][j]; v[j] = (fminf(z, 0.f) - __logf(1.f + fexp(-fabsf(z)))) * (1.0f / 16.0f); }
                            } else if (mode == 3) {
#pragma unroll
                                for (int j = 0; j < 4; ++j) v[j] = v[j] * sigmoidf_(v[j]);
                            }
                            o[bj][n] = v;
                        }
                    *(u32x4*)(obase + (size_t)rr * PP) = pack8(o[0][0], o[0][1]);
                    *(u32x4*)(obase + (size_t)rr * PP + 32) = pack8(o[1][0], o[1][1]);
                    asm volatile("" ::: "memory");
                }
        }
        return false;
    }
};

template <bool LATE> struct EpiGatesT {
    static constexpr bool PERM = true; static constexpr int NST = (DBG_DUP == 11) ? 0 : 16;
    bf16_t* O; int nostore; const float* ssq; int late; float oscale;
    __device__ __forceinline__ void prefetch(const Unit& u, float (&pre)[8]) const {
        if constexpr (LATE) return;
        int t = threadIdx.x; asm volatile("" : "+v"(t)); const int row0 = u.pm * BM + ((t >> 8) & 1) * 64 + (t & 15);
#pragma unroll
        for (int st = 0; st < 8; ++st) pre[st] = ssq[row0 + (st >> 2) * HALF + (st & 3) * 16];
    }
    __device__ __forceinline__ bool operator()(Acc& acc, const Unit& u, const float (&pre)[8]) const {
        int wr, wc, fr, fq; lane_ids(wr, wc, fr, fq);
        if (nostore) {
#pragma unroll
            for (int ai = 0; ai < 2; ++ai)
#pragma unroll
                for (int bj = 0; bj < 2; ++bj)
#pragma unroll
                    for (int m = 0; m < 4; ++m) asm volatile("" :: "v"(acc[ai][bj][m][0]), "v"(acc[ai][bj][m][1]));
            return false;
        }
        const int row0 = u.pm * BM + wr * 64 + fr, col0 = u.pn * BM + wc * 32 + 8 * fq;
        float rsv[8];
#pragma unroll
        for (int st = 0; st < 8; ++st) rsv[st] = LATE ? ssq[row0 + (st >> 2) * HALF + (st & 3) * 16] : pre[st];
#pragma unroll
        for (int ai = 0; ai < 2; ++ai)
#pragma unroll
            for (int m = 0; m < 4; ++m) { unsigned char* rowp = (unsigned char*)O + (size_t)(row0 + ai * HALF + m * 16) * GW + col0;
                const float rs = frsq(rsv[ai * 4 + m] * (1.0f / D) + EPS) * oscale;
#pragma unroll
                for (int bj = 0; bj < 2; ++bj) { f32x4 v0 = acc[ai][bj][m][0] * rs, v1 = acc[ai][bj][m][1] * rs;
                    unsigned w0 = 0u, w1 = 0u;
#pragma unroll
                    for (int j = 0; j < 4; ++j) { w0 = __builtin_amdgcn_cvt_pk_u8_f32(fmaxf(sigmoidf_(v0[j]) * 255.0f, 1.0f), j, w0); w1 = __builtin_amdgcn_cvt_pk_u8_f32(fmaxf(sigmoidf_(v1[j]) * 255.0f, 1.0f), j, w1); }
                    *(u32x2*)(rowp + bj * HALF) = (u32x2){w0, w1}; } }
        return false;
    }
};

typedef EpiGatesT<false> EpiGates;
struct EpiMerge {
    static constexpr bool PERM = true; static constexpr int NST = 16;
    const bf16_t* Gt;
    bf16_t* O;
    __device__ __forceinline__ void prefetch(const Unit&, float (&)[8]) const {}
    __device__ __forceinline__ bool operator()(Acc& acc, const Unit& u, const float (&pre)[8]) const {
        int wr, wc, fr, fq; lane_ids(wr, wc, fr, fq);
        const int row0 = u.pm * BM + wr * 64 + fr, col0 = u.pn * BM + wc * 32 + 8 * fq;
        const bool last = u.sub == 2;
        const unsigned char* G8 = (const unsigned char*)Gt;
        u32x2 ga[2][4][2], gb[2][4][2];
#pragma unroll
        for (int ai = 0; ai < 2; ++ai)
#pragma unroll
            for (int m = 0; m < 4; ++m)
#pragma unroll
                for (int bj = 0; bj < 2; ++bj) {
                    const unsigned char* gp = G8 + (size_t)(row0 + ai * HALF + m * 16) * GW + (size_t)u.sub * D + col0 + bj * HALF;
                    ga[ai][m][bj] = *(const u32x2*)gp;
                    gb[ai][m][bj] = last ? (u32x2){0x01010101u, 0x01010101u} : *(const u32x2*)(gp + D);
                }
        asm volatile("" ::: "memory");
        const float fin = last ? (1.0f / 255.0f) : 1.0f;
#pragma unroll
        for (int ai = 0; ai < 2; ++ai)
#pragma unroll
            for (int m = 0; m < 4; ++m)
#pragma unroll
                for (int bj = 0; bj < 2; ++bj) {
                    const u32x2 a = ga[ai][m][bj], b = gb[ai][m][bj];
                    const f32x4 s0 = {(float)(a.x & 0xffu) * frcp((float)(b.x & 0xffu)), (float)((a.x >> 8) & 0xffu) * frcp((float)((b.x >> 8) & 0xffu)), (float)((a.x >> 16) & 0xffu) * frcp((float)((b.x >> 16) & 0xffu)), (float)(a.x >> 24) * frcp((float)(b.x >> 24))};
                    const f32x4 s1 = {(float)(a.y & 0xffu) * frcp((float)(b.y & 0xffu)), (float)((a.y >> 8) & 0xffu) * frcp((float)((b.y >> 8) & 0xffu)), (float)((a.y >> 16) & 0xffu) * frcp((float)((b.y >> 16) & 0xffu)), (float)(a.y >> 24) * frcp((float)(b.y >> 24))};
                    acc[ai][bj][m][0] *= s0 * fin; acc[ai][bj][m][1] *= s1 * fin;
                    if (last) *(u32x4*)(O + (size_t)(row0 + ai * HALF + m * 16) * D + col0 + bj * HALF) = pack8(acc[ai][bj][m][0], acc[ai][bj][m][1]);
                }
        asm volatile("" ::: "memory");
        return !last;
    }
};

struct EpiGBM {
    static constexpr bool PERM = true; static constexpr int NST = 16;
    EpiGates eg; EpiMerge em;
    __device__ __forceinline__ void prefetch(const Unit&, float (&)[8]) const {}
    __device__ __forceinline__ bool operator()(Acc& acc, const Unit& u, const float (&pre)[8]) const {
        if (u.sub < 3) { const Unit v = {u.pm, 4 * u.sub + u.pn, 0}; return eg(acc, v, pre); }
        const Unit v = {u.pm, u.pn, u.sub - 3}; return em(acc, v, pre);
    }
};

struct EpiResid {
    static constexpr bool PERM = true; static constexpr int NST = 32;
    const bf16_t* base; float* out; bf16_t* xb; float* ssq; unsigned char* xb8;
    __device__ __forceinline__ void prefetch(const Unit&, float (&)[8]) const {}
    __device__ __forceinline__ bool operator()(Acc& acc, const Unit& u, const float (&pre)[8]) const {
        int wr, wc, fr, fq; lane_ids(wr, wc, fr, fq);
        const int row0 = u.pm * BM + wr * 64 + fr, col0 = u.pn * BM + wc * 32 + 8 * fq;
        u32x4 bw[2][4][2];
#pragma unroll
        for (int ai = 0; ai < 2; ++ai)
#pragma unroll
            for (int m = 0; m < 4; ++m)
#pragma unroll
                for (int bj = 0; bj < 2; ++bj) bw[ai][m][bj] = *(const u32x4*)(base + (size_t)(row0 + ai * HALF + m * 16) * D + col0 + bj * HALF);
        asm volatile("" ::: "memory");
#pragma unroll
        for (int ai = 0; ai < 2; ++ai) {
#pragma unroll
            for (int m = 0; m < 4; ++m) { const size_t off = (size_t)(row0 + ai * HALF + m * 16) * D + col0; float ss = 0.f;
#pragma unroll
                for (int bj = 0; bj < 2; ++bj) {
                    const u32x4 w = bw[ai][m][bj];
                    const f32x4 o0 = (f32x4){bf_lo(w.x), bf_hi(w.x), bf_lo(w.y), bf_hi(w.y)} + acc[ai][bj][m][0], o1 = (f32x4){bf_lo(w.z), bf_hi(w.z), bf_lo(w.w), bf_hi(w.w)} + acc[ai][bj][m][1];
                    if (out) { *(f32x4*)(out + off + bj * HALF) = o0; *(f32x4*)(out + off + bj * HALF + 4) = o1; }
                    if (xb) { ss += ((o0[0] * o0[0] + o0[1] * o0[1]) + (o0[2] * o0[2] + o0[3] * o0[3])) + ((o1[0] * o1[0] + o1[1] * o1[1]) + (o1[2] * o1[2] + o1[3] * o1[3]));
                        *(u32x4*)(xb + off + bj * HALF) = pack8(o0, o1);
                        if (xb8) *(u32x2*)(xb8 + off + bj * HALF) = (u32x2){cvt4_fp8(o0[0] * XS8, o0[1] * XS8, o0[2] * XS8, o0[3] * XS8), cvt4_fp8(o1[0] * XS8, o1[1] * XS8, o1[2] * XS8, o1[3] * XS8)}; } }
                if (xb) { ss = addx32(addx16(ss)); if (fq == 0) atomicAdd(ssq + (row0 + ai * HALF + m * 16), ss); } }
            asm volatile("" ::: "memory");
        }
        return false;
    }
};

struct EpiFfn1 {
    static constexpr bool PERM = true; static constexpr int NST = 8;
    bf16_t* O; const float* ssq;
    __device__ __forceinline__ void prefetch(const Unit& u, float (&pre)[8]) const {
        int t = threadIdx.x; asm volatile("" : "+v"(t)); const int row0 = u.pm * BM + ((t >> 8) & 1) * 64 + (t & 15);
#pragma unroll
        for (int st = 0; st < 8; ++st) pre[st] = ssq[row0 + (st >> 2) * HALF + (st & 3) * 16];
    }
    __device__ __forceinline__ bool operator()(Acc& acc, const Unit& u, const float (&pre)[8]) const {
        int wr, wc, fr, fq; lane_ids(wr, wc, fr, fq);
        const int row0 = u.pm * BM + wr * 64 + fr, col0 = u.pn * HALF + wc * 32 + 8 * fq;
#pragma unroll
        for (int ai = 0; ai < 2; ++ai)
#pragma unroll
            for (int m = 0; m < 4; ++m) {
                const float rs = frsq(pre[ai * 4 + m] * (1.0f / D) + EPS);
                f32x4 o[2];
#pragma unroll
                for (int n = 0; n < 2; ++n) { const f32x4 gt = acc[ai][0][m][n] * rs, up = acc[ai][1][m][n] * rs;
#pragma unroll
                    for (int j = 0; j < 4; ++j) o[n][j] = gt[j] * sigmoidf_(gt[j]) * up[j]; }
                *(u32x4*)(O + (size_t)(row0 + ai * HALF + m * 16) * FF + col0) = pack8(o[0], o[1]);
            }
        return false;
    }
};
}

namespace att {
constexpr int SLOTB = 8192;
constexpr int L_K = 0, L_V = 2 * SLOTB, L_WS = 4 * SLOTB, L_OST = L_WS + 8 * 256, L_KM = L_OST + 8 * 4096, L_END = L_KM + 7 * 64 * 4;
__device__ __forceinline__ int crow(int r, int hi) { return (r & 3) + 8 * (r >> 2) + 4 * hi; }
__device__ __forceinline__ void glds16(const void* gsrc, unsigned lds_dst) { unsigned keep;
    asm volatile("s_mov_b32 %0, m0\n\ts_mov_b32 m0, %2\n\ts_nop 0\n\tglobal_load_lds_dwordx4 %1, off\n\ts_mov_b32 m0, %0" : "=&s"(keep) : "v"(gsrc), "s"(lds_dst) : "memory"); }
#define ATT_WAIT_BAR0() asm volatile("s_waitcnt vmcnt(0) lgkmcnt(0)\n\ts_barrier" ::: "memory")
#define ATT_SBAR() __builtin_amdgcn_sched_barrier(0)

__device__ __forceinline__ void qkt(f32x16& p0, f32x16& p1, LAS const unsigned char* Kslot, const bf16x8* qr, int r32, int hi) {
    LAS const unsigned char* kb = Kslot + hi * 1024 + r32 * 16;
    p0 = f32x16{}; p1 = f32x16{};
#pragma unroll
    for (int d0 = 0; d0 < 4; ++d0) {
        const bf16x8 b0 = *(LAS const bf16x8*)(kb + d0 * 2048);
        const bf16x8 b1 = *(LAS const bf16x8*)(kb + d0 * 2048 + 512);
        p0 = __builtin_amdgcn_mfma_f32_32x32x16_bf16(b0, qr[d0], p0, 0, 0, 0);
        p1 = __builtin_amdgcn_mfma_f32_32x32x16_bf16(b1, qr[d0], p1, 0, 0, 0);
    }
}
__device__ __forceinline__ float rowmax(const f32x16& p0, const f32x16& p1) {
    float a = fmaxf(p0[0], p1[0]);
#pragma unroll
    for (int r = 1; r < 16; ++r) a = fmaxf(a, fmaxf(p0[r], p1[r]));
    return maxx32(a);
}
__device__ __forceinline__ void pv(f32x16* o, int vb, bf16x8 pa0, bf16x8 pa1, bf16x8 pa2, bf16x8 pa3) {
#pragma unroll
    for (int d0 = 0; d0 < 2; ++d0) { s16x4 lo[4], hi[4];
#pragma unroll
        for (int ks = 0; ks < 4; ++ks) {
            asm volatile("ds_read_b64_tr_b16 %0,%1 offset:%c2" : "=&v"(lo[ks]) : "v"(vb), "i"(d0 * 4096 + ks * 1024) : "memory");
            asm volatile("ds_read_b64_tr_b16 %0,%1 offset:%c2" : "=&v"(hi[ks]) : "v"(vb), "i"(d0 * 4096 + ks * 1024 + 512) : "memory"); }
        asm volatile("s_waitcnt lgkmcnt(0)" ::: "memory"); ATT_SBAR();
#define ATT_PK(k) (bf16x8){lo[k][0], lo[k][1], lo[k][2], lo[k][3], hi[k][0], hi[k][1], hi[k][2], hi[k][3]}
        o[d0] = __builtin_amdgcn_mfma_f32_32x32x16_bf16(pa0, ATT_PK(0), o[d0], 0, 0, 0);
        o[d0] = __builtin_amdgcn_mfma_f32_32x32x16_bf16(pa1, ATT_PK(1), o[d0], 0, 0, 0);
        o[d0] = __builtin_amdgcn_mfma_f32_32x32x16_bf16(pa2, ATT_PK(2), o[d0], 0, 0, 0);
        o[d0] = __builtin_amdgcn_mfma_f32_32x32x16_bf16(pa3, ATT_PK(3), o[d0], 0, 0, 0);
#undef ATT_PK
    }
}

template <int MODE>
__device__ __forceinline__ void attn_unit(const bf16_t* proj, bf16_t* Y, int b, int hh, int qb, const float* sinks, const float* kmp, LAS unsigned char* shm) {
    int tid_ = threadIdx.x; asm volatile("" : "+v"(tid_));
    const int tid = tid_, lane = tid & 63, r32 = lane & 31, hi = lane >> 5; const int wid = __builtin_amdgcn_readfirstlane(tid >> 6);
    const long rowbase = (long)b * SEQ;
    int qhead, qrow0, kcol, vcol, qcol, ycol, t_first, t_last;
    if (MODE == 0) { qhead = 4 * hh + (wid >> 1); qrow0 = 64 * qb + 32 * (wid & 1); qcol = 64 * qhead; kcol = 512 + 64 * hh; vcol = 640 + 64 * hh; ycol = 64 * qhead; t_first = qb >= 2 ? qb - 2 : 0; t_last = qb; }
    else { qhead = hh; qrow0 = 256 * qb + 32 * wid; qcol = 768 + 64 * hh; kcol = 1280 + 64 * hh; vcol = 1792 + 64 * hh; ycol = 512 + 64 * hh; t_first = 0; t_last = 4 * qb + 3; }
    const bf16_t* Qw = proj + (rowbase + qrow0) * PP + qcol;
    const bf16_t* Kh = proj + rowbase * PP + kcol; const bf16_t* Vh = proj + rowbase * PP + vcol;
    const unsigned lds0 = (unsigned)(uintptr_t)shm;
    LAS float* wsf = (LAS float*)(shm + L_WS) + wid * 64;
    const bf16_t* ksrc = Kh + (long)lane * PP + wid * 8;
    const bf16_t* vsrc = Vh + (long)(16 * (wid & 3) + (lane >> 2)) * PP + (wid >> 2) * 32 + (lane & 3) * 8;
    const unsigned kdst = lds0 + L_K + wid * 1024, vdst = lds0 + L_V + wid * 1024;
#define ATT_DMA(t, slot) do { glds16(ksrc + (long)(t) * 64 * PP, (unsigned)__builtin_amdgcn_readfirstlane(kdst + (slot))); glds16(vsrc + (long)(t) * 64 * PP, (unsigned)__builtin_amdgcn_readfirstlane(vdst + (slot))); } while (0)
    const int vb0 = (int)(lds0 + L_V) + ((lane >> 4) & 1) * 32 + (lane & 3) * 8 + (4 * hi + ((lane & 15) >> 2)) * 64;
    bf16x8 qr[4];
#pragma unroll
    for (int d0 = 0; d0 < 4; ++d0) qr[d0] = *(const bf16x8*)(Qw + (long)r32 * PP + d0 * 16 + hi * 8);
    unsigned sel = 0u;
    if (MODE == 1) {
        LAS float* km = (LAS float*)(shm + L_KM);
        if (qb > 0) { for (int idx = tid; idx < qb * 64; idx += 512) { const int n = idx >> 6, d = idx & 63; const float* p = kmp + ((size_t)(((b * 8 + n) * 8 + hh) * 2)) * 64 + d; km[idx] = p[0] + p[64]; } }
        LDS_WAIT(); __syncthreads();
        if (qb <= 3) sel = (1u << qb) - 1u;
        else {
            float qf[32];
#pragma unroll
            for (int d0 = 0; d0 < 4; ++d0)
#pragma unroll
                for (int j = 0; j < 8; ++j) qf[d0 * 8 + j] = bf1((bf16_t)qr[d0][j]);
            float gsc[7];
#pragma unroll
            for (int n = 0; n < 7; ++n) {
                float a = 0.f;
                if (n < qb) {
#pragma unroll
                    for (int d0 = 0; d0 < 4; ++d0) { const f32x4 k0 = *(LAS const f32x4*)(km + n * 64 + d0 * 16 + hi * 8), k1 = *(LAS const f32x4*)(km + n * 64 + d0 * 16 + hi * 8 + 4);
                        a += qf[d0 * 8 + 0] * k0[0] + qf[d0 * 8 + 1] * k0[1] + qf[d0 * 8 + 2] * k0[2] + qf[d0 * 8 + 3] * k0[3] + qf[d0 * 8 + 4] * k1[0] + qf[d0 * 8 + 5] * k1[1] + qf[d0 * 8 + 6] * k1[2] + qf[d0 * 8 + 7] * k1[3]; }
                    a = addx32(a);
                } else a = -INFINITY;
                gsc[n] = a;
            }
#pragma unroll
            for (int n = 0; n < 7; ++n) { int cnt = 0;
#pragma unroll
                for (int m2 = 0; m2 < 7; ++m2) if (m2 != n) cnt += (gsc[m2] > gsc[n] || (gsc[m2] == gsc[n] && m2 < n)) ? 1 : 0;
                if (cnt < 3 && n < qb) sel |= 1u << n; }
        }
    }
    float mhat, l_reg; f32x16 o[2]; o[0] = f32x16{}; o[1] = f32x16{};
    if (MODE == 0) { mhat = sinks[qhead] * LOG2E; l_reg = hi == 0 ? 1.f : 0.f; } else { mhat = -1e30f; l_reg = 0.f; }
    const int qabs = qrow0 + r32;
    ATT_DMA(t_first, 0);
    int slot = 0;
    for (int t = t_first; t <= t_last; ++t) {
        ATT_WAIT_BAR0();
        if (t < t_last) ATT_DMA(t + 1, slot ^ SLOTB);
        bool active = true;
        if (MODE == 1 && t < 4 * qb) active = __any((sel >> (t >> 2)) & 1u);
        if (active) {
            f32x16 p0, p1;
            qkt(p0, p1, shm + L_K + slot, qr, r32, hi);
            if (MODE == 0) {
                const int kb = 64 * t + 4 * hi;
#pragma unroll
                for (int r = 0; r < 16; ++r) { const int kv = kb + (r & 3) + 8 * (r >> 2);
                    if (!(kv <= qabs && kv > qabs - 128)) p0[r] = -INFINITY;
                    if (!(kv + 32 <= qabs && kv + 32 > qabs - 128)) p1[r] = -INFINITY; }
            } else {
                if (t >= 4 * qb) {
                    const int kb = 64 * t + 4 * hi;
#pragma unroll
                    for (int r = 0; r < 16; ++r) { const int kv = kb + (r & 3) + 8 * (r >> 2); if (kv > qabs) p0[r] = -INFINITY; if (kv + 32 > qabs) p1[r] = -INFINITY; }
                } else if (!((sel >> (t >> 2)) & 1u)) {
#pragma unroll
                    for (int r = 0; r < 16; ++r) { p0[r] = -INFINITY; p1[r] = -INFINITY; }
                }
            }
            const float rm = rowmax(p0, p1);
            const float mnew = fmaxf(mhat, rm);
            const float f = fexp2(mhat - mnew);
            mhat = mnew;
            float sacc = 0.f;
#pragma unroll
            for (int r = 0; r < 16; ++r) { p0[r] = fexp2(p0[r] - mnew); p1[r] = fexp2(p1[r] - mnew); sacc += p0[r] + p1[r]; }
            l_reg = l_reg * f + sacc;
            if (__any(f != 1.0f)) {
                if (hi == 0) wsf[r32] = f;
                LDS_WAIT();
#pragma unroll
                for (int r = 0; r < 16; ++r) { const float fr_ = wsf[crow(r, hi)]; o[0][r] *= fr_; o[1][r] *= fr_; }
            }
            u32x4 pw0, pw1, pw2, pw3;
#define ATT_PKW(P, B) cvt_pk_bf16(P[B], P[B + 1])
            pw0 = (u32x4){ATT_PKW(p0, 0), ATT_PKW(p0, 2), ATT_PKW(p0, 4), ATT_PKW(p0, 6)}; pw1 = (u32x4){ATT_PKW(p0, 8), ATT_PKW(p0, 10), ATT_PKW(p0, 12), ATT_PKW(p0, 14)};
            pw2 = (u32x4){ATT_PKW(p1, 0), ATT_PKW(p1, 2), ATT_PKW(p1, 4), ATT_PKW(p1, 6)}; pw3 = (u32x4){ATT_PKW(p1, 8), ATT_PKW(p1, 10), ATT_PKW(p1, 12), ATT_PKW(p1, 14)};
#undef ATT_PKW
            ATT_SBAR();
            pv(o, vb0 + slot, __builtin_bit_cast(bf16x8, pw0), __builtin_bit_cast(bf16x8, pw1), __builtin_bit_cast(bf16x8, pw2), __builtin_bit_cast(bf16x8, pw3));
        }
        slot ^= SLOTB;
    }
    l_reg = addx32(l_reg);
    if (hi == 0) wsf[32 + r32] = l_reg;
    LDS_WAIT();
    float rli[16];
#pragma unroll
    for (int r = 0; r < 16; ++r) rli[r] = frcp(wsf[32 + crow(r, hi)]);
    bf16_t* Ow = Y + (rowbase + qrow0) * YW + ycol;
    { LAS bf16_t* stg = (LAS bf16_t*)(shm + L_OST) + wid * 2048;
#pragma unroll
        for (int r = 0; r < 16; ++r) { const int orow = crow(r, hi);
#pragma unroll
            for (int d0 = 0; d0 < 2; ++d0) stg[orow * 64 + d0 * 32 + r32] = f2bf(o[d0][r] * rli[r]); }
        LDS_WAIT();
#pragma unroll
        for (int i = 0; i < 4; ++i) { const int row = i * 8 + (lane >> 3), ch = lane & 7; const u32x4 v = *(LAS const u32x4*)(stg + row * 64 + ch * 8); *(u32x4*)(Ow + (long)row * YW + ch * 8) = v; } }
    asm volatile("s_waitcnt lgkmcnt(0)\n\ts_barrier" ::: "memory");
#undef ATT_DMA
}
}

namespace att2 {
#define SBAR() __builtin_amdgcn_sched_barrier(0)
__device__ __forceinline__ int crow(int r,int hi){return (r&3)+8*(r>>2)+4*hi;}
#define SBAR() __builtin_amdgcn_sched_barrier(0)
__device__ __forceinline__ void cmask(f32x16&p0,f32x16&p1,int jb,int qrel,int hi){
  const float NEG=-INFINITY; int kb=64*jb+4*hi;
  #pragma unroll
  for(int r=0;r<16;++r){int kv=kb+(r&3)+8*(r>>2); if(kv>qrel)p0[r]=NEG; if(kv+32>qrel)p1[r]=NEG;}
}

constexpr int NW=8,QBLK=32,QB=256,KVBLK=64,DM=PP;
constexpr int NSLOT=3, SLOTB=8192;
constexpr int LDS_K=0, LDS_V=NSLOT*SLOTB, LDS_WS=2*NSLOT*SLOTB, LDS_OST=LDS_WS+NW*64*4, LDS_KM=LDS_OST+NW*4096, LDS_BYTES=LDS_KM+7*64*4;
__device__ __forceinline__ void glds16(const void*gsrc,unsigned lds_dst){unsigned keep;
  asm volatile("s_mov_b32 %0, m0\n\ts_mov_b32 m0, %2\n\ts_nop 0\n\tglobal_load_lds_dwordx4 %1, off\n\ts_mov_b32 m0, %0":"=&s"(keep):"v"(gsrc),"s"(lds_dst):"memory");}
__device__ __forceinline__ float max3f(float a,float b,float c){float r;asm("v_max3_f32 %0, %1, %2, %3":"=v"(r):"v"(a),"v"(b),"v"(c));return r;}
__device__ __forceinline__ float max2f(float a,float b){float r;asm("v_max_f32_e32 %0, %1, %2":"=v"(r):"v"(a),"v"(b));return r;}
__device__ __forceinline__ float fadd_s(float a,float b){float r;asm("v_add_f32_e32 %0, %1, %2":"=v"(r):"v"(a),"v"(b));return r;}
__device__ __forceinline__ float fsub_s(float a,float b){float r;asm("v_sub_f32_e32 %0, %1, %2":"=v"(r):"v"(a),"v"(b));return r;}
typedef float f32x2_t __attribute__((ext_vector_type(2))); typedef __bf16 bf16x2_t __attribute__((ext_vector_type(2)));
typedef int v8i_t __attribute__((ext_vector_type(8)));
__device__ __forceinline__ unsigned cvtpk_s(float lo,float hi){f32x2_t v={lo,hi};bf16x2_t b=__builtin_convertvector(v,bf16x2_t);return __builtin_bit_cast(unsigned,b);}
#define WAIT_BAR(N) asm volatile("s_waitcnt vmcnt(" #N ") lgkmcnt(0)\n\ts_barrier":::"memory")

typedef __attribute__((address_space(3))) const char* lds_cptr;
__device__ __forceinline__ void qkt(f32x16&p0,f32x16&p1,lds_cptr Kslot,const bf16x8*qr,const f32x16&negm,int r32,int hi){
  lds_cptr kb=Kslot+hi*1024+r32*16;
  #pragma unroll
  for(int d0=0;d0<4;++d0){
    const bf16x8 b0=*(const __attribute__((address_space(3))) bf16x8*)(kb+d0*2048);
    const bf16x8 b1=*(const __attribute__((address_space(3))) bf16x8*)(kb+d0*2048+512);
    if(d0==0){p0=__builtin_amdgcn_mfma_f32_32x32x16_bf16(b0,qr[0],negm,0,0,0);p1=__builtin_amdgcn_mfma_f32_32x32x16_bf16(b1,qr[0],negm,0,0,0);}
    else{p0=__builtin_amdgcn_mfma_f32_32x32x16_bf16(b0,qr[d0],p0,0,0,0);p1=__builtin_amdgcn_mfma_f32_32x32x16_bf16(b1,qr[d0],p1,0,0,0);}}
}
__device__ __forceinline__ void kload8(bf16x8*kf,lds_cptr kp){
  kf[0]=*(const __attribute__((address_space(3))) bf16x8*)(kp);      kf[1]=*(const __attribute__((address_space(3))) bf16x8*)(kp+512);
  kf[2]=*(const __attribute__((address_space(3))) bf16x8*)(kp+2048); kf[3]=*(const __attribute__((address_space(3))) bf16x8*)(kp+2560);
  kf[4]=*(const __attribute__((address_space(3))) bf16x8*)(kp+4096); kf[5]=*(const __attribute__((address_space(3))) bf16x8*)(kp+4608);
  kf[6]=*(const __attribute__((address_space(3))) bf16x8*)(kp+6144); kf[7]=*(const __attribute__((address_space(3))) bf16x8*)(kp+6656);
}
__device__ __forceinline__ void kload2(bf16x8*kf,lds_cptr kp,int j){ kf[2*j]=*(const __attribute__((address_space(3))) bf16x8*)(kp+j*2048); kf[2*j+1]=*(const __attribute__((address_space(3))) bf16x8*)(kp+j*2048+512); }
__device__ __forceinline__ s16x4 vtr(lds_cptr p){ return __builtin_bit_cast(s16x4,__builtin_amdgcn_ds_read_tr16_b64_v4i16((__attribute__((address_space(3))) v4i16_t*)p)); }
__device__ __forceinline__ float rowmax(const f32x16&p0,const f32x16&p1){
  float a=max3f(p0[0],p0[1],p1[0]),b=max3f(p0[2],p0[3],p1[1]);a=max3f(a,p1[2],p1[3]);
  #pragma unroll
  for(int r=4;r<16;r+=4){a=max3f(a,p0[r],p0[r+1]);b=max3f(b,p0[r+2],p0[r+3]);a=max3f(a,p1[r],p1[r+1]);b=max3f(b,p1[r+2],p1[r+3]);}
  const float m=max2f(a,b);
  auto rr=__builtin_amdgcn_permlane32_swap(__float_as_uint(m),__float_as_uint(m),false,false);
  return max2f(__uint_as_float(rr[0]),__uint_as_float(rr[1]));
}
__device__ __forceinline__ void pv(f32x16*o,int vb,bf16x8 pa0,bf16x8 pa1,bf16x8 pa2,bf16x8 pa3){
  #pragma unroll
  for(int d0=0;d0<2;++d0){s16x4 lo[4],hi[4];
    #pragma unroll
    for(int ks=0;ks<4;++ks){
      asm volatile("ds_read_b64_tr_b16 %0,%1 offset:%c2":"=&v"(lo[ks]):"v"(vb),"i"(d0*4096+ks*1024):"memory");
      asm volatile("ds_read_b64_tr_b16 %0,%1 offset:%c2":"=&v"(hi[ks]):"v"(vb),"i"(d0*4096+ks*1024+512):"memory");}
    asm volatile("s_waitcnt lgkmcnt(0)":::"memory");SBAR();
    #define PK(k) (bf16x8){lo[k][0],lo[k][1],lo[k][2],lo[k][3],hi[k][0],hi[k][1],hi[k][2],hi[k][3]}
    o[d0]=__builtin_amdgcn_mfma_f32_32x32x16_bf16(pa0,PK(0),o[d0],0,0,0);
    o[d0]=__builtin_amdgcn_mfma_f32_32x32x16_bf16(pa1,PK(1),o[d0],0,0,0);
    o[d0]=__builtin_amdgcn_mfma_f32_32x32x16_bf16(pa2,PK(2),o[d0],0,0,0);
    o[d0]=__builtin_amdgcn_mfma_f32_32x32x16_bf16(pa3,PK(3),o[d0],0,0,0);
    #undef PK
  }
}

template<int THRL> __device__ __forceinline__ void moba_unit(int b,int h,int qb,const bf16_t*proj,bf16_t*Y,const float*kmp,LAS unsigned char*shm){
  int tid_=threadIdx.x; asm volatile("":"+v"(tid_));
  const int tid=tid_,lane=tid&63,r32=lane&31,hi=lane>>5; const int wid=__builtin_amdgcn_readfirstlane(tid>>6);
  const long rowbase=(long)b*SEQ; const int q0=qb*QB;
  const bf16_t*Qw=proj+(rowbase+q0+wid*QBLK)*DM+768+h*64;
  const bf16_t*Kh=proj+rowbase*DM+1280+h*64,*Vh=proj+rowbase*DM+1792+h*64;
  const unsigned lds0=(unsigned)(uintptr_t)shm;
  LAS float*wsf=(LAS float*)(shm+LDS_WS)+wid*64;
  const bf16_t*ksrc=Kh+(long)lane*DM+wid*8;
  const bf16_t*vsrc=Vh+(long)(16*(wid&3)+(lane>>2))*DM+(wid>>2)*32+(lane&3)*8;
  const unsigned kdst=lds0+LDS_K+wid*1024, vdst=lds0+LDS_V+wid*1024;
  #define DMA_K(t,slot) glds16(ksrc+(long)(t)*KVBLK*DM,(unsigned)__builtin_amdgcn_readfirstlane(kdst+(slot)))
  #define DMA_V(t,slot) glds16(vsrc+(long)(t)*KVBLK*DM,(unsigned)__builtin_amdgcn_readfirstlane(vdst+(slot)))
  const int vb0=(int)(lds0+LDS_V)+((lane>>4)&1)*32+(lane&3)*8+(4*hi+((lane&15)>>2))*64;
  const lds_cptr Kbase=(lds_cptr)(shm+LDS_K); bf16x8 kf[8];
  const lds_cptr shm3=(lds_cptr)shm; const lds_cptr kp0=shm3+LDS_K+hi*1024+r32*16; const lds_cptr vp0=shm3+LDS_V+((lane>>4)&1)*32+(lane&3)*8+(4*hi+((lane&15)>>2))*64;
  const int NT=(q0+QB)/KVBLK;
  bf16x8 qr[4];
  #pragma unroll
  for(int d0=0;d0<4;++d0)qr[d0]=*reinterpret_cast<const bf16x8*>(&Qw[(long)r32*DM+d0*16+hi*8]);
  LAS float*km=(LAS float*)(shm+LDS_KM);
  if(tid<qb*64){ const int n_=tid>>6,d_=tid&63; const float*p_=kmp+((size_t)(((b*8+n_)*8+h)*2))*64+d_; km[tid]=p_[0]+p_[64]; }
  DMA_K(0,0);DMA_V(0,0);DMA_K(1,SLOTB);
  asm volatile("s_waitcnt lgkmcnt(0)\n\ts_barrier":::"memory");
  unsigned sel=0u;
  if(qb<=3)sel=(1u<<qb)-1u;
  else{
    float qf[32];
    #pragma unroll
    for(int d0=0;d0<4;++d0)
      #pragma unroll
      for(int j=0;j<8;++j)qf[d0*8+j]=bf1((bf16_t)qr[d0][j]);
    float gsc[7];
    #pragma unroll
    for(int n=0;n<7;++n){
      float a=0.f;
      if(n<qb){
        #pragma unroll
        for(int d0=0;d0<4;++d0){ const f32x4 k0=*(LAS const f32x4*)(km+n*64+d0*16+hi*8),k1=*(LAS const f32x4*)(km+n*64+d0*16+hi*8+4);
          a+=qf[d0*8+0]*k0[0]+qf[d0*8+1]*k0[1]+qf[d0*8+2]*k0[2]+qf[d0*8+3]*k0[3]+qf[d0*8+4]*k1[0]+qf[d0*8+5]*k1[1]+qf[d0*8+6]*k1[2]+qf[d0*8+7]*k1[3]; }
        a=addx32(a);
      } else a=-INFINITY;
      gsc[n]=a;
    }
    #pragma unroll
    for(int n=0;n<7;++n){ int cnt=0;
      #pragma unroll
      for(int m2=0;m2<7;++m2) if(m2!=n) cnt+=(gsc[m2]>gsc[n]||(gsc[m2]==gsc[n]&&m2<n))?1:0;
      if(cnt<3&&n<qb)sel|=1u<<n; }
  }
  float mhat=0.f,l_reg=0.f;f32x16 o[2];o[0]=f32x16{};o[1]=f32x16{};f32x16 negm=f32x16{};asm volatile("":"+v"(negm));
  const int qrel=wid*QBLK+r32;
  #define BLKM(P0,P1,t) do{ const float mk_=((sel>>((t)>>2))&1u)?0.f:-INFINITY; _Pragma("unroll") for(int r=0;r<16;++r){P0[r]+=mk_;P1[r]+=mk_;} }while(0)
  #define CMASK(P0,P1,t) do{int jb_=(t)-(NT-4); if(jb_>=0)cmask(P0,P1,jb_,qrel,hi); else BLKM(P0,P1,t);}while(0)
  bool resc=false;
  #define START(P0,P1) do{ const float rm=rowmax(P0,P1); resc=false; \
    { const float dl=__builtin_fmaxf(rm,-60.f); mhat=fadd_s(mhat,dl); \
      _Pragma("unroll") for(int r=0;r<16;++r){P0[r]=fsub_s(P0[r],dl);P1[r]=fsub_s(P1[r],dl);} \
      _Pragma("unroll") for(int r=0;r<16;++r)negm[r]=-mhat; asm volatile("":"+v"(negm)); } \
    _Pragma("unroll") for(int r=0;r<16;++r)P0[r]=__builtin_amdgcn_exp2f(P0[r]); }while(0)
  #define RESC() do{ if(resc){ asm volatile("s_waitcnt lgkmcnt(0)":::"memory"); \
      _Pragma("unroll") for(int d_=0;d_<2;++d_) _Pragma("unroll") for(int r=0;r<16;++r)o[d_][r]*=wsf[crow(r,hi)]; } }while(0)
  f32x16 pA0,pA1,pB0,pB1;
  int sl_prev=0,sl_cur=0,sl_next=SLOTB;
  #define ROT() do{sl_prev=sl_cur;sl_cur=sl_next;sl_next=(sl_next==(NSLOT-1)*SLOTB)?0:sl_next+SLOTB;}while(0)
  DMA_K(2,2*SLOTB);
  WAIT_BAR(3);
  qkt(pA0,pA1,Kbase,qr,negm,r32,hi);asm volatile("s_nop 15\n\ts_nop 7":"+v"(pA0),"+v"(pA1));CMASK(pA0,pA1,0);
  START(pA0,pA1);
  _Pragma("unroll") for(int r=0;r<16;++r)pA1[r]=__builtin_amdgcn_exp2f(pA1[r]);
  WAIT_BAR(0);
  DMA_K(3,0);DMA_V(1,SLOTB);
  ROT();
  kload8(kf,kp0+sl_cur);
  WAIT_BAR(2);
  s16x4 vlo[8],vhi[8]; u32x4 pw0,pw1,pw2,pw3;
  #define PKW(P,B) cvtpk_s(P[B],P[B+1])
  #define PAF(k) __builtin_bit_cast(bf16x8,pw##k)
  #define VFR(i) (bf16x8){vlo[i][0],vlo[i][1],vlo[i][2],vlo[i][3],vhi[i][0],vhi[i][1],vhi[i][2],vhi[i][3]}
  #define PIN(x) asm volatile("":"+v"(x))
  #define MX3(a,b,c) __builtin_fmaxf(__builtin_fmaxf((a),(b)),(c))
  #define GAPA(MF,A0,A1,A2,A3,W0,W1,PW) do{ MF; sacc+=A0; sacc+=A1; sacc+=A2; sacc+=A3; PIN(sacc); W0; W1; PIN(PW); SBAR(); }while(0)
  #define EX(v) __builtin_amdgcn_exp2f(v)
  #define GAPB(MF,X,B) do{ MF; X[B]=EX(X[B]); X[B+1]=EX(X[B+1]); X[B+2]=EX(X[B+2]); X[B+3]=EX(X[B+3]); PIN(X); SBAR(); }while(0)
  #define VRD(i) do{ vlo[i]=vtr(vp_+(((i)>>2)*4096+((i)&3)*1024)); vhi[i]=vtr(vp_+(((i)>>2)*4096+((i)&3)*1024+512)); }while(0)
  #define KRD(G,j) do{ if(G){ kload2(kf,kp0+sl_next,j); SBAR(); } }while(0)
  #define STEP(C0,C1,P0,P1,t,GK,GV,GL) do{ SBAR(); \
    const lds_cptr vp_=vp0+sl_prev; \
    VRD(0); SBAR(); float sacc=(P0[0]+P0[1]); \
    GAPA(C0=__builtin_amdgcn_mfma_f32_32x32x16_bf16(kf[0],qr[0],negm,0,0,0), P0[2],P0[3],P0[4],P0[5],     pw0[0]=PKW(P0,0), pw0[1]=PKW(P0,2), pw0); \
    VRD(4); SBAR(); GAPA(C1=__builtin_amdgcn_mfma_f32_32x32x16_bf16(kf[1],qr[0],negm,0,0,0), P0[6],P0[7],P0[8],P0[9],     pw0[2]=PKW(P0,4), pw0[3]=PKW(P0,6), pw0); \
    VRD(1); SBAR(); GAPA(C0=__builtin_amdgcn_mfma_f32_32x32x16_bf16(kf[2],qr[1],C0,0,0,0),   P0[10],P0[11],P0[12],P0[13], pw1[0]=PKW(P0,8), pw1[1]=PKW(P0,10), pw1); \
    VRD(5); SBAR(); GAPA(C1=__builtin_amdgcn_mfma_f32_32x32x16_bf16(kf[3],qr[1],C1,0,0,0),   P0[14],P0[15],P1[0],P1[1],   pw1[2]=PKW(P0,12),pw1[3]=PKW(P0,14), pw1); \
    VRD(2); SBAR(); GAPA(C0=__builtin_amdgcn_mfma_f32_32x32x16_bf16(kf[4],qr[2],C0,0,0,0),   P1[2],P1[3],P1[4],P1[5],     pw2[0]=PKW(P1,0), pw2[1]=PKW(P1,2), pw2); \
    VRD(6); SBAR(); GAPA(C1=__builtin_amdgcn_mfma_f32_32x32x16_bf16(kf[5],qr[2],C1,0,0,0),   P1[6],P1[7],P1[8],P1[9],     pw2[2]=PKW(P1,4), pw2[3]=PKW(P1,6), pw2); \
    VRD(3); SBAR(); GAPA(C0=__builtin_amdgcn_mfma_f32_32x32x16_bf16(kf[6],qr[3],C0,0,0,0),   P1[10],P1[11],P1[12],P1[13], pw3[0]=PKW(P1,8), pw3[1]=PKW(P1,10), pw3); \
    VRD(7); SBAR(); GAPA(C1=__builtin_amdgcn_mfma_f32_32x32x16_bf16(kf[7],qr[3],C1,0,0,0),   P1[14],P1[15],0.f,0.f,       pw3[2]=PKW(P1,12),pw3[3]=PKW(P1,14), pw3); \
    l_reg+=sacc; \
    if(GK){DMA_K((t)+3,sl_cur);} if(GV){DMA_V((t)+1,sl_next);} \
    CMASK(C0,C1,t); \
    { float a=MX3(C0[0],C0[1],C1[0]),b=MX3(C0[2],C0[3],C1[1]); a=MX3(a,C1[2],C1[3]); \
      _Pragma("unroll") for(int r=4;r<16;r+=4){a=MX3(a,C0[r],C0[r+1]);b=MX3(b,C0[r+2],C0[r+3]);a=MX3(a,C1[r],C1[r+1]);b=MX3(b,C1[r+2],C1[r+3]);} \
      float rm=__builtin_fmaxf(a,b); { auto rr=__builtin_amdgcn_permlane32_swap(__float_as_uint(rm),__float_as_uint(rm),false,false); rm=__builtin_fmaxf(__uint_as_float(rr[0]),__uint_as_float(rr[1])); } \
      resc=false; \
      if(__builtin_expect(__any(rm>(float)THRL),0)){ const float dl=__builtin_fmaxf(rm,0.f); mhat+=dl; \
        _Pragma("unroll") for(int r=0;r<16;++r){C0[r]-=dl;C1[r]-=dl;} \
        _Pragma("unroll") for(int r=0;r<16;++r)negm[r]=-mhat; asm volatile("":"+v"(negm)); \
        const float f=__builtin_amdgcn_exp2f(-dl); l_reg*=f; if(hi==0)wsf[r32]=f; resc=true; } } \
    SBAR(); \
    GAPB(o[0]=__builtin_amdgcn_mfma_f32_32x32x16_bf16(PAF(0),VFR(0),o[0],0,0,0), C0,0); \
    GAPB(o[1]=__builtin_amdgcn_mfma_f32_32x32x16_bf16(PAF(0),VFR(4),o[1],0,0,0), C0,4); \
    KRD(GL,0); GAPB(o[0]=__builtin_amdgcn_mfma_f32_32x32x16_bf16(PAF(1),VFR(1),o[0],0,0,0), C0,8); \
    KRD(GL,1); GAPB(o[1]=__builtin_amdgcn_mfma_f32_32x32x16_bf16(PAF(1),VFR(5),o[1],0,0,0), C0,12); \
    KRD(GL,2); GAPB(o[0]=__builtin_amdgcn_mfma_f32_32x32x16_bf16(PAF(2),VFR(2),o[0],0,0,0), C1,0); \
    KRD(GL,3); GAPB(o[1]=__builtin_amdgcn_mfma_f32_32x32x16_bf16(PAF(2),VFR(6),o[1],0,0,0), C1,4); \
    GAPB(o[0]=__builtin_amdgcn_mfma_f32_32x32x16_bf16(PAF(3),VFR(3),o[0],0,0,0), C1,8); \
    GAPB(o[1]=__builtin_amdgcn_mfma_f32_32x32x16_bf16(PAF(3),VFR(7),o[1],0,0,0), C1,12); \
    }while(0)
  int t=1;
  #undef CMASK
  #define CMASK(P0,P1,t) BLKM(P0,P1,t)
  for(;t+5<NT;t+=2){
    STEP(pB0,pB1,pA0,pA1,t,true,true,true);     WAIT_BAR(2); RESC(); ROT();
    STEP(pA0,pA1,pB0,pB1,t+1,true,true,true);   WAIT_BAR(2); RESC(); ROT();
  }
  #undef CMASK
  #define CMASK(P0,P1,t) do{int jb_=(t)-(NT-4); if(jb_>=0)cmask(P0,P1,jb_,qrel,hi); else BLKM(P0,P1,t);}while(0)
  #define ENDW(tt) do{ if((tt)+3<NT){WAIT_BAR(2);} else if((tt)+2<NT){WAIT_BAR(1);} else {WAIT_BAR(0);} }while(0)
  for(;t+1<NT;t+=2){
    STEP(pB0,pB1,pA0,pA1,t,(t+3<NT),(t+1<NT),(t+1<NT));       ENDW(t);   RESC(); ROT();
    STEP(pA0,pA1,pB0,pB1,t+1,(t+4<NT),(t+2<NT),(t+2<NT));     ENDW(t+1); RESC(); ROT();
  }
  STEP(pB0,pB1,pA0,pA1,NT-1,false,false,false); RESC();
  { float sacc=pB0[0]+pB0[1]; _Pragma("unroll") for(int r=2;r<16;++r)sacc+=pB0[r]; _Pragma("unroll") for(int r=0;r<16;++r)sacc+=pB1[r]; l_reg+=sacc;
    pw0=(u32x4){PKW(pB0,0),PKW(pB0,2),PKW(pB0,4),PKW(pB0,6)};pw1=(u32x4){PKW(pB0,8),PKW(pB0,10),PKW(pB0,12),PKW(pB0,14)};pw2=(u32x4){PKW(pB1,0),PKW(pB1,2),PKW(pB1,4),PKW(pB1,6)};pw3=(u32x4){PKW(pB1,8),PKW(pB1,10),PKW(pB1,12),PKW(pB1,14)};
    SBAR(); pv(o,vb0+sl_cur,PAF(0),PAF(1),PAF(2),PAF(3)); }
  #undef PKW
  #undef PAF
  #undef VFR
  #undef PIN
  #undef MX3
  #undef GAPA
  #undef GAPB
  #undef EX
  #undef VRD
  #undef KRD
  #undef STEP
  #undef ENDW
  {auto rr=__builtin_amdgcn_permlane32_swap(__float_as_uint(l_reg),__float_as_uint(l_reg),false,false);l_reg=__uint_as_float(rr[0])+__uint_as_float(rr[1]);}
  if(hi==0)wsf[32+r32]=l_reg;asm volatile("s_waitcnt lgkmcnt(0)":::"memory");
  float rli[16];
  #pragma unroll
  for(int r=0;r<16;++r)rli[r]=__builtin_amdgcn_rcpf(wsf[32+crow(r,hi)]);
  bf16_t*Ow=Y+(rowbase+q0+wid*QBLK)*YW+512+h*64;
  { LAS bf16_t*stg=(LAS bf16_t*)(shm+LDS_OST)+wid*2048;
    #pragma unroll
    for(int r=0;r<16;++r){const int orow=crow(r,hi);
      #pragma unroll
      for(int d0=0;d0<2;++d0)stg[orow*64+d0*32+r32]=f2bf(o[d0][r]*rli[r]);}
    asm volatile("s_waitcnt lgkmcnt(0)":::"memory");
    #pragma unroll
    for(int i=0;i<4;++i){const int row=i*8+(lane>>3),ch=lane&7; const u32x4 v=*(LAS const u32x4*)(stg+row*64+ch*8); *(u32x4*)(Ow+(long)row*YW+ch*8)=v;} }
  asm volatile("s_waitcnt lgkmcnt(0)\n\ts_barrier":::"memory");
  #undef DMA_K
  #undef DMA_V
  #undef CMASK
  #undef BLKM
  #undef START
  #undef RESC
  #undef ROT
}

#undef SBAR
#undef WAIT_BAR
}

namespace gla {
constexpr int PB = 144, PV = 272;
constexpr int L_LAR = 0, L_QR = 9216, L_KR = 18432, L_VR = 27648, L_RR = 45056, L_QD = 62464, L_KD = 71680, L_KTL = 80896, L_AM = 90112, L_DEC = 99328, L_SSQ = 99584, L_Y = 101632, L_END = 119040;
__device__ __forceinline__ f32x4 mfma16(bf16x8 a, bf16x8 b, f32x4 c) { return __builtin_amdgcn_mfma_f32_16x16x32_bf16(a, b, c, 0, 0, 0); }
__device__ __forceinline__ s16x4 trd(LAS const unsigned char* p) { return __builtin_bit_cast(s16x4, __builtin_amdgcn_ds_read_tr16_b64_v4i16((LAS v4i16_t*)p)); }
__device__ __forceinline__ bf16x8 tr_frag(LAS const unsigned char* img, int pitch, int k0, int c0, int lane) {
    const int g = lane >> 4, q = (lane & 15) >> 2, p = lane & 3;
    LAS const unsigned char* a = img + (k0 + 8 * g + q) * pitch + (c0 + 4 * p) * 2;
    const s16x4 lo = trd(a), hi = trd(a + 4 * pitch);
    return (bf16x8){lo[0], lo[1], lo[2], lo[3], hi[0], hi[1], hi[2], hi[3]};
}

template <int VAR = 0> __device__ __forceinline__ void gla_unit(const bf16_t* proj, bf16_t* Y, int b, int h, const float* gnorm, LAS unsigned char* lds) {
    int tid_ = threadIdx.x; asm volatile("" : "+v"(tid_));
    const int tid = tid_, lane = tid & 63, fr = lane & 15, fq = lane >> 4; const int wid = __builtin_amdgcn_readfirstlane(tid >> 6);
    const long rowbase = (long)b * SEQ;
    const int cq = 2304 + 64 * h, ck = 2560 + 64 * h, cv = 2816 + 128 * h, cla = 3328 + 64 * h, cr = 3584 + 128 * h;
    const int lt = tid >> 3, ldc = (tid & 7) * 8;
    const int vrow0 = tid >> 4, ve0 = (tid & 15) * 8;
    f32x4 sd[4];
#pragma unroll
    for (int i = 0; i < 4; ++i) sd[i] = (f32x4){0.f, 0.f, 0.f, 0.f};
    const f32x4 gn4 = *(const f32x4*)(gnorm + 16 * wid + 4 * fq);
    u32x4 nq, nk, nla, nv0, nv1, nr0, nr1;
    {
        const bf16_t* base = proj + (rowbase + lt) * PP;
        nq = *(const u32x4*)(base + cq + ldc); nk = *(const u32x4*)(base + ck + ldc); nla = *(const u32x4*)(base + cla + ldc);
        const bf16_t* bv = proj + (rowbase + vrow0) * PP;
        nv0 = *(const u32x4*)(bv + cv + ve0); nv1 = *(const u32x4*)(bv + (size_t)32 * PP + cv + ve0);
        nr0 = *(const u32x4*)(bv + cr + ve0); nr1 = *(const u32x4*)(bv + (size_t)32 * PP + cr + ve0);
    }
    LAS float* DEC = (LAS float*)(lds + L_DEC); LAS float* SSQ = (LAS float*)(lds + L_SSQ);
    const int db = wid & 3, ibp = wid >> 2;
    for (int n = 0; n < 32; ++n) {
        *(LAS u32x4*)(lds + L_LAR + lt * PB + ldc * 2) = nla; *(LAS u32x4*)(lds + L_QR + lt * PB + ldc * 2) = nq; *(LAS u32x4*)(lds + L_KR + lt * PB + ldc * 2) = nk;
        *(LAS u32x4*)(lds + L_VR + vrow0 * PV + ve0 * 2) = nv0; *(LAS u32x4*)(lds + L_VR + (vrow0 + 32) * PV + ve0 * 2) = nv1;
        const int rro = (n & 1) ? L_Y : L_RR;
        *(LAS u32x4*)(lds + rro + vrow0 * PV + ve0 * 2) = nr0; *(LAS u32x4*)(lds + rro + (vrow0 + 32) * PV + ve0 * 2) = nr1;
        if (n + 1 < 32) {
            const long r1 = rowbase + (long)(n + 1) * 64;
            const bf16_t* base = proj + (r1 + lt) * PP;
            nq = *(const u32x4*)(base + cq + ldc); nk = *(const u32x4*)(base + ck + ldc); nla = *(const u32x4*)(base + cla + ldc);
            const bf16_t* bv = proj + (r1 + vrow0) * PP;
            nv0 = *(const u32x4*)(bv + cv + ve0); nv1 = *(const u32x4*)(bv + (size_t)32 * PP + cv + ve0);
            nr0 = *(const u32x4*)(bv + cr + ve0); nr1 = *(const u32x4*)(bv + (size_t)32 * PP + cr + ve0);
        }
        LDS_WAIT(); __builtin_amdgcn_s_barrier(); asm volatile("" ::: "memory");
        {
            bf16x8 af[2];
#pragma unroll
            for (int s = 0; s < 2; ++s) af[s] = tr_frag(lds + L_LAR, PB, 32 * s, 16 * db, lane);
            const u32x4 one4 = {0x3F803F80u, 0x3F803F80u, 0x3F803F80u, 0x3F803F80u};
            f32x4 bl = {0.f, 0.f, 0.f, 0.f};
            bl = mfma16(af[0], __builtin_bit_cast(bf16x8, one4), bl); bl = mfma16(af[1], __builtin_bit_cast(bf16x8, one4), bl);
#pragma unroll
            for (int rep = 0; rep < 2; ++rep) {
                const int ib = 2 * ibp + rep, i_ = 16 * ib + fr;
                f32x4 bc = {0.f, 0.f, 0.f, 0.f};
#pragma unroll
                for (int s = 0; s < 2; ++s) {
                    const int nones = i_ - (32 * s + 8 * fq) + 1;
                    u32x4 lw;
                    lw.x = (nones > 0 ? 0x3F80u : 0u) | (nones > 1 ? 0x3F800000u : 0u); lw.y = (nones > 2 ? 0x3F80u : 0u) | (nones > 3 ? 0x3F800000u : 0u);
                    lw.z = (nones > 4 ? 0x3F80u : 0u) | (nones > 5 ? 0x3F800000u : 0u); lw.w = (nones > 6 ? 0x3F80u : 0u) | (nones > 7 ? 0x3F800000u : 0u);
                    bc = mfma16(af[s], __builtin_bit_cast(bf16x8, lw), bc);
                }
                const int off = i_ * PB + (16 * db + 4 * fq) * 2;
                const u32x2 qw = *(LAS const u32x2*)(lds + L_QR + off), kw = *(LAS const u32x2*)(lds + L_KR + off);
                const float q4[4] = {bf_lo(qw.x), bf_hi(qw.x), bf_lo(qw.y), bf_hi(qw.y)}, k4[4] = {bf_lo(kw.x), bf_hi(kw.x), bf_lo(kw.y), bf_hi(kw.y)};
                float qd[4], kd[4], kt[4];
#pragma unroll
                for (int r = 0; r < 4; ++r) { qd[r] = q4[r] * fexp(bc[r]); kd[r] = k4[r] * fexp(-bc[r]); kt[r] = k4[r] * fexp(bl[r] - bc[r]); }
                *(LAS u32x2*)(lds + L_QD + off) = (u32x2){cvt_pk_bf16(qd[0], qd[1]), cvt_pk_bf16(qd[2], qd[3])};
                *(LAS u32x2*)(lds + L_KD + off) = (u32x2){cvt_pk_bf16(kd[0], kd[1]), cvt_pk_bf16(kd[2], kd[3])};
                *(LAS u32x2*)(lds + L_KTL + off) = (u32x2){cvt_pk_bf16(kt[0], kt[1]), cvt_pk_bf16(kt[2], kt[3])};
            }
            if (ibp == 0 && fr == 0) *(LAS f32x4*)(DEC + 16 * db + 4 * fq) = (f32x4){fexp(bl[0]), fexp(bl[1]), fexp(bl[2]), fexp(bl[3])};
        }
        LDS_WAIT(); __builtin_amdgcn_s_barrier(); asm volatile("" ::: "memory");
#pragma unroll
        for (int rep = 0; rep < 2; ++rep) {
            const int id = wid + 8 * rep, ib = id >> 2, jb = id & 3;
            u32x2 w = {0u, 0u};
            if (jb <= ib) {
                f32x4 a = {0.f, 0.f, 0.f, 0.f};
#pragma unroll
                for (int s = 0; s < 2; ++s) {
                    const bf16x8 ka = *(LAS const bf16x8*)(lds + L_KD + (16 * jb + fr) * PB + (32 * s + 8 * fq) * 2);
                    const bf16x8 qb_ = *(LAS const bf16x8*)(lds + L_QD + (16 * ib + fr) * PB + (32 * s + 8 * fq) * 2);
                    a = mfma16(ka, qb_, a);
                }
                const int i_ = 16 * ib + fr, j0 = 16 * jb + 4 * fq;
#pragma unroll
                for (int r = 0; r < 4; ++r) if (j0 + r > i_) a[r] = 0.f;
                w.x = cvt_pk_bf16(a[0], a[1]); w.y = cvt_pk_bf16(a[2], a[3]);
            }
            *(LAS u32x2*)(lds + L_AM + (16 * ib + fr) * PB + (16 * jb + 4 * fq) * 2) = w;
        }
        f32x4 ao[4];
        {
            bf16x8 sb[2];
#pragma unroll
            for (int s = 0; s < 2; ++s) { u32x4 w; w.x = cvt_pk_bf16(sd[2 * s][0], sd[2 * s][1]); w.y = cvt_pk_bf16(sd[2 * s][2], sd[2 * s][3]); w.z = cvt_pk_bf16(sd[2 * s + 1][0], sd[2 * s + 1][1]); w.w = cvt_pk_bf16(sd[2 * s + 1][2], sd[2 * s + 1][3]); sb[s] = __builtin_bit_cast(bf16x8, w); }
#pragma unroll
            for (int ib = 0; ib < 4; ++ib) {
                f32x4 a = {0.f, 0.f, 0.f, 0.f};
#pragma unroll
                for (int s = 0; s < 2; ++s) {
                    const u32x2 lo = *(LAS const u32x2*)(lds + L_QD + (16 * ib + fr) * PB + (32 * s + 4 * fq) * 2);
                    const u32x2 hi = *(LAS const u32x2*)(lds + L_QD + (16 * ib + fr) * PB + (32 * s + 16 + 4 * fq) * 2);
                    const u32x4 qa = {lo.x, lo.y, hi.x, hi.y};
                    a = mfma16(sb[s], __builtin_bit_cast(bf16x8, qa), a);
                }
                ao[ib] = a;
            }
        }
        LDS_WAIT(); __builtin_amdgcn_s_barrier(); asm volatile("" ::: "memory");
        {
            bf16x8 vf[2];
#pragma unroll
            for (int s = 0; s < 2; ++s) vf[s] = tr_frag(lds + L_VR, PV, 32 * s, 16 * wid, lane);
#pragma unroll
            for (int ib = 0; ib < 4; ++ib)
#pragma unroll
                for (int s = 0; s < 2; ++s) {
                    if (32 * s > 16 * ib + 15) continue;
                    const bf16x8 af = *(LAS const bf16x8*)(lds + L_AM + (16 * ib + fr) * PB + (32 * s + 8 * fq) * 2);
                    ao[ib] = mfma16(vf[s], af, ao[ib]);
                }
#pragma unroll
            for (int d4 = 0; d4 < 4; ++d4) {
                const f32x4 dc = *(LAS const f32x4*)(DEC + 16 * d4 + 4 * fq);
                f32x4 a = sd[d4] * dc;
#pragma unroll
                for (int s = 0; s < 2; ++s) { const bf16x8 kf = tr_frag(lds + L_KTL, PB, 32 * s, 16 * d4, lane); a = mfma16(kf, vf[s], a); }
                sd[d4] = a;
            }
        }
#pragma unroll
        for (int ib = 0; ib < 4; ++ib) { float v = (ao[ib][0] * ao[ib][0] + ao[ib][1] * ao[ib][1]) + (ao[ib][2] * ao[ib][2] + ao[ib][3] * ao[ib][3]); v = addx32(addx16(v));
            if (fq == 0) SSQ[(16 * ib + fr) * 8 + wid] = v; }
        LDS_WAIT(); __builtin_amdgcn_s_barrier(); asm volatile("" ::: "memory");
        {
            const long r0 = rowbase + (long)n * 64;
#pragma unroll
            for (int ib = 0; ib < 4; ++ib) { const int i_ = 16 * ib + fr;
                const f32x4 s0 = *(LAS const f32x4*)(SSQ + i_ * 8), s1 = *(LAS const f32x4*)(SSQ + i_ * 8 + 4);
                const float tot = ((s0[0] + s0[1]) + (s0[2] + s0[3])) + ((s1[0] + s1[1]) + (s1[2] + s1[3]));
                const float rstd = frsq(tot * (1.0f / 128.0f) + EPS);
                const u32x2 rw = *(LAS const u32x2*)(lds + rro + i_ * PV + (16 * wid + 4 * fq) * 2);
                const f32x4 y = ao[ib] * rstd * gn4 * (f32x4){bf_lo(rw.x), bf_hi(rw.x), bf_lo(rw.y), bf_hi(rw.y)};
                *(u32x2*)(Y + (r0 + i_) * YW + 1024 + 128 * h + 16 * wid + 4 * fq) = (u32x2){cvt_pk_bf16(y[0], y[1]), cvt_pk_bf16(y[2], y[3])}; }
        }
    }
    LDS_WAIT(); __builtin_amdgcn_s_barrier(); asm volatile("" ::: "memory");
}
}

constexpr int NWAVES = 8;
constexpr int RING_BYTES = 131072, MISC_OFF = RING_BYTES, LDS_BYTES = 147456;
static_assert(gla::L_END <= RING_BYTES && att::L_END <= RING_BYTES && att2::LDS_BYTES <= RING_BYTES, "LDS map");

struct Params { const float* in[20]; float* out; unsigned char* ws; double invf[32]; int ph_lo, ph_hi; };

__device__ __forceinline__ void norm_row(const float* xrow, const float* gain, bf16_t* orow, int lane) {
    const f32x4* xr = (const f32x4*)xrow + lane; const f32x4* gr = (const f32x4*)gain + lane;
    f32x4 v[4]; float s = 0.f;
#pragma unroll
    for (int j = 0; j < 4; ++j) { v[j] = xr[64 * j]; s += (v[j][0] * v[j][0] + v[j][1] * v[j][1]) + (v[j][2] * v[j][2] + v[j][3] * v[j][3]); }
    const float rstd = 1.0f / sqrtf(wave_sum(s) * (1.0f / D) + EPS);
    u32x2* o8 = (u32x2*)orow + lane;
#pragma unroll
    for (int j = 0; j < 4; ++j) { const f32x4 g = gr[64 * j]; u32x2 w; w.x = cvt_pk_bf16(v[j][0] * rstd * g[0], v[j][1] * rstd * g[1]); w.y = cvt_pk_bf16(v[j][2] * rstd * g[2], v[j][3] * rstd * g[3]); o8[64 * j] = w; }
}
__device__ __forceinline__ void norm_phase(const float* x, const float* gain, bf16_t* H, int gw, int ngw, int lane) {
    for (int m = gw; m < T; m += ngw) norm_row(x + (size_t)m * D, gain, H + (size_t)m * D, lane);
}

__device__ __forceinline__ void conv_item(const float* src, int pitch, int col, int K, bf16_t* dst, int prow, int k0, const float* kscale = nullptr) {
    const float* s = src + (size_t)k0 * pitch + col;
    bf16_t* d = dst + (size_t)prow * K + k0;
#pragma unroll 2
    for (int kk = 0; kk < 8; ++kk) {
        float v[8];
#pragma unroll
        for (int i = 0; i < 8; ++i) v[i] = s[(size_t)(kk * 8 + i) * pitch];
        if (kscale) {
#pragma unroll
            for (int i = 0; i < 8; ++i) v[i] *= kscale[k0 + kk * 8 + i]; }
        u32x4 w; w.x = cvt_pk_bf16(v[0], v[1]); w.y = cvt_pk_bf16(v[2], v[3]); w.z = cvt_pk_bf16(v[4], v[5]); w.w = cvt_pk_bf16(v[6], v[7]);
        *(u32x4*)(d + kk * 8) = w;
    }
}
constexpr int IT_WIN = (PW / 64) * (D / 64), IT_WG = (GW / 64) * (D / 64), IT_WB = 3 * (D / 64) * (512 / 64), IT_WO = (D / 64) * (D / 64), IT_F1 = (FFP / 64) * (D / 64), IT_F2 = (D / 64) * (FF / 64);
constexpr int IT_LAYER = IT_WIN + IT_WG + IT_WB + IT_WO + IT_F1 + IT_F2;

__device__ __forceinline__ void sincos_d(double a, float& c, float& s) {
    const double kq = rint(a * 0.63661977236758134308);
    double r = fma(-kq, 1.57079632679489655800e+00, a); r = fma(-kq, 6.12323399573676603587e-17, r);
    const double r2 = r * r;
    const double sp = r * (1.0 + r2 * (-1.0 / 6 + r2 * (1.0 / 120 + r2 * (-1.0 / 5040 + r2 * (1.0 / 362880 + r2 * (-1.0 / 39916800 + r2 * (1.0 / 6227020800.0)))))));
    const double cp = 1.0 + r2 * (-0.5 + r2 * (1.0 / 24 + r2 * (-1.0 / 720 + r2 * (1.0 / 40320 + r2 * (-1.0 / 3628800 + r2 * (1.0 / 479001600 + r2 * (-1.0 / 87178291200.0)))))));
    const int q = ((int)kq) & 3;
    const double ss = (q == 0) ? sp : (q == 1) ? cp : (q == 2) ? -sp : -cp;
    const double cc = (q == 0) ? cp : (q == 1) ? -sp : (q == 2) ? -cp : sp;
    c = (float)cc; s = (float)ss;
}

__device__ __forceinline__ void prologue(const Params& P, int gw, int ngw, int lane) {
    unsigned char* ws = P.ws;
    for (int rep = 0; rep < (DBG_DUP == 4 ? 2 : 1); ++rep)
    for (int it = gw; it < 2 * IT_LAYER; it += ngw) {
        const int l = it / IT_LAYER; int r = it - l * IT_LAYER;
        unsigned char* wl = ws + WS_W + (size_t)l * LW_BYTES;
        if (r < IT_WIN) {
            const int rb = r / (D / 64), kb = r % (D / 64), p = rb * 64 + lane, k0 = kb * 64;
            const int pn = p >> 8, bj = (p >> 7) & 1, wc = (p >> 5) & 3, rem = p & 31, c = 256 * pn + 64 * wc + 32 * bj + rem;
            const float* win = P.in[3] + (size_t)l * D * DIN;
            bf16_t* dst = (bf16_t*)(wl + OFF_WIN);
            const float* ga = P.in[2] + (size_t)l * D;
            if (c < 3328) conv_item(win, DIN, c, D, dst, p, k0, ga);
            else if (c >= 3584) conv_item(win, DIN, 3344 + (c - 3584), D, dst, p, k0, ga);
            else {
                const float* wa = P.in[9] + (size_t)l * 16 * 256 + (c - 3328);
                float a[16];
#pragma unroll
                for (int q = 0; q < 16; ++q) a[q] = wa[q * 256];
                for (int kk = 0; kk < 8; ++kk) {
                    float v[8];
#pragma unroll
                    for (int i = 0; i < 8; ++i) { const float* wr_ = win + (size_t)(k0 + kk * 8 + i) * DIN + 3328; float acc = 0.f;
#pragma unroll
                        for (int q = 0; q < 16; ++q) acc += wr_[q] * a[q];
                        v[i] = acc * ga[k0 + kk * 8 + i]; }
                    u32x4 w; w.x = cvt_pk_bf16(v[0], v[1]); w.y = cvt_pk_bf16(v[2], v[3]); w.z = cvt_pk_bf16(v[4], v[5]); w.w = cvt_pk_bf16(v[6], v[7]);
                    *(u32x4*)(dst + (size_t)p * D + k0 + kk * 8) = w;
                }
            }
            continue;
        }
        r -= IT_WIN;
        if (r < IT_WG) {
            const int rb = r / (D / 64), kb = r % (D / 64), p = rb * 64 + lane, k0 = kb * 64;
            const float* sp = P.in[3] + (size_t)l * D * DIN + (size_t)k0 * DIN + 3856 + p; const float* ga = P.in[2] + (size_t)l * D + k0;
            unsigned char* d8 = wl + OFF_WG + (size_t)p * D + k0;
#pragma unroll 2
            for (int kk = 0; kk < 4; ++kk) { float v[16];
#pragma unroll
                for (int i = 0; i < 16; ++i) v[i] = sp[(size_t)(kk * 16 + i) * DIN] * ga[kk * 16 + i] * WS8;
                *(u32x4*)(d8 + kk * 16) = (u32x4){cvt4_fp8(v[0], v[1], v[2], v[3]), cvt4_fp8(v[4], v[5], v[6], v[7]), cvt4_fp8(v[8], v[9], v[10], v[11]), cvt4_fp8(v[12], v[13], v[14], v[15])}; }
            continue; }
        r -= IT_WG;
        if (r < IT_WB) { const int j = r / ((D / 64) * 8), r2 = r % ((D / 64) * 8), rb = r2 / 8, kb = r2 % 8, p = rb * 64 + lane;
            conv_item(P.in[12 + j] + (size_t)l * 512 * D, D, p, 512, (bf16_t*)(wl + OFF_WB) + (size_t)j * D * 512, p, kb * 64); continue; }
        r -= IT_WB;
        if (r < IT_WO) { const int rb = r / (D / 64), kb = r % (D / 64), p = rb * 64 + lane; conv_item(P.in[15] + (size_t)l * D * D, D, p, D, (bf16_t*)(wl + OFF_WO), p, kb * 64); continue; }
        r -= IT_WO;
        if (r < IT_F1) { const int rb = r / (D / 64), kb = r % (D / 64), p = rb * 64 + lane; const int pn = p >> 8, bj = (p >> 7) & 1, c = 128 * pn + (p & 127);
            conv_item(P.in[bj ? 18 : 17] + (size_t)l * D * FF, FF, c, D, (bf16_t*)(wl + OFF_F1), p, kb * 64, P.in[16] + (size_t)l * D); continue; }
        r -= IT_F1;
        { const int rb = r / (FF / 64), kb = r % (FF / 64), p = rb * 64 + lane; conv_item(P.in[19] + (size_t)l * FF * D, D, p, FF, (bf16_t*)(wl + OFF_F2), p, kb * 64); }
    }
    {
        bf16_t* rope = (bf16_t*)(ws + WS_ROPE); const int* pos = (const int*)P.in[1];
        for (int idx = gw * 64 + lane; idx < T * 32; idx += ngw * 64) { const int t = idx >> 5, i = idx & 31; float c, s; sincos_d((double)pos[t] * P.invf[i], c, s); rope[(size_t)t * 64 + i] = f2bf(c); rope[(size_t)t * 64 + 32 + i] = f2bf(s); }
    }
    {
        float* SS = (float*)(ws + WS_SS); bf16_t* XB = (bf16_t*)P.out;
        for (int m = gw; m < T; m += ngw) {
            const f32x4* xr = (const f32x4*)(P.in[0] + (size_t)m * D) + lane; u32x2* o8 = (u32x2*)(XB + (size_t)m * D) + lane; float s2 = 0.f;
#pragma unroll
            for (int j = 0; j < 4; ++j) { const f32x4 v = xr[64 * j]; s2 += (v[0] * v[0] + v[1] * v[1]) + (v[2] * v[2] + v[3] * v[3]); u32x2 w; w.x = cvt_pk_bf16(v[0], v[1]); w.y = cvt_pk_bf16(v[2], v[3]); o8[64 * j] = w;
                ((unsigned*)(ws + WS_XB8 + (size_t)m * D))[lane + 64 * j] = cvt4_fp8(v[0] * XS8, v[1] * XS8, v[2] * XS8, v[3] * XS8); }
            s2 = wave_sum(s2);
            if (lane == 0) SS[m] = s2;
        }
        for (int idx = gw * 64 + lane; idx < 3 * T; idx += ngw * 64) SS[T + idx] = 0.f;
    }
}

constexpr int Q_GLA = 8, Q_MOBA = 128, Q_SWA = 128;

__global__ void __launch_bounds__(NWAVES * 64, 2) mk_fwd(Params P) {
    extern __shared__ __attribute__((aligned(16))) unsigned char lds_raw[];
    LAS unsigned char* lds = (LAS unsigned char*)lds_raw;
    volatile LAS unsigned* MISC = (volatile LAS unsigned*)(lds + MISC_OFF);
    const int tid = threadIdx.x, lane = tid & 63, wave = __builtin_amdgcn_readfirstlane(tid >> 6);
    const int G = gridDim.x, bx = blockIdx.x;
    const int vcu = (G % 8 == 0) ? (bx % 8) * (G / 8) + bx / 8 : bx;
    const int gw = vcu * NWAVES + wave, ngw = G * NWAVES;
    unsigned char* ws = P.ws;
    unsigned* ctl = (unsigned*)(ws + WS_CTL);
    for (int u = tid; u < 64; u += NWAVES * 64) MISC[u] = 0u;
    __syncthreads();
    XcdBarrier bar; bar.bar = ctl + CW_BAR; bar.x = 0; bar.st = nullptr;
    if (!MK_PER_PHASE) bar = xcd_barrier_post(ctl + CW_BAR, MISC + 8);
    if (!MK_PER_PHASE && tid == 0) (void)__hip_atomic_fetch_or(ctl + CW_GMASK + 64 * (bx & 7), 1u << xb_xcc_id(), __ATOMIC_RELAXED, __HIP_MEMORY_SCOPE_AGENT);
    const int lo = P.ph_lo, hi = P.ph_hi;
    int fastg = 0; unsigned gbn = 0u;
#define IN(k) (lo <= (k) && (k) < hi)
#define SEAM(k) do { if (IN(k) && IN((k) + 1)) xcd_barrier(bar); } while (0)
#define SEAMG(k) do { if (IN(k) && IN((k) + 1)) { if (fastg) { ++gbn; grp_barrier(ctl + CW_GRP + 64 * (bx & 7), gbn * (unsigned)(G / 8), ctl + CW_BAR); } else xcd_barrier(bar); } } while (0)

#define Hb ((bf16_t*)(ws + WS_H + (size_t)grp * SH_H))
#define PROJ ((bf16_t*)(ws + WS_PROJ))
#define GATES ((bf16_t*)(ws + WS_PROJ + (size_t)grp * SH_GATES))
#define MERGED ((bf16_t*)(ws + WS_PROJ + OFF_MERGED_IN_SLAB + (size_t)grp * SH_MERGED))
#define ACT ((bf16_t*)(ws + WS_PROJ + (size_t)grp * SH_ACT))
#define Yb ((bf16_t*)(ws + WS_Y))
#define rope ((bf16_t*)(ws + WS_ROPE))
#define kmp ((float*)(ws + WS_KM))
#define SS ((float*)(ws + WS_SS))

    #ifndef DBG_NO_PRO
    if (IN(1)) { prologue(P, gw, ngw, lane); }
#endif
    SEAM(1);
    if (!MK_PER_PHASE && IN(1) && IN(2)) {
        if (tid == 0) { unsigned ok = (G % 8 == 0) ? 1u : 0u;
            for (int j = 0; j < 8; ++j) { const unsigned m = xb_ld(ctl + CW_GMASK + 64 * j); ok &= (m != 0u && (m & (m - 1u)) == 0u) ? 1u : 0u; }
            MISC[20] = ok; }
        __syncthreads();
        fastg = __builtin_amdgcn_readfirstlane((int)MISC[20]);
    }
    for (int l = 0; l < DEPTH; ++l) {
        const int pb = 9 * l;
        unsigned char* ws = P.ws; asm volatile("" : "+s"(ws));
        int lane_l = lane; asm volatile("" : "+v"(lane_l));
        int bxl = blockIdx.x; asm volatile("" : "+s"(bxl));
        const int grp = bxl & 7;
        const float* xin = (l == 0) ? P.in[0] : P.out;
        unsigned char* wl = ws + WS_W + (size_t)l * LW_BYTES;
        if (IN(2 + pb)) for (int rep = 0; rep < (DBG_DUP == 2 ? 2 : 1); ++rep) {
            if (rep) xcd_barrier(bar);
            pg8::Gemm g{(const bf16_t*)P.out, (const bf16_t*)(wl + OFF_WIN), D, D, D, 0, 0, nullptr, nullptr, 0, 0, 0, 0, 0, 1 << 30}; pg8::TileOrderBal S; S.init(T, PW, G, bxl, 1);
            pg8::EpiInProj E{PROJ, rope, P.in[4] + l * 64, P.in[5] + l * 64, P.in[7] + l * 64, P.in[8] + l * 64, P.in[10] + l * 256, kmp, SS + (size_t)(2 * l) * T};
#ifndef DBG_NO_EPIINPROJ
            pg8::gemm_phase<pg8::EpiInProj, false, pg8::TileOrderBal>(lds, g, S, E, 0);
#endif
        }
        SEAMG(2 + pb);
        if (IN(3 + pb)) {
            unsigned* qctr = ctl + CW_Q + 256 * (8 * l + grp);
            int it = 0;
            for (;; ++it) {
                if (tid == 0) MISC[16 + (it & 1)] = __hip_atomic_fetch_add(qctr, 1u, __ATOMIC_RELAXED, __HIP_MEMORY_SCOPE_AGENT);
                __syncthreads();
                const int id = (int)MISC[16 + (it & 1)];
                if (id >= Q_GLA) break;
                gla::gla_unit(PROJ, Yb, 2 * grp + (id >> 2), id & 3, P.in[11] + l * 128, lds);
            }
            ++it;
            for (;; ++it) {
                if (tid == 0) MISC[16 + (it & 1)] = __hip_atomic_fetch_add(qctr + 64, 1u, __ATOMIC_RELAXED, __HIP_MEMORY_SCOPE_AGENT);
                __syncthreads();
                const int m = (int)MISC[16 + (it & 1)];
                if (m >= Q_MOBA) break;
                att2::moba_unit<8>(2 * grp + ((m >> 3) & 1), m & 7, 7 - (m >> 4), PROJ, Yb, kmp, lds);
            }
            ++it;
            for (;; ++it) {
                if (tid == 0) MISC[16 + (it & 1)] = __hip_atomic_fetch_add(qctr + 128, 1u, __ATOMIC_RELAXED, __HIP_MEMORY_SCOPE_AGENT);
                __syncthreads();
                const int sidx = (int)MISC[16 + (it & 1)];
                if (sidx >= Q_SWA) break;
                att::attn_unit<0>(PROJ, Yb, 2 * grp + (sidx >> 6), (sidx >> 5) & 1, sidx & 31, P.in[6] + l * 8, nullptr, lds);
            }
        }
        SEAMG(3 + pb);
        if (IN(4 + pb)) {
            pg8::TileOrder S0; S0.init(T, D, G, bxl, 1);
            for (int ti = 0;; ++ti) {
                pg8::Unit u0; if (!S0.next(ti, u0)) break;
                { pg8::Gemm g{(const bf16_t*)(ws + WS_XB8), (const bf16_t*)(wl + OFF_WG), D / 2, D / 2, D / 2, 0, 0, nullptr, nullptr, 0, 0, 0, 0, 0, 1 << 30}; pg8::GateTriple S{u0.pm, u0.pn};
                  pg8::EpiGatesT<false> E{GATES, 0, SS + (size_t)(2 * l) * T, 0, 1.0f / (XS8 * WS8)};
                  pg8::gemm_phase<pg8::EpiGatesT<false>, false, pg8::GateTriple, true>(lds, g, S, E, 0); }
                { pg8::Gemm g{Yb, (const bf16_t*)(wl + OFF_WB), 512, YW, 512, 512, (long)D * 512, nullptr, nullptr, 0, 0, 0, 0, 0, 1 << 30}; pg8::SubTriple S{u0.pm, u0.pn};
                  pg8::EpiMerge E{GATES, MERGED};
                  pg8::gemm_phase<pg8::EpiMerge, false, pg8::SubTriple>(lds, g, S, E, 0); }
            }
        }
        SEAMG(4 + pb);
        if (IN(6 + pb)) for (int rep = 0; rep < ((DBG_DUP == 13 && l == 0) ? 2 : 1); ++rep) {
            if (rep) xcd_barrier(bar);
            pg8::Gemm g{MERGED, (const bf16_t*)(wl + OFF_WO), D, D, D, 0, 0, nullptr, nullptr, 0, 0, 0, 0, 0, 1 << 30}; pg8::TileOrder S; S.init(T, D, G, bxl, 1);
            pg8::EpiResid E{(const bf16_t*)P.out, nullptr, Hb, SS + (size_t)(2 * l + 1) * T, nullptr};
#ifndef DBG_NO_RESID
            pg8::gemm_phase<pg8::EpiResid>(lds, g, S, E, ((bxl >> 3) & 3) * STG_F);
#endif
        }
        SEAMG(6 + pb);
        if (DBG_DUP == 5) { for (int rep = 0; rep < 8; ++rep) xcd_barrier(bar); }
        if (IN(8 + pb)) for (int rep = 0; rep < (DBG_DUP == 6 ? 2 : 1); ++rep) {
            if (rep) xcd_barrier(bar);
            pg8::Gemm g{Hb, (const bf16_t*)(wl + OFF_F1), D, D, D, 0, 0, nullptr, nullptr, 0, 0, 0, 0, 0, 1 << 30}; pg8::TileOrder S; S.init(T, FFP, G, bxl, 1);
            pg8::EpiFfn1 E{ACT, SS + (size_t)(2 * l + 1) * T};
#ifndef DBG_NO_EPIFFN1
            pg8::gemm_phase<pg8::EpiFfn1>(lds, g, S, E, ((bxl >> 3) & 3) * STG_B);
#endif
        }
        if (l + 1 < DEPTH) SEAMG(8 + pb); else SEAM(8 + pb);
        if (IN(9 + pb)) {
            pg8::Gemm g{ACT, (const bf16_t*)(wl + OFF_F2), FF, FF, FF, 0, 0, nullptr, nullptr, 0, 0, 0, 0, 0, 1 << 30}; pg8::TileOrder S; S.init(T, D, G, bxl, 1);
            pg8::EpiResid E{(const bf16_t*)Hb, (l + 1 < DEPTH) ? nullptr : P.out, (l + 1 < DEPTH) ? (bf16_t*)P.out : nullptr, (l + 1 < DEPTH) ? SS + (size_t)(2 * l + 2) * T : nullptr, (l + 1 < DEPTH) ? ws + WS_XB8 : nullptr};
#ifndef DBG_NO_RESID
            pg8::gemm_phase<pg8::EpiResid>(lds, g, S, E, ((bxl >> 3) & 3) * STG_F);
#endif
        }
        SEAMG(9 + pb);
    }
#undef IN
#undef SEAM
#undef SEAMG
#undef Hb
#undef PROJ
#undef GATES
#undef MERGED
#undef ACT
#undef Yb
#undef rope
#undef kmp
#undef SS
}

extern "C" void kernel_launch(void* const* d_in, const int* in_sizes, int n_in, void* d_out, int out_size, void* d_ws, size_t ws_size, hipStream_t stream) {
    static int grid = 0;
    if (grid == 0) {
        if (n_in != 20 || out_size != T * D || ws_size < WS_END) { fprintf(stderr, "kernel_launch: unexpected problem (n_in %d, out %d, ws %zu < %zu)\n", n_in, out_size, ws_size, (size_t)WS_END); grid = -1; return; }
        int dev = 0, cus = 0;
        if (hipGetDevice(&dev) != hipSuccess || hipDeviceGetAttribute(&cus, hipDeviceAttributeMultiprocessorCount, dev) != hipSuccess) { grid = -1; return; }
        if (hipFuncSetAttribute((const void*)mk_fwd, hipFuncAttributeMaxDynamicSharedMemorySize, LDS_BYTES) != hipSuccess) { fprintf(stderr, "kernel_launch: hipFuncSetAttribute failed\n"); grid = -1; return; }
        int per_cu = 0;
        if (hipOccupancyMaxActiveBlocksPerMultiprocessor(&per_cu, (const void*)mk_fwd, NWAVES * 64, LDS_BYTES) != hipSuccess || per_cu < 1) fprintf(stderr, "kernel_launch: occupancy query says %d\n", per_cu);
        (void)hipGetLastError();
        grid = (cus / 8) * 8;
    }
    if (grid < 0) return;
    (void)hipMemsetAsync((char*)d_ws + WS_CTL, 0, CTL_ZERO_BYTES, stream);
    Params p{};
    for (int i = 0; i < 20; ++i) p.in[i] = (const float*)d_in[i];
    p.out = (float*)d_out; p.ws = (unsigned char*)d_ws;
    for (int i = 0; i < 32; ++i) p.invf[i] = std::pow(10000.0, -(double)i / 32.0);
#if MK_PER_PHASE
    for (int k = 1; k <= 18; ++k) { p.ph_lo = k; p.ph_hi = k + 1; hipLaunchKernelGGL(mk_fwd, dim3(grid), dim3(NWAVES * 64), LDS_BYTES, stream, p); }
#else
    p.ph_lo = 1; p.ph_hi = 19;
    hipLaunchKernelGGL(mk_fwd, dim3(grid), dim3(NWAVES * 64), LDS_BYTES, stream, p);
#endif
}
```

```cpp
#include <hip/hip_runtime.h>
#include <cstdint>
#include <cstdio>
#include <cmath>

#ifndef MK_PER_PHASE
#define MK_PER_PHASE 0
#endif

#ifndef DBG_DUP
#define DBG_DUP 0
#endif
#ifndef STG_B
#define STG_B 0
#endif
#ifndef STG_F
#define STG_F 0
#endif
#define GAS __attribute__((address_space(1)))
#define LAS __attribute__((address_space(3)))
typedef unsigned short bf16_t;
typedef short bf16x8 __attribute__((ext_vector_type(8)));
typedef short s16x4 __attribute__((ext_vector_type(4)));
typedef short v4i16_t __attribute__((ext_vector_type(4)));
typedef float f32x2 __attribute__((ext_vector_type(2)));
typedef float f32x4 __attribute__((ext_vector_type(4)));
typedef float f32x16 __attribute__((ext_vector_type(16)));
typedef unsigned u32x2 __attribute__((ext_vector_type(2)));
typedef unsigned u32x4 __attribute__((ext_vector_type(4)));
typedef __bf16 bf16x2_t __attribute__((ext_vector_type(2)));
typedef int v8i_t __attribute__((ext_vector_type(8)));

constexpr int T = 32768, SEQ = 2048, NBATCH = 16, D = 1024, DEPTH = 2;
constexpr int PP = 4096 + 64;
constexpr int PW = 4096;
constexpr int GW = 3072;
constexpr int YW = 1536;
constexpr int FF = 2816, FFP = 5632;
constexpr int DIN = 6928;
constexpr float EPS = 1e-6f;
constexpr float LOG2E = 1.4426950408889634f;
constexpr float C2 = 0.125f * LOG2E;

constexpr size_t MiB = 1u << 20;
constexpr size_t WS_CTL = 0, CTL_ZERO_BYTES = 1 * MiB;
constexpr size_t OFF_WIN = 0, OFF_WG = OFF_WIN + (size_t)PW * D * 2  , OFF_WB = OFF_WG + (size_t)GW * D, OFF_WO = OFF_WB + (size_t)3 * D * 512 * 2,
                 OFF_F1 = OFF_WO + (size_t)D * D * 2, OFF_F2 = OFF_F1 + (size_t)FFP * D * 2, LW_BYTES = OFF_F2 + (size_t)D * FF * 2;
constexpr size_t WS_W = 1 * MiB;
constexpr size_t WS_ROPE = WS_W + 2 * LW_BYTES;
constexpr size_t WS_KM = WS_ROPE + (size_t)T * 64 * 4;
constexpr size_t WS_SS = WS_KM + 512 * 1024;
constexpr size_t WS_H = WS_KM + 1 * MiB;
constexpr size_t WS_PROJ = WS_H + (size_t)T * YW * 2;
constexpr size_t WS_MERGED = WS_PROJ + (size_t)T * GW * 2;
constexpr size_t WS_Y = WS_H;
constexpr size_t WS_XB8 = WS_PROJ + (size_t)T * PP * 2;
constexpr size_t WS_END = WS_XB8 + (size_t)T * D;
static_assert(WS_ROPE % 256 == 0 && WS_END <= 512 * MiB, "workspace map");
constexpr int CW_TMO = 0, CW_BAR = 4096, CW_Q = 16384;
constexpr int CW_GRP = 8192, CW_GMASK = 9216;
constexpr int RPG = T / 8;
constexpr size_t SLAB = (size_t)RPG * PP * 2;
constexpr size_t SH_H = (size_t)RPG * (YW - D) * 2, SH_GATES = SLAB - (size_t)RPG * GW, SH_MERGED = SLAB - (size_t)RPG * D * 2, SH_ACT = SLAB - (size_t)RPG * FF * 2;
constexpr size_t OFF_MERGED_IN_SLAB = (size_t)RPG * GW;
constexpr size_t XSH = (size_t)RPG * D;
static_assert(OFF_MERGED_IN_SLAB + (size_t)RPG * D * 2 <= SLAB && (size_t)RPG * FF * 2 <= SLAB, "group slabs");

__device__ __forceinline__ unsigned cvt_pk_bf16(float lo, float hi) { f32x2 v = {lo, hi}; bf16x2_t b = __builtin_convertvector(v, bf16x2_t); return __builtin_bit_cast(unsigned, b); }
__device__ __forceinline__ float bf_lo(unsigned w) { return __uint_as_float(w << 16); }
__device__ __forceinline__ float bf_hi(unsigned w) { return __uint_as_float(w & 0xffff0000u); }
__device__ __forceinline__ float bf1(bf16_t x) { return __uint_as_float(((unsigned)x) << 16); }
__device__ __forceinline__ bf16_t f2bf(float f) { return (bf16_t)(cvt_pk_bf16(f, 0.f) & 0xffffu); }
__device__ __forceinline__ unsigned cvt4_fp8(float a, float b, float c, float d) { unsigned w = 0; w = __builtin_amdgcn_cvt_pk_fp8_f32(a, b, w, false); w = __builtin_amdgcn_cvt_pk_fp8_f32(c, d, w, true); return w; }
constexpr float XS8 = 16.0f, WS8 = 64.0f;
__device__ __forceinline__ float fexp2(float x) { return __builtin_amdgcn_exp2f(x); }
__device__ __forceinline__ float fexp(float x) { return __builtin_amdgcn_exp2f(x * LOG2E); }
__device__ __forceinline__ float frcp(float x) { return __builtin_amdgcn_rcpf(x); }
__device__ __forceinline__ float frsq(float x) { return __builtin_amdgcn_rsqf(x); }
__device__ __forceinline__ float sigmoidf_(float x) { return frcp(1.f + fexp(-x)); }
template <int CTRL> __device__ __forceinline__ float dpp_f(float v) { return __builtin_bit_cast(float, __builtin_amdgcn_update_dpp(0, __builtin_bit_cast(int, v), CTRL, 0xf, 0xf, true)); }
__device__ __forceinline__ float sum16(float v) { v += dpp_f<0xB1>(v); v += dpp_f<0x4E>(v); v += dpp_f<0x141>(v); v += dpp_f<0x140>(v); return v; }
__device__ __forceinline__ float addx16(float v) { auto r = __builtin_amdgcn_permlane16_swap(__float_as_uint(v), __float_as_uint(v), false, false); return __uint_as_float(r[0]) + __uint_as_float(r[1]); }
__device__ __forceinline__ float addx32(float v) { auto r = __builtin_amdgcn_permlane32_swap(__float_as_uint(v), __float_as_uint(v), false, false); return __uint_as_float(r[0]) + __uint_as_float(r[1]); }
__device__ __forceinline__ float maxx32(float v) { auto r = __builtin_amdgcn_permlane32_swap(__float_as_uint(v), __float_as_uint(v), false, false); return fmaxf(__uint_as_float(r[0]), __uint_as_float(r[1])); }
__device__ __forceinline__ float wave_sum(float v) { return addx32(addx16(sum16(v))); }
#define LDS_WAIT() asm volatile("s_waitcnt lgkmcnt(0)" ::: "memory")
#define VM_WAIT() asm volatile("s_waitcnt vmcnt(0)" ::: "memory")

#define XB_TMO      128
#define XB_XCNT(j)  (256  + 64 * (j))
#define XB_XSUB(j)  (1280 + 64 * (j))
#define XB_XGEN(j)  (2304 + 64 * (j))
#define XB_TOP      3328
#define XB_TOPGEN   3392
#define XCD_BAR_WORDS 3456
#define XB_SPIN_CAP (1u << 18)
__device__ __forceinline__ unsigned xb_ld(unsigned* p)              { return __hip_atomic_load(p, __ATOMIC_RELAXED, __HIP_MEMORY_SCOPE_AGENT); }
__device__ __forceinline__ unsigned xb_add(unsigned* p, unsigned v) { return __hip_atomic_fetch_add(p, v, __ATOMIC_RELAXED, __HIP_MEMORY_SCOPE_AGENT); }
__device__ __forceinline__ unsigned xb_xcc_id() { return (unsigned)__builtin_amdgcn_s_getreg((3 << 11) | 20) & 0xFu; }
#define XB_SPIN(cond, bar) do { unsigned _sp = 0; while (cond) { __builtin_amdgcn_s_sleep(1); \
    if ((++_sp & 255u) == 0u) { if (xb_ld(&(bar)[XB_TMO])) break; if (_sp > XB_SPIN_CAP) { atomicAdd(&(bar)[XB_TMO], 1u); break; } } } } while (0)
struct XcdBarrier { unsigned* bar; unsigned x; volatile LAS unsigned* st; };
__device__ __forceinline__ XcdBarrier xcd_barrier_post(unsigned* bar, volatile LAS unsigned* st) {
    XcdBarrier b; b.bar = bar; b.x = xb_xcc_id(); b.st = st;
    if (threadIdx.x == 0) (void)xb_add(&bar[XB_XCNT(b.x)], 1u);
    return b;
}
__device__ __forceinline__ void xcd_barrier_complete(unsigned* bar, unsigned x, unsigned& nloc, unsigned& nx) {
    const unsigned G = gridDim.x * gridDim.y * gridDim.z;
    unsigned sum, cnt, mine, sp = 0u;
    for (;;) {
        sum = 0u; cnt = 0u; mine = 0u;
#pragma unroll
        for (unsigned j = 0; j < 16; ++j) { const unsigned c = xb_ld(&bar[XB_XCNT(j)]); sum += c; cnt += (c > 0u) ? 1u : 0u; mine = (j == x) ? c : mine; }
        if (sum == G) break;
        __builtin_amdgcn_s_sleep(1);
        if ((++sp & 255u) == 0u) { if (xb_ld(&bar[XB_TMO])) break; if (sp > XB_SPIN_CAP) { atomicAdd(&bar[XB_TMO], 1u); break; } }
    }
    nloc = mine > 0u ? mine : 1u; nx = cnt > 0u ? cnt : 1u;
}
__device__ __forceinline__ void xcd_barrier(const XcdBarrier& b) {
    asm volatile("s_waitcnt vmcnt(0)" ::: "memory");
    __syncthreads();
    if (threadIdx.x == 0) {
        unsigned* bar = b.bar;
        __builtin_amdgcn_s_waitcnt(0);
        unsigned nloc = b.st[0], nx = b.st[1];
        if (nloc == 0u) { xcd_barrier_complete(bar, b.x, nloc, nx); b.st[0] = nloc; b.st[1] = nx; }
        const unsigned old = xb_add(&bar[XB_XSUB(b.x)], 1u);
        const unsigned gen = old / nloc;
        if (old + 1u == (gen + 1u) * nloc) {
            __builtin_amdgcn_fence(__ATOMIC_RELEASE, "agent");
            asm volatile("s_waitcnt vmcnt(0)" ::: "memory");
            const unsigned og = xb_add(&bar[XB_TOP], 1u);
            const unsigned tg = og / nx;
            if (og + 1u == (tg + 1u) * nx) xb_add(&bar[XB_TOPGEN], 1u);
            else XB_SPIN(xb_ld(&bar[XB_TOPGEN]) == tg, bar);
            __builtin_amdgcn_fence(__ATOMIC_ACQUIRE, "agent");
            xb_add(&bar[XB_XGEN(b.x)], 1u);
            asm volatile("s_waitcnt vmcnt(0)" ::: "memory");
        } else {
            XB_SPIN(xb_ld(&bar[XB_XGEN(b.x)]) == gen, bar);
            __builtin_amdgcn_fence(__ATOMIC_ACQUIRE, "agent");
            asm volatile("s_waitcnt vmcnt(0)" ::: "memory");
        }
    }
    __syncthreads();
}

__device__ __forceinline__ void grp_barrier(unsigned* gword, unsigned target, unsigned* bar) {
    asm volatile("s_waitcnt vmcnt(0)" ::: "memory");
    __syncthreads();
    if (threadIdx.x == 0) {
        __builtin_amdgcn_s_waitcnt(0);
        (void)xb_add(gword, 1u);
        XB_SPIN(xb_ld(gword) < target, bar);
        __builtin_amdgcn_fence(__ATOMIC_ACQUIRE, "agent");
        asm volatile("s_waitcnt vmcnt(0)" ::: "memory");
    }
    __syncthreads();
}

namespace pg8 {
constexpr int BM = 256, BK = 64, HALF = 128, HTB = HALF * BK * 2, STAGE_BYTES = 8 * HTB, NXCD = 8, WGM = 8;
__host__ __device__ __forceinline__ int lds_byte(int r, int c) { const int st = (r >> 4) * 2 + (c >> 5), rr = r & 15, cc = c & 31, ob = rr * 64 + cc * 2; return st * 1024 + (ob ^ (((ob >> 9) & 1) << 5)); }
__host__ __device__ __forceinline__ void stage_rc(int b, int& R, int& C) { const int st = b / 1024, sb = b % 1024, swz = sb ^ (((sb >> 9) & 1) << 5); R = (st >> 1) * 16 + swz / 64; C = (st & 1) * 32 + (swz % 64) / 2; }
__host__ __device__ __forceinline__ int perm32(int rho) { const int n = rho >> 4, i = rho & 15; return 8 * (i >> 2) + 4 * n + (i & 3); }

struct Unit { int pm, pn, sub; };
struct Gemm { const bf16_t* A; const bf16_t* Bt; int K, lda, ldb; long a_sub, b_sub;
              const bf16_t* A1; const bf16_t* Bt1; int K1, lda1, ldb1; long a_sub1, b_sub1; int sub1; };

struct TileOrder {
    int nM, nN, nwg, G, c, nsub;
    __device__ __forceinline__ void init(int M, int N, int G_, int c_, int nsub_) { nM = M / BM; nN = N / BM; nwg = nM * nN; G = G_; c = c_; nsub = nsub_; }
    __device__ __forceinline__ bool next(int i, Unit& u) const {
        const int ti = i / nsub; u.sub = i - ti * nsub;
        const long L = (long)ti * G + c; if (L >= nwg) return false;
        int wgid = (int)L; { const int q = nwg / NXCD, r = nwg % NXCD, xcd = wgid % NXCD, off = wgid / NXCD; wgid = (xcd < r ? xcd * (q + 1) : r * (q + 1) + (xcd - r) * q) + off; }
        const int nig = WGM * nN, gid = wgid / nig, fm = gid * WGM, gsz = (nM - fm) < WGM ? (nM - fm) : WGM;
        u.pm = fm + ((wgid % nig) % gsz); u.pn = (wgid % nig) / gsz; return true;
    }
};

struct TileOrderBal : TileOrder {
    __device__ __forceinline__ bool next(int i, Unit& u) const { if (!TileOrder::next(i, u)) return false;
        const unsigned long long tab = 0xCBA8FD97E2654310ull;
        u.pn = (int)((tab >> (4 * u.pn)) & 15ull); return true; } };
struct GateTriple { int pm, pn; __device__ __forceinline__ bool next(int i, Unit& u) const { if (i >= 3) return false; u.pm = pm; u.pn = 4 * i + pn; u.sub = 0; return true; } };
struct SubTriple { int pm, pn; __device__ __forceinline__ bool next(int i, Unit& u) const { if (i >= 3) return false; u.pm = pm; u.pn = pn; u.sub = i; return true; } };

typedef f32x4 Acc[2][2][4][2];

template <class Epi, bool DUAL = false, class Sched = TileOrder, bool F8 = false>
__device__ __forceinline__ void gemm_phase(LAS unsigned char* lds, const Gemm g, const Sched& S, const Epi& E, int stagger = 0) {
    for (int i_ = 0; i_ < stagger; ++i_) __builtin_amdgcn_s_sleep(32);
    int tid_ = threadIdx.x; asm volatile("" : "+v"(tid_));
    const int tid = tid_, wid = __builtin_amdgcn_readfirstlane(tid >> 6), lane = tid & 63, wr = wid >> 2, wc = wid & 3, fr = lane & 15, fq = lane >> 4;
    const size_t kstep = (size_t)(BK * 2);
    const unsigned ldsw = (unsigned)wid * 1024u;
    const int aoff = F8 ? lds_byte(wr * 64 + fr, fq * 16) : lds_byte(wr * 64 + fr, fq * 8), boff = F8 ? lds_byte(wc * 32 + fr, fq * 16) : lds_byte(wc * 32 + fr, fq * 8);
#define PG8_SA(b, h) (((b) * 2 + (h)) * HTB)
#define PG8_SB(b, h) ((4 + (b) * 2 + (h)) * HTB)
#define PG8_STAGE(bufoff, gbase, voff, hs) do { _Pragma("unroll") for (int _i = 0; _i < 2; ++_i) \
        __builtin_amdgcn_global_load_lds((const unsigned*)((const char*)(gbase) + (size_t)_i * (hs) + (voff)), (LAS unsigned*)(lds + (bufoff) + ldsw + _i * 8192), 16, 0, 0); } while (0)
#define PG8_LD32(p) __builtin_bit_cast(v8i_t, __builtin_shufflevector(*(const LAS bf16x8*)(p), *(const LAS bf16x8*)((p) + 16), 0, 1, 2, 3, 4, 5, 6, 7, 8, 9, 10, 11, 12, 13, 14, 15))
#define PG8_LDA(dst, b, h) do { if constexpr (F8) { _Pragma("unroll") for (int m = 0; m < 4; ++m) dst##8[m] = PG8_LD32(lds + PG8_SA(b, h) + aoff + m * 2048); } \
        else { _Pragma("unroll") for (int m = 0; m < 4; ++m) _Pragma("unroll") for (int k = 0; k < 2; ++k) dst[m][k] = *(const LAS bf16x8*)(lds + PG8_SA(b, h) + aoff + m * 2048 + k * 1024); } } while (0)
#define PG8_LDB(dst, b, h) do { if constexpr (F8) { _Pragma("unroll") for (int n = 0; n < 2; ++n) dst##8[n] = PG8_LD32(lds + PG8_SB(b, h) + boff + n * 2048); } \
        else { _Pragma("unroll") for (int n = 0; n < 2; ++n) _Pragma("unroll") for (int k = 0; k < 2; ++k) dst[n][k] = *(const LAS bf16x8*)(lds + PG8_SB(b, h) + boff + n * 2048 + k * 1024); } } while (0)
#define PG8_MMA(ai, bj, At, Bt) do { __builtin_amdgcn_s_setprio(1); _Pragma("unroll") for (int m = 0; m < 4; ++m) _Pragma("unroll") for (int n = 0; n < 2; ++n) { \
        if constexpr (F8) asm volatile("v_mfma_scale_f32_16x16x128_f8f6f4 %0, %1, %2, %0, %3, %3 op_sel_hi:[0,0,0]" : "+v"(acc[ai][bj][m][n]) : "v"(Bt##8[n]), "v"(At##8[m]), "v"(sc8));   \
        else { _Pragma("unroll") for (int k = 0; k < 2; ++k) acc[ai][bj][m][n] = __builtin_amdgcn_mfma_f32_16x16x32_bf16(Bt[n][k], At[m][k], acc[ai][bj][m][n], 0, 0, 0); } } \
        __builtin_amdgcn_s_setprio(0); } while (0)
#define PG8_WAIT_V(n) asm volatile("s_waitcnt vmcnt(" #n ")" ::: "memory")
#define PG8_WAIT_L(n) asm volatile("s_waitcnt lgkmcnt(" #n ")" ::: "memory")
#define PG8_WAIT_VX(flag) do { if constexpr (Epi::NST == 8) asm volatile("s_cmp_eq_u32 %0, 0\n\ts_cbranch_scc1 1f\n\ts_waitcnt vmcnt(16)\n\ts_branch 2f\n1:\n\ts_waitcnt vmcnt(8)\n2:" :: "s"(flag) : "memory", "scc"); \
        else if constexpr (Epi::NST == 16) asm volatile("s_cmp_eq_u32 %0, 0\n\ts_cbranch_scc1 1f\n\ts_waitcnt vmcnt(24)\n\ts_branch 2f\n1:\n\ts_waitcnt vmcnt(8)\n2:" :: "s"(flag) : "memory", "scc"); \
        else if constexpr (Epi::NST == 32) asm volatile("s_cmp_eq_u32 %0, 0\n\ts_cbranch_scc1 1f\n\ts_waitcnt vmcnt(40)\n\ts_branch 2f\n1:\n\ts_waitcnt vmcnt(8)\n2:" :: "s"(flag) : "memory", "scc"); \
        else asm volatile("s_waitcnt vmcnt(8)" ::: "memory"); } while (0)
#define PG8_BAR __builtin_amdgcn_s_barrier()
#define PG8_SCHED __builtin_amdgcn_sched_barrier(0)
#define PG8_KIND(u) (DUAL && (u).sub >= g.sub1)
#define PG8_ABASE(u) (PG8_KIND(u) ? (const char*)g.A1 + ((size_t)(u).pm * BM * g.lda1 + (size_t)((u).sub - g.sub1) * g.a_sub1) * 2 : (const char*)g.A + ((size_t)(u).pm * BM * g.lda + (size_t)(u).sub * g.a_sub) * 2)
#define PG8_BBASE(u) (PG8_KIND(u) ? (const char*)g.Bt1 + ((size_t)(u).pn * BM * g.ldb1 + (size_t)((u).sub - g.sub1) * g.b_sub1) * 2 : (const char*)g.Bt + ((size_t)(u).pn * BM * g.ldb + (size_t)(u).sub * g.b_sub) * 2)
#define PG8_VOFF(kd, vA, vB) do { const bool k_ = (kd); const int la_ = k_ ? g.lda1 : g.lda, lb_ = k_ ? g.ldb1 : g.ldb; \
        vA = (unsigned)(sR * la_ + sC) * 2u; vB = (unsigned)(sRb * lb_ + sC) * 2u; } while (0)
#define PG8_SETCFG(kd, hA, hB, ntv) do { const bool k_ = (kd); hA = (size_t)HALF * (k_ ? g.lda1 : g.lda) * 2; hB = (size_t)HALF * (k_ ? g.ldb1 : g.ldb) * 2; ntv = (k_ ? g.K1 : g.K) / BK; } while (0)
    Unit cur, nxt; int ui = 0;
    if (!S.next(0, cur)) return;
    Acc acc;
#pragma unroll
    for (int a = 0; a < 2; ++a)
#pragma unroll
        for (int b = 0; b < 2; ++b)
#pragma unroll
            for (int m = 0; m < 4; ++m)
#pragma unroll
                for (int n = 0; n < 2; ++n) acc[a][b][m][n] = (f32x4){0.f, 0.f, 0.f, 0.f};
    bf16x8 At[4][2], B0[2][2], B1[2][2];
    v8i_t At8[4], B08[2], B18[2];
    const int sc8 = 0x7f7f7f7f;
    float pre[8];
#pragma unroll
    for (int i = 0; i < 8; ++i) pre[i] = 0.f;
    const char* cA = PG8_ABASE(cur); const char* cB = PG8_BBASE(cur);
    int sR, sC; stage_rc(tid * 16, sR, sC); const int sRb = Epi::PERM ? ((sR & ~31) + perm32(sR & 31)) : sR;
    unsigned voffA, voffB; size_t hstepA, hstepB, xhA, xhB; int nt, xnt; bool xkind;
    PG8_VOFF(PG8_KIND(cur), voffA, voffB); PG8_SETCFG(PG8_KIND(cur), hstepA, hstepB, nt);
    PG8_STAGE(PG8_SB(0, 0), cB, voffB, hstepB >> 1); PG8_STAGE(PG8_SB(0, 1), cB + hstepB, voffB, hstepB >> 1); PG8_STAGE(PG8_SA(0, 0), cA, voffA, hstepA >> 1); PG8_STAGE(PG8_SA(0, 1), cA + hstepA, voffA, hstepA >> 1);
    if (wr == 1) PG8_BAR;
    PG8_WAIT_V(2); PG8_BAR;
    PG8_STAGE(PG8_SB(1, 0), cB + kstep, voffB, hstepB >> 1); PG8_STAGE(PG8_SA(1, 0), cA + kstep, voffA, hstepA >> 1); PG8_STAGE(PG8_SB(1, 1), cB + hstepB + kstep, voffB, hstepB >> 1);
    PG8_WAIT_V(6); PG8_BAR;
    for (;;) {
        const bool has_next = S.next(ui + 1, nxt);
        const char* nA = has_next ? PG8_ABASE(nxt) : cA; const char* nB = has_next ? PG8_BBASE(nxt) : cB;
        xkind = has_next ? PG8_KIND(nxt) : PG8_KIND(cur); PG8_SETCFG(xkind, xhA, xhB, xnt);
        for (int t = 0; t < nt; t += 2) {
            const bool last = (t == nt - 2);
            const char* a1 = cA + (size_t)(t + 1) * kstep;
            const char* a2 = last ? nA : cA + (size_t)(t + 2) * kstep; const char* b2 = last ? nB : cB + (size_t)(t + 2) * kstep;
            const char* a3 = a2 + kstep; const char* b3 = b2 + kstep;
            unsigned vA2 = voffA, vB2 = voffB;
            if (DUAL && last) PG8_VOFF(xkind, vA2, vB2);
            const size_t hA2 = last ? xhA : hstepA, hB2 = last ? xhB : hstepB;
            if (last) E.prefetch(cur, pre);
            const int rxi = __builtin_amdgcn_readfirstlane(((Epi::NST > 0) && (t == 0) && (ui > 0)) ? 1 : 0);
            PG8_LDB(B0, 0, 0); PG8_LDB(B1, 0, 1); PG8_SCHED; PG8_LDA(At, 0, 0); PG8_STAGE(PG8_SA(1, 1), a1 + hstepA, voffA, hstepA >> 1);
            PG8_WAIT_VX(rxi);
            PG8_WAIT_L(0); PG8_BAR; PG8_MMA(0, 0, At, B0); PG8_MMA(0, 1, At, B1); PG8_BAR; PG8_SCHED;
            PG8_LDA(At, 0, 1); PG8_STAGE(PG8_SB(0, 0), b2, vB2, hB2 >> 1); PG8_STAGE(PG8_SB(0, 1), b2 + hB2, vB2, hB2 >> 1); PG8_STAGE(PG8_SA(0, 0), a2, vA2, hA2 >> 1);
            PG8_WAIT_VX(rxi);
            PG8_WAIT_L(0); PG8_BAR; PG8_MMA(1, 0, At, B0); PG8_MMA(1, 1, At, B1); PG8_BAR; PG8_SCHED;
            PG8_LDB(B0, 1, 0); PG8_LDB(B1, 1, 1); PG8_SCHED; PG8_LDA(At, 1, 0); PG8_STAGE(PG8_SA(0, 1), a2 + hA2, vA2, hA2 >> 1);
            PG8_WAIT_V(8); PG8_WAIT_L(0); PG8_BAR; PG8_MMA(0, 0, At, B0); PG8_MMA(0, 1, At, B1); PG8_BAR; PG8_SCHED;
            PG8_LDA(At, 1, 1); PG8_STAGE(PG8_SB(1, 0), b3, vB2, hB2 >> 1); PG8_STAGE(PG8_SB(1, 1), b3 + hB2, vB2, hB2 >> 1); PG8_STAGE(PG8_SA(1, 0), a3, vA2, hA2 >> 1);
            PG8_WAIT_V(8); PG8_WAIT_L(0); PG8_BAR; PG8_MMA(1, 0, At, B0); PG8_MMA(1, 1, At, B1); PG8_BAR; PG8_SCHED;
        }
        if (wr == 0) PG8_BAR;
        if constexpr (F8) asm volatile("s_nop 15\n\ts_nop 7" ::: "memory");
        const bool keep = E(acc, cur, pre);
        if (!has_next) break;
        if (!keep) {
#pragma unroll
            for (int a = 0; a < 2; ++a)
#pragma unroll
                for (int b = 0; b < 2; ++b)
#pragma unroll
                    for (int m = 0; m < 4; ++m)
#pragma unroll
                        for (int n = 0; n < 2; ++n) acc[a][b][m][n] = (f32x4){0.f, 0.f, 0.f, 0.f};
        }
        cur = nxt; cA = nA; cB = nB; ++ui;
        if (DUAL) PG8_VOFF(xkind, voffA, voffB);
        hstepA = xhA; hstepB = xhB; nt = xnt;
        if (wr == 1) PG8_BAR;
    }
    PG8_WAIT_V(0);
    PG8_BAR;
#undef PG8_SA
#undef PG8_SB
#undef PG8_STAGE
#undef PG8_LDA
#undef PG8_LD32
#undef PG8_LDB
#undef PG8_MMA
#undef PG8_WAIT_V
#undef PG8_WAIT_L
#undef PG8_WAIT_VX
#undef PG8_BAR
#undef PG8_SCHED
#undef PG8_ABASE
#undef PG8_BBASE
#undef PG8_KIND
#undef PG8_SETCFG
#undef PG8_VOFF
}

__device__ __forceinline__ void lane_ids(int& wr, int& wc, int& fr, int& fq) { int t = threadIdx.x; asm volatile("" : "+v"(t)); const int wid = __builtin_amdgcn_readfirstlane(t >> 6); wr = wid >> 2; wc = wid & 3; fr = t & 15; fq = (t >> 4) & 3; }
__device__ __forceinline__ u32x4 pack8(const f32x4 a, const f32x4 b) { u32x4 w; w.x = cvt_pk_bf16(a[0], a[1]); w.y = cvt_pk_bf16(a[2], a[3]); w.z = cvt_pk_bf16(b[0], b[1]); w.w = cvt_pk_bf16(b[2], b[3]); return w; }

struct EpiInProj {
    static constexpr bool PERM = true; static constexpr int NST = 16;
    bf16_t* O;
    const bf16_t* rope;
    const float* g_qa; const float* g_ka; const float* g_qb; const float* g_kb;
    const float* b_alpha;
    float* kmp;
    const float* ssq;
    __device__ __forceinline__ void prefetch(const Unit& u, float (&pre)[8]) const {
        int t = threadIdx.x; asm volatile("" : "+v"(t)); const int row0 = u.pm * BM + ((t >> 8) & 1) * 64 + (t & 15);
#pragma unroll
        for (int st = 0; st < 8; ++st) pre[st] = ssq[row0 + (st >> 2) * HALF + (st & 3) * 16];
    }
    __device__ __forceinline__ bool operator()(Acc& acc, const Unit& u, const float (&pre)[8]) const {
        int wr, wc, fr, fq; lane_ids(wr, wc, fr, fq);
        const int G = 4 * u.pn + wc;
        const int row0 = u.pm * BM + wr * 64 + fr;
        {
#pragma unroll
            for (int st = 0; st < 8; ++st) { const float rs = frsq(pre[st] * (1.0f / D) + EPS);
#pragma unroll
                for (int bj = 0; bj < 2; ++bj)
#pragma unroll
                    for (int n = 0; n < 2; ++n) acc[st >> 2][bj][st & 3][n] *= rs; }
        }
        bf16_t* obase = O + (size_t)row0 * PP + 64 * G + 8 * fq;
        const float* gain = nullptr; float qs = 1.f; bool mean = false;
        if (G < 8) { gain = g_qa; qs = C2; } else if (G < 10) gain = g_ka; else if (G >= 12 && G < 20) { gain = g_qb; qs = C2; } else if (G >= 20 && G < 28) { gain = g_kb; mean = true; }
        if (gain) {
            f32x4 gn[2][2];
#pragma unroll
            for (int bj = 0; bj < 2; ++bj)
#pragma unroll
                for (int n = 0; n < 2; ++n) gn[bj][n] = *(const f32x4*)(gain + 32 * bj + 8 * fq + 4 * n);
            f32x4 ks[2][2];
#pragma unroll
            for (int bj = 0; bj < 2; ++bj)
#pragma unroll
                for (int n = 0; n < 2; ++n) ks[bj][n] = (f32x4){0.f, 0.f, 0.f, 0.f};
            u32x4 cw[8], sw[8];
#define INP_ROPE_LD(g_) do { const int rn_ = ((g_) >> 2) * HALF + ((g_) & 3) * 16; const bf16_t* cs_ = rope + (size_t)(row0 + rn_) * 64 + 8 * fq; cw[g_] = *(const u32x4*)cs_; sw[g_] = *(const u32x4*)(cs_ + 32); } while (0)
            INP_ROPE_LD(0); INP_ROPE_LD(1);
#pragma unroll
            for (int st = 0; st < 8; ++st) {
                const int ai = st >> 2, m = st & 3, rr = ai * HALF + m * 16;
                if (st + 2 < 8) INP_ROPE_LD(st + 2);
                const u32x4 cq_ = cw[st], sq_ = sw[st];
                const f32x4 c0 = {bf_lo(cq_.x), bf_hi(cq_.x), bf_lo(cq_.y), bf_hi(cq_.y)}, c1 = {bf_lo(cq_.z), bf_hi(cq_.z), bf_lo(cq_.w), bf_hi(cq_.w)};
                const f32x4 s0 = {bf_lo(sq_.x), bf_hi(sq_.x), bf_lo(sq_.y), bf_hi(sq_.y)}, s1 = {bf_lo(sq_.z), bf_hi(sq_.z), bf_lo(sq_.w), bf_hi(sq_.w)};
                float ss = 0.f;
#pragma unroll
                for (int bj = 0; bj < 2; ++bj)
#pragma unroll
                    for (int n = 0; n < 2; ++n) { const f32x4 v = acc[ai][bj][m][n]; ss += (v[0] * v[0] + v[1] * v[1]) + (v[2] * v[2] + v[3] * v[3]); }
                ss = addx32(addx16(ss));
                const float rs = frsq(ss * (1.0f / 64.0f) + EPS);
                f32x4 o0[2], o1[2];
#pragma unroll
                for (int n = 0; n < 2; ++n) {
                    const f32x4 c = n ? c1 : c0, sx = n ? s1 : s0;
                    const f32x4 y0 = acc[ai][0][m][n] * rs * gn[0][n], y1 = acc[ai][1][m][n] * rs * gn[1][n];
                    o0[n] = y0 * c - y1 * sx; o1[n] = y1 * c + y0 * sx;
                    ks[0][n] += o0[n]; ks[1][n] += o1[n];
                    o0[n] *= qs; o1[n] *= qs;
                }
                *(u32x4*)(obase + (size_t)rr * PP) = pack8(o0[0], o0[1]);
                *(u32x4*)(obase + (size_t)rr * PP + 32) = pack8(o1[0], o1[1]);
                asm volatile("" : "+v"(ks[0][0]), "+v"(ks[0][1]), "+v"(ks[1][0]), "+v"(ks[1][1]) :: "memory");
            }
#undef INP_ROPE_LD
            if (mean) {
#pragma unroll
                for (int bj = 0; bj < 2; ++bj)
#pragma unroll
                    for (int n = 0; n < 2; ++n)
#pragma unroll
                        for (int j = 0; j < 4; ++j) ks[bj][n][j] = sum16(ks[bj][n][j]);
                if (fr == 0) {
                    float* kp = kmp + ((size_t)((u.pm * 8 + (G - 20)) * 2 + wr)) * 64 + 8 * fq;
#pragma unroll
                    for (int bj = 0; bj < 2; ++bj)
#pragma unroll
                        for (int n = 0; n < 2; ++n) *(f32x4*)(kp + 32 * bj + 4 * n) = ks[bj][n];
                }
            }
        } else {
            const int mode = (G >= 36 && G < 40) ? 1 : (G >= 52 && G < 56) ? 2 : (G >= 56) ? 3 : 0;
            f32x4 bb[2][2];
#pragma unroll
            for (int bj = 0; bj < 2; ++bj)
#pragma unroll
                for (int n = 0; n < 2; ++n) bb[bj][n] = (mode == 2) ? *(const f32x4*)(b_alpha + 64 * (G - 52) + 32 * bj + 8 * fq + 4 * n) : (f32x4){0.f, 0.f, 0.f, 0.f};
#pragma unroll
            for (int ai = 0; ai < 2; ++ai)
#pragma unroll
                for (int m = 0; m < 4; ++m) {
                    const int rr = ai * HALF + m * 16;
                    f32x4 o[2][2];
#pragma unroll
                    for (int bj = 0; bj < 2; ++bj)
#pragma unroll
                        for (int n = 0; n < 2; ++n) {
                            f32x4 v = acc[ai][bj][m][n];
                            if (mode == 1) v *= 0.125f;
                            else if (mode == 2) {
#pragma unroll
                                for (int j = 0; j < 4; ++j) { const float z = v[j] + bb[bj][n][j]; v[j] = (fminf(z, 0.f) - __logf(1.f + fexp(-fabsf(z)))) * (1.0f / 16.0f); }
                            } else if (mode == 3) {
#pragma unroll
                                for (int j = 0; j < 4; ++j) v[j] = v[j] * sigmoidf_(v[j]);
                            }
                            o[bj][n] = v;
                        }
                    *(u32x4*)(obase + (size_t)rr * PP) = pack8(o[0][0], o[0][1]);
                    *(u32x4*)(obase + (size_t)rr * PP + 32) = pack8(o[1][0], o[1][1]);
                    asm volatile("" ::: "memory");
                }
        }
        return false;
    }
};

template <bool LATE> struct EpiGatesT {
    static constexpr bool PERM = true; static constexpr int NST = (DBG_DUP == 11) ? 0 : 16;
    bf16_t* O; int nostore; const float* ssq; int late; float oscale;
    __device__ __forceinline__ void prefetch(const Unit& u, float (&pre)[8]) const {
        if constexpr (LATE) return;
        int t = threadIdx.x; asm volatile("" : "+v"(t)); const int row0 = u.pm * BM + ((t >> 8) & 1) * 64 + (t & 15);
#pragma unroll
        for (int st = 0; st < 8; ++st) pre[st] = ssq[row0 + (st >> 2) * HALF + (st & 3) * 16];
    }
    __device__ __forceinline__ bool operator()(Acc& acc, const Unit& u, const float (&pre)[8]) const {
        int wr, wc, fr, fq; lane_ids(wr, wc, fr, fq);
        if (nostore) {
#pragma unroll
            for (int ai = 0; ai < 2; ++ai)
#pragma unroll
                for (int bj = 0; bj < 2; ++bj)
#pragma unroll
                    for (int m = 0; m < 4; ++m) asm volatile("" :: "v"(acc[ai][bj][m][0]), "v"(acc[ai][bj][m][1]));
            return false;
        }
        const int row0 = u.pm * BM + wr * 64 + fr, col0 = u.pn * BM + wc * 32 + 8 * fq;
        float rsv[8];
#pragma unroll
        for (int st = 0; st < 8; ++st) rsv[st] = LATE ? ssq[row0 + (st >> 2) * HALF + (st & 3) * 16] : pre[st];
#pragma unroll
        for (int ai = 0; ai < 2; ++ai)
#pragma unroll
            for (int m = 0; m < 4; ++m) { unsigned char* rowp = (unsigned char*)O + (size_t)(row0 + ai * HALF + m * 16) * GW + col0;
                const float rs = frsq(rsv[ai * 4 + m] * (1.0f / D) + EPS) * oscale;
#pragma unroll
                for (int bj = 0; bj < 2; ++bj) { f32x4 v0 = acc[ai][bj][m][0] * rs, v1 = acc[ai][bj][m][1] * rs;
                    unsigned w0 = 0u, w1 = 0u;
#pragma unroll
                    for (int j = 0; j < 4; ++j) { w0 = __builtin_amdgcn_cvt_pk_u8_f32(fmaxf(sigmoidf_(v0[j]) * 255.0f, 1.0f), j, w0); w1 = __builtin_amdgcn_cvt_pk_u8_f32(fmaxf(sigmoidf_(v1[j]) * 255.0f, 1.0f), j, w1); }
                    *(u32x2*)(rowp + bj * HALF) = (u32x2){w0, w1}; } }
        return false;
    }
};

typedef EpiGatesT<false> EpiGates;
struct EpiMerge {
    static constexpr bool PERM = true; static constexpr int NST = 16;
    const bf16_t* Gt;
    bf16_t* O;
    __device__ __forceinline__ void prefetch(const Unit&, float (&)[8]) const {}
    __device__ __forceinline__ bool operator()(Acc& acc, const Unit& u, const float (&pre)[8]) const {
        int wr, wc, fr, fq; lane_ids(wr, wc, fr, fq);
        const int row0 = u.pm * BM + wr * 64 + fr, col0 = u.pn * BM + wc * 32 + 8 * fq;
        const bool last = u.sub == 2;
        const unsigned char* G8 = (const unsigned char*)Gt;
        u32x2 ga[2][4][2], gb[2][4][2];
#pragma unroll
        for (int ai = 0; ai < 2; ++ai)
#pragma unroll
            for (int m = 0; m < 4; ++m)
#pragma unroll
                for (int bj = 0; bj < 2; ++bj) {
                    const unsigned char* gp = G8 + (size_t)(row0 + ai * HALF + m * 16) * GW + (size_t)u.sub * D + col0 + bj * HALF;
                    ga[ai][m][bj] = *(const u32x2*)gp;
                    gb[ai][m][bj] = last ? (u32x2){0x01010101u, 0x01010101u} : *(const u32x2*)(gp + D);
                }
        asm volatile("" ::: "memory");
        const float fin = last ? (1.0f / 255.0f) : 1.0f;
#pragma unroll
        for (int ai = 0; ai < 2; ++ai)
#pragma unroll
            for (int m = 0; m < 4; ++m)
#pragma unroll
                for (int bj = 0; bj < 2; ++bj) {
                    const u32x2 a = ga[ai][m][bj], b = gb[ai][m][bj];
                    const f32x4 s0 = {(float)(a.x & 0xffu) * frcp((float)(b.x & 0xffu)), (float)((a.x >> 8) & 0xffu) * frcp((float)((b.x >> 8) & 0xffu)), (float)((a.x >> 16) & 0xffu) * frcp((float)((b.x >> 16) & 0xffu)), (float)(a.x >> 24) * frcp((float)(b.x >> 24))};
                    const f32x4 s1 = {(float)(a.y & 0xffu) * frcp((float)(b.y & 0xffu)), (float)((a.y >> 8) & 0xffu) * frcp((float)((b.y >> 8) & 0xffu)), (float)((a.y >> 16) & 0xffu) * frcp((float)((b.y >> 16) & 0xffu)), (float)(a.y >> 24) * frcp((float)(b.y >> 24))};
                    acc[ai][bj][m][0] *= s0 * fin; acc[ai][bj][m][1] *= s1 * fin;
                    if (last) *(u32x4*)(O + (size_t)(row0 + ai * HALF + m * 16) * D + col0 + bj * HALF) = pack8(acc[ai][bj][m][0], acc[ai][bj][m][1]);
                }
        asm volatile("" ::: "memory");
        return !last;
    }
};

struct EpiGBM {
    static constexpr bool PERM = true; static constexpr int NST = 16;
    EpiGates eg; EpiMerge em;
    __device__ __forceinline__ void prefetch(const Unit&, float (&)[8]) const {}
    __device__ __forceinline__ bool operator()(Acc& acc, const Unit& u, const float (&pre)[8]) const {
        if (u.sub < 3) { const Unit v = {u.pm, 4 * u.sub + u.pn, 0}; return eg(acc, v, pre); }
        const Unit v = {u.pm, u.pn, u.sub - 3}; return em(acc, v, pre);
    }
};

struct EpiResid {
    static constexpr bool PERM = true; static constexpr int NST = 32;
    const bf16_t* base; float* out; bf16_t* xb; float* ssq; unsigned char* xb8;
    __device__ __forceinline__ void prefetch(const Unit&, float (&)[8]) const {}
    __device__ __forceinline__ bool operator()(Acc& acc, const Unit& u, const float (&pre)[8]) const {
        int wr, wc, fr, fq; lane_ids(wr, wc, fr, fq);
        const int row0 = u.pm * BM + wr * 64 + fr, col0 = u.pn * BM + wc * 32 + 8 * fq;
        u32x4 bw[2][4][2];
#pragma unroll
        for (int ai = 0; ai < 2; ++ai)
#pragma unroll
            for (int m = 0; m < 4; ++m)
#pragma unroll
                for (int bj = 0; bj < 2; ++bj) bw[ai][m][bj] = *(const u32x4*)(base + (size_t)(row0 + ai * HALF + m * 16) * D + col0 + bj * HALF);
        asm volatile("" ::: "memory");
#pragma unroll
        for (int ai = 0; ai < 2; ++ai) {
#pragma unroll
            for (int m = 0; m < 4; ++m) { const size_t off = (size_t)(row0 + ai * HALF + m * 16) * D + col0; float ss = 0.f;
#pragma unroll
                for (int bj = 0; bj < 2; ++bj) {
                    const u32x4 w = bw[ai][m][bj];
                    const f32x4 o0 = (f32x4){bf_lo(w.x), bf_hi(w.x), bf_lo(w.y), bf_hi(w.y)} + acc[ai][bj][m][0], o1 = (f32x4){bf_lo(w.z), bf_hi(w.z), bf_lo(w.w), bf_hi(w.w)} + acc[ai][bj][m][1];
                    if (out) { *(f32x4*)(out + off + bj * HALF) = o0; *(f32x4*)(out + off + bj * HALF + 4) = o1; }
                    if (xb) { ss += ((o0[0] * o0[0] + o0[1] * o0[1]) + (o0[2] * o0[2] + o0[3] * o0[3])) + ((o1[0] * o1[0] + o1[1] * o1[1]) + (o1[2] * o1[2] + o1[3] * o1[3]));
                        *(u32x4*)(xb + off + bj * HALF) = pack8(o0, o1);
                        if (xb8) *(u32x2*)(xb8 + off + bj * HALF) = (u32x2){cvt4_fp8(o0[0] * XS8, o0[1] * XS8, o0[2] * XS8, o0[3] * XS8), cvt4_fp8(o1[0] * XS8, o1[1] * XS8, o1[2] * XS8, o1[3] * XS8)}; } }
                if (xb) { ss = addx32(addx16(ss)); if (fq == 0) atomicAdd(ssq + (row0 + ai * HALF + m * 16), ss); } }
            asm volatile("" ::: "memory");
        }
        return false;
    }
};

struct EpiFfn1 {
    static constexpr bool PERM = true; static constexpr int NST = 8;
    bf16_t* O; const float* ssq;
    __device__ __forceinline__ void prefetch(const Unit& u, float (&pre)[8]) const {
        int t = threadIdx.x; asm volatile("" : "+v"(t)); const int row0 = u.pm * BM + ((t >> 8) & 1) * 64 + (t & 15);
#pragma unroll
        for (int st = 0; st < 8; ++st) pre[st] = ssq[row0 + (st >> 2) * HALF + (st & 3) * 16];
    }
    __device__ __forceinline__ bool operator()(Acc& acc, const Unit& u, const float (&pre)[8]) const {
        int wr, wc, fr, fq; lane_ids(wr, wc, fr, fq);
        const int row0 = u.pm * BM + wr * 64 + fr, col0 = u.pn * HALF + wc * 32 + 8 * fq;
#pragma unroll
        for (int ai = 0; ai < 2; ++ai)
#pragma unroll
            for (int m = 0; m < 4; ++m) {
                const float rs = frsq(pre[ai * 4 + m] * (1.0f / D) + EPS);
                f32x4 o[2];
#pragma unroll
                for (int n = 0; n < 2; ++n) { const f32x4 gt = acc[ai][0][m][n] * rs, up = acc[ai][1][m][n] * rs;
#pragma unroll
                    for (int j = 0; j < 4; ++j) o[n][j] = gt[j] * sigmoidf_(gt[j]) * up[j]; }
                *(u32x4*)(O + (size_t)(row0 + ai * HALF + m * 16) * FF + col0) = pack8(o[0], o[1]);
            }
        return false;
    }
};
}

namespace att {
constexpr int SLOTB = 8192;
constexpr int L_K = 0, L_V = 2 * SLOTB, L_WS = 4 * SLOTB, L_OST = L_WS + 8 * 256, L_KM = L_OST + 8 * 4096, L_END = L_KM + 7 * 64 * 4;
__device__ __forceinline__ int crow(int r, int hi) { return (r & 3) + 8 * (r >> 2) + 4 * hi; }
__device__ __forceinline__ void glds16(const void* gsrc, unsigned lds_dst) { unsigned keep;
    asm volatile("s_mov_b32 %0, m0\n\ts_mov_b32 m0, %2\n\ts_nop 0\n\tglobal_load_lds_dwordx4 %1, off\n\ts_mov_b32 m0, %0" : "=&s"(keep) : "v"(gsrc), "s"(lds_dst) : "memory"); }
#define ATT_WAIT_BAR0() asm volatile("s_waitcnt vmcnt(0) lgkmcnt(0)\n\ts_barrier" ::: "memory")
#define ATT_SBAR() __builtin_amdgcn_sched_barrier(0)

__device__ __forceinline__ void qkt(f32x16& p0, f32x16& p1, LAS const unsigned char* Kslot, const bf16x8* qr, int r32, int hi) {
    LAS const unsigned char* kb = Kslot + hi * 1024 + r32 * 16;
    p0 = f32x16{}; p1 = f32x16{};
#pragma unroll
    for (int d0 = 0; d0 < 4; ++d0) {
        const bf16x8 b0 = *(LAS const bf16x8*)(kb + d0 * 2048);
        const bf16x8 b1 = *(LAS const bf16x8*)(kb + d0 * 2048 + 512);
        p0 = __builtin_amdgcn_mfma_f32_32x32x16_bf16(b0, qr[d0], p0, 0, 0, 0);
        p1 = __builtin_amdgcn_mfma_f32_32x32x16_bf16(b1, qr[d0], p1, 0, 0, 0);
    }
}
__device__ __forceinline__ float rowmax(const f32x16& p0, const f32x16& p1) {
    float a = fmaxf(p0[0], p1[0]);
#pragma unroll
    for (int r = 1; r < 16; ++r) a = fmaxf(a, fmaxf(p0[r], p1[r]));
    return maxx32(a);
}
__device__ __forceinline__ void pv(f32x16* o, int vb, bf16x8 pa0, bf16x8 pa1, bf16x8 pa2, bf16x8 pa3) {
#pragma unroll
    for (int d0 = 0; d0 < 2; ++d0) { s16x4 lo[4], hi[4];
#pragma unroll
        for (int ks = 0; ks < 4; ++ks) {
            asm volatile("ds_read_b64_tr_b16 %0,%1 offset:%c2" : "=&v"(lo[ks]) : "v"(vb), "i"(d0 * 4096 + ks * 1024) : "memory");
            asm volatile("ds_read_b64_tr_b16 %0,%1 offset:%c2" : "=&v"(hi[ks]) : "v"(vb), "i"(d0 * 4096 + ks * 1024 + 512) : "memory"); }
        asm volatile("s_waitcnt lgkmcnt(0)" ::: "memory"); ATT_SBAR();
#define ATT_PK(k) (bf16x8){lo[k][0], lo[k][1], lo[k][2], lo[k][3], hi[k][0], hi[k][1], hi[k][2], hi[k][3]}
        o[d0] = __builtin_amdgcn_mfma_f32_32x32x16_bf16(pa0, ATT_PK(0), o[d0], 0, 0, 0);
        o[d0] = __builtin_amdgcn_mfma_f32_32x32x16_bf16(pa1, ATT_PK(1), o[d0], 0, 0, 0);
        o[d0] = __builtin_amdgcn_mfma_f32_32x32x16_bf16(pa2, ATT_PK(2), o[d0], 0, 0, 0);
        o[d0] = __builtin_amdgcn_mfma_f32_32x32x16_bf16(pa3, ATT_PK(3), o[d0], 0, 0, 0);
#undef ATT_PK
    }
}

template <int MODE>
__device__ __forceinline__ void attn_unit(const bf16_t* proj, bf16_t* Y, int b, int hh, int qb, const float* sinks, const float* kmp, LAS unsigned char* shm) {
    int tid_ = threadIdx.x; asm volatile("" : "+v"(tid_));
    const int tid = tid_, lane = tid & 63, r32 = lane & 31, hi = lane >> 5; const int wid = __builtin_amdgcn_readfirstlane(tid >> 6);
    const long rowbase = (long)b * SEQ;
    int qhead, qrow0, kcol, vcol, qcol, ycol, t_first, t_last;
    if (MODE == 0) { qhead = 4 * hh + (wid >> 1); qrow0 = 64 * qb + 32 * (wid & 1); qcol = 64 * qhead; kcol = 512 + 64 * hh; vcol = 640 + 64 * hh; ycol = 64 * qhead; t_first = qb >= 2 ? qb - 2 : 0; t_last = qb; }
    else { qhead = hh; qrow0 = 256 * qb + 32 * wid; qcol = 768 + 64 * hh; kcol = 1280 + 64 * hh; vcol = 1792 + 64 * hh; ycol = 512 + 64 * hh; t_first = 0; t_last = 4 * qb + 3; }
    const bf16_t* Qw = proj + (rowbase + qrow0) * PP + qcol;
    const bf16_t* Kh = proj + rowbase * PP + kcol; const bf16_t* Vh = proj + rowbase * PP + vcol;
    const unsigned lds0 = (unsigned)(uintptr_t)shm;
    LAS float* wsf = (LAS float*)(shm + L_WS) + wid * 64;
    const bf16_t* ksrc = Kh + (long)lane * PP + wid * 8;
    const bf16_t* vsrc = Vh + (long)(16 * (wid & 3) + (lane >> 2)) * PP + (wid >> 2) * 32 + (lane & 3) * 8;
    const unsigned kdst = lds0 + L_K + wid * 1024, vdst = lds0 + L_V + wid * 1024;
#define ATT_DMA(t, slot) do { glds16(ksrc + (long)(t) * 64 * PP, (unsigned)__builtin_amdgcn_readfirstlane(kdst + (slot))); glds16(vsrc + (long)(t) * 64 * PP, (unsigned)__builtin_amdgcn_readfirstlane(vdst + (slot))); } while (0)
    const int vb0 = (int)(lds0 + L_V) + ((lane >> 4) & 1) * 32 + (lane & 3) * 8 + (4 * hi + ((lane & 15) >> 2)) * 64;
    bf16x8 qr[4];
#pragma unroll
    for (int d0 = 0; d0 < 4; ++d0) qr[d0] = *(const bf16x8*)(Qw + (long)r32 * PP + d0 * 16 + hi * 8);
    unsigned sel = 0u;
    if (MODE == 1) {
        LAS float* km = (LAS float*)(shm + L_KM);
        if (qb > 0) { for (int idx = tid; idx < qb * 64; idx += 512) { const int n = idx >> 6, d = idx & 63; const float* p = kmp + ((size_t)(((b * 8 + n) * 8 + hh) * 2)) * 64 + d; km[idx] = p[0] + p[64]; } }
        LDS_WAIT(); __syncthreads();
        if (qb <= 3) sel = (1u << qb) - 1u;
        else {
            float qf[32];
#pragma unroll
            for (int d0 = 0; d0 < 4; ++d0)
#pragma unroll
                for (int j = 0; j < 8; ++j) qf[d0 * 8 + j] = bf1((bf16_t)qr[d0][j]);
            float gsc[7];
#pragma unroll
            for (int n = 0; n < 7; ++n) {
                float a = 0.f;
                if (n < qb) {
#pragma unroll
                    for (int d0 = 0; d0 < 4; ++d0) { const f32x4 k0 = *(LAS const f32x4*)(km + n * 64 + d0 * 16 + hi * 8), k1 = *(LAS const f32x4*)(km + n * 64 + d0 * 16 + hi * 8 + 4);
                        a += qf[d0 * 8 + 0] * k0[0] + qf[d0 * 8 + 1] * k0[1] + qf[d0 * 8 + 2] * k0[2] + qf[d0 * 8 + 3] * k0[3] + qf[d0 * 8 + 4] * k1[0] + qf[d0 * 8 + 5] * k1[1] + qf[d0 * 8 + 6] * k1[2] + qf[d0 * 8 + 7] * k1[3]; }
                    a = addx32(a);
                } else a = -INFINITY;
                gsc[n] = a;
            }
#pragma unroll
            for (int n = 0; n < 7; ++n) { int cnt = 0;
#pragma unroll
                for (int m2 = 0; m2 < 7; ++m2) if (m2 != n) cnt += (gsc[m2] > gsc[n] || (gsc[m2] == gsc[n] && m2 < n)) ? 1 : 0;
                if (cnt < 3 && n < qb) sel |= 1u << n; }
        }
    }
    float mhat, l_reg; f32x16 o[2]; o[0] = f32x16{}; o[1] = f32x16{};
    if (MODE == 0) { mhat = sinks[qhead] * LOG2E; l_reg = hi == 0 ? 1.f : 0.f; } else { mhat = -1e30f; l_reg = 0.f; }
    const int qabs = qrow0 + r32;
    ATT_DMA(t_first, 0);
    int slot = 0;
    for (int t = t_first; t <= t_last; ++t) {
        ATT_WAIT_BAR0();
        if (t < t_last) ATT_DMA(t + 1, slot ^ SLOTB);
        bool active = true;
        if (MODE == 1 && t < 4 * qb) active = __any((sel >> (t >> 2)) & 1u);
        if (active) {
            f32x16 p0, p1;
            qkt(p0, p1, shm + L_K + slot, qr, r32, hi);
            if (MODE == 0) {
                const int kb = 64 * t + 4 * hi;
#pragma unroll
                for (int r = 0; r < 16; ++r) { const int kv = kb + (r & 3) + 8 * (r >> 2);
                    if (!(kv <= qabs && kv > qabs - 128)) p0[r] = -INFINITY;
                    if (!(kv + 32 <= qabs && kv + 32 > qabs - 128)) p1[r] = -INFINITY; }
            } else {
                if (t >= 4 * qb) {
                    const int kb = 64 * t + 4 * hi;
#pragma unroll
                    for (int r = 0; r < 16; ++r) { const int kv = kb + (r & 3) + 8 * (r >> 2); if (kv > qabs) p0[r] = -INFINITY; if (kv + 32 > qabs) p1[r] = -INFINITY; }
                } else if (!((sel >> (t >> 2)) & 1u)) {
#pragma unroll
                    for (int r = 0; r < 16; ++r) { p0[r] = -INFINITY; p1[r] = -INFINITY; }
                }
            }
            const float rm = rowmax(p0, p1);
            const float mnew = fmaxf(mhat, rm);
            const float f = fexp2(mhat - mnew);
            mhat = mnew;
            float sacc = 0.f;
#pragma unroll
            for (int r = 0; r < 16; ++r) { p0[r] = fexp2(p0[r] - mnew); p1[r] = fexp2(p1[r] - mnew); sacc += p0[r] + p1[r]; }
            l_reg = l_reg * f + sacc;
            if (__any(f != 1.0f)) {
                if (hi == 0) wsf[r32] = f;
                LDS_WAIT();
#pragma unroll
                for (int r = 0; r < 16; ++r) { const float fr_ = wsf[crow(r, hi)]; o[0][r] *= fr_; o[1][r] *= fr_; }
            }
            u32x4 pw0, pw1, pw2, pw3;
#define ATT_PKW(P, B) cvt_pk_bf16(P[B], P[B + 1])
            pw0 = (u32x4){ATT_PKW(p0, 0), ATT_PKW(p0, 2), ATT_PKW(p0, 4), ATT_PKW(p0, 6)}; pw1 = (u32x4){ATT_PKW(p0, 8), ATT_PKW(p0, 10), ATT_PKW(p0, 12), ATT_PKW(p0, 14)};
            pw2 = (u32x4){ATT_PKW(p1, 0), ATT_PKW(p1, 2), ATT_PKW(p1, 4), ATT_PKW(p1, 6)}; pw3 = (u32x4){ATT_PKW(p1, 8), ATT_PKW(p1, 10), ATT_PKW(p1, 12), ATT_PKW(p1, 14)};
#undef ATT_PKW
            ATT_SBAR();
            pv(o, vb0 + slot, __builtin_bit_cast(bf16x8, pw0), __builtin_bit_cast(bf16x8, pw1), __builtin_bit_cast(bf16x8, pw2), __builtin_bit_cast(bf16x8, pw3));
        }
        slot ^= SLOTB;
    }
    l_reg = addx32(l_reg);
    if (hi == 0) wsf[32 + r32] = l_reg;
    LDS_WAIT();
    float rli[16];
#pragma unroll
    for (int r = 0; r < 16; ++r) rli[r] = frcp(wsf[32 + crow(r, hi)]);
    bf16_t* Ow = Y + (rowbase + qrow0) * YW + ycol;
    { LAS bf16_t* stg = (LAS bf16_t*)(shm + L_OST) + wid * 2048;
#pragma unroll
        for (int r = 0; r < 16; ++r) { const int orow = crow(r, hi);
#pragma unroll
            for (int d0 = 0; d0 < 2; ++d0) stg[orow * 64 + d0 * 32 + r32] = f2bf(o[d0][r] * rli[r]); }
        LDS_WAIT();
#pragma unroll
        for (int i = 0; i < 4; ++i) { const int row = i * 8 + (lane >> 3), ch = lane & 7; const u32x4 v = *(LAS const u32x4*)(stg + row * 64 + ch * 8); *(u32x4*)(Ow + (long)row * YW + ch * 8) = v; } }
    asm volatile("s_waitcnt lgkmcnt(0)\n\ts_barrier" ::: "memory");
#undef ATT_DMA
}
}

namespace att2 {
#define SBAR() __builtin_amdgcn_sched_barrier(0)
__device__ __forceinline__ int crow(int r,int hi){return (r&3)+8*(r>>2)+4*hi;}
#define SBAR() __builtin_amdgcn_sched_barrier(0)
__device__ __forceinline__ void cmask(f32x16&p0,f32x16&p1,int jb,int qrel,int hi){
  const float NEG=-INFINITY; int kb=64*jb+4*hi;
  #pragma unroll
  for(int r=0;r<16;++r){int kv=kb+(r&3)+8*(r>>2); if(kv>qrel)p0[r]=NEG; if(kv+32>qrel)p1[r]=NEG;}
}

constexpr int NW=8,QBLK=32,QB=256,KVBLK=64,DM=PP;
constexpr int NSLOT=3, SLOTB=8192;
constexpr int LDS_K=0, LDS_V=NSLOT*SLOTB, LDS_WS=2*NSLOT*SLOTB, LDS_OST=LDS_WS+NW*64*4, LDS_KM=LDS_OST+NW*4096, LDS_BYTES=LDS_KM+7*64*4;
__device__ __forceinline__ void glds16(const void*gsrc,unsigned lds_dst){unsigned keep;
  asm volatile("s_mov_b32 %0, m0\n\ts_mov_b32 m0, %2\n\ts_nop 0\n\tglobal_load_lds_dwordx4 %1, off\n\ts_mov_b32 m0, %0":"=&s"(keep):"v"(gsrc),"s"(lds_dst):"memory");}
__device__ __forceinline__ float max3f(float a,float b,float c){float r;asm("v_max3_f32 %0, %1, %2, %3":"=v"(r):"v"(a),"v"(b),"v"(c));return r;}
__device__ __forceinline__ float max2f(float a,float b){float r;asm("v_max_f32_e32 %0, %1, %2":"=v"(r):"v"(a),"v"(b));return r;}
__device__ __forceinline__ float fadd_s(float a,float b){float r;asm("v_add_f32_e32 %0, %1, %2":"=v"(r):"v"(a),"v"(b));return r;}
__device__ __forceinline__ float fsub_s(float a,float b){float r;asm("v_sub_f32_e32 %0, %1, %2":"=v"(r):"v"(a),"v"(b));return r;}
typedef float f32x2_t __attribute__((ext_vector_type(2))); typedef __bf16 bf16x2_t __attribute__((ext_vector_type(2)));
typedef int v8i_t __attribute__((ext_vector_type(8)));
__device__ __forceinline__ unsigned cvtpk_s(float lo,float hi){f32x2_t v={lo,hi};bf16x2_t b=__builtin_convertvector(v,bf16x2_t);return __builtin_bit_cast(unsigned,b);}
#define WAIT_BAR(N) asm volatile("s_waitcnt vmcnt(" #N ") lgkmcnt(0)\n\ts_barrier":::"memory")

typedef __attribute__((address_space(3))) const char* lds_cptr;
__device__ __forceinline__ void qkt(f32x16&p0,f32x16&p1,lds_cptr Kslot,const bf16x8*qr,const f32x16&negm,int r32,int hi){
  lds_cptr kb=Kslot+hi*1024+r32*16;
  #pragma unroll
  for(int d0=0;d0<4;++d0){
    const bf16x8 b0=*(const __attribute__((address_space(3))) bf16x8*)(kb+d0*2048);
    const bf16x8 b1=*(const __attribute__((address_space(3))) bf16x8*)(kb+d0*2048+512);
    if(d0==0){p0=__builtin_amdgcn_mfma_f32_32x32x16_bf16(b0,qr[0],negm,0,0,0);p1=__builtin_amdgcn_mfma_f32_32x32x16_bf16(b1,qr[0],negm,0,0,0);}
    else{p0=__builtin_amdgcn_mfma_f32_32x32x16_bf16(b0,qr[d0],p0,0,0,0);p1=__builtin_amdgcn_mfma_f32_32x32x16_bf16(b1,qr[d0],p1,0,0,0);}}
}
__device__ __forceinline__ void kload8(bf16x8*kf,lds_cptr kp){
  kf[0]=*(const __attribute__((address_space(3))) bf16x8*)(kp);      kf[1]=*(const __attribute__((address_space(3))) bf16x8*)(kp+512);
  kf[2]=*(const __attribute__((address_space(3))) bf16x8*)(kp+2048); kf[3]=*(const __attribute__((address_space(3))) bf16x8*)(kp+2560);
  kf[4]=*(const __attribute__((address_space(3))) bf16x8*)(kp+4096); kf[5]=*(const __attribute__((address_space(3))) bf16x8*)(kp+4608);
  kf[6]=*(const __attribute__((address_space(3))) bf16x8*)(kp+6144); kf[7]=*(const __attribute__((address_space(3))) bf16x8*)(kp+6656);
}
__device__ __forceinline__ void kload2(bf16x8*kf,lds_cptr kp,int j){ kf[2*j]=*(const __attribute__((address_space(3))) bf16x8*)(kp+j*2048); kf[2*j+1]=*(const __attribute__((address_space(3))) bf16x8*)(kp+j*2048+512); }
__device__ __forceinline__ s16x4 vtr(lds_cptr p){ return __builtin_bit_cast(s16x4,__builtin_amdgcn_ds_read_tr16_b64_v4i16((__attribute__((address_space(3))) v4i16_t*)p)); }
__device__ __forceinline__ float rowmax(const f32x16&p0,const f32x16&p1){
  float a=max3f(p0[0],p0[1],p1[0]),b=max3f(p0[2],p0[3],p1[1]);a=max3f(a,p1[2],p1[3]);
  #pragma unroll
  for(int r=4;r<16;r+=4){a=max3f(a,p0[r],p0[r+1]);b=max3f(b,p0[r+2],p0[r+3]);a=max3f(a,p1[r],p1[r+1]);b=max3f(b,p1[r+2],p1[r+3]);}
  const float m=max2f(a,b);
  auto rr=__builtin_amdgcn_permlane32_swap(__float_as_uint(m),__float_as_uint(m),false,false);
  return max2f(__uint_as_float(rr[0]),__uint_as_float(rr[1]));
}
__device__ __forceinline__ void pv(f32x16*o,int vb,bf16x8 pa0,bf16x8 pa1,bf16x8 pa2,bf16x8 pa3){
  #pragma unroll
  for(int d0=0;d0<2;++d0){s16x4 lo[4],hi[4];
    #pragma unroll
    for(int ks=0;ks<4;++ks){
      asm volatile("ds_read_b64_tr_b16 %0,%1 offset:%c2":"=&v"(lo[ks]):"v"(vb),"i"(d0*4096+ks*1024):"memory");
      asm volatile("ds_read_b64_tr_b16 %0,%1 offset:%c2":"=&v"(hi[ks]):"v"(vb),"i"(d0*4096+ks*1024+512):"memory");}
    asm volatile("s_waitcnt lgkmcnt(0)":::"memory");SBAR();
    #define PK(k) (bf16x8){lo[k][0],lo[k][1],lo[k][2],lo[k][3],hi[k][0],hi[k][1],hi[k][2],hi[k][3]}
    o[d0]=__builtin_amdgcn_mfma_f32_32x32x16_bf16(pa0,PK(0),o[d0],0,0,0);
    o[d0]=__builtin_amdgcn_mfma_f32_32x32x16_bf16(pa1,PK(1),o[d0],0,0,0);
    o[d0]=__builtin_amdgcn_mfma_f32_32x32x16_bf16(pa2,PK(2),o[d0],0,0,0);
    o[d0]=__builtin_amdgcn_mfma_f32_32x32x16_bf16(pa3,PK(3),o[d0],0,0,0);
    #undef PK
  }
}

template<int THRL> __device__ __forceinline__ void moba_unit(int b,int h,int qb,const bf16_t*proj,bf16_t*Y,const float*kmp,LAS unsigned char*shm){
  int tid_=threadIdx.x; asm volatile("":"+v"(tid_));
  const int tid=tid_,lane=tid&63,r32=lane&31,hi=lane>>5; const int wid=__builtin_amdgcn_readfirstlane(tid>>6);
  const long rowbase=(long)b*SEQ; const int q0=qb*QB;
  const bf16_t*Qw=proj+(rowbase+q0+wid*QBLK)*DM+768+h*64;
  const bf16_t*Kh=proj+rowbase*DM+1280+h*64,*Vh=proj+rowbase*DM+1792+h*64;
  const unsigned lds0=(unsigned)(uintptr_t)shm;
  LAS float*wsf=(LAS float*)(shm+LDS_WS)+wid*64;
  const bf16_t*ksrc=Kh+(long)lane*DM+wid*8;
  const bf16_t*vsrc=Vh+(long)(16*(wid&3)+(lane>>2))*DM+(wid>>2)*32+(lane&3)*8;
  const unsigned kdst=lds0+LDS_K+wid*1024, vdst=lds0+LDS_V+wid*1024;
  #define DMA_K(t,slot) glds16(ksrc+(long)(t)*KVBLK*DM,(unsigned)__builtin_amdgcn_readfirstlane(kdst+(slot)))
  #define DMA_V(t,slot) glds16(vsrc+(long)(t)*KVBLK*DM,(unsigned)__builtin_amdgcn_readfirstlane(vdst+(slot)))
  const int vb0=(int)(lds0+LDS_V)+((lane>>4)&1)*32+(lane&3)*8+(4*hi+((lane&15)>>2))*64;
  const lds_cptr Kbase=(lds_cptr)(shm+LDS_K); bf16x8 kf[8];
  const lds_cptr shm3=(lds_cptr)shm; const lds_cptr kp0=shm3+LDS_K+hi*1024+r32*16; const lds_cptr vp0=shm3+LDS_V+((lane>>4)&1)*32+(lane&3)*8+(4*hi+((lane&15)>>2))*64;
  const int NT=(q0+QB)/KVBLK;
  bf16x8 qr[4];
  #pragma unroll
  for(int d0=0;d0<4;++d0)qr[d0]=*reinterpret_cast<const bf16x8*>(&Qw[(long)r32*DM+d0*16+hi*8]);
  LAS float*km=(LAS float*)(shm+LDS_KM);
  if(tid<qb*64){ const int n_=tid>>6,d_=tid&63; const float*p_=kmp+((size_t)(((b*8+n_)*8+h)*2))*64+d_; km[tid]=p_[0]+p_[64]; }
  DMA_K(0,0);DMA_V(0,0);DMA_K(1,SLOTB);
  asm volatile("s_waitcnt lgkmcnt(0)\n\ts_barrier":::"memory");
  unsigned sel=0u;
  if(qb<=3)sel=(1u<<qb)-1u;
  else{
    float qf[32];
    #pragma unroll
    for(int d0=0;d0<4;++d0)
      #pragma unroll
      for(int j=0;j<8;++j)qf[d0*8+j]=bf1((bf16_t)qr[d0][j]);
    float gsc[7];
    #pragma unroll
    for(int n=0;n<7;++n){
      float a=0.f;
      if(n<qb){
        #pragma unroll
        for(int d0=0;d0<4;++d0){ const f32x4 k0=*(LAS const f32x4*)(km+n*64+d0*16+hi*8),k1=*(LAS const f32x4*)(km+n*64+d0*16+hi*8+4);
          a+=qf[d0*8+0]*k0[0]+qf[d0*8+1]*k0[1]+qf[d0*8+2]*k0[2]+qf[d0*8+3]*k0[3]+qf[d0*8+4]*k1[0]+qf[d0*8+5]*k1[1]+qf[d0*8+6]*k1[2]+qf[d0*8+7]*k1[3]; }
        a=addx32(a);
      } else a=-INFINITY;
      gsc[n]=a;
    }
    #pragma unroll
    for(int n=0;n<7;++n){ int cnt=0;
      #pragma unroll
      for(int m2=0;m2<7;++m2) if(m2!=n) cnt+=(gsc[m2]>gsc[n]||(gsc[m2]==gsc[n]&&m2<n))?1:0;
      if(cnt<3&&n<qb)sel|=1u<<n; }
  }
  float mhat=0.f,l_reg=0.f;f32x16 o[2];o[0]=f32x16{};o[1]=f32x16{};f32x16 negm=f32x16{};asm volatile("":"+v"(negm));
  const int qrel=wid*QBLK+r32;
  #define BLKM(P0,P1,t) do{ const float mk_=((sel>>((t)>>2))&1u)?0.f:-INFINITY; _Pragma("unroll") for(int r=0;r<16;++r){P0[r]+=mk_;P1[r]+=mk_;} }while(0)
  #define CMASK(P0,P1,t) do{int jb_=(t)-(NT-4); if(jb_>=0)cmask(P0,P1,jb_,qrel,hi); else BLKM(P0,P1,t);}while(0)
  bool resc=false;
  #define START(P0,P1) do{ const float rm=rowmax(P0,P1); resc=false; \
    { const float dl=__builtin_fmaxf(rm,-60.f); mhat=fadd_s(mhat,dl); \
      _Pragma("unroll") for(int r=0;r<16;++r){P0[r]=fsub_s(P0[r],dl);P1[r]=fsub_s(P1[r],dl);} \
      _Pragma("unroll") for(int r=0;r<16;++r)negm[r]=-mhat; asm volatile("":"+v"(negm)); } \
    _Pragma("unroll") for(int r=0;r<16;++r)P0[r]=__builtin_amdgcn_exp2f(P0[r]); }while(0)
  #define RESC() do{ if(resc){ asm volatile("s_waitcnt lgkmcnt(0)":::"memory"); \
      _Pragma("unroll") for(int d_=0;d_<2;++d_) _Pragma("unroll") for(int r=0;r<16;++r)o[d_][r]*=wsf[crow(r,hi)]; } }while(0)
  f32x16 pA0,pA1,pB0,pB1;
  int sl_prev=0,sl_cur=0,sl_next=SLOTB;
  #define ROT() do{sl_prev=sl_cur;sl_cur=sl_next;sl_next=(sl_next==(NSLOT-1)*SLOTB)?0:sl_next+SLOTB;}while(0)
  DMA_K(2,2*SLOTB);
  WAIT_BAR(3);
  qkt(pA0,pA1,Kbase,qr,negm,r32,hi);asm volatile("s_nop 15\n\ts_nop 7":"+v"(pA0),"+v"(pA1));CMASK(pA0,pA1,0);
  START(pA0,pA1);
  _Pragma("unroll") for(int r=0;r<16;++r)pA1[r]=__builtin_amdgcn_exp2f(pA1[r]);
  WAIT_BAR(0);
  DMA_K(3,0);DMA_V(1,SLOTB);
  ROT();
  kload8(kf,kp0+sl_cur);
  WAIT_BAR(2);
  s16x4 vlo[8],vhi[8]; u32x4 pw0,pw1,pw2,pw3;
  #define PKW(P,B) cvtpk_s(P[B],P[B+1])
  #define PAF(k) __builtin_bit_cast(bf16x8,pw##k)
  #define VFR(i) (bf16x8){vlo[i][0],vlo[i][1],vlo[i][2],vlo[i][3],vhi[i][0],vhi[i][1],vhi[i][2],vhi[i][3]}
  #define PIN(x) asm volatile("":"+v"(x))
  #define MX3(a,b,c) __builtin_fmaxf(__builtin_fmaxf((a),(b)),(c))
  #define GAPA(MF,A0,A1,A2,A3,W0,W1,PW) do{ MF; sacc+=A0; sacc+=A1; sacc+=A2; sacc+=A3; PIN(sacc); W0; W1; PIN(PW); SBAR(); }while(0)
  #define EX(v) __builtin_amdgcn_exp2f(v)
  #define GAPB(MF,X,B) do{ MF; X[B]=EX(X[B]); X[B+1]=EX(X[B+1]); X[B+2]=EX(X[B+2]); X[B+3]=EX(X[B+3]); PIN(X); SBAR(); }while(0)
  #define VRD(i) do{ vlo[i]=vtr(vp_+(((i)>>2)*4096+((i)&3)*1024)); vhi[i]=vtr(vp_+(((i)>>2)*4096+((i)&3)*1024+512)); }while(0)
  #define KRD(G,j) do{ if(G){ kload2(kf,kp0+sl_next,j); SBAR(); } }while(0)
  #define STEP(C0,C1,P0,P1,t,GK,GV,GL) do{ SBAR(); \
    const lds_cptr vp_=vp0+sl_prev; \
    VRD(0); SBAR(); float sacc=(P0[0]+P0[1]); \
    GAPA(C0=__builtin_amdgcn_mfma_f32_32x32x16_bf16(kf[0],qr[0],negm,0,0,0), P0[2],P0[3],P0[4],P0[5],     pw0[0]=PKW(P0,0), pw0[1]=PKW(P0,2), pw0); \
    VRD(4); SBAR(); GAPA(C1=__builtin_amdgcn_mfma_f32_32x32x16_bf16(kf[1],qr[0],negm,0,0,0), P0[6],P0[7],P0[8],P0[9],     pw0[2]=PKW(P0,4), pw0[3]=PKW(P0,6), pw0); \
    VRD(1); SBAR(); GAPA(C0=__builtin_amdgcn_mfma_f32_32x32x16_bf16(kf[2],qr[1],C0,0,0,0),   P0[10],P0[11],P0[12],P0[13], pw1[0]=PKW(P0,8), pw1[1]=PKW(P0,10), pw1); \
    VRD(5); SBAR(); GAPA(C1=__builtin_amdgcn_mfma_f32_32x32x16_bf16(kf[3],qr[1],C1,0,0,0),   P0[14],P0[15],P1[0],P1[1],   pw1[2]=PKW(P0,12),pw1[3]=PKW(P0,14), pw1); \
    VRD(2); SBAR(); GAPA(C0=__builtin_amdgcn_mfma_f32_32x32x16_bf16(kf[4],qr[2],C0,0,0,0),   P1[2],P1[3],P1[4],P1[5],     pw2[0]=PKW(P1,0), pw2[1]=PKW(P1,2), pw2); \
    VRD(6); SBAR(); GAPA(C1=__builtin_amdgcn_mfma_f32_32x32x16_bf16(kf[5],qr[2],C1,0,0,0),   P1[6],P1[7],P1[8],P1[9],     pw2[2]=PKW(P1,4), pw2[3]=PKW(P1,6), pw2); \
    VRD(3); SBAR(); GAPA(C0=__builtin_amdgcn_mfma_f32_32x32x16_bf16(kf[6],qr[3],C0,0,0,0),   P1[10],P1[11],P1[12],P1[13], pw3[0]=PKW(P1,8), pw3[1]=PKW(P1,10), pw3); \
    VRD(7); SBAR(); GAPA(C1=__builtin_amdgcn_mfma_f32_32x32x16_bf16(kf[7],qr[3],C1,0,0,0),   P1[14],P1[15],0.f,0.f,       pw3[2]=PKW(P1,12),pw3[3]=PKW(P1,14), pw3); \
    l_reg+=sacc; \
    if(GK){DMA_K((t)+3,sl_cur);} if(GV){DMA_V((t)+1,sl_next);} \
    CMASK(C0,C1,t); \
    { float a=MX3(C0[0],C0[1],C1[0]),b=MX3(C0[2],C0[3],C1[1]); a=MX3(a,C1[2],C1[3]); \
      _Pragma("unroll") for(int r=4;r<16;r+=4){a=MX3(a,C0[r],C0[r+1]);b=MX3(b,C0[r+2],C0[r+3]);a=MX3(a,C1[r],C1[r+1]);b=MX3(b,C1[r+2],C1[r+3]);} \
      float rm=__builtin_fmaxf(a,b); { auto rr=__builtin_amdgcn_permlane32_swap(__float_as_uint(rm),__float_as_uint(rm),false,false); rm=__builtin_fmaxf(__uint_as_float(rr[0]),__uint_as_float(rr[1])); } \
      resc=false; \
      if(__builtin_expect(__any(rm>(float)THRL),0)){ const float dl=__builtin_fmaxf(rm,0.f); mhat+=dl; \
        _Pragma("unroll") for(int r=0;r<16;++r){C0[r]-=dl;C1[r]-=dl;} \
        _Pragma("unroll") for(int r=0;r<16;++r)negm[r]=-mhat; asm volatile("":"+v"(negm)); \
        const float f=__builtin_amdgcn_exp2f(-dl); l_reg*=f; if(hi==0)wsf[r32]=f; resc=true; } } \
    SBAR(); \
    GAPB(o[0]=__builtin_amdgcn_mfma_f32_32x32x16_bf16(PAF(0),VFR(0),o[0],0,0,0), C0,0); \
    GAPB(o[1]=__builtin_amdgcn_mfma_f32_32x32x16_bf16(PAF(0),VFR(4),o[1],0,0,0), C0,4); \
    KRD(GL,0); GAPB(o[0]=__builtin_amdgcn_mfma_f32_32x32x16_bf16(PAF(1),VFR(1),o[0],0,0,0), C0,8); \
    KRD(GL,1); GAPB(o[1]=__builtin_amdgcn_mfma_f32_32x32x16_bf16(PAF(1),VFR(5),o[1],0,0,0), C0,12); \
    KRD(GL,2); GAPB(o[0]=__builtin_amdgcn_mfma_f32_32x32x16_bf16(PAF(2),VFR(2),o[0],0,0,0), C1,0); \
    KRD(GL,3); GAPB(o[1]=__builtin_amdgcn_mfma_f32_32x32x16_bf16(PAF(2),VFR(6),o[1],0,0,0), C1,4); \
    GAPB(o[0]=__builtin_amdgcn_mfma_f32_32x32x16_bf16(PAF(3),VFR(3),o[0],0,0,0), C1,8); \
    GAPB(o[1]=__builtin_amdgcn_mfma_f32_32x32x16_bf16(PAF(3),VFR(7),o[1],0,0,0), C1,12); \
    }while(0)
  int t=1;
  #undef CMASK
  #define CMASK(P0,P1,t) BLKM(P0,P1,t)
  for(;t+5<NT;t+=2){
    STEP(pB0,pB1,pA0,pA1,t,true,true,true);     WAIT_BAR(2); RESC(); ROT();
    STEP(pA0,pA1,pB0,pB1,t+1,true,true,true);   WAIT_BAR(2); RESC(); ROT();
  }
  #undef CMASK
  #define CMASK(P0,P1,t) do{int jb_=(t)-(NT-4); if(jb_>=0)cmask(P0,P1,jb_,qrel,hi); else BLKM(P0,P1,t);}while(0)
  #define ENDW(tt) do{ if((tt)+3<NT){WAIT_BAR(2);} else if((tt)+2<NT){WAIT_BAR(1);} else {WAIT_BAR(0);} }while(0)
  for(;t+1<NT;t+=2){
    STEP(pB0,pB1,pA0,pA1,t,(t+3<NT),(t+1<NT),(t+1<NT));       ENDW(t);   RESC(); ROT();
    STEP(pA0,pA1,pB0,pB1,t+1,(t+4<NT),(t+2<NT),(t+2<NT));     ENDW(t+1); RESC(); ROT();
  }
  STEP(pB0,pB1,pA0,pA1,NT-1,false,false,false); RESC();
  { float sacc=pB0[0]+pB0[1]; _Pragma("unroll") for(int r=2;r<16;++r)sacc+=pB0[r]; _Pragma("unroll") for(int r=0;r<16;++r)sacc+=pB1[r]; l_reg+=sacc;
    pw0=(u32x4){PKW(pB0,0),PKW(pB0,2),PKW(pB0,4),PKW(pB0,6)};pw1=(u32x4){PKW(pB0,8),PKW(pB0,10),PKW(pB0,12),PKW(pB0,14)};pw2=(u32x4){PKW(pB1,0),PKW(pB1,2),PKW(pB1,4),PKW(pB1,6)};pw3=(u32x4){PKW(pB1,8),PKW(pB1,10),PKW(pB1,12),PKW(pB1,14)};
    SBAR(); pv(o,vb0+sl_cur,PAF(0),PAF(1),PAF(2),PAF(3)); }
  #undef PKW
  #undef PAF
  #undef VFR
  #undef PIN
  #undef MX3
  #undef GAPA
  #undef GAPB
  #undef EX
  #undef VRD
  #undef KRD
  #undef STEP
  #undef ENDW
  {auto rr=__builtin_amdgcn_permlane32_swap(__float_as_uint(l_reg),__float_as_uint(l_reg),false,false);l_reg=__uint_as_float(rr[0])+__uint_as_float(rr[1]);}
  if(hi==0)wsf[32+r32]=l_reg;asm volatile("s_waitcnt lgkmcnt(0)":::"memory");
  float rli[16];
  #pragma unroll
  for(int r=0;r<16;++r)rli[r]=__builtin_amdgcn_rcpf(wsf[32+crow(r,hi)]);
  bf16_t*Ow=Y+(rowbase+q0+wid*QBLK)*YW+512+h*64;
  { LAS bf16_t*stg=(LAS bf16_t*)(shm+LDS_OST)+wid*2048;
    #pragma unroll
    for(int r=0;r<16;++r){const int orow=crow(r,hi);
      #pragma unroll
      for(int d0=0;d0<2;++d0)stg[orow*64+d0*32+r32]=f2bf(o[d0][r]*rli[r]);}
    asm volatile("s_waitcnt lgkmcnt(0)":::"memory");
    #pragma unroll
    for(int i=0;i<4;++i){const int row=i*8+(lane>>3),ch=lane&7; const u32x4 v=*(LAS const u32x4*)(stg+row*64+ch*8); *(u32x4*)(Ow+(long)row*YW+ch*8)=v;} }
  asm volatile("s_waitcnt lgkmcnt(0)\n\ts_barrier":::"memory");
  #undef DMA_K
  #undef DMA_V
  #undef CMASK
  #undef BLKM
  #undef START
  #undef RESC
  #undef ROT
}

#undef SBAR
#undef WAIT_BAR
}

namespace gla {
constexpr int PB = 144, PV = 272;
constexpr int L_LAR = 0, L_QR = 9216, L_KR = 18432, L_VR = 27648, L_RR = 45056, L_QD = 62464, L_KD = 71680, L_KTL = 80896, L_AM = 90112, L_DEC = 99328, L_SSQ = 99584, L_Y = 101632, L_END = 119040;
__device__ __forceinline__ f32x4 mfma16(bf16x8 a, bf16x8 b, f32x4 c) { return __builtin_amdgcn_mfma_f32_16x16x32_bf16(a, b, c, 0, 0, 0); }
__device__ __forceinline__ s16x4 trd(LAS const unsigned char* p) { return __builtin_bit_cast(s16x4, __builtin_amdgcn_ds_read_tr16_b64_v4i16((LAS v4i16_t*)p)); }
__device__ __forceinline__ bf16x8 tr_frag(LAS const unsigned char* img, int pitch, int k0, int c0, int lane) {
    const int g = lane >> 4, q = (lane & 15) >> 2, p = lane & 3;
    LAS const unsigned char* a = img + (k0 + 8 * g + q) * pitch + (c0 + 4 * p) * 2;
    const s16x4 lo = trd(a), hi = trd(a + 4 * pitch);
    return (bf16x8){lo[0], lo[1], lo[2], lo[3], hi[0], hi[1], hi[2], hi[3]};
}

template <int VAR = 0> __device__ __forceinline__ void gla_unit(const bf16_t* proj, bf16_t* Y, int b, int h, const float* gnorm, LAS unsigned char* lds) {
    int tid_ = threadIdx.x; asm volatile("" : "+v"(tid_));
    const int tid = tid_, lane = tid & 63, fr = lane & 15, fq = lane >> 4; const int wid = __builtin_amdgcn_readfirstlane(tid >> 6);
    const long rowbase = (long)b * SEQ;
    const int cq = 2304 + 64 * h, ck = 2560 + 64 * h, cv = 2816 + 128 * h, cla = 3328 + 64 * h, cr = 3584 + 128 * h;
    const int lt = tid >> 3, ldc = (tid & 7) * 8;
    const int vrow0 = tid >> 4, ve0 = (tid & 15) * 8;
    f32x4 sd[4];
#pragma unroll
    for (int i = 0; i < 4; ++i) sd[i] = (f32x4){0.f, 0.f, 0.f, 0.f};
    const f32x4 gn4 = *(const f32x4*)(gnorm + 16 * wid + 4 * fq);
    u32x4 nq, nk, nla, nv0, nv1, nr0, nr1;
    {
        const bf16_t* base = proj + (rowbase + lt) * PP;
        nq = *(const u32x4*)(base + cq + ldc); nk = *(const u32x4*)(base + ck + ldc); nla = *(const u32x4*)(base + cla + ldc);
        const bf16_t* bv = proj + (rowbase + vrow0) * PP;
        nv0 = *(const u32x4*)(bv + cv + ve0); nv1 = *(const u32x4*)(bv + (size_t)32 * PP + cv + ve0);
        nr0 = *(const u32x4*)(bv + cr + ve0); nr1 = *(const u32x4*)(bv + (size_t)32 * PP + cr + ve0);
    }
    LAS float* DEC = (LAS float*)(lds + L_DEC); LAS float* SSQ = (LAS float*)(lds + L_SSQ);
    const int db = wid & 3, ibp = wid >> 2;
    for (int n = 0; n < 32; ++n) {
        *(LAS u32x4*)(lds + L_LAR + lt * PB + ldc * 2) = nla; *(LAS u32x4*)(lds + L_QR + lt * PB + ldc * 2) = nq; *(LAS u32x4*)(lds + L_KR + lt * PB + ldc * 2) = nk;
        *(LAS u32x4*)(lds + L_VR + vrow0 * PV + ve0 * 2) = nv0; *(LAS u32x4*)(lds + L_VR + (vrow0 + 32) * PV + ve0 * 2) = nv1;
        const int rro = (n & 1) ? L_Y : L_RR;
        *(LAS u32x4*)(lds + rro + vrow0 * PV + ve0 * 2) = nr0; *(LAS u32x4*)(lds + rro + (vrow0 + 32) * PV + ve0 * 2) = nr1;
        if (n + 1 < 32) {
            const long r1 = rowbase + (long)(n + 1) * 64;
            const bf16_t* base = proj + (r1 + lt) * PP;
            nq = *(const u32x4*)(base + cq + ldc); nk = *(const u32x4*)(base + ck + ldc); nla = *(const u32x4*)(base + cla + ldc);
            const bf16_t* bv = proj + (r1 + vrow0) * PP;
            nv0 = *(const u32x4*)(bv + cv + ve0); nv1 = *(const u32x4*)(bv + (size_t)32 * PP + cv + ve0);
            nr0 = *(const u32x4*)(bv + cr + ve0); nr1 = *(const u32x4*)(bv + (size_t)32 * PP + cr + ve0);
        }
        LDS_WAIT(); __builtin_amdgcn_s_barrier(); asm volatile("" ::: "memory");
        {
            bf16x8 af[2];
#pragma unroll
            for (int s = 0; s < 2; ++s) af[s] = tr_frag(lds + L_LAR, PB, 32 * s, 16 * db, lane);
            const u32x4 one4 = {0x3F803F80u, 0x3F803F80u, 0x3F803F80u, 0x3F803F80u};
            f32x4 bl = {0.f, 0.f, 0.f, 0.f};
            bl = mfma16(af[0], __builtin_bit_cast(bf16x8, one4), bl); bl = mfma16(af[1], __builtin_bit_cast(bf16x8, one4), bl);
#pragma unroll
            for (int rep = 0; rep < 2; ++rep) {
                const int ib = 2 * ibp + rep, i_ = 16 * ib + fr;
                f32x4 bc = {0.f, 0.f, 0.f, 0.f};
#pragma unroll
                for (int s = 0; s < 2; ++s) {
                    const int nones = i_ - (32 * s + 8 * fq) + 1;
                    u32x4 lw;
                    lw.x = (nones > 0 ? 0x3F80u : 0u) | (nones > 1 ? 0x3F800000u : 0u); lw.y = (nones > 2 ? 0x3F80u : 0u) | (nones > 3 ? 0x3F800000u : 0u);
                    lw.z = (nones > 4 ? 0x3F80u : 0u) | (nones > 5 ? 0x3F800000u : 0u); lw.w = (nones > 6 ? 0x3F80u : 0u) | (nones > 7 ? 0x3F800000u : 0u);
                    bc = mfma16(af[s], __builtin_bit_cast(bf16x8, lw), bc);
                }
                const int off = i_ * PB + (16 * db + 4 * fq) * 2;
                const u32x2 qw = *(LAS const u32x2*)(lds + L_QR + off), kw = *(LAS const u32x2*)(lds + L_KR + off);
                const float q4[4] = {bf_lo(qw.x), bf_hi(qw.x), bf_lo(qw.y), bf_hi(qw.y)}, k4[4] = {bf_lo(kw.x), bf_hi(kw.x), bf_lo(kw.y), bf_hi(kw.y)};
                float qd[4], kd[4], kt[4];
#pragma unroll
                for (int r = 0; r < 4; ++r) { qd[r] = q4[r] * fexp(bc[r]); kd[r] = k4[r] * fexp(-bc[r]); kt[r] = k4[r] * fexp(bl[r] - bc[r]); }
                *(LAS u32x2*)(lds + L_QD + off) = (u32x2){cvt_pk_bf16(qd[0], qd[1]), cvt_pk_bf16(qd[2], qd[3])};
                *(LAS u32x2*)(lds + L_KD + off) = (u32x2){cvt_pk_bf16(kd[0], kd[1]), cvt_pk_bf16(kd[2], kd[3])};
                *(LAS u32x2*)(lds + L_KTL + off) = (u32x2){cvt_pk_bf16(kt[0], kt[1]), cvt_pk_bf16(kt[2], kt[3])};
            }
            if (ibp == 0 && fr == 0) *(LAS f32x4*)(DEC + 16 * db + 4 * fq) = (f32x4){fexp(bl[0]), fexp(bl[1]), fexp(bl[2]), fexp(bl[3])};
        }
        LDS_WAIT(); __builtin_amdgcn_s_barrier(); asm volatile("" ::: "memory");
#pragma unroll
        for (int rep = 0; rep < 2; ++rep) {
            const int id = wid + 8 * rep, ib = id >> 2, jb = id & 3;
            u32x2 w = {0u, 0u};
            if (jb <= ib) {
                f32x4 a = {0.f, 0.f, 0.f, 0.f};
#pragma unroll
                for (int s = 0; s < 2; ++s) {
                    const bf16x8 ka = *(LAS const bf16x8*)(lds + L_KD + (16 * jb + fr) * PB + (32 * s + 8 * fq) * 2);
                    const bf16x8 qb_ = *(LAS const bf16x8*)(lds + L_QD + (16 * ib + fr) * PB + (32 * s + 8 * fq) * 2);
                    a = mfma16(ka, qb_, a);
                }
                const int i_ = 16 * ib + fr, j0 = 16 * jb + 4 * fq;
#pragma unroll
                for (int r = 0; r < 4; ++r) if (j0 + r > i_) a[r] = 0.f;
                w.x = cvt_pk_bf16(a[0], a[1]); w.y = cvt_pk_bf16(a[2], a[3]);
            }
            *(LAS u32x2*)(lds + L_AM + (16 * ib + fr) * PB + (16 * jb + 4 * fq) * 2) = w;
        }
        f32x4 ao[4];
        {
            bf16x8 sb[2];
#pragma unroll
            for (int s = 0; s < 2; ++s) { u32x4 w; w.x = cvt_pk_bf16(sd[2 * s][0], sd[2 * s][1]); w.y = cvt_pk_bf16(sd[2 * s][2], sd[2 * s][3]); w.z = cvt_pk_bf16(sd[2 * s + 1][0], sd[2 * s + 1][1]); w.w = cvt_pk_bf16(sd[2 * s + 1][2], sd[2 * s + 1][3]); sb[s] = __builtin_bit_cast(bf16x8, w); }
#pragma unroll
            for (int ib = 0; ib < 4; ++ib) {
                f32x4 a = {0.f, 0.f, 0.f, 0.f};
#pragma unroll
                for (int s = 0; s < 2; ++s) {
                    const u32x2 lo = *(LAS const u32x2*)(lds + L_QD + (16 * ib + fr) * PB + (32 * s + 4 * fq) * 2);
                    const u32x2 hi = *(LAS const u32x2*)(lds + L_QD + (16 * ib + fr) * PB + (32 * s + 16 + 4 * fq) * 2);
                    const u32x4 qa = {lo.x, lo.y, hi.x, hi.y};
                    a = mfma16(sb[s], __builtin_bit_cast(bf16x8, qa), a);
                }
                ao[ib] = a;
            }
        }
        LDS_WAIT(); __builtin_amdgcn_s_barrier(); asm volatile("" ::: "memory");
        {
            bf16x8 vf[2];
#pragma unroll
            for (int s = 0; s < 2; ++s) vf[s] = tr_frag(lds + L_VR, PV, 32 * s, 16 * wid, lane);
#pragma unroll
            for (int ib = 0; ib < 4; ++ib)
#pragma unroll
                for (int s = 0; s < 2; ++s) {
                    if (32 * s > 16 * ib + 15) continue;
                    const bf16x8 af = *(LAS const bf16x8*)(lds + L_AM + (16 * ib + fr) * PB + (32 * s + 8 * fq) * 2);
                    ao[ib] = mfma16(vf[s], af, ao[ib]);
                }
#pragma unroll
            for (int d4 = 0; d4 < 4; ++d4) {
                const f32x4 dc = *(LAS const f32x4*)(DEC + 16 * d4 + 4 * fq);
                f32x4 a = sd[d4] * dc;
#pragma unroll
                for (int s = 0; s < 2; ++s) { const bf16x8 kf = tr_frag(lds + L_KTL, PB, 32 * s, 16 * d4, lane); a = mfma16(kf, vf[s], a); }
                sd[d4] = a;
            }
        }
#pragma unroll
        for (int ib = 0; ib < 4; ++ib) { float v = (ao[ib][0] * ao[ib][0] + ao[ib][1] * ao[ib][1]) + (ao[ib][2] * ao[ib][2] + ao[ib][3] * ao[ib][3]); v = addx32(addx16(v));
            if (fq == 0) SSQ[(16 * ib + fr) * 8 + wid] = v; }
        LDS_WAIT(); __builtin_amdgcn_s_barrier(); asm volatile("" ::: "memory");
        {
            const long r0 = rowbase + (long)n * 64;
#pragma unroll
            for (int ib = 0; ib < 4; ++ib) { const int i_ = 16 * ib + fr;
                const f32x4 s0 = *(LAS const f32x4*)(SSQ + i_ * 8), s1 = *(LAS const f32x4*)(SSQ + i_ * 8 + 4);
                const float tot = ((s0[0] + s0[1]) + (s0[2] + s0[3])) + ((s1[0] + s1[1]) + (s1[2] + s1[3]));
                const float rstd = frsq(tot * (1.0f / 128.0f) + EPS);
                const u32x2 rw = *(LAS const u32x2*)(lds + rro + i_ * PV + (16 * wid + 4 * fq) * 2);
                const f32x4 y = ao[ib] * rstd * gn4 * (f32x4){bf_lo(rw.x), bf_hi(rw.x), bf_lo(rw.y), bf_hi(rw.y)};
                *(u32x2*)(Y + (r0 + i_) * YW + 1024 + 128 * h + 16 * wid + 4 * fq) = (u32x2){cvt_pk_bf16(y[0], y[1]), cvt_pk_bf16(y[2], y[3])}; }
        }
    }
    LDS_WAIT(); __builtin_amdgcn_s_barrier(); asm volatile("" ::: "memory");
}
}

constexpr int NWAVES = 8;
constexpr int RING_BYTES = 131072, MISC_OFF = RING_BYTES, LDS_BYTES = 147456;
static_assert(gla::L_END <= RING_BYTES && att::L_END <= RING_BYTES && att2::LDS_BYTES <= RING_BYTES, "LDS map");

struct Params { const float* in[20]; float* out; unsigned char* ws; double invf[32]; int ph_lo, ph_hi; };

__device__ __forceinline__ void norm_row(const float* xrow, const float* gain, bf16_t* orow, int lane) {
    const f32x4* xr = (const f32x4*)xrow + lane; const f32x4* gr = (const f32x4*)gain + lane;
    f32x4 v[4]; float s = 0.f;
#pragma unroll
    for (int j = 0; j < 4; ++j) { v[j] = xr[64 * j]; s += (v[j][0] * v[j][0] + v[j][1] * v[j][1]) + (v[j][2] * v[j][2] + v[j][3] * v[j][3]); }
    const float rstd = 1.0f / sqrtf(wave_sum(s) * (1.0f / D) + EPS);
    u32x2* o8 = (u32x2*)orow + lane;
#pragma unroll
    for (int j = 0; j < 4; ++j) { const f32x4 g = gr[64 * j]; u32x2 w; w.x = cvt_pk_bf16(v[j][0] * rstd * g[0], v[j][1] * rstd * g[1]); w.y = cvt_pk_bf16(v[j][2] * rstd * g[2], v[j][3] * rstd * g[3]); o8[64 * j] = w; }
}
__device__ __forceinline__ void norm_phase(const float* x, const float* gain, bf16_t* H, int gw, int ngw, int lane) {
    for (int m = gw; m < T; m += ngw) norm_row(x + (size_t)m * D, gain, H + (size_t)m * D, lane);
}

__device__ __forceinline__ void conv_item(const float* src, int pitch, int col, int K, bf16_t* dst, int prow, int k0, const float* kscale = nullptr) {
    const float* s = src + (size_t)k0 * pitch + col;
    bf16_t* d = dst + (size_t)prow * K + k0;
#pragma unroll 2
    for (int kk = 0; kk < 8; ++kk) {
        float v[8];
#pragma unroll
        for (int i = 0; i < 8; ++i) v[i] = s[(size_t)(kk * 8 + i) * pitch];
        if (kscale) {
#pragma unroll
            for (int i = 0; i < 8; ++i) v[i] *= kscale[k0 + kk * 8 + i]; }
        u32x4 w; w.x = cvt_pk_bf16(v[0], v[1]); w.y = cvt_pk_bf16(v[2], v[3]); w.z = cvt_pk_bf16(v[4], v[5]); w.w = cvt_pk_bf16(v[6], v[7]);
        *(u32x4*)(d + kk * 8) = w;
    }
}
constexpr int IT_WIN = (PW / 64) * (D / 64), IT_WG = (GW / 64) * (D / 64), IT_WB = 3 * (D / 64) * (512 / 64), IT_WO = (D / 64) * (D / 64), IT_F1 = (FFP / 64) * (D / 64), IT_F2 = (D / 64) * (FF / 64);
constexpr int IT_LAYER = IT_WIN + IT_WG + IT_WB + IT_WO + IT_F1 + IT_F2;

__device__ __forceinline__ void sincos_d(double a, float& c, float& s) {
    const double kq = rint(a * 0.63661977236758134308);
    double r = fma(-kq, 1.57079632679489655800e+00, a); r = fma(-kq, 6.12323399573676603587e-17, r);
    const double r2 = r * r;
    const double sp = r * (1.0 + r2 * (-1.0 / 6 + r2 * (1.0 / 120 + r2 * (-1.0 / 5040 + r2 * (1.0 / 362880 + r2 * (-1.0 / 39916800 + r2 * (1.0 / 6227020800.0)))))));
    const double cp = 1.0 + r2 * (-0.5 + r2 * (1.0 / 24 + r2 * (-1.0 / 720 + r2 * (1.0 / 40320 + r2 * (-1.0 / 3628800 + r2 * (1.0 / 479001600 + r2 * (-1.0 / 87178291200.0)))))));
    const int q = ((int)kq) & 3;
    const double ss = (q == 0) ? sp : (q == 1) ? cp : (q == 2) ? -sp : -cp;
    const double cc = (q == 0) ? cp : (q == 1) ? -sp : (q == 2) ? -cp : sp;
    c = (float)cc; s = (float)ss;
}

__device__ __forceinline__ void prologue(const Params& P, int gw, int ngw, int lane) {
    unsigned char* ws = P.ws;
    for (int rep = 0; rep < (DBG_DUP == 4 ? 2 : 1); ++rep)
    for (int it = gw; it < 2 * IT_LAYER; it += ngw) {
        const int l = it / IT_LAYER; int r = it - l * IT_LAYER;
        unsigned char* wl = ws + WS_W + (size_t)l * LW_BYTES;
        if (r < IT_WIN) {
            const int rb = r / (D / 64), kb = r % (D / 64), p = rb * 64 + lane, k0 = kb * 64;
            const int pn = p >> 8, bj = (p >> 7) & 1, wc = (p >> 5) & 3, rem = p & 31, c = 256 * pn + 64 * wc + 32 * bj + rem;
            const float* win = P.in[3] + (size_t)l * D * DIN;
            bf16_t* dst = (bf16_t*)(wl + OFF_WIN);
            const float* ga = P.in[2] + (size_t)l * D;
            if (c < 3328) conv_item(win, DIN, c, D, dst, p, k0, ga);
            else if (c >= 3584) conv_item(win, DIN, 3344 + (c - 3584), D, dst, p, k0, ga);
            else {
                const float* wa = P.in[9] + (size_t)l * 16 * 256 + (c - 3328);
                float a[16];
#pragma unroll
                for (int q = 0; q < 16; ++q) a[q] = wa[q * 256];
                for (int kk = 0; kk < 8; ++kk) {
                    float v[8];
#pragma unroll
                    for (int i = 0; i < 8; ++i) { const float* wr_ = win + (size_t)(k0 + kk * 8 + i) * DIN + 3328; float acc = 0.f;
#pragma unroll
                        for (int q = 0; q < 16; ++q) acc += wr_[q] * a[q];
                        v[i] = acc * ga[k0 + kk * 8 + i]; }
                    u32x4 w; w.x = cvt_pk_bf16(v[0], v[1]); w.y = cvt_pk_bf16(v[2], v[3]); w.z = cvt_pk_bf16(v[4], v[5]); w.w = cvt_pk_bf16(v[6], v[7]);
                    *(u32x4*)(dst + (size_t)p * D + k0 + kk * 8) = w;
                }
            }
            continue;
        }
        r -= IT_WIN;
        if (r < IT_WG) {
            const int rb = r / (D / 64), kb = r % (D / 64), p = rb * 64 + lane, k0 = kb * 64;
            const float* sp = P.in[3] + (size_t)l * D * DIN + (size_t)k0 * DIN + 3856 + p; const float* ga = P.in[2] + (size_t)l * D + k0;
            unsigned char* d8 = wl + OFF_WG + (size_t)p * D + k0;
#pragma unroll 2
            for (int kk = 0; kk < 4; ++kk) { float v[16];
#pragma unroll
                for (int i = 0; i < 16; ++i) v[i] = sp[(size_t)(kk * 16 + i) * DIN] * ga[kk * 16 + i] * WS8;
                *(u32x4*)(d8 + kk * 16) = (u32x4){cvt4_fp8(v[0], v[1], v[2], v[3]), cvt4_fp8(v[4], v[5], v[6], v[7]), cvt4_fp8(v[8], v[9], v[10], v[11]), cvt4_fp8(v[12], v[13], v[14], v[15])}; }
            continue; }
        r -= IT_WG;
        if (r < IT_WB) { const int j = r / ((D / 64) * 8), r2 = r % ((D / 64) * 8), rb = r2 / 8, kb = r2 % 8, p = rb * 64 + lane;
            conv_item(P.in[12 + j] + (size_t)l * 512 * D, D, p, 512, (bf16_t*)(wl + OFF_WB) + (size_t)j * D * 512, p, kb * 64); continue; }
        r -= IT_WB;
        if (r < IT_WO) { const int rb = r / (D / 64), kb = r % (D / 64), p = rb * 64 + lane; conv_item(P.in[15] + (size_t)l * D * D, D, p, D, (bf16_t*)(wl + OFF_WO), p, kb * 64); continue; }
        r -= IT_WO;
        if (r < IT_F1) { const int rb = r / (D / 64), kb = r % (D / 64), p = rb * 64 + lane; const int pn = p >> 8, bj = (p >> 7) & 1, c = 128 * pn + (p & 127);
            conv_item(P.in[bj ? 18 : 17] + (size_t)l * D * FF, FF, c, D, (bf16_t*)(wl + OFF_F1), p, kb * 64, P.in[16] + (size_t)l * D); continue; }
        r -= IT_F1;
        { const int rb = r / (FF / 64), kb = r % (FF / 64), p = rb * 64 + lane; conv_item(P.in[19] + (size_t)l * FF * D, D, p, FF, (bf16_t*)(wl + OFF_F2), p, kb * 64); }
    }
    {
        bf16_t* rope = (bf16_t*)(ws + WS_ROPE); const int* pos = (const int*)P.in[1];
        for (int idx = gw * 64 + lane; idx < T * 32; idx += ngw * 64) { const int t = idx >> 5, i = idx & 31; float c, s; sincos_d((double)pos[t] * P.invf[i], c, s); rope[(size_t)t * 64 + i] = f2bf(c); rope[(size_t)t * 64 + 32 + i] = f2bf(s); }
    }
    {
        float* SS = (float*)(ws + WS_SS); bf16_t* XB = (bf16_t*)P.out;
        for (int m = gw; m < T; m += ngw) {
            const f32x4* xr = (const f32x4*)(P.in[0] + (size_t)m * D) + lane; u32x2* o8 = (u32x2*)(XB + (size_t)(m / RPG) * XSH + (size_t)m * D) + lane; float s2 = 0.f;
#pragma unroll
            for (int j = 0; j < 4; ++j) { const f32x4 v = xr[64 * j]; s2 += (v[0] * v[0] + v[1] * v[1]) + (v[2] * v[2] + v[3] * v[3]); u32x2 w; w.x = cvt_pk_bf16(v[0], v[1]); w.y = cvt_pk_bf16(v[2], v[3]); o8[64 * j] = w;
                ((unsigned*)(ws + WS_XB8 + (size_t)m * D))[lane + 64 * j] = cvt4_fp8(v[0] * XS8, v[1] * XS8, v[2] * XS8, v[3] * XS8); }
            s2 = wave_sum(s2);
            if (lane == 0) SS[m] = s2;
        }
        for (int idx = gw * 64 + lane; idx < 3 * T; idx += ngw * 64) SS[T + idx] = 0.f;
    }
}

constexpr int Q_GLA = 8, Q_MOBA = 128, Q_SWA = 128;

__global__ void __launch_bounds__(NWAVES * 64, 2) mk_fwd(Params P) {
    extern __shared__ __attribute__((aligned(16))) unsigned char lds_raw[];
    LAS unsigned char* lds = (LAS unsigned char*)lds_raw;
    volatile LAS unsigned* MISC = (volatile LAS unsigned*)(lds + MISC_OFF);
    const int tid = threadIdx.x, lane = tid & 63, wave = __builtin_amdgcn_readfirstlane(tid >> 6);
    const int G = gridDim.x, bx = blockIdx.x;
    const int vcu = (G % 8 == 0) ? (bx % 8) * (G / 8) + bx / 8 : bx;
    const int gw = vcu * NWAVES + wave, ngw = G * NWAVES;
    unsigned char* ws = P.ws;
    unsigned* ctl = (unsigned*)(ws + WS_CTL);
    for (int u = tid; u < 64; u += NWAVES * 64) MISC[u] = 0u;
    __syncthreads();
    XcdBarrier bar; bar.bar = ctl + CW_BAR; bar.x = 0; bar.st = nullptr;
    if (!MK_PER_PHASE) bar = xcd_barrier_post(ctl + CW_BAR, MISC + 8);
    if (!MK_PER_PHASE && tid == 0) (void)__hip_atomic_fetch_or(ctl + CW_GMASK + 64 * (bx & 7), 1u << xb_xcc_id(), __ATOMIC_RELAXED, __HIP_MEMORY_SCOPE_AGENT);
    const int lo = P.ph_lo, hi = P.ph_hi;
    int fastg = 0; unsigned gbn = 0u;
#define IN(k) (lo <= (k) && (k) < hi)
#define SEAM(k) do { if (IN(k) && IN((k) + 1)) xcd_barrier(bar); } while (0)
#define SEAMG(k) do { if (IN(k) && IN((k) + 1)) { if (fastg) { ++gbn; grp_barrier(ctl + CW_GRP + 64 * (bx & 7), gbn * (unsigned)(G / 8), ctl + CW_BAR); } else xcd_barrier(bar); } } while (0)

#define Hb ((bf16_t*)(ws + WS_H + (size_t)grp * SH_H))
#define PROJ ((bf16_t*)(ws + WS_PROJ))
#define XS ((bf16_t*)P.out + (size_t)grp * XSH)
#define GATES ((bf16_t*)(ws + WS_PROJ + (size_t)grp * SH_GATES))
#define MERGED ((bf16_t*)(ws + WS_PROJ + OFF_MERGED_IN_SLAB + (size_t)grp * SH_MERGED))
#define ACT ((bf16_t*)(ws + WS_PROJ + (size_t)grp * SH_ACT))
#define Yb ((bf16_t*)(ws + WS_Y))
#define rope ((bf16_t*)(ws + WS_ROPE))
#define kmp ((float*)(ws + WS_KM))
#define SS ((float*)(ws + WS_SS))

    #ifndef DBG_NO_PRO
    if (IN(1)) { prologue(P, gw, ngw, lane); }
#endif
    SEAM(1);
    if (!MK_PER_PHASE && IN(1) && IN(2)) {
        if (tid == 0) { unsigned ok = (G % 8 == 0) ? 1u : 0u;
            for (int j = 0; j < 8; ++j) { const unsigned m = xb_ld(ctl + CW_GMASK + 64 * j); ok &= (m != 0u && (m & (m - 1u)) == 0u) ? 1u : 0u; }
            MISC[20] = ok; }
        __syncthreads();
        fastg = __builtin_amdgcn_readfirstlane((int)MISC[20]);
    }
    for (int l = 0; l < DEPTH; ++l) {
        const int pb = 9 * l;
        unsigned char* ws = P.ws; asm volatile("" : "+s"(ws));
        int lane_l = lane; asm volatile("" : "+v"(lane_l));
        int bxl = blockIdx.x; asm volatile("" : "+s"(bxl));
        const int grp = bxl & 7;
        unsigned char* wl = ws + WS_W + (size_t)l * LW_BYTES;
        if (IN(2 + pb)) for (int rep = 0; rep < (DBG_DUP == 2 ? 2 : 1); ++rep) {
            if (rep) xcd_barrier(bar);
            pg8::Gemm g{XS, (const bf16_t*)(wl + OFF_WIN), D, D, D, 0, 0, nullptr, nullptr, 0, 0, 0, 0, 0, 1 << 30}; pg8::TileOrderBal S; S.init(T, PW, G, bxl, 1);
            pg8::EpiInProj E{PROJ, rope, P.in[4] + l * 64, P.in[5] + l * 64, P.in[7] + l * 64, P.in[8] + l * 64, P.in[10] + l * 256, kmp, SS + (size_t)(2 * l) * T};
#ifndef DBG_NO_EPIINPROJ
            pg8::gemm_phase<pg8::EpiInProj, false, pg8::TileOrderBal>(lds, g, S, E, 0);
#endif
        }
        SEAMG(2 + pb);
        if (IN(3 + pb)) {
            unsigned* qctr = ctl + CW_Q + 256 * (8 * l + grp);
            int it = 0;
            for (;; ++it) {
                if (tid == 0) MISC[16 + (it & 1)] = __hip_atomic_fetch_add(qctr, 1u, __ATOMIC_RELAXED, __HIP_MEMORY_SCOPE_AGENT);
                __syncthreads();
                const int id = (int)MISC[16 + (it & 1)];
                if (id >= Q_GLA) break;
                gla::gla_unit(PROJ, Yb, 2 * grp + (id >> 2), id & 3, P.in[11] + l * 128, lds);
            }
            ++it;
            for (;; ++it) {
                if (tid == 0) MISC[16 + (it & 1)] = __hip_atomic_fetch_add(qctr + 64, 1u, __ATOMIC_RELAXED, __HIP_MEMORY_SCOPE_AGENT);
                __syncthreads();
                const int m = (int)MISC[16 + (it & 1)];
                if (m >= Q_MOBA) break;
                att2::moba_unit<8>(2 * grp + ((m >> 3) & 1), m & 7, 7 - (m >> 4), PROJ, Yb, kmp, lds);
            }
            ++it;
            for (;; ++it) {
                if (tid == 0) MISC[16 + (it & 1)] = __hip_atomic_fetch_add(qctr + 128, 1u, __ATOMIC_RELAXED, __HIP_MEMORY_SCOPE_AGENT);
                __syncthreads();
                const int sidx = (int)MISC[16 + (it & 1)];
                if (sidx >= Q_SWA) break;
                att::attn_unit<0>(PROJ, Yb, 2 * grp + (sidx >> 6), (sidx >> 5) & 1, sidx & 31, P.in[6] + l * 8, nullptr, lds);
            }
        }
        SEAMG(3 + pb);
        if (IN(4 + pb)) {
            pg8::TileOrder S0; S0.init(T, D, G, bxl, 1);
            for (int ti = 0;; ++ti) {
                pg8::Unit u0; if (!S0.next(ti, u0)) break;
                { pg8::Gemm g{(const bf16_t*)(ws + WS_XB8), (const bf16_t*)(wl + OFF_WG), D / 2, D / 2, D / 2, 0, 0, nullptr, nullptr, 0, 0, 0, 0, 0, 1 << 30}; pg8::GateTriple S{u0.pm, u0.pn};
                  pg8::EpiGatesT<false> E{GATES, 0, SS + (size_t)(2 * l) * T, 0, 1.0f / (XS8 * WS8)};
                  pg8::gemm_phase<pg8::EpiGatesT<false>, false, pg8::GateTriple, true>(lds, g, S, E, 0); }
                { pg8::Gemm g{Yb, (const bf16_t*)(wl + OFF_WB), 512, YW, 512, 512, (long)D * 512, nullptr, nullptr, 0, 0, 0, 0, 0, 1 << 30}; pg8::SubTriple S{u0.pm, u0.pn};
                  pg8::EpiMerge E{GATES, MERGED};
                  pg8::gemm_phase<pg8::EpiMerge, false, pg8::SubTriple>(lds, g, S, E, 0); }
            }
        }
        SEAMG(4 + pb);
        if (IN(6 + pb)) for (int rep = 0; rep < ((DBG_DUP == 13 && l == 0) ? 2 : 1); ++rep) {
            if (rep) xcd_barrier(bar);
            pg8::Gemm g{MERGED, (const bf16_t*)(wl + OFF_WO), D, D, D, 0, 0, nullptr, nullptr, 0, 0, 0, 0, 0, 1 << 30}; pg8::TileOrder S; S.init(T, D, G, bxl, 1);
            pg8::EpiResid E{XS, nullptr, Hb, SS + (size_t)(2 * l + 1) * T, nullptr};
#ifndef DBG_NO_RESID
            pg8::gemm_phase<pg8::EpiResid>(lds, g, S, E, ((bxl >> 3) & 3) * STG_F);
#endif
        }
        SEAMG(6 + pb);
        if (DBG_DUP == 5) { for (int rep = 0; rep < 8; ++rep) xcd_barrier(bar); }
        if (IN(8 + pb)) for (int rep = 0; rep < (DBG_DUP == 6 ? 2 : 1); ++rep) {
            if (rep) xcd_barrier(bar);
            pg8::Gemm g{Hb, (const bf16_t*)(wl + OFF_F1), D, D, D, 0, 0, nullptr, nullptr, 0, 0, 0, 0, 0, 1 << 30}; pg8::TileOrder S; S.init(T, FFP, G, bxl, 1);
            pg8::EpiFfn1 E{ACT, SS + (size_t)(2 * l + 1) * T};
#ifndef DBG_NO_EPIFFN1
            pg8::gemm_phase<pg8::EpiFfn1>(lds, g, S, E, ((bxl >> 3) & 3) * STG_B);
#endif
        }
        SEAMG(8 + pb);
        if (IN(9 + pb)) {
            pg8::Gemm g{ACT, (const bf16_t*)(wl + OFF_F2), FF, FF, FF, 0, 0, nullptr, nullptr, 0, 0, 0, 0, 0, 1 << 30}; pg8::TileOrder S; S.init(T, D, G, bxl, 1);
            pg8::EpiResid E{(const bf16_t*)Hb, (l + 1 < DEPTH) ? nullptr : P.out, (l + 1 < DEPTH) ? XS : nullptr, (l + 1 < DEPTH) ? SS + (size_t)(2 * l + 2) * T : nullptr, (l + 1 < DEPTH) ? ws + WS_XB8 : nullptr};
#ifndef DBG_NO_RESID
            pg8::gemm_phase<pg8::EpiResid>(lds, g, S, E, ((bxl >> 3) & 3) * STG_F);
#endif
        }
        SEAMG(9 + pb);
    }
#undef IN
#undef SEAM
#undef SEAMG
#undef Hb
#undef PROJ
#undef XS
#undef GATES
#undef MERGED
#undef ACT
#undef Yb
#undef rope
#undef kmp
#undef SS
}

extern "C" void kernel_launch(void* const* d_in, const int* in_sizes, int n_in, void* d_out, int out_size, void* d_ws, size_t ws_size, hipStream_t stream) {
    static int grid = 0;
    if (grid == 0) {
        if (n_in != 20 || out_size != T * D || ws_size < WS_END) { fprintf(stderr, "kernel_launch: unexpected problem (n_in %d, out %d, ws %zu < %zu)\n", n_in, out_size, ws_size, (size_t)WS_END); grid = -1; return; }
        int dev = 0, cus = 0;
        if (hipGetDevice(&dev) != hipSuccess || hipDeviceGetAttribute(&cus, hipDeviceAttributeMultiprocessorCount, dev) != hipSuccess) { grid = -1; return; }
        if (hipFuncSetAttribute((const void*)mk_fwd, hipFuncAttributeMaxDynamicSharedMemorySize, LDS_BYTES) != hipSuccess) { fprintf(stderr, "kernel_launch: hipFuncSetAttribute failed\n"); grid = -1; return; }
        int per_cu = 0;
        if (hipOccupancyMaxActiveBlocksPerMultiprocessor(&per_cu, (const void*)mk_fwd, NWAVES * 64, LDS_BYTES) != hipSuccess || per_cu < 1) fprintf(stderr, "kernel_launch: occupancy query says %d\n", per_cu);
        (void)hipGetLastError();
        grid = (cus / 8) * 8;
    }
    if (grid < 0) return;
    (void)hipMemsetAsync((char*)d_ws + WS_CTL, 0, CTL_ZERO_BYTES, stream);
    Params p{};
    for (int i = 0; i < 20; ++i) p.in[i] = (const float*)d_in[i];
    p.out = (float*)d_out; p.ws = (unsigned char*)d_ws;
    for (int i = 0; i < 32; ++i) p.invf[i] = std::pow(10000.0, -(double)i / 32.0);
#if MK_PER_PHASE
    for (int k = 1; k <= 18; ++k) { p.ph_lo = k; p.ph_hi = k + 1; hipLaunchKernelGGL(mk_fwd, dim3(grid), dim3(NWAVES * 64), LDS_BYTES, stream, p); }
#else
    p.ph_lo = 1; p.ph_hi = 19;
    hipLaunchKernelGGL(mk_fwd, dim3(grid), dim3(NWAVES * 64), LDS_BYTES, stream, p);
#endif
}
```

```cpp
#include <hip/hip_runtime.h>
#include <cstdint>
#include <cstdio>
#include <cmath>

#ifndef MK_PER_PHASE
#define MK_PER_PHASE 0
#endif

#ifndef DBG_DUP
#define DBG_DUP 0
#endif
#ifndef STG_B
#define STG_B 0
#endif
#ifndef FP8_LATE
#define FP8_LATE false
#endif
#ifndef STG_F
#define STG_F 0
#endif
#define GAS __attribute__((address_space(1)))
#define LAS __attribute__((address_space(3)))
typedef unsigned short bf16_t;
typedef short bf16x8 __attribute__((ext_vector_type(8)));
typedef short s16x4 __attribute__((ext_vector_type(4)));
typedef short v4i16_t __attribute__((ext_vector_type(4)));
typedef float f32x2 __attribute__((ext_vector_type(2)));
typedef float f32x4 __attribute__((ext_vector_type(4)));
typedef float f32x16 __attribute__((ext_vector_type(16)));
typedef unsigned u32x2 __attribute__((ext_vector_type(2)));
typedef unsigned u32x4 __attribute__((ext_vector_type(4)));
typedef __bf16 bf16x2_t __attribute__((ext_vector_type(2)));
typedef int v8i_t __attribute__((ext_vector_type(8)));

constexpr int T = 32768, SEQ = 2048, NBATCH = 16, D = 1024, DEPTH = 2;
constexpr int PP = 4096 + 64;
constexpr int PW = 4096;
constexpr int GW = 3072;
constexpr int YW = 1536;
constexpr int FF = 2816, FFP = 5632;
constexpr int DIN = 6928;
constexpr float EPS = 1e-6f;
constexpr float LOG2E = 1.4426950408889634f;
constexpr float C2 = 0.125f * LOG2E;

constexpr size_t MiB = 1u << 20;
constexpr size_t WS_CTL = 0, CTL_ZERO_BYTES = 128 * 1024;
constexpr size_t OFF_WIN = 0, OFF_WG = OFF_WIN + (size_t)PW * D * 2  , OFF_WB = OFF_WG + (size_t)GW * D, OFF_WO = OFF_WB + (size_t)3 * D * 512 * 2,
                 OFF_F1 = OFF_WO + (size_t)D * D * 2, OFF_F2 = OFF_F1 + (size_t)FFP * D * 2, OFF_WIN8 = OFF_F2 + (size_t)D * FF * 2  , LW_BYTES = OFF_WIN8 + (size_t)PW * D;
constexpr size_t WS_W = 1 * MiB;
constexpr size_t WS_ROPE = WS_W + 2 * LW_BYTES;
constexpr size_t WS_KM = WS_ROPE + (size_t)T * 64 * 4;
constexpr size_t WS_SS = WS_KM + 512 * 1024;
constexpr size_t WS_H = WS_KM + 1 * MiB;
constexpr size_t WS_PROJ = WS_H + (size_t)T * YW * 2;
constexpr size_t WS_MERGED = WS_PROJ + (size_t)T * GW * 2;
constexpr size_t WS_Y = WS_H;
constexpr size_t WS_XB8 = WS_PROJ + (size_t)T * PP * 2;
constexpr size_t WS_END = WS_XB8 + (size_t)T * D;
static_assert(WS_ROPE % 256 == 0 && WS_END <= 512 * MiB, "workspace map");
constexpr int CW_TMO = 0, CW_BAR = 4096, CW_Q = 16384;
constexpr int CW_GRP = 8192, CW_GMASK = 9216;
constexpr int RPG = T / 8;
constexpr size_t SLAB = (size_t)RPG * PP * 2;
constexpr size_t SH_H = (size_t)RPG * (YW - D) * 2, SH_GATES = SLAB - (size_t)RPG * GW, SH_MERGED = SLAB - (size_t)RPG * D * 2, SH_ACT = SLAB - (size_t)RPG * FF * 2;
constexpr size_t OFF_MERGED_IN_SLAB = (size_t)RPG * GW;
constexpr size_t XSH = (size_t)RPG * D;
static_assert(OFF_MERGED_IN_SLAB + (size_t)RPG * D * 2 <= SLAB && (size_t)RPG * FF * 2 <= SLAB, "group slabs");

__device__ __forceinline__ unsigned cvt_pk_bf16(float lo, float hi) { f32x2 v = {lo, hi}; bf16x2_t b = __builtin_convertvector(v, bf16x2_t); return __builtin_bit_cast(unsigned, b); }
__device__ __forceinline__ float bf_lo(unsigned w) { return __uint_as_float(w << 16); }
__device__ __forceinline__ float bf_hi(unsigned w) { return __uint_as_float(w & 0xffff0000u); }
__device__ __forceinline__ float bf1(bf16_t x) { return __uint_as_float(((unsigned)x) << 16); }
__device__ __forceinline__ bf16_t f2bf(float f) { return (bf16_t)(cvt_pk_bf16(f, 0.f) & 0xffffu); }
__device__ __forceinline__ unsigned cvt4_fp8(float a, float b, float c, float d) { unsigned w = 0; w = __builtin_amdgcn_cvt_pk_fp8_f32(a, b, w, false); w = __builtin_amdgcn_cvt_pk_fp8_f32(c, d, w, true); return w; }
constexpr float XS8 = 16.0f, WS8 = 64.0f;
__device__ __forceinline__ float fexp2(float x) { return __builtin_amdgcn_exp2f(x); }
__device__ __forceinline__ float fexp(float x) { return __builtin_amdgcn_exp2f(x * LOG2E); }
__device__ __forceinline__ float frcp(float x) { return __builtin_amdgcn_rcpf(x); }
__device__ __forceinline__ float frsq(float x) { return __builtin_amdgcn_rsqf(x); }
__device__ __forceinline__ float sigmoidf_(float x) { return frcp(1.f + fexp(-x)); }
template <int CTRL> __device__ __forceinline__ float dpp_f(float v) { return __builtin_bit_cast(float, __builtin_amdgcn_update_dpp(0, __builtin_bit_cast(int, v), CTRL, 0xf, 0xf, true)); }
__device__ __forceinline__ float sum16(float v) { v += dpp_f<0xB1>(v); v += dpp_f<0x4E>(v); v += dpp_f<0x141>(v); v += dpp_f<0x140>(v); return v; }
__device__ __forceinline__ float addx16(float v) { auto r = __builtin_amdgcn_permlane16_swap(__float_as_uint(v), __float_as_uint(v), false, false); return __uint_as_float(r[0]) + __uint_as_float(r[1]); }
__device__ __forceinline__ float addx32(float v) { auto r = __builtin_amdgcn_permlane32_swap(__float_as_uint(v), __float_as_uint(v), false, false); return __uint_as_float(r[0]) + __uint_as_float(r[1]); }
__device__ __forceinline__ float maxx32(float v) { auto r = __builtin_amdgcn_permlane32_swap(__float_as_uint(v), __float_as_uint(v), false, false); return fmaxf(__uint_as_float(r[0]), __uint_as_float(r[1])); }
__device__ __forceinline__ float wave_sum(float v) { return addx32(addx16(sum16(v))); }
#define LDS_WAIT() asm volatile("s_waitcnt lgkmcnt(0)" ::: "memory")
#define VM_WAIT() asm volatile("s_waitcnt vmcnt(0)" ::: "memory")

#define XB_TMO      128
#define XB_XCNT(j)  (256  + 64 * (j))
#define XB_XSUB(j)  (1280 + 64 * (j))
#define XB_XGEN(j)  (2304 + 64 * (j))
#define XB_TOP      3328
#define XB_TOPGEN   3392
#define XCD_BAR_WORDS 3456
#define XB_SPIN_CAP (1u << 18)
__device__ __forceinline__ unsigned xb_ld(unsigned* p)              { return __hip_atomic_load(p, __ATOMIC_RELAXED, __HIP_MEMORY_SCOPE_AGENT); }
__device__ __forceinline__ unsigned xb_add(unsigned* p, unsigned v) { return __hip_atomic_fetch_add(p, v, __ATOMIC_RELAXED, __HIP_MEMORY_SCOPE_AGENT); }
__device__ __forceinline__ unsigned xb_xcc_id() { return (unsigned)__builtin_amdgcn_s_getreg((3 << 11) | 20) & 0xFu; }
#define XB_SPIN(cond, bar) do { unsigned _sp = 0; while (cond) { __builtin_amdgcn_s_sleep(1); \
    if ((++_sp & 255u) == 0u) { if (xb_ld(&(bar)[XB_TMO])) break; if (_sp > XB_SPIN_CAP) { atomicAdd(&(bar)[XB_TMO], 1u); break; } } } } while (0)
struct XcdBarrier { unsigned* bar; unsigned x; volatile LAS unsigned* st; };
__device__ __forceinline__ XcdBarrier xcd_barrier_post(unsigned* bar, volatile LAS unsigned* st) {
    XcdBarrier b; b.bar = bar; b.x = xb_xcc_id(); b.st = st;
    if (threadIdx.x == 0) (void)xb_add(&bar[XB_XCNT(b.x)], 1u);
    return b;
}
__device__ __forceinline__ void xcd_barrier_complete(unsigned* bar, unsigned x, unsigned& nloc, unsigned& nx) {
    const unsigned G = gridDim.x * gridDim.y * gridDim.z;
    unsigned sum, cnt, mine, sp = 0u;
    for (;;) {
        sum = 0u; cnt = 0u; mine = 0u;
#pragma unroll
        for (unsigned j = 0; j < 16; ++j) { const unsigned c = xb_ld(&bar[XB_XCNT(j)]); sum += c; cnt += (c > 0u) ? 1u : 0u; mine = (j == x) ? c : mine; }
        if (sum == G) break;
        __builtin_amdgcn_s_sleep(1);
        if ((++sp & 255u) == 0u) { if (xb_ld(&bar[XB_TMO])) break; if (sp > XB_SPIN_CAP) { atomicAdd(&bar[XB_TMO], 1u); break; } }
    }
    nloc = mine > 0u ? mine : 1u; nx = cnt > 0u ? cnt : 1u;
}
__device__ __forceinline__ void xcd_barrier(const XcdBarrier& b) {
    asm volatile("s_waitcnt vmcnt(0)" ::: "memory");
    __syncthreads();
    if (threadIdx.x == 0) {
        unsigned* bar = b.bar;
        __builtin_amdgcn_s_waitcnt(0);
        unsigned nloc = b.st[0], nx = b.st[1];
        if (nloc == 0u) { xcd_barrier_complete(bar, b.x, nloc, nx); b.st[0] = nloc; b.st[1] = nx; }
        const unsigned old = xb_add(&bar[XB_XSUB(b.x)], 1u);
        const unsigned gen = old / nloc;
        if (old + 1u == (gen + 1u) * nloc) {
            __builtin_amdgcn_fence(__ATOMIC_RELEASE, "agent");
            asm volatile("s_waitcnt vmcnt(0)" ::: "memory");
            const unsigned og = xb_add(&bar[XB_TOP], 1u);
            const unsigned tg = og / nx;
            if (og + 1u == (tg + 1u) * nx) xb_add(&bar[XB_TOPGEN], 1u);
            else XB_SPIN(xb_ld(&bar[XB_TOPGEN]) == tg, bar);
            __builtin_amdgcn_fence(__ATOMIC_ACQUIRE, "agent");
            xb_add(&bar[XB_XGEN(b.x)], 1u);
            asm volatile("s_waitcnt vmcnt(0)" ::: "memory");
        } else {
            XB_SPIN(xb_ld(&bar[XB_XGEN(b.x)]) == gen, bar);
            __builtin_amdgcn_fence(__ATOMIC_ACQUIRE, "agent");
            asm volatile("s_waitcnt vmcnt(0)" ::: "memory");
        }
    }
    __syncthreads();
}

__device__ __forceinline__ void grp_barrier(unsigned* gword, unsigned target, unsigned* bar) {
    asm volatile("s_waitcnt vmcnt(0)" ::: "memory");
    __syncthreads();
    if (threadIdx.x == 0) {
        __builtin_amdgcn_s_waitcnt(0);
        (void)xb_add(gword, 1u);
        __builtin_amdgcn_fence(__ATOMIC_ACQUIRE, "agent");
        XB_SPIN(xb_ld(gword) < target, bar);
        asm volatile("s_waitcnt vmcnt(0)" ::: "memory");
    }
    __syncthreads();
}

namespace pg8 {
constexpr int BM = 256, BK = 64, HALF = 128, HTB = HALF * BK * 2, STAGE_BYTES = 8 * HTB, NXCD = 8, WGM = 8;
__host__ __device__ __forceinline__ int lds_byte(int r, int c) { const int st = (r >> 4) * 2 + (c >> 5), rr = r & 15, cc = c & 31, ob = rr * 64 + cc * 2; return st * 1024 + (ob ^ (((ob >> 9) & 1) << 5)); }
__host__ __device__ __forceinline__ void stage_rc(int b, int& R, int& C) { const int st = b / 1024, sb = b % 1024, swz = sb ^ (((sb >> 9) & 1) << 5); R = (st >> 1) * 16 + swz / 64; C = (st & 1) * 32 + (swz % 64) / 2; }
__host__ __device__ __forceinline__ int perm32(int rho) { const int n = rho >> 4, i = rho & 15; return 8 * (i >> 2) + 4 * n + (i & 3); }

struct Unit { int pm, pn, sub; };
struct Gemm { const bf16_t* A; const bf16_t* Bt; int K, lda, ldb; long a_sub, b_sub;
              const bf16_t* A1; const bf16_t* Bt1; int K1, lda1, ldb1; long a_sub1, b_sub1; int sub1; };

struct TileOrder {
    int nM, nN, nwg, G, c, nsub;
    __device__ __forceinline__ void init(int M, int N, int G_, int c_, int nsub_) { nM = M / BM; nN = N / BM; nwg = nM * nN; G = G_; c = c_; nsub = nsub_; }
    __device__ __forceinline__ bool next(int i, Unit& u) const {
        const int ti = i / nsub; u.sub = i - ti * nsub;
        const long L = (long)ti * G + c; if (L >= nwg) return false;
        int wgid = (int)L; { const int q = nwg / NXCD, r = nwg % NXCD, xcd = wgid % NXCD, off = wgid / NXCD; wgid = (xcd < r ? xcd * (q + 1) : r * (q + 1) + (xcd - r) * q) + off; }
        const int nig = WGM * nN, gid = wgid / nig, fm = gid * WGM, gsz = (nM - fm) < WGM ? (nM - fm) : WGM;
        u.pm = fm + ((wgid % nig) % gsz); u.pn = (wgid % nig) / gsz; return true;
    }
};

struct TileOrderBal : TileOrder {
    __device__ __forceinline__ bool next(int i, Unit& u) const { if (!TileOrder::next(i, u)) return false;
        const unsigned long long tab = 0xCBA8FD97E2654310ull;
        u.pn = (int)((tab >> (4 * u.pn)) & 15ull); return true; } };
struct TileOrderFix : TileOrder { __device__ __forceinline__ bool next(int i, Unit& u) const { if (!TileOrder::next(i, u)) return false; u.pm &= 1; u.pn &= 1; return true; } };
struct TileOrderSub : TileOrder { int mode;
    __device__ __forceinline__ bool next(int i, Unit& u) const { if (!TileOrder::next(i, u)) return false; u.pn = (mode == 1) ? u.pn + (u.pn >= 2 ? 1 : 0) : (u.pn == 0 ? 2 : u.pn + 6); return true; } };
struct GateTriple { int pm, pn; __device__ __forceinline__ bool next(int i, Unit& u) const { if (i >= 3) return false; u.pm = pm; u.pn = 4 * i + pn; u.sub = 0; return true; } };
struct SubTriple { int pm, pn; __device__ __forceinline__ bool next(int i, Unit& u) const { if (i >= 3) return false; u.pm = pm; u.pn = pn; u.sub = i; return true; } };

typedef f32x4 Acc[2][2][4][2];

template <class Epi, bool DUAL = false, class Sched = TileOrder, bool F8 = false>
__device__ __forceinline__ void gemm_phase(LAS unsigned char* lds, const Gemm g, const Sched& S, const Epi& E, int stagger = 0) {
    for (int i_ = 0; i_ < stagger; ++i_) __builtin_amdgcn_s_sleep(32);
    int tid_ = threadIdx.x; asm volatile("" : "+v"(tid_));
    const int tid = tid_, wid = __builtin_amdgcn_readfirstlane(tid >> 6), lane = tid & 63, wr = wid >> 2, wc = wid & 3, fr = lane & 15, fq = lane >> 4;
    const size_t kstep = (size_t)(BK * 2);
    const unsigned ldsw = (unsigned)wid * 1024u;
    const int aoff = F8 ? lds_byte(wr * 64 + fr, fq * 16) : lds_byte(wr * 64 + fr, fq * 8), boff = F8 ? lds_byte(wc * 32 + fr, fq * 16) : lds_byte(wc * 32 + fr, fq * 8);
#define PG8_SA(b, h) (((b) * 2 + (h)) * HTB)
#define PG8_SB(b, h) ((4 + (b) * 2 + (h)) * HTB)
#define PG8_STAGE(bufoff, gbase, voff, hs) do { _Pragma("unroll") for (int _i = 0; _i < 2; ++_i) \
        __builtin_amdgcn_global_load_lds((const unsigned*)((const char*)(gbase) + (size_t)_i * (hs) + (voff)), (LAS unsigned*)(lds + (bufoff) + ldsw + _i * 8192), 16, 0, 0); } while (0)
#define PG8_LD32(p) __builtin_bit_cast(v8i_t, __builtin_shufflevector(*(const LAS bf16x8*)(p), *(const LAS bf16x8*)((p) + 16), 0, 1, 2, 3, 4, 5, 6, 7, 8, 9, 10, 11, 12, 13, 14, 15))
#define PG8_LDA(dst, b, h) do { if constexpr (F8) { _Pragma("unroll") for (int m = 0; m < 4; ++m) dst##8[m] = PG8_LD32(lds + PG8_SA(b, h) + aoff + m * 2048); } \
        else { _Pragma("unroll") for (int m = 0; m < 4; ++m) _Pragma("unroll") for (int k = 0; k < 2; ++k) dst[m][k] = *(const LAS bf16x8*)(lds + PG8_SA(b, h) + aoff + m * 2048 + k * 1024); } } while (0)
#define PG8_LDB(dst, b, h) do { if constexpr (F8) { _Pragma("unroll") for (int n = 0; n < 2; ++n) dst##8[n] = PG8_LD32(lds + PG8_SB(b, h) + boff + n * 2048); } \
        else { _Pragma("unroll") for (int n = 0; n < 2; ++n) _Pragma("unroll") for (int k = 0; k < 2; ++k) dst[n][k] = *(const LAS bf16x8*)(lds + PG8_SB(b, h) + boff + n * 2048 + k * 1024); } } while (0)
#define PG8_MMA(ai, bj, At, Bt) do { __builtin_amdgcn_s_setprio(1); _Pragma("unroll") for (int m = 0; m < 4; ++m) _Pragma("unroll") for (int n = 0; n < 2; ++n) { \
        if constexpr (F8) asm volatile("v_mfma_scale_f32_16x16x128_f8f6f4 %0, %1, %2, %0, %3, %3 op_sel_hi:[0,0,0]" : "+v"(acc[ai][bj][m][n]) : "v"(Bt##8[n]), "v"(At##8[m]), "v"(sc8));   \
        else { _Pragma("unroll") for (int k = 0; k < 2; ++k) acc[ai][bj][m][n] = __builtin_amdgcn_mfma_f32_16x16x32_bf16(Bt[n][k], At[m][k], acc[ai][bj][m][n], 0, 0, 0); } } \
        __builtin_amdgcn_s_setprio(0); } while (0)
#define PG8_WAIT_V(n) asm volatile("s_waitcnt vmcnt(" #n ")" ::: "memory")
#define PG8_WAIT_L(n) asm volatile("s_waitcnt lgkmcnt(" #n ")" ::: "memory")
#define PG8_WAIT_VX(flag) do { if constexpr (Epi::NST == 8) asm volatile("s_cmp_eq_u32 %0, 0\n\ts_cbranch_scc1 1f\n\ts_waitcnt vmcnt(16)\n\ts_branch 2f\n1:\n\ts_waitcnt vmcnt(8)\n2:" :: "s"(flag) : "memory", "scc"); \
        else if constexpr (Epi::NST == 16) asm volatile("s_cmp_eq_u32 %0, 0\n\ts_cbranch_scc1 1f\n\ts_waitcnt vmcnt(24)\n\ts_branch 2f\n1:\n\ts_waitcnt vmcnt(8)\n2:" :: "s"(flag) : "memory", "scc"); \
        else if constexpr (Epi::NST == 32) asm volatile("s_cmp_eq_u32 %0, 0\n\ts_cbranch_scc1 1f\n\ts_waitcnt vmcnt(40)\n\ts_branch 2f\n1:\n\ts_waitcnt vmcnt(8)\n2:" :: "s"(flag) : "memory", "scc"); \
        else asm volatile("s_waitcnt vmcnt(8)" ::: "memory"); } while (0)
#define PG8_BAR __builtin_amdgcn_s_barrier()
#define PG8_SCHED __builtin_amdgcn_sched_barrier(0)
#define PG8_KIND(u) (DUAL && (u).sub >= g.sub1)
#define PG8_ABASE(u) (PG8_KIND(u) ? (const char*)g.A1 + ((size_t)(u).pm * BM * g.lda1 + (size_t)((u).sub - g.sub1) * g.a_sub1) * 2 : (const char*)g.A + ((size_t)(u).pm * BM * g.lda + (size_t)(u).sub * g.a_sub) * 2)
#define PG8_BBASE(u) (PG8_KIND(u) ? (const char*)g.Bt1 + ((size_t)(u).pn * BM * g.ldb1 + (size_t)((u).sub - g.sub1) * g.b_sub1) * 2 : (const char*)g.Bt + ((size_t)(u).pn * BM * g.ldb + (size_t)(u).sub * g.b_sub) * 2)
#define PG8_VOFF(kd, vA, vB) do { const bool k_ = (kd); const int la_ = k_ ? g.lda1 : g.lda, lb_ = k_ ? g.ldb1 : g.ldb; \
        vA = (unsigned)(sR * la_ + sC) * 2u; vB = (unsigned)(sRb * lb_ + sC) * 2u; } while (0)
#define PG8_SETCFG(kd, hA, hB, ntv) do { const bool k_ = (kd); hA = (size_t)HALF * (k_ ? g.lda1 : g.lda) * 2; hB = (size_t)HALF * (k_ ? g.ldb1 : g.ldb) * 2; ntv = (k_ ? g.K1 : g.K) / BK; } while (0)
    Unit cur, nxt; int ui = 0;
    if (!S.next(0, cur)) return;
    Acc acc;
#pragma unroll
    for (int a = 0; a < 2; ++a)
#pragma unroll
        for (int b = 0; b < 2; ++b)
#pragma unroll
            for (int m = 0; m < 4; ++m)
#pragma unroll
                for (int n = 0; n < 2; ++n) acc[a][b][m][n] = (f32x4){0.f, 0.f, 0.f, 0.f};
    bf16x8 At[4][2], B0[2][2], B1[2][2];
    v8i_t At8[4], B08[2], B18[2];
    const int sc8 = 0x7f7f7f7f;
    float pre[8];
#pragma unroll
    for (int i = 0; i < 8; ++i) pre[i] = 0.f;
    const char* cA = PG8_ABASE(cur); const char* cB = PG8_BBASE(cur);
    int sR, sC; stage_rc(tid * 16, sR, sC); const int sRb = Epi::PERM ? ((sR & ~31) + perm32(sR & 31)) : sR;
    unsigned voffA, voffB; size_t hstepA, hstepB, xhA, xhB; int nt, xnt; bool xkind;
    PG8_VOFF(PG8_KIND(cur), voffA, voffB); PG8_SETCFG(PG8_KIND(cur), hstepA, hstepB, nt);
    PG8_STAGE(PG8_SB(0, 0), cB, voffB, hstepB >> 1); PG8_STAGE(PG8_SB(0, 1), cB + hstepB, voffB, hstepB >> 1); PG8_STAGE(PG8_SA(0, 0), cA, voffA, hstepA >> 1); PG8_STAGE(PG8_SA(0, 1), cA + hstepA, voffA, hstepA >> 1);
    if (wr == 1) PG8_BAR;
    PG8_WAIT_V(2); PG8_BAR;
    PG8_STAGE(PG8_SB(1, 0), cB + kstep, voffB, hstepB >> 1); PG8_STAGE(PG8_SA(1, 0), cA + kstep, voffA, hstepA >> 1); PG8_STAGE(PG8_SB(1, 1), cB + hstepB + kstep, voffB, hstepB >> 1);
    PG8_WAIT_V(6); PG8_BAR;
    for (;;) {
        const bool has_next = S.next(ui + 1, nxt);
        const char* nA = has_next ? PG8_ABASE(nxt) : cA; const char* nB = has_next ? PG8_BBASE(nxt) : cB;
        xkind = has_next ? PG8_KIND(nxt) : PG8_KIND(cur); PG8_SETCFG(xkind, xhA, xhB, xnt);
        for (int t = 0; t < nt; t += 2) {
            const bool last = (t == nt - 2);
            const char* a1 = cA + (size_t)(t + 1) * kstep;
            const char* a2 = last ? nA : cA + (size_t)(t + 2) * kstep; const char* b2 = last ? nB : cB + (size_t)(t + 2) * kstep;
            const char* a3 = a2 + kstep; const char* b3 = b2 + kstep;
            unsigned vA2 = voffA, vB2 = voffB;
            if (DUAL && last) PG8_VOFF(xkind, vA2, vB2);
            const size_t hA2 = last ? xhA : hstepA, hB2 = last ? xhB : hstepB;
            if (last) E.prefetch(cur, pre);
            const int rxi = __builtin_amdgcn_readfirstlane(((Epi::NST > 0) && (t == 0) && (ui > 0)) ? 1 : 0);
            PG8_LDB(B0, 0, 0); PG8_LDB(B1, 0, 1); PG8_SCHED; PG8_LDA(At, 0, 0); PG8_STAGE(PG8_SA(1, 1), a1 + hstepA, voffA, hstepA >> 1);
            PG8_WAIT_VX(rxi);
            PG8_WAIT_L(0); PG8_BAR; PG8_MMA(0, 0, At, B0); PG8_MMA(0, 1, At, B1); PG8_BAR; PG8_SCHED;
            PG8_LDA(At, 0, 1); PG8_STAGE(PG8_SB(0, 0), b2, vB2, hB2 >> 1); PG8_STAGE(PG8_SB(0, 1), b2 + hB2, vB2, hB2 >> 1); PG8_STAGE(PG8_SA(0, 0), a2, vA2, hA2 >> 1);
            PG8_WAIT_VX(rxi);
            PG8_WAIT_L(0); PG8_BAR; PG8_MMA(1, 0, At, B0); PG8_MMA(1, 1, At, B1); PG8_BAR; PG8_SCHED;
            PG8_LDB(B0, 1, 0); PG8_LDB(B1, 1, 1); PG8_SCHED; PG8_LDA(At, 1, 0); PG8_STAGE(PG8_SA(0, 1), a2 + hA2, vA2, hA2 >> 1);
            PG8_WAIT_V(8); PG8_WAIT_L(0); PG8_BAR; PG8_MMA(0, 0, At, B0); PG8_MMA(0, 1, At, B1); PG8_BAR; PG8_SCHED;
            PG8_LDA(At, 1, 1); PG8_STAGE(PG8_SB(1, 0), b3, vB2, hB2 >> 1); PG8_STAGE(PG8_SB(1, 1), b3 + hB2, vB2, hB2 >> 1); PG8_STAGE(PG8_SA(1, 0), a3, vA2, hA2 >> 1);
            PG8_WAIT_V(8); PG8_WAIT_L(0); PG8_BAR; PG8_MMA(1, 0, At, B0); PG8_MMA(1, 1, At, B1); PG8_BAR; PG8_SCHED;
        }
        if (wr == 0) PG8_BAR;
        if constexpr (F8) asm volatile("s_nop 15\n\ts_nop 7" ::: "memory");
        const bool keep = E(acc, cur, pre);
        if (!has_next) break;
        if (!keep) {
#pragma unroll
            for (int a = 0; a < 2; ++a)
#pragma unroll
                for (int b = 0; b < 2; ++b)
#pragma unroll
                    for (int m = 0; m < 4; ++m)
#pragma unroll
                        for (int n = 0; n < 2; ++n) acc[a][b][m][n] = (f32x4){0.f, 0.f, 0.f, 0.f};
        }
        cur = nxt; cA = nA; cB = nB; ++ui;
        if (DUAL) PG8_VOFF(xkind, voffA, voffB);
        hstepA = xhA; hstepB = xhB; nt = xnt;
        if (wr == 1) PG8_BAR;
    }
    PG8_WAIT_V(0);
    PG8_BAR;
#undef PG8_SA
#undef PG8_SB
#undef PG8_STAGE
#undef PG8_LDA
#undef PG8_LD32
#undef PG8_LDB
#undef PG8_MMA
#undef PG8_WAIT_V
#undef PG8_WAIT_L
#undef PG8_WAIT_VX
#undef PG8_BAR
#undef PG8_SCHED
#undef PG8_ABASE
#undef PG8_BBASE
#undef PG8_KIND
#undef PG8_SETCFG
#undef PG8_VOFF
}

constexpr int ROWS_SCR_OFF = 131072 + 1024;
__device__ __forceinline__ void prefetch_rows(const float* ssq, const Unit& u, float (&pre)[8]) {
    int t = threadIdx.x; asm volatile("" : "+v"(t));
    const f32x4 v = *(const GAS f32x4*)(ssq + u.pm * BM + ((t >> 4) & 1) * HALF + ((t >> 8) & 1) * 64 + 4 * (t & 15));
    pre[0] = v[0]; pre[1] = v[1]; pre[2] = v[2]; pre[3] = v[3];
}
__device__ __forceinline__ void unpack_rows(const float (&pre)[8], float (&rsv)[8]) {
    extern __shared__ __attribute__((aligned(16))) unsigned char lds_raw[];
    int t = threadIdx.x; asm volatile("" : "+v"(t));
    const unsigned scr = (unsigned)(uintptr_t)((LAS unsigned char*)lds_raw + ROWS_SCR_OFF) + (unsigned)(t >> 6) * 512u;
    const unsigned wa = scr + (unsigned)(t & 31) * 16u, ra = scr + (unsigned)(t & 15) * 4u;
    const f32x4 d = {pre[0], pre[1], pre[2], pre[3]};
    asm volatile("ds_write_b128 %8, %9\n\tds_read_b32 %0, %10\n\tds_read_b32 %1, %10 offset:64\n\tds_read_b32 %2, %10 offset:128\n\tds_read_b32 %3, %10 offset:192\n\t"
                 "ds_read_b32 %4, %10 offset:256\n\tds_read_b32 %5, %10 offset:320\n\tds_read_b32 %6, %10 offset:384\n\tds_read_b32 %7, %10 offset:448\n\ts_waitcnt lgkmcnt(0)"
                 : "=&v"(rsv[0]), "=&v"(rsv[1]), "=&v"(rsv[2]), "=&v"(rsv[3]), "=&v"(rsv[4]), "=&v"(rsv[5]), "=&v"(rsv[6]), "=&v"(rsv[7]) : "v"(wa), "v"(d), "v"(ra) : "memory");
}

__device__ __forceinline__ void lane_ids(int& wr, int& wc, int& fr, int& fq) { int t = threadIdx.x; asm volatile("" : "+v"(t)); const int wid = __builtin_amdgcn_readfirstlane(t >> 6); wr = wid >> 2; wc = wid & 3; fr = t & 15; fq = (t >> 4) & 3; }
__device__ __forceinline__ u32x4 pack8(const f32x4 a, const f32x4 b) { u32x4 w; w.x = cvt_pk_bf16(a[0], a[1]); w.y = cvt_pk_bf16(a[2], a[3]); w.z = cvt_pk_bf16(b[0], b[1]); w.w = cvt_pk_bf16(b[2], b[3]); return w; }

template <bool LATE> struct EpiInProjT {
    static constexpr bool PERM = true; static constexpr int NST = 16;
    bf16_t* O;
    const bf16_t* rope;
    const float* g_qa; const float* g_ka; const float* g_qb; const float* g_kb;
    const float* b_alpha;
    float* kmp;
    const float* ssq;
    float oscale;
    __device__ __forceinline__ void prefetch(const Unit& u, float (&pre)[8]) const {
        if constexpr (LATE) return;
        prefetch_rows(ssq, u, pre);
    }
    __device__ __forceinline__ bool operator()(Acc& acc, const Unit& u, const float (&pre)[8]) const {
        int wr, wc, fr, fq; lane_ids(wr, wc, fr, fq);
        const int G = 4 * u.pn + wc;
        const int row0 = u.pm * BM + wr * 64 + fr;
        static_assert(!LATE, "the row sums come from the K-loop's prefetch (pre[])");
        float rsv[8]; unpack_rows(pre, rsv);
#define INP_MV(st_) (rsv[st_] * (1.0f / D) + EPS)
        bf16_t* obase = O + (size_t)row0 * PP + 64 * G + 8 * fq;
        const float* gain = nullptr; float qs = 1.f; bool mean = false;
        if (G < 8) { gain = g_qa; qs = C2; } else if (G < 10) gain = g_ka; else if (G >= 12 && G < 20) { gain = g_qb; qs = C2; } else if (G >= 20 && G < 28) { gain = g_kb; mean = true; }
        if (gain) {
            const float ios2 = 1.0f / (oscale * oscale);
            f32x4 gn[2][2];
#pragma unroll
            for (int bj = 0; bj < 2; ++bj)
#pragma unroll
                for (int n = 0; n < 2; ++n) gn[bj][n] = *(const GAS f32x4*)(gain + 32 * bj + 8 * fq + 4 * n) * qs;
            f32x4 ks[2][2];
#pragma unroll
            for (int bj = 0; bj < 2; ++bj)
#pragma unroll
                for (int n = 0; n < 2; ++n) ks[bj][n] = (f32x4){0.f, 0.f, 0.f, 0.f};
            u32x4 cw[8], sw[8];
#define INP_ROPE_LD(g_) do { const int rn_ = ((g_) >> 2) * HALF + ((g_) & 3) * 16; const bf16_t* cs_ = rope + (size_t)(row0 + rn_) * 64 + 8 * fq; cw[g_] = *(const GAS u32x4*)cs_; sw[g_] = *(const GAS u32x4*)(cs_ + 32); } while (0)
            INP_ROPE_LD(0); INP_ROPE_LD(1);
#pragma unroll
            for (int st = 0; st < 8; ++st) {
                const int ai = st >> 2, m = st & 3, rr = ai * HALF + m * 16;
                if (st + 2 < 8) INP_ROPE_LD(st + 2);
                const u32x4 cq_ = cw[st], sq_ = sw[st];
                const f32x4 c0 = {bf_lo(cq_.x), bf_hi(cq_.x), bf_lo(cq_.y), bf_hi(cq_.y)}, c1 = {bf_lo(cq_.z), bf_hi(cq_.z), bf_lo(cq_.w), bf_hi(cq_.w)};
                const f32x4 s0 = {bf_lo(sq_.x), bf_hi(sq_.x), bf_lo(sq_.y), bf_hi(sq_.y)}, s1 = {bf_lo(sq_.z), bf_hi(sq_.z), bf_lo(sq_.w), bf_hi(sq_.w)};
                float ss = 0.f;
#pragma unroll
                for (int bj = 0; bj < 2; ++bj)
#pragma unroll
                    for (int n = 0; n < 2; ++n) { const f32x4 v = acc[ai][bj][m][n]; ss += (v[0] * v[0] + v[1] * v[1]) + (v[2] * v[2] + v[3] * v[3]); }
                ss = addx32(addx16(ss));
                const float rs = frsq(ss * (1.0f / 64.0f) + EPS * INP_MV(st) * ios2);
                f32x4 o0[2], o1[2];
#pragma unroll
                for (int n = 0; n < 2; ++n) {
                    const f32x4 c = n ? c1 : c0, sx = n ? s1 : s0;
                    const f32x4 y0 = acc[ai][0][m][n] * rs * gn[0][n], y1 = acc[ai][1][m][n] * rs * gn[1][n];
                    o0[n] = y0 * c - y1 * sx; o1[n] = y1 * c + y0 * sx;
                    ks[0][n] += o0[n]; ks[1][n] += o1[n];
                }
                *(GAS u32x4*)(obase + (size_t)rr * PP) = pack8(o0[0], o0[1]);
                *(GAS u32x4*)(obase + (size_t)rr * PP + 32) = pack8(o1[0], o1[1]);
                asm volatile("" : "+v"(ks[0][0]), "+v"(ks[0][1]), "+v"(ks[1][0]), "+v"(ks[1][1]) :: "memory");
            }
#undef INP_ROPE_LD
            if (mean) {
#pragma unroll
                for (int bj = 0; bj < 2; ++bj)
#pragma unroll
                    for (int n = 0; n < 2; ++n)
#pragma unroll
                        for (int j = 0; j < 4; ++j) ks[bj][n][j] = sum16(ks[bj][n][j]);
                if (fr == 0) {
                    float* kp = kmp + ((size_t)((u.pm * 8 + (G - 20)) * 2 + wr)) * 64 + 8 * fq;
#pragma unroll
                    for (int bj = 0; bj < 2; ++bj)
#pragma unroll
                        for (int n = 0; n < 2; ++n) *(GAS f32x4*)(kp + 32 * bj + 4 * n) = ks[bj][n];
                }
            }
        } else {
            const int mode = (G >= 36 && G < 40) ? 1 : (G >= 52 && G < 56) ? 2 : (G >= 56) ? 3 : 0;
            f32x4 bb[2][2];
#pragma unroll
            for (int bj = 0; bj < 2; ++bj)
#pragma unroll
                for (int n = 0; n < 2; ++n) bb[bj][n] = (mode == 2) ? *(const GAS f32x4*)(b_alpha + 64 * (G - 52) + 32 * bj + 8 * fq + 4 * n) : (f32x4){0.f, 0.f, 0.f, 0.f};
#pragma unroll
            for (int ai = 0; ai < 2; ++ai)
#pragma unroll
                for (int m = 0; m < 4; ++m) {
                    const int rr = ai * HALF + m * 16;
                    const float rs = frsq(INP_MV(ai * 4 + m)) * oscale * (mode == 1 ? 0.125f : 1.0f);
                    f32x4 o[2][2];
#pragma unroll
                    for (int bj = 0; bj < 2; ++bj)
#pragma unroll
                        for (int n = 0; n < 2; ++n) {
                            f32x4 v = acc[ai][bj][m][n] * rs;
                            if (mode == 1) {}
                            else if (mode == 2) {
#pragma unroll
                                for (int j = 0; j < 4; ++j) { const float z = v[j] + bb[bj][n][j]; v[j] = (fminf(z, 0.f) - __logf(1.f + fexp(-fabsf(z)))) * (1.0f / 16.0f); }
                            } else if (mode == 3) {
#pragma unroll
                                for (int j = 0; j < 4; ++j) v[j] = v[j] * sigmoidf_(v[j]);
                            }
                            o[bj][n] = v;
                        }
                    *(GAS u32x4*)(obase + (size_t)rr * PP) = pack8(o[0][0], o[0][1]);
                    *(GAS u32x4*)(obase + (size_t)rr * PP + 32) = pack8(o[1][0], o[1][1]);
                    asm volatile("" ::: "memory");
                }
        }
        return false;
    }
};

#undef INP_MV
typedef EpiInProjT<false> EpiInProj;

template <bool LATE> struct EpiGatesT {
    static constexpr bool PERM = true; static constexpr int NST = (DBG_DUP == 11 || (DBG_DUP >= 18 && DBG_DUP <= 22)) ? 0 : 8;
    bf16_t* O; int nostore; const float* ssq; int late; float oscale;
    __device__ __forceinline__ void prefetch(const Unit& u, float (&pre)[8]) const {
        if constexpr (LATE) return;
        prefetch_rows(ssq, u, pre);
    }
    __device__ __forceinline__ bool operator()(Acc& acc, const Unit& u, const float (&pre)[8]) const {
        int wr, wc, fr, fq; lane_ids(wr, wc, fr, fq);
        if (nostore) {
#pragma unroll
            for (int ai = 0; ai < 2; ++ai)
#pragma unroll
                for (int bj = 0; bj < 2; ++bj)
#pragma unroll
                    for (int m = 0; m < 4; ++m) asm volatile("" :: "v"(acc[ai][bj][m][0]), "v"(acc[ai][bj][m][1]));
            return false;
        }
        const int row0 = u.pm * BM + wr * 64 + fr, col0 = u.pn * BM + wc * 64 + 16 * fq;
        float rsv[8];
        if constexpr (LATE) {
#pragma unroll
            for (int st = 0; st < 8; ++st) rsv[st] = ((const GAS float*)ssq)[row0 + (st >> 2) * HALF + (st & 3) * 16];
        } else unpack_rows(pre, rsv);
#pragma unroll
        for (int ai = 0; ai < 2; ++ai)
#pragma unroll
            for (int m = 0; m < 4; ++m) { unsigned char* rowp = (unsigned char*)O + (size_t)(row0 + ai * HALF + m * 16) * GW + col0;
                const float rs = frsq(rsv[ai * 4 + m] * (1.0f / D) + EPS) * oscale * (-LOG2E);
                unsigned ww[4];
#pragma unroll
                for (int bj = 0; bj < 2; ++bj) { f32x4 v0 = acc[ai][bj][m][0] * rs, v1 = acc[ai][bj][m][1] * rs;
                    unsigned w0 = 0u, w1 = 0u;
#pragma unroll
                    for (int j = 0; j < 4; ++j) { w0 = __builtin_amdgcn_cvt_pk_u8_f32(fmaxf(frcp(fmaf(fexp2(v0[j]), 1.0f / 255.0f, 1.0f / 255.0f)), 1.0f), j, w0);
                                                  w1 = __builtin_amdgcn_cvt_pk_u8_f32(fmaxf(frcp(fmaf(fexp2(v1[j]), 1.0f / 255.0f, 1.0f / 255.0f)), 1.0f), j, w1); }
                    ww[2 * bj] = w0; ww[2 * bj + 1] = w1; }
                *(GAS u32x4*)rowp = (u32x4){ww[0], ww[1], ww[2], ww[3]}; }
        return false;
    }
};

typedef EpiGatesT<false> EpiGates;
struct EpiMerge {
    static constexpr bool PERM = true; static constexpr int NST = (DBG_DUP == 22) ? 0 : 16;
    const bf16_t* Gt;
    bf16_t* O;
    int probe;
    __device__ __forceinline__ void prefetch(const Unit&, float (&)[8]) const {}
    __device__ __forceinline__ bool operator()(Acc& acc, const Unit& u, const float (&pre)[8]) const {
        int wr, wc, fr, fq; lane_ids(wr, wc, fr, fq);
        const int row0 = u.pm * BM + wr * 64 + fr, col0 = u.pn * BM + wc * 32 + 8 * fq, gcol0 = u.pn * BM + wc * 64 + 16 * fq;
        const bool last = u.sub == 2;
        if (DBG_DUP == 22 && probe) {
#pragma unroll
            for (int ai = 0; ai < 2; ++ai)
#pragma unroll
                for (int bj = 0; bj < 2; ++bj)
#pragma unroll
                    for (int m = 0; m < 4; ++m) asm volatile("" :: "v"(acc[ai][bj][m][0]), "v"(acc[ai][bj][m][1]));
            return !last;
        }
        const unsigned char* G8 = (const unsigned char*)Gt;
        u32x2 ga[2][4][2], gb[2][4][2];
#pragma unroll
        for (int ai = 0; ai < 2; ++ai)
#pragma unroll
            for (int m = 0; m < 4; ++m) {
                const unsigned char* gp = G8 + (size_t)(row0 + ai * HALF + m * 16) * GW + (size_t)u.sub * D + gcol0;
                const u32x4 a4 = *(const GAS u32x4*)gp, b4 = last ? (u32x4){0x01010101u, 0x01010101u, 0x01010101u, 0x01010101u} : *(const GAS u32x4*)(gp + D);
                ga[ai][m][0] = (u32x2){a4.x, a4.y}; ga[ai][m][1] = (u32x2){a4.z, a4.w};
                gb[ai][m][0] = (u32x2){b4.x, b4.y}; gb[ai][m][1] = (u32x2){b4.z, b4.w};
            }
        asm volatile("" ::: "memory");
        const float fin = last ? (1.0f / 255.0f) : 1.0f;
#pragma unroll
        for (int ai = 0; ai < 2; ++ai)
#pragma unroll
            for (int m = 0; m < 4; ++m)
#pragma unroll
                for (int bj = 0; bj < 2; ++bj) {
                    const u32x2 a = ga[ai][m][bj], b = gb[ai][m][bj];
                    if (last) {
                        const f32x4 s0 = {(float)(a.x & 0xffu), (float)((a.x >> 8) & 0xffu), (float)((a.x >> 16) & 0xffu), (float)(a.x >> 24)};
                        const f32x4 s1 = {(float)(a.y & 0xffu), (float)((a.y >> 8) & 0xffu), (float)((a.y >> 16) & 0xffu), (float)(a.y >> 24)};
                        acc[ai][bj][m][0] *= s0 * fin; acc[ai][bj][m][1] *= s1 * fin;
                        *(GAS u32x4*)(O + (size_t)(row0 + ai * HALF + m * 16) * D + col0 + bj * HALF) = pack8(acc[ai][bj][m][0], acc[ai][bj][m][1]);
                    } else {
                        const f32x4 s0 = {(float)(a.x & 0xffu) * frcp((float)(b.x & 0xffu)), (float)((a.x >> 8) & 0xffu) * frcp((float)((b.x >> 8) & 0xffu)), (float)((a.x >> 16) & 0xffu) * frcp((float)((b.x >> 16) & 0xffu)), (float)(a.x >> 24) * frcp((float)(b.x >> 24))};
                        const f32x4 s1 = {(float)(a.y & 0xffu) * frcp((float)(b.y & 0xffu)), (float)((a.y >> 8) & 0xffu) * frcp((float)((b.y >> 8) & 0xffu)), (float)((a.y >> 16) & 0xffu) * frcp((float)((b.y >> 16) & 0xffu)), (float)(a.y >> 24) * frcp((float)(b.y >> 24))};
                        acc[ai][bj][m][0] *= s0; acc[ai][bj][m][1] *= s1;
                    }
                }
        asm volatile("" ::: "memory");
        return !last;
    }
};

struct EpiGBM {
    static constexpr bool PERM = true; static constexpr int NST = 16;
    EpiGates eg; EpiMerge em;
    __device__ __forceinline__ void prefetch(const Unit&, float (&)[8]) const {}
    __device__ __forceinline__ bool operator()(Acc& acc, const Unit& u, const float (&pre)[8]) const {
        if (u.sub < 3) { const Unit v = {u.pm, 4 * u.sub + u.pn, 0}; return eg(acc, v, pre); }
        const Unit v = {u.pm, u.pn, u.sub - 3}; return em(acc, v, pre);
    }
};

struct EpiResid {
    static constexpr bool PERM = true; static constexpr int NST = 32;
    const bf16_t* base; float* out; bf16_t* xb; float* ssq; unsigned char* xb8;
    __device__ __forceinline__ void prefetch(const Unit&, float (&)[8]) const {}
    __device__ __forceinline__ bool operator()(Acc& acc, const Unit& u, const float (&pre)[8]) const {
        int wr, wc, fr, fq; lane_ids(wr, wc, fr, fq);
        const int row0 = u.pm * BM + wr * 64 + fr, col0 = u.pn * BM + wc * 32 + 8 * fq;
        u32x4 bw[2][4][2];
#pragma unroll
        for (int ai = 0; ai < 2; ++ai)
#pragma unroll
            for (int m = 0; m < 4; ++m)
#pragma unroll
                for (int bj = 0; bj < 2; ++bj) bw[ai][m][bj] = *(const GAS u32x4*)(base + (size_t)(row0 + ai * HALF + m * 16) * D + col0 + bj * HALF);
        asm volatile("" ::: "memory");
#pragma unroll
        for (int ai = 0; ai < 2; ++ai) {
#pragma unroll
            for (int m = 0; m < 4; ++m) { const size_t off = (size_t)(row0 + ai * HALF + m * 16) * D + col0; float ss = 0.f;
#pragma unroll
                for (int bj = 0; bj < 2; ++bj) {
                    const u32x4 w = bw[ai][m][bj];
                    const f32x4 o0 = (f32x4){bf_lo(w.x), bf_hi(w.x), bf_lo(w.y), bf_hi(w.y)} + acc[ai][bj][m][0], o1 = (f32x4){bf_lo(w.z), bf_hi(w.z), bf_lo(w.w), bf_hi(w.w)} + acc[ai][bj][m][1];
                    if (out) { *(GAS f32x4*)(out + off + bj * HALF) = o0; *(GAS f32x4*)(out + off + bj * HALF + 4) = o1; }
                    if (xb) { ss += ((o0[0] * o0[0] + o0[1] * o0[1]) + (o0[2] * o0[2] + o0[3] * o0[3])) + ((o1[0] * o1[0] + o1[1] * o1[1]) + (o1[2] * o1[2] + o1[3] * o1[3]));
                        *(GAS u32x4*)(xb + off + bj * HALF) = pack8(o0, o1);
                        if (xb8) *(GAS u32x2*)(xb8 + off + bj * HALF) = (u32x2){cvt4_fp8(o0[0] * XS8, o0[1] * XS8, o0[2] * XS8, o0[3] * XS8), cvt4_fp8(o1[0] * XS8, o1[1] * XS8, o1[2] * XS8, o1[3] * XS8)}; } }
                if (xb) { ss = addx32(addx16(ss)); if (fq == 0) (void)__hip_atomic_fetch_add((GAS float*)ssq + (row0 + ai * HALF + m * 16), ss, __ATOMIC_RELAXED, __HIP_MEMORY_SCOPE_AGENT); } }
            asm volatile("" ::: "memory");
        }
        return false;
    }
};

struct EpiFfn1 {
    static constexpr bool PERM = true; static constexpr int NST = (DBG_DUP == 6 || DBG_DUP >= 14) ? 0 : 8;
    bf16_t* O; const float* ssq; int nostore;
    __device__ __forceinline__ void prefetch(const Unit& u, float (&pre)[8]) const {
        prefetch_rows(ssq, u, pre);
    }
    __device__ __forceinline__ bool operator()(Acc& acc, const Unit& u, const float (&pre)[8]) const {
        int wr, wc, fr, fq; lane_ids(wr, wc, fr, fq);
        const int row0 = u.pm * BM + wr * 64 + fr, col0 = u.pn * HALF + wc * 32 + 8 * fq;
        if (DBG_DUP >= 14 && nostore) {
#pragma unroll
            for (int ai = 0; ai < 2; ++ai)
#pragma unroll
                for (int bj = 0; bj < 2; ++bj)
#pragma unroll
                    for (int m = 0; m < 4; ++m) asm volatile("" :: "v"(acc[ai][bj][m][0]), "v"(acc[ai][bj][m][1]));
            return false;
        }
        float rsv[8]; unpack_rows(pre, rsv);
#pragma unroll
        for (int ai = 0; ai < 2; ++ai)
#pragma unroll
            for (int m = 0; m < 4; ++m) {
                const float rs = frsq(rsv[ai * 4 + m] * (1.0f / D) + EPS), rsn = -rs * LOG2E, rs2 = rs * rs;
                f32x4 o[2];
#pragma unroll
                for (int n = 0; n < 2; ++n) { const f32x4 g = acc[ai][0][m][n], u = acc[ai][1][m][n]; const f32x4 t = g * rsn; f32x4 e, r;
#pragma unroll
                    for (int j = 0; j < 4; ++j) e[j] = fexp2(t[j]);
                    const f32x4 d = e + 1.0f;
#pragma unroll
                    for (int j = 0; j < 4; ++j) r[j] = frcp(d[j]);
                    o[n] = (g * u) * (r * rs2); }
                *(GAS u32x4*)(O + (size_t)(row0 + ai * HALF + m * 16) * FF + col0) = pack8(o[0], o[1]);
            }
        return false;
    }
};
}

namespace att {
constexpr int SLOTB = 8192;
constexpr int L_K = 0, L_V = 3 * SLOTB, L_WS = 6 * SLOTB, L_OST = L_WS + 8 * 256, L_KM = L_OST + 8 * 4096, L_END = L_KM + 7 * 64 * 4;
__device__ __forceinline__ int crow(int r, int hi) { return (r & 3) + 8 * (r >> 2) + 4 * hi; }
__device__ __forceinline__ void glds16(const void* gsrc, unsigned lds_dst) { unsigned keep;
    asm volatile("s_mov_b32 %0, m0\n\ts_mov_b32 m0, %2\n\ts_nop 0\n\tglobal_load_lds_dwordx4 %1, off\n\ts_mov_b32 m0, %0" : "=&s"(keep) : "v"(gsrc), "s"(lds_dst) : "memory"); }
#define ATT_WAIT_BAR0() asm volatile("s_waitcnt vmcnt(0) lgkmcnt(0)\n\ts_barrier" ::: "memory")
#define ATT_SBAR() __builtin_amdgcn_sched_barrier(0)

__device__ __forceinline__ void qkt(f32x16& p0, f32x16& p1, LAS const unsigned char* Kslot, const bf16x8* qr, int r32, int hi) {
    LAS const unsigned char* kb = Kslot + hi * 1024 + r32 * 16;
    p0 = f32x16{}; p1 = f32x16{};
#pragma unroll
    for (int d0 = 0; d0 < 4; ++d0) {
        const bf16x8 b0 = *(LAS const bf16x8*)(kb + d0 * 2048);
        const bf16x8 b1 = *(LAS const bf16x8*)(kb + d0 * 2048 + 512);
        p0 = __builtin_amdgcn_mfma_f32_32x32x16_bf16(b0, qr[d0], p0, 0, 0, 0);
        p1 = __builtin_amdgcn_mfma_f32_32x32x16_bf16(b1, qr[d0], p1, 0, 0, 0);
    }
}
__device__ __forceinline__ float rowmax(const f32x16& p0, const f32x16& p1) {
    float a = fmaxf(p0[0], p1[0]);
#pragma unroll
    for (int r = 1; r < 16; ++r) a = fmaxf(a, fmaxf(p0[r], p1[r]));
    return maxx32(a);
}
__device__ __forceinline__ void pv(f32x16* o, int vb, bf16x8 pa0, bf16x8 pa1, bf16x8 pa2, bf16x8 pa3) {
#pragma unroll
    for (int d0 = 0; d0 < 2; ++d0) { s16x4 lo[4], hi[4];
#pragma unroll
        for (int ks = 0; ks < 4; ++ks) {
            asm volatile("ds_read_b64_tr_b16 %0,%1 offset:%c2" : "=&v"(lo[ks]) : "v"(vb), "i"(d0 * 4096 + ks * 1024) : "memory");
            asm volatile("ds_read_b64_tr_b16 %0,%1 offset:%c2" : "=&v"(hi[ks]) : "v"(vb), "i"(d0 * 4096 + ks * 1024 + 512) : "memory"); }
        asm volatile("s_waitcnt lgkmcnt(0)" ::: "memory"); ATT_SBAR();
#define ATT_PK(k) (bf16x8){lo[k][0], lo[k][1], lo[k][2], lo[k][3], hi[k][0], hi[k][1], hi[k][2], hi[k][3]}
        o[d0] = __builtin_amdgcn_mfma_f32_32x32x16_bf16(pa0, ATT_PK(0), o[d0], 0, 0, 0);
        o[d0] = __builtin_amdgcn_mfma_f32_32x32x16_bf16(pa1, ATT_PK(1), o[d0], 0, 0, 0);
        o[d0] = __builtin_amdgcn_mfma_f32_32x32x16_bf16(pa2, ATT_PK(2), o[d0], 0, 0, 0);
        o[d0] = __builtin_amdgcn_mfma_f32_32x32x16_bf16(pa3, ATT_PK(3), o[d0], 0, 0, 0);
#undef ATT_PK
    }
}

template <int MODE>
__device__ __forceinline__ void attn_unit(const bf16_t* proj, bf16_t* Y, int b, int hh, int qb, const float* sinks, const float* kmp, LAS unsigned char* shm) {
    int tid_ = threadIdx.x; asm volatile("" : "+v"(tid_));
    const int tid = tid_, lane = tid & 63, r32 = lane & 31, hi = lane >> 5; const int wid = __builtin_amdgcn_readfirstlane(tid >> 6);
    const long rowbase = (long)b * SEQ;
    int qhead, qrow0, kcol, vcol, qcol, ycol, t_first, t_last;
    if (MODE == 0) { qhead = 4 * hh + (wid >> 1); qrow0 = 64 * qb + 32 * (wid & 1); qcol = 64 * qhead; kcol = 512 + 64 * hh; vcol = 640 + 64 * hh; ycol = 64 * qhead; t_first = qb >= 2 ? qb - 2 : 0; t_last = qb; }
    else { qhead = hh; qrow0 = 256 * qb + 32 * wid; qcol = 768 + 64 * hh; kcol = 1280 + 64 * hh; vcol = 1792 + 64 * hh; ycol = 512 + 64 * hh; t_first = 0; t_last = 4 * qb + 3; }
    const bf16_t* Qw = proj + (rowbase + qrow0) * PP + qcol;
    const bf16_t* Kh = proj + rowbase * PP + kcol; const bf16_t* Vh = proj + rowbase * PP + vcol;
    const unsigned lds0 = (unsigned)(uintptr_t)shm;
    LAS float* wsf = (LAS float*)(shm + L_WS) + wid * 64;
    const bf16_t* ksrc = Kh + (long)lane * PP + wid * 8;
    const bf16_t* vsrc = Vh + (long)(16 * (wid & 3) + (lane >> 2)) * PP + (wid >> 2) * 32 + (lane & 3) * 8;
    const unsigned kdst = lds0 + L_K + wid * 1024, vdst = lds0 + L_V + wid * 1024;
#define ATT_DMA(t, slot) do { glds16(ksrc + (long)(t) * 64 * PP, (unsigned)__builtin_amdgcn_readfirstlane(kdst + (slot))); glds16(vsrc + (long)(t) * 64 * PP, (unsigned)__builtin_amdgcn_readfirstlane(vdst + (slot))); } while (0)
    const int vb0 = (int)(lds0 + L_V) + ((lane >> 4) & 1) * 32 + (lane & 3) * 8 + (4 * hi + ((lane & 15) >> 2)) * 64;
    bf16x8 qr[4];
#pragma unroll
    for (int d0 = 0; d0 < 4; ++d0) qr[d0] = *(const GAS bf16x8*)(Qw + (long)r32 * PP + d0 * 16 + hi * 8);
    unsigned sel = 0u;
    if (MODE == 1) {
        LAS float* km = (LAS float*)(shm + L_KM);
        if (qb > 0) { for (int idx = tid; idx < qb * 64; idx += 512) { const int n = idx >> 6, d = idx & 63; const float* p = kmp + ((size_t)(((b * 8 + n) * 8 + hh) * 2)) * 64 + d; km[idx] = p[0] + p[64]; } }
        LDS_WAIT(); __syncthreads();
        if (qb <= 3) sel = (1u << qb) - 1u;
        else {
            float qf[32];
#pragma unroll
            for (int d0 = 0; d0 < 4; ++d0)
#pragma unroll
                for (int j = 0; j < 8; ++j) qf[d0 * 8 + j] = bf1((bf16_t)qr[d0][j]);
            float gsc[7];
#pragma unroll
            for (int n = 0; n < 7; ++n) {
                float a = 0.f;
                if (n < qb) {
#pragma unroll
                    for (int d0 = 0; d0 < 4; ++d0) { const f32x4 k0 = *(LAS const f32x4*)(km + n * 64 + d0 * 16 + hi * 8), k1 = *(LAS const f32x4*)(km + n * 64 + d0 * 16 + hi * 8 + 4);
                        a += qf[d0 * 8 + 0] * k0[0] + qf[d0 * 8 + 1] * k0[1] + qf[d0 * 8 + 2] * k0[2] + qf[d0 * 8 + 3] * k0[3] + qf[d0 * 8 + 4] * k1[0] + qf[d0 * 8 + 5] * k1[1] + qf[d0 * 8 + 6] * k1[2] + qf[d0 * 8 + 7] * k1[3]; }
                    a = addx32(a);
                } else a = -INFINITY;
                gsc[n] = a;
            }
#pragma unroll
            for (int n = 0; n < 7; ++n) { int cnt = 0;
#pragma unroll
                for (int m2 = 0; m2 < 7; ++m2) if (m2 != n) cnt += (gsc[m2] > gsc[n] || (gsc[m2] == gsc[n] && m2 < n)) ? 1 : 0;
                if (cnt < 3 && n < qb) sel |= 1u << n; }
        }
    }
    float mhat, l_reg; f32x16 o[2]; o[0] = f32x16{}; o[1] = f32x16{};
    if (MODE == 0) { mhat = sinks[qhead] * LOG2E; l_reg = hi == 0 ? 1.f : 0.f; } else { mhat = -1e30f; l_reg = 0.f; }
    const int qabs = qrow0 + r32;
    int slot = 0;
    if (MODE == 0) {
        for (int t = t_first; t <= t_last; ++t) ATT_DMA(t, (t - t_first) * SLOTB);
        ATT_WAIT_BAR0();
    } else ATT_DMA(t_first, 0);
    for (int t = t_first; t <= t_last; ++t) {
        if (MODE != 0) { ATT_WAIT_BAR0();
            if (t < t_last) ATT_DMA(t + 1, slot ^ SLOTB); }
        bool active = true;
        if (MODE == 1 && t < 4 * qb) active = __any((sel >> (t >> 2)) & 1u);
        if (active) {
            f32x16 p0, p1;
            qkt(p0, p1, shm + L_K + slot, qr, r32, hi);
            if (MODE == 0) {
                const int kb = 64 * t + 4 * hi;
#pragma unroll
                for (int r = 0; r < 16; ++r) { const int kv = kb + (r & 3) + 8 * (r >> 2);
                    if (!(kv <= qabs && kv > qabs - 128)) p0[r] = -INFINITY;
                    if (!(kv + 32 <= qabs && kv + 32 > qabs - 128)) p1[r] = -INFINITY; }
            } else {
                if (t >= 4 * qb) {
                    const int kb = 64 * t + 4 * hi;
#pragma unroll
                    for (int r = 0; r < 16; ++r) { const int kv = kb + (r & 3) + 8 * (r >> 2); if (kv > qabs) p0[r] = -INFINITY; if (kv + 32 > qabs) p1[r] = -INFINITY; }
                } else if (!((sel >> (t >> 2)) & 1u)) {
#pragma unroll
                    for (int r = 0; r < 16; ++r) { p0[r] = -INFINITY; p1[r] = -INFINITY; }
                }
            }
            const float rm = rowmax(p0, p1);
            const float mnew = fmaxf(mhat, rm);
            const float f = fexp2(mhat - mnew);
            mhat = mnew;
            float sacc = 0.f;
#pragma unroll
            for (int r = 0; r < 16; ++r) { p0[r] = fexp2(p0[r] - mnew); p1[r] = fexp2(p1[r] - mnew); sacc += p0[r] + p1[r]; }
            l_reg = l_reg * f + sacc;
            if (__any(f != 1.0f)) {
                if (hi == 0) wsf[r32] = f;
                LDS_WAIT();
#pragma unroll
                for (int r = 0; r < 16; ++r) { const float fr_ = wsf[crow(r, hi)]; o[0][r] *= fr_; o[1][r] *= fr_; }
            }
            u32x4 pw0, pw1, pw2, pw3;
#define ATT_PKW(P, B) cvt_pk_bf16(P[B], P[B + 1])
            pw0 = (u32x4){ATT_PKW(p0, 0), ATT_PKW(p0, 2), ATT_PKW(p0, 4), ATT_PKW(p0, 6)}; pw1 = (u32x4){ATT_PKW(p0, 8), ATT_PKW(p0, 10), ATT_PKW(p0, 12), ATT_PKW(p0, 14)};
            pw2 = (u32x4){ATT_PKW(p1, 0), ATT_PKW(p1, 2), ATT_PKW(p1, 4), ATT_PKW(p1, 6)}; pw3 = (u32x4){ATT_PKW(p1, 8), ATT_PKW(p1, 10), ATT_PKW(p1, 12), ATT_PKW(p1, 14)};
#undef ATT_PKW
            ATT_SBAR();
            pv(o, vb0 + slot, __builtin_bit_cast(bf16x8, pw0), __builtin_bit_cast(bf16x8, pw1), __builtin_bit_cast(bf16x8, pw2), __builtin_bit_cast(bf16x8, pw3));
        }
        if (MODE == 0) slot += SLOTB; else slot ^= SLOTB;
    }
    l_reg = addx32(l_reg);
    if (hi == 0) wsf[32 + r32] = l_reg;
    LDS_WAIT();
    float rli[16];
#pragma unroll
    for (int r = 0; r < 16; ++r) rli[r] = frcp(wsf[32 + crow(r, hi)]);
    bf16_t* Ow = Y + (rowbase + qrow0) * YW + ycol;
    { LAS bf16_t* stg = (LAS bf16_t*)(shm + L_OST) + wid * 2048;
#pragma unroll
        for (int r = 0; r < 16; ++r) { const int orow = crow(r, hi);
#pragma unroll
            for (int d0 = 0; d0 < 2; ++d0) stg[orow * 64 + d0 * 32 + r32] = f2bf(o[d0][r] * rli[r]); }
        LDS_WAIT();
#pragma unroll
        for (int i = 0; i < 4; ++i) { const int row = i * 8 + (lane >> 3), ch = lane & 7; const u32x4 v = *(LAS const u32x4*)(stg + row * 64 + ch * 8); *(GAS u32x4*)(Ow + (long)row * YW + ch * 8) = v; } }
    asm volatile("s_waitcnt lgkmcnt(0)\n\ts_barrier" ::: "memory");
#undef ATT_DMA
}
}

namespace att2 {
#define SBAR() __builtin_amdgcn_sched_barrier(0)
__device__ __forceinline__ int crow(int r,int hi){return (r&3)+8*(r>>2)+4*hi;}
#define SBAR() __builtin_amdgcn_sched_barrier(0)
__device__ __forceinline__ void cmask(f32x16&p0,f32x16&p1,int jb,int qrel,int hi){
  const float NEG=-INFINITY; int kb=64*jb+4*hi;
  #pragma unroll
  for(int r=0;r<16;++r){int kv=kb+(r&3)+8*(r>>2); if(kv>qrel)p0[r]=NEG; if(kv+32>qrel)p1[r]=NEG;}
}

constexpr int NW=8,QBLK=32,QB=256,KVBLK=64,DM=PP;
constexpr int NSLOT=3, SLOTB=8192;
constexpr int LDS_K=0, LDS_V=NSLOT*SLOTB, LDS_WS=2*NSLOT*SLOTB, LDS_OST=LDS_WS+NW*64*4, LDS_KM=LDS_OST+NW*4096, LDS_BYTES=LDS_KM+7*64*4;
__device__ __forceinline__ void glds16(const void*gsrc,unsigned lds_dst){unsigned keep;
  asm volatile("s_mov_b32 %0, m0\n\ts_mov_b32 m0, %2\n\ts_nop 0\n\tglobal_load_lds_dwordx4 %1, off\n\ts_mov_b32 m0, %0":"=&s"(keep):"v"(gsrc),"s"(lds_dst):"memory");}
__device__ __forceinline__ float max3f(float a,float b,float c){float r;asm("v_max3_f32 %0, %1, %2, %3":"=v"(r):"v"(a),"v"(b),"v"(c));return r;}
__device__ __forceinline__ float max2f(float a,float b){float r;asm("v_max_f32_e32 %0, %1, %2":"=v"(r):"v"(a),"v"(b));return r;}
__device__ __forceinline__ float fadd_s(float a,float b){float r;asm("v_add_f32_e32 %0, %1, %2":"=v"(r):"v"(a),"v"(b));return r;}
__device__ __forceinline__ float fsub_s(float a,float b){float r;asm("v_sub_f32_e32 %0, %1, %2":"=v"(r):"v"(a),"v"(b));return r;}
typedef float f32x2_t __attribute__((ext_vector_type(2))); typedef __bf16 bf16x2_t __attribute__((ext_vector_type(2)));
typedef int v8i_t __attribute__((ext_vector_type(8)));
__device__ __forceinline__ unsigned cvtpk_s(float lo,float hi){f32x2_t v={lo,hi};bf16x2_t b=__builtin_convertvector(v,bf16x2_t);return __builtin_bit_cast(unsigned,b);}
#define WAIT_BAR(N) asm volatile("s_waitcnt vmcnt(" #N ") lgkmcnt(0)\n\ts_barrier":::"memory")

typedef __attribute__((address_space(3))) const char* lds_cptr;
__device__ __forceinline__ void qkt(f32x16&p0,f32x16&p1,lds_cptr Kslot,const bf16x8*qr,const f32x16&negm,int r32,int hi){
  lds_cptr kb=Kslot+hi*1024+r32*16;
  #pragma unroll
  for(int d0=0;d0<4;++d0){
    const bf16x8 b0=*(const __attribute__((address_space(3))) bf16x8*)(kb+d0*2048);
    const bf16x8 b1=*(const __attribute__((address_space(3))) bf16x8*)(kb+d0*2048+512);
    if(d0==0){p0=__builtin_amdgcn_mfma_f32_32x32x16_bf16(b0,qr[0],negm,0,0,0);p1=__builtin_amdgcn_mfma_f32_32x32x16_bf16(b1,qr[0],negm,0,0,0);}
    else{p0=__builtin_amdgcn_mfma_f32_32x32x16_bf16(b0,qr[d0],p0,0,0,0);p1=__builtin_amdgcn_mfma_f32_32x32x16_bf16(b1,qr[d0],p1,0,0,0);}}
}
__device__ __forceinline__ void kload8(bf16x8*kf,lds_cptr kp){
  kf[0]=*(const __attribute__((address_space(3))) bf16x8*)(kp);      kf[1]=*(const __attribute__((address_space(3))) bf16x8*)(kp+512);
  kf[2]=*(const __attribute__((address_space(3))) bf16x8*)(kp+2048); kf[3]=*(const __attribute__((address_space(3))) bf16x8*)(kp+2560);
  kf[4]=*(const __attribute__((address_space(3))) bf16x8*)(kp+4096); kf[5]=*(const __attribute__((address_space(3))) bf16x8*)(kp+4608);
  kf[6]=*(const __attribute__((address_space(3))) bf16x8*)(kp+6144); kf[7]=*(const __attribute__((address_space(3))) bf16x8*)(kp+6656);
}
__device__ __forceinline__ void kload2(bf16x8*kf,lds_cptr kp,int j){ kf[2*j]=*(const __attribute__((address_space(3))) bf16x8*)(kp+j*2048); kf[2*j+1]=*(const __attribute__((address_space(3))) bf16x8*)(kp+j*2048+512); }
__device__ __forceinline__ s16x4 vtr(lds_cptr p){ return __builtin_bit_cast(s16x4,__builtin_amdgcn_ds_read_tr16_b64_v4i16((__attribute__((address_space(3))) v4i16_t*)p)); }
__device__ __forceinline__ float rowmax(const f32x16&p0,const f32x16&p1){
  float a=max3f(p0[0],p0[1],p1[0]),b=max3f(p0[2],p0[3],p1[1]);a=max3f(a,p1[2],p1[3]);
  #pragma unroll
  for(int r=4;r<16;r+=4){a=max3f(a,p0[r],p0[r+1]);b=max3f(b,p0[r+2],p0[r+3]);a=max3f(a,p1[r],p1[r+1]);b=max3f(b,p1[r+2],p1[r+3]);}
  const float m=max2f(a,b);
  auto rr=__builtin_amdgcn_permlane32_swap(__float_as_uint(m),__float_as_uint(m),false,false);
  return max2f(__uint_as_float(rr[0]),__uint_as_float(rr[1]));
}
__device__ __forceinline__ void pv(f32x16*o,int vb,bf16x8 pa0,bf16x8 pa1,bf16x8 pa2,bf16x8 pa3){
  #pragma unroll
  for(int d0=0;d0<2;++d0){s16x4 lo[4],hi[4];
    #pragma unroll
    for(int ks=0;ks<4;++ks){
      asm volatile("ds_read_b64_tr_b16 %0,%1 offset:%c2":"=&v"(lo[ks]):"v"(vb),"i"(d0*4096+ks*1024):"memory");
      asm volatile("ds_read_b64_tr_b16 %0,%1 offset:%c2":"=&v"(hi[ks]):"v"(vb),"i"(d0*4096+ks*1024+512):"memory");}
    asm volatile("s_waitcnt lgkmcnt(0)":::"memory");SBAR();
    #define PK(k) (bf16x8){lo[k][0],lo[k][1],lo[k][2],lo[k][3],hi[k][0],hi[k][1],hi[k][2],hi[k][3]}
    o[d0]=__builtin_amdgcn_mfma_f32_32x32x16_bf16(pa0,PK(0),o[d0],0,0,0);
    o[d0]=__builtin_amdgcn_mfma_f32_32x32x16_bf16(pa1,PK(1),o[d0],0,0,0);
    o[d0]=__builtin_amdgcn_mfma_f32_32x32x16_bf16(pa2,PK(2),o[d0],0,0,0);
    o[d0]=__builtin_amdgcn_mfma_f32_32x32x16_bf16(pa3,PK(3),o[d0],0,0,0);
    #undef PK
  }
}

template<int THRL> __device__ __forceinline__ void moba_unit(int b,int h,int qb,const bf16_t*proj,bf16_t*Y,const float*kmp,LAS unsigned char*shm){
  int tid_=threadIdx.x; asm volatile("":"+v"(tid_));
  const int tid=tid_,lane=tid&63,r32=lane&31,hi=lane>>5; const int wid=__builtin_amdgcn_readfirstlane(tid>>6);
  const long rowbase=(long)b*SEQ; const int q0=qb*QB;
  const bf16_t*Qw=proj+(rowbase+q0+wid*QBLK)*DM+768+h*64;
  const bf16_t*Kh=proj+rowbase*DM+1280+h*64,*Vh=proj+rowbase*DM+1792+h*64;
  const unsigned lds0=(unsigned)(uintptr_t)shm;
  LAS float*wsf=(LAS float*)(shm+LDS_WS)+wid*64;
  const bf16_t*ksrc=Kh+(long)lane*DM+wid*8;
  const bf16_t*vsrc=Vh+(long)(16*(wid&3)+(lane>>2))*DM+(wid>>2)*32+(lane&3)*8;
  const unsigned kdst=lds0+LDS_K+wid*1024, vdst=lds0+LDS_V+wid*1024;
  #define DMA_K(t,slot) glds16(ksrc+(long)(t)*KVBLK*DM,(unsigned)__builtin_amdgcn_readfirstlane(kdst+(slot)))
  #define DMA_V(t,slot) glds16(vsrc+(long)(t)*KVBLK*DM,(unsigned)__builtin_amdgcn_readfirstlane(vdst+(slot)))
  const int vb0=(int)(lds0+LDS_V)+((lane>>4)&1)*32+(lane&3)*8+(4*hi+((lane&15)>>2))*64;
  const lds_cptr Kbase=(lds_cptr)(shm+LDS_K); bf16x8 kf[8];
  const lds_cptr shm3=(lds_cptr)shm; const lds_cptr kp0=shm3+LDS_K+hi*1024+r32*16; const lds_cptr vp0=shm3+LDS_V+((lane>>4)&1)*32+(lane&3)*8+(4*hi+((lane&15)>>2))*64;
  const int NT=(q0+QB)/KVBLK;
  bf16x8 qr[4];
  #pragma unroll
  for(int d0=0;d0<4;++d0)qr[d0]=*(const GAS bf16x8*)(&Qw[(long)r32*DM+d0*16+hi*8]);
  LAS float*km=(LAS float*)(shm+LDS_KM);
  if(tid<qb*64){ const int n_=tid>>6,d_=tid&63; const float*p_=kmp+((size_t)(((b*8+n_)*8+h)*2))*64+d_; km[tid]=p_[0]+p_[64]; }
  DMA_K(0,0);DMA_V(0,0);DMA_K(1,SLOTB);
  asm volatile("s_waitcnt lgkmcnt(0)\n\ts_barrier":::"memory");
  unsigned sel=0u;
  if(qb<=3)sel=(1u<<qb)-1u;
  else{
    float qf[32];
    #pragma unroll
    for(int d0=0;d0<4;++d0)
      #pragma unroll
      for(int j=0;j<8;++j)qf[d0*8+j]=bf1((bf16_t)qr[d0][j]);
    float gsc[7];
    #pragma unroll
    for(int n=0;n<7;++n){
      float a=0.f;
      if(n<qb){
        #pragma unroll
        for(int d0=0;d0<4;++d0){ const f32x4 k0=*(LAS const f32x4*)(km+n*64+d0*16+hi*8),k1=*(LAS const f32x4*)(km+n*64+d0*16+hi*8+4);
          a+=qf[d0*8+0]*k0[0]+qf[d0*8+1]*k0[1]+qf[d0*8+2]*k0[2]+qf[d0*8+3]*k0[3]+qf[d0*8+4]*k1[0]+qf[d0*8+5]*k1[1]+qf[d0*8+6]*k1[2]+qf[d0*8+7]*k1[3]; }
        a=addx32(a);
      } else a=-INFINITY;
      gsc[n]=a;
    }
    #pragma unroll
    for(int n=0;n<7;++n){ int cnt=0;
      #pragma unroll
      for(int m2=0;m2<7;++m2) if(m2!=n) cnt+=(gsc[m2]>gsc[n]||(gsc[m2]==gsc[n]&&m2<n))?1:0;
      if(cnt<3&&n<qb)sel|=1u<<n; }
  }
  float mhat=0.f,l_reg=0.f;f32x16 o[2];o[0]=f32x16{};o[1]=f32x16{};f32x16 negm=f32x16{};asm volatile("":"+v"(negm));
  const int qrel=wid*QBLK+r32;
  #define BLKM(P0,P1,t) do{ const float mk_=((sel>>((t)>>2))&1u)?0.f:-INFINITY; _Pragma("unroll") for(int r=0;r<16;++r){P0[r]+=mk_;P1[r]+=mk_;} }while(0)
  #define CMASK(P0,P1,t) do{int jb_=(t)-(NT-4); if(jb_>=0)cmask(P0,P1,jb_,qrel,hi); else BLKM(P0,P1,t);}while(0)
  bool resc=false;
  #define START(P0,P1) do{ const float rm=rowmax(P0,P1); resc=false; \
    { const float dl=__builtin_fmaxf(rm,-60.f); mhat=fadd_s(mhat,dl); \
      _Pragma("unroll") for(int r=0;r<16;++r){P0[r]=fsub_s(P0[r],dl);P1[r]=fsub_s(P1[r],dl);} \
      _Pragma("unroll") for(int r=0;r<16;++r)negm[r]=-mhat; asm volatile("":"+v"(negm)); } \
    _Pragma("unroll") for(int r=0;r<16;++r)P0[r]=__builtin_amdgcn_exp2f(P0[r]); }while(0)
  #define RESC() do{ if(resc){ asm volatile("s_waitcnt lgkmcnt(0)":::"memory"); \
      _Pragma("unroll") for(int d_=0;d_<2;++d_) _Pragma("unroll") for(int r=0;r<16;++r)o[d_][r]*=wsf[crow(r,hi)]; } }while(0)
  f32x16 pA0,pA1,pB0,pB1;
  int sl_prev=0,sl_cur=0,sl_next=SLOTB;
  #define ROT() do{sl_prev=sl_cur;sl_cur=sl_next;sl_next=(sl_next==(NSLOT-1)*SLOTB)?0:sl_next+SLOTB;}while(0)
  DMA_K(2,2*SLOTB);
  WAIT_BAR(3);
  qkt(pA0,pA1,Kbase,qr,negm,r32,hi);asm volatile("s_nop 15\n\ts_nop 7":"+v"(pA0),"+v"(pA1));CMASK(pA0,pA1,0);
  START(pA0,pA1);
  _Pragma("unroll") for(int r=0;r<16;++r)pA1[r]=__builtin_amdgcn_exp2f(pA1[r]);
  WAIT_BAR(0);
  DMA_K(3,0);DMA_V(1,SLOTB);
  ROT();
  kload8(kf,kp0+sl_cur);
  WAIT_BAR(2);
  s16x4 vlo[8],vhi[8]; u32x4 pw0,pw1,pw2,pw3;
  #define PKW(P,B) cvtpk_s(P[B],P[B+1])
  #define PAF(k) __builtin_bit_cast(bf16x8,pw##k)
  #define VFR(i) (bf16x8){vlo[i][0],vlo[i][1],vlo[i][2],vlo[i][3],vhi[i][0],vhi[i][1],vhi[i][2],vhi[i][3]}
  #define PIN(x) asm volatile("":"+v"(x))
  #define MX3(a,b,c) __builtin_fmaxf(__builtin_fmaxf((a),(b)),(c))
  #define GAPA(MF,A0,A1,A2,A3,W0,W1,PW) do{ MF; sacc+=A0; sacc+=A1; sacc+=A2; sacc+=A3; PIN(sacc); W0; W1; PIN(PW); SBAR(); }while(0)
  #define EX(v) __builtin_amdgcn_exp2f(v)
  #define GAPB(MF,X,B) do{ MF; X[B]=EX(X[B]); X[B+1]=EX(X[B+1]); X[B+2]=EX(X[B+2]); X[B+3]=EX(X[B+3]); PIN(X); SBAR(); }while(0)
  #define VRD(i) do{ vlo[i]=vtr(vp_+(((i)>>2)*4096+((i)&3)*1024)); vhi[i]=vtr(vp_+(((i)>>2)*4096+((i)&3)*1024+512)); }while(0)
  #define KRD(G,j) do{ if(G){ kload2(kf,kp0+sl_next,j); SBAR(); } }while(0)
  #define STEP(C0,C1,P0,P1,t,GK,GV,GL) do{ SBAR(); \
    const lds_cptr vp_=vp0+sl_prev; \
    VRD(0); SBAR(); float sacc=(P0[0]+P0[1]); \
    GAPA(C0=__builtin_amdgcn_mfma_f32_32x32x16_bf16(kf[0],qr[0],negm,0,0,0), P0[2],P0[3],P0[4],P0[5],     pw0[0]=PKW(P0,0), pw0[1]=PKW(P0,2), pw0); \
    VRD(4); SBAR(); GAPA(C1=__builtin_amdgcn_mfma_f32_32x32x16_bf16(kf[1],qr[0],negm,0,0,0), P0[6],P0[7],P0[8],P0[9],     pw0[2]=PKW(P0,4), pw0[3]=PKW(P0,6), pw0); \
    VRD(1); SBAR(); GAPA(C0=__builtin_amdgcn_mfma_f32_32x32x16_bf16(kf[2],qr[1],C0,0,0,0),   P0[10],P0[11],P0[12],P0[13], pw1[0]=PKW(P0,8), pw1[1]=PKW(P0,10), pw1); \
    VRD(5); SBAR(); GAPA(C1=__builtin_amdgcn_mfma_f32_32x32x16_bf16(kf[3],qr[1],C1,0,0,0),   P0[14],P0[15],P1[0],P1[1],   pw1[2]=PKW(P0,12),pw1[3]=PKW(P0,14), pw1); \
    VRD(2); SBAR(); GAPA(C0=__builtin_amdgcn_mfma_f32_32x32x16_bf16(kf[4],qr[2],C0,0,0,0),   P1[2],P1[3],P1[4],P1[5],     pw2[0]=PKW(P1,0), pw2[1]=PKW(P1,2), pw2); \
    VRD(6); SBAR(); GAPA(C1=__builtin_amdgcn_mfma_f32_32x32x16_bf16(kf[5],qr[2],C1,0,0,0),   P1[6],P1[7],P1[8],P1[9],     pw2[2]=PKW(P1,4), pw2[3]=PKW(P1,6), pw2); \
    VRD(3); SBAR(); GAPA(C0=__builtin_amdgcn_mfma_f32_32x32x16_bf16(kf[6],qr[3],C0,0,0,0),   P1[10],P1[11],P1[12],P1[13], pw3[0]=PKW(P1,8), pw3[1]=PKW(P1,10), pw3); \
    VRD(7); SBAR(); GAPA(C1=__builtin_amdgcn_mfma_f32_32x32x16_bf16(kf[7],qr[3],C1,0,0,0),   P1[14],P1[15],0.f,0.f,       pw3[2]=PKW(P1,12),pw3[3]=PKW(P1,14), pw3); \
    l_reg+=sacc; \
    if(GK){DMA_K((t)+3,sl_cur);} if(GV){DMA_V((t)+1,sl_next);} \
    CMASK(C0,C1,t); \
    { float a=MX3(C0[0],C0[1],C1[0]),b=MX3(C0[2],C0[3],C1[1]); a=MX3(a,C1[2],C1[3]); \
      _Pragma("unroll") for(int r=4;r<16;r+=4){a=MX3(a,C0[r],C0[r+1]);b=MX3(b,C0[r+2],C0[r+3]);a=MX3(a,C1[r],C1[r+1]);b=MX3(b,C1[r+2],C1[r+3]);} \
      float rm=__builtin_fmaxf(a,b); { auto rr=__builtin_amdgcn_permlane32_swap(__float_as_uint(rm),__float_as_uint(rm),false,false); rm=__builtin_fmaxf(__uint_as_float(rr[0]),__uint_as_float(rr[1])); } \
      resc=false; \
      if(__builtin_expect(__any(rm>(float)THRL),0)){ const float dl=__builtin_fmaxf(rm,0.f); mhat+=dl; \
        _Pragma("unroll") for(int r=0;r<16;++r){C0[r]-=dl;C1[r]-=dl;} \
        _Pragma("unroll") for(int r=0;r<16;++r)negm[r]=-mhat; asm volatile("":"+v"(negm)); \
        const float f=__builtin_amdgcn_exp2f(-dl); l_reg*=f; if(hi==0)wsf[r32]=f; resc=true; } } \
    SBAR(); \
    GAPB(o[0]=__builtin_amdgcn_mfma_f32_32x32x16_bf16(PAF(0),VFR(0),o[0],0,0,0), C0,0); \
    GAPB(o[1]=__builtin_amdgcn_mfma_f32_32x32x16_bf16(PAF(0),VFR(4),o[1],0,0,0), C0,4); \
    KRD(GL,0); GAPB(o[0]=__builtin_amdgcn_mfma_f32_32x32x16_bf16(PAF(1),VFR(1),o[0],0,0,0), C0,8); \
    KRD(GL,1); GAPB(o[1]=__builtin_amdgcn_mfma_f32_32x32x16_bf16(PAF(1),VFR(5),o[1],0,0,0), C0,12); \
    KRD(GL,2); GAPB(o[0]=__builtin_amdgcn_mfma_f32_32x32x16_bf16(PAF(2),VFR(2),o[0],0,0,0), C1,0); \
    KRD(GL,3); GAPB(o[1]=__builtin_amdgcn_mfma_f32_32x32x16_bf16(PAF(2),VFR(6),o[1],0,0,0), C1,4); \
    GAPB(o[0]=__builtin_amdgcn_mfma_f32_32x32x16_bf16(PAF(3),VFR(3),o[0],0,0,0), C1,8); \
    GAPB(o[1]=__builtin_amdgcn_mfma_f32_32x32x16_bf16(PAF(3),VFR(7),o[1],0,0,0), C1,12); \
    }while(0)
  int t=1;
  #undef CMASK
  #define CMASK(P0,P1,t) BLKM(P0,P1,t)
  for(;t+5<NT;t+=2){
    STEP(pB0,pB1,pA0,pA1,t,true,true,true);     WAIT_BAR(2); RESC(); ROT();
    STEP(pA0,pA1,pB0,pB1,t+1,true,true,true);   WAIT_BAR(2); RESC(); ROT();
  }
  #undef CMASK
  #define CMASK(P0,P1,t) do{int jb_=(t)-(NT-4); if(jb_>=0)cmask(P0,P1,jb_,qrel,hi); else BLKM(P0,P1,t);}while(0)
  #define ENDW(tt) do{ if((tt)+3<NT){WAIT_BAR(2);} else if((tt)+2<NT){WAIT_BAR(1);} else {WAIT_BAR(0);} }while(0)
  for(;t+1<NT;t+=2){
    STEP(pB0,pB1,pA0,pA1,t,(t+3<NT),(t+1<NT),(t+1<NT));       ENDW(t);   RESC(); ROT();
    STEP(pA0,pA1,pB0,pB1,t+1,(t+4<NT),(t+2<NT),(t+2<NT));     ENDW(t+1); RESC(); ROT();
  }
  STEP(pB0,pB1,pA0,pA1,NT-1,false,false,false); RESC();
  { float sacc=pB0[0]+pB0[1]; _Pragma("unroll") for(int r=2;r<16;++r)sacc+=pB0[r]; _Pragma("unroll") for(int r=0;r<16;++r)sacc+=pB1[r]; l_reg+=sacc;
    pw0=(u32x4){PKW(pB0,0),PKW(pB0,2),PKW(pB0,4),PKW(pB0,6)};pw1=(u32x4){PKW(pB0,8),PKW(pB0,10),PKW(pB0,12),PKW(pB0,14)};pw2=(u32x4){PKW(pB1,0),PKW(pB1,2),PKW(pB1,4),PKW(pB1,6)};pw3=(u32x4){PKW(pB1,8),PKW(pB1,10),PKW(pB1,12),PKW(pB1,14)};
    SBAR(); pv(o,vb0+sl_cur,PAF(0),PAF(1),PAF(2),PAF(3)); }
  #undef PKW
  #undef PAF
  #undef VFR
  #undef PIN
  #undef MX3
  #undef GAPA
  #undef GAPB
  #undef EX
  #undef VRD
  #undef KRD
  #undef STEP
  #undef ENDW
  {auto rr=__builtin_amdgcn_permlane32_swap(__float_as_uint(l_reg),__float_as_uint(l_reg),false,false);l_reg=__uint_as_float(rr[0])+__uint_as_float(rr[1]);}
  if(hi==0)wsf[32+r32]=l_reg;asm volatile("s_waitcnt lgkmcnt(0)":::"memory");
  float rli[16];
  #pragma unroll
  for(int r=0;r<16;++r)rli[r]=__builtin_amdgcn_rcpf(wsf[32+crow(r,hi)]);
  bf16_t*Ow=Y+(rowbase+q0+wid*QBLK)*YW+512+h*64;
  { LAS bf16_t*stg=(LAS bf16_t*)(shm+LDS_OST)+wid*2048;
    #pragma unroll
    for(int r=0;r<16;++r){const int orow=crow(r,hi);
      #pragma unroll
      for(int d0=0;d0<2;++d0)stg[orow*64+d0*32+r32]=f2bf(o[d0][r]*rli[r]);}
    asm volatile("s_waitcnt lgkmcnt(0)":::"memory");
    #pragma unroll
    for(int i=0;i<4;++i){const int row=i*8+(lane>>3),ch=lane&7; const u32x4 v=*(LAS const u32x4*)(stg+row*64+ch*8); *(GAS u32x4*)(Ow+(long)row*YW+ch*8)=v;} }
  asm volatile("s_waitcnt lgkmcnt(0)\n\ts_barrier":::"memory");
  #undef DMA_K
  #undef DMA_V
  #undef CMASK
  #undef BLKM
  #undef START
  #undef RESC
  #undef ROT
}

#undef SBAR
#undef WAIT_BAR
}

namespace gla {
constexpr int PB = 144, PV = 272;
constexpr int L_LAR = 0, L_QR = 9216, L_KR = 18432, L_VR = 27648, L_RR = 45056, L_QD = 62464, L_KD = 71680, L_KTL = 80896, L_AM = 90112, L_DEC = 99328, L_SSQ = 99584, L_Y = 101632, L_END = 119040;
__device__ __forceinline__ f32x4 mfma16(bf16x8 a, bf16x8 b, f32x4 c) { return __builtin_amdgcn_mfma_f32_16x16x32_bf16(a, b, c, 0, 0, 0); }
__device__ __forceinline__ s16x4 trd(LAS const unsigned char* p) { return __builtin_bit_cast(s16x4, __builtin_amdgcn_ds_read_tr16_b64_v4i16((LAS v4i16_t*)p)); }
__device__ __forceinline__ bf16x8 tr_frag(LAS const unsigned char* img, int pitch, int k0, int c0, int lane) {
    const int g = lane >> 4, q = (lane & 15) >> 2, p = lane & 3;
    LAS const unsigned char* a = img + (k0 + 8 * g + q) * pitch + (c0 + 4 * p) * 2;
    const s16x4 lo = trd(a), hi = trd(a + 4 * pitch);
    return (bf16x8){lo[0], lo[1], lo[2], lo[3], hi[0], hi[1], hi[2], hi[3]};
}

template <int VAR = 0> __device__ __forceinline__ void gla_unit(const bf16_t* proj, bf16_t* Y, int b, int h, const float* gnorm, LAS unsigned char* lds) {
    int tid_ = threadIdx.x; asm volatile("" : "+v"(tid_));
    const int tid = tid_, lane = tid & 63, fr = lane & 15, fq = lane >> 4; const int wid = __builtin_amdgcn_readfirstlane(tid >> 6);
    const long rowbase = (long)b * SEQ;
    const int cq = 2304 + 64 * h, ck = 2560 + 64 * h, cv = 2816 + 128 * h, cla = 3328 + 64 * h, cr = 3584 + 128 * h;
    const int lt = tid >> 3, ldc = (tid & 7) * 8;
    const int vrow0 = tid >> 4, ve0 = (tid & 15) * 8;
    f32x4 sd[4];
#pragma unroll
    for (int i = 0; i < 4; ++i) sd[i] = (f32x4){0.f, 0.f, 0.f, 0.f};
    const f32x4 gn4 = *(const GAS f32x4*)(gnorm + 16 * wid + 4 * fq);
    u32x4 nq, nk, nla, nv0, nv1, nr0, nr1;
    {
        const bf16_t* base = proj + (rowbase + lt) * PP;
        nq = *(const GAS u32x4*)(base + cq + ldc); nk = *(const GAS u32x4*)(base + ck + ldc); nla = *(const GAS u32x4*)(base + cla + ldc);
        const bf16_t* bv = proj + (rowbase + vrow0) * PP;
        nv0 = *(const GAS u32x4*)(bv + cv + ve0); nv1 = *(const GAS u32x4*)(bv + (size_t)32 * PP + cv + ve0);
        nr0 = *(const GAS u32x4*)(bv + cr + ve0); nr1 = *(const GAS u32x4*)(bv + (size_t)32 * PP + cr + ve0);
    }
    LAS float* DEC = (LAS float*)(lds + L_DEC); LAS float* SSQ = (LAS float*)(lds + L_SSQ);
    const int db = wid & 3, ibp = wid >> 2;
    for (int n = 0; n < 32; ++n) {
        *(LAS u32x4*)(lds + L_LAR + lt * PB + ldc * 2) = nla; *(LAS u32x4*)(lds + L_QR + lt * PB + ldc * 2) = nq; *(LAS u32x4*)(lds + L_KR + lt * PB + ldc * 2) = nk;
        *(LAS u32x4*)(lds + L_VR + vrow0 * PV + ve0 * 2) = nv0; *(LAS u32x4*)(lds + L_VR + (vrow0 + 32) * PV + ve0 * 2) = nv1;
        const int rro = (n & 1) ? L_Y : L_RR;
        *(LAS u32x4*)(lds + rro + vrow0 * PV + ve0 * 2) = nr0; *(LAS u32x4*)(lds + rro + (vrow0 + 32) * PV + ve0 * 2) = nr1;
        if (n + 1 < 32) {
            const long r1 = rowbase + (long)(n + 1) * 64;
            const bf16_t* base = proj + (r1 + lt) * PP;
            nq = *(const GAS u32x4*)(base + cq + ldc); nk = *(const GAS u32x4*)(base + ck + ldc); nla = *(const GAS u32x4*)(base + cla + ldc);
            const bf16_t* bv = proj + (r1 + vrow0) * PP;
            nv0 = *(const GAS u32x4*)(bv + cv + ve0); nv1 = *(const GAS u32x4*)(bv + (size_t)32 * PP + cv + ve0);
            nr0 = *(const GAS u32x4*)(bv + cr + ve0); nr1 = *(const GAS u32x4*)(bv + (size_t)32 * PP + cr + ve0);
        }
        LDS_WAIT(); __builtin_amdgcn_s_barrier(); asm volatile("" ::: "memory");
        {
            bf16x8 af[2];
#pragma unroll
            for (int s = 0; s < 2; ++s) af[s] = tr_frag(lds + L_LAR, PB, 32 * s, 16 * db, lane);
            const u32x4 one4 = {0x3F803F80u, 0x3F803F80u, 0x3F803F80u, 0x3F803F80u};
            f32x4 bl = {0.f, 0.f, 0.f, 0.f};
            bl = mfma16(af[0], __builtin_bit_cast(bf16x8, one4), bl); bl = mfma16(af[1], __builtin_bit_cast(bf16x8, one4), bl);
#pragma unroll
            for (int rep = 0; rep < 2; ++rep) {
                const int ib = 2 * ibp + rep, i_ = 16 * ib + fr;
                f32x4 bc = {0.f, 0.f, 0.f, 0.f};
#pragma unroll
                for (int s = 0; s < 2; ++s) {
                    const int nones = i_ - (32 * s + 8 * fq) + 1;
                    u32x4 lw;
                    lw.x = (nones > 0 ? 0x3F80u : 0u) | (nones > 1 ? 0x3F800000u : 0u); lw.y = (nones > 2 ? 0x3F80u : 0u) | (nones > 3 ? 0x3F800000u : 0u);
                    lw.z = (nones > 4 ? 0x3F80u : 0u) | (nones > 5 ? 0x3F800000u : 0u); lw.w = (nones > 6 ? 0x3F80u : 0u) | (nones > 7 ? 0x3F800000u : 0u);
                    bc = mfma16(af[s], __builtin_bit_cast(bf16x8, lw), bc);
                }
                const int off = i_ * PB + (16 * db + 4 * fq) * 2;
                const u32x2 qw = *(LAS const u32x2*)(lds + L_QR + off), kw = *(LAS const u32x2*)(lds + L_KR + off);
                const float q4[4] = {bf_lo(qw.x), bf_hi(qw.x), bf_lo(qw.y), bf_hi(qw.y)}, k4[4] = {bf_lo(kw.x), bf_hi(kw.x), bf_lo(kw.y), bf_hi(kw.y)};
                float qd[4], kd[4], kt[4];
#pragma unroll
                for (int r = 0; r < 4; ++r) { qd[r] = q4[r] * fexp(bc[r]); kd[r] = k4[r] * fexp(-bc[r]); kt[r] = k4[r] * fexp(bl[r] - bc[r]); }
                *(LAS u32x2*)(lds + L_QD + off) = (u32x2){cvt_pk_bf16(qd[0], qd[1]), cvt_pk_bf16(qd[2], qd[3])};
                *(LAS u32x2*)(lds + L_KD + off) = (u32x2){cvt_pk_bf16(kd[0], kd[1]), cvt_pk_bf16(kd[2], kd[3])};
                *(LAS u32x2*)(lds + L_KTL + off) = (u32x2){cvt_pk_bf16(kt[0], kt[1]), cvt_pk_bf16(kt[2], kt[3])};
            }
            if (ibp == 0 && fr == 0) *(LAS f32x4*)(DEC + 16 * db + 4 * fq) = (f32x4){fexp(bl[0]), fexp(bl[1]), fexp(bl[2]), fexp(bl[3])};
        }
        LDS_WAIT(); __builtin_amdgcn_s_barrier(); asm volatile("" ::: "memory");
#pragma unroll
        for (int rep = 0; rep < 2; ++rep) {
            const int id = wid + 8 * rep, ib = id >> 2, jb = id & 3;
            u32x2 w = {0u, 0u};
            if (jb <= ib) {
                f32x4 a = {0.f, 0.f, 0.f, 0.f};
#pragma unroll
                for (int s = 0; s < 2; ++s) {
                    const bf16x8 ka = *(LAS const bf16x8*)(lds + L_KD + (16 * jb + fr) * PB + (32 * s + 8 * fq) * 2);
                    const bf16x8 qb_ = *(LAS const bf16x8*)(lds + L_QD + (16 * ib + fr) * PB + (32 * s + 8 * fq) * 2);
                    a = mfma16(ka, qb_, a);
                }
                const int i_ = 16 * ib + fr, j0 = 16 * jb + 4 * fq;
#pragma unroll
                for (int r = 0; r < 4; ++r) if (j0 + r > i_) a[r] = 0.f;
                w.x = cvt_pk_bf16(a[0], a[1]); w.y = cvt_pk_bf16(a[2], a[3]);
            }
            *(LAS u32x2*)(lds + L_AM + (16 * ib + fr) * PB + (16 * jb + 4 * fq) * 2) = w;
        }
        f32x4 ao[4];
        {
            bf16x8 sb[2];
#pragma unroll
            for (int s = 0; s < 2; ++s) { u32x4 w; w.x = cvt_pk_bf16(sd[2 * s][0], sd[2 * s][1]); w.y = cvt_pk_bf16(sd[2 * s][2], sd[2 * s][3]); w.z = cvt_pk_bf16(sd[2 * s + 1][0], sd[2 * s + 1][1]); w.w = cvt_pk_bf16(sd[2 * s + 1][2], sd[2 * s + 1][3]); sb[s] = __builtin_bit_cast(bf16x8, w); }
#pragma unroll
            for (int ib = 0; ib < 4; ++ib) {
                f32x4 a = {0.f, 0.f, 0.f, 0.f};
#pragma unroll
                for (int s = 0; s < 2; ++s) {
                    const u32x2 lo = *(LAS const u32x2*)(lds + L_QD + (16 * ib + fr) * PB + (32 * s + 4 * fq) * 2);
                    const u32x2 hi = *(LAS const u32x2*)(lds + L_QD + (16 * ib + fr) * PB + (32 * s + 16 + 4 * fq) * 2);
                    const u32x4 qa = {lo.x, lo.y, hi.x, hi.y};
                    a = mfma16(sb[s], __builtin_bit_cast(bf16x8, qa), a);
                }
                ao[ib] = a;
            }
        }
        LDS_WAIT(); __builtin_amdgcn_s_barrier(); asm volatile("" ::: "memory");
        {
            bf16x8 vf[2];
#pragma unroll
            for (int s = 0; s < 2; ++s) vf[s] = tr_frag(lds + L_VR, PV, 32 * s, 16 * wid, lane);
#pragma unroll
            for (int ib = 0; ib < 4; ++ib)
#pragma unroll
                for (int s = 0; s < 2; ++s) {
                    if (32 * s > 16 * ib + 15) continue;
                    const bf16x8 af = *(LAS const bf16x8*)(lds + L_AM + (16 * ib + fr) * PB + (32 * s + 8 * fq) * 2);
                    ao[ib] = mfma16(vf[s], af, ao[ib]);
                }
#pragma unroll
            for (int d4 = 0; d4 < 4; ++d4) {
                const f32x4 dc = *(LAS const f32x4*)(DEC + 16 * d4 + 4 * fq);
                f32x4 a = sd[d4] * dc;
#pragma unroll
                for (int s = 0; s < 2; ++s) { const bf16x8 kf = tr_frag(lds + L_KTL, PB, 32 * s, 16 * d4, lane); a = mfma16(kf, vf[s], a); }
                sd[d4] = a;
            }
        }
#pragma unroll
        for (int ib = 0; ib < 4; ++ib) { float v = (ao[ib][0] * ao[ib][0] + ao[ib][1] * ao[ib][1]) + (ao[ib][2] * ao[ib][2] + ao[ib][3] * ao[ib][3]); v = addx32(addx16(v));
            if (fq == 0) SSQ[(16 * ib + fr) * 8 + wid] = v; }
        LDS_WAIT(); __builtin_amdgcn_s_barrier(); asm volatile("" ::: "memory");
        {
            const long r0 = rowbase + (long)n * 64;
#pragma unroll
            for (int ib = 0; ib < 4; ++ib) { const int i_ = 16 * ib + fr;
                const f32x4 s0 = *(LAS const f32x4*)(SSQ + i_ * 8), s1 = *(LAS const f32x4*)(SSQ + i_ * 8 + 4);
                const float tot = ((s0[0] + s0[1]) + (s0[2] + s0[3])) + ((s1[0] + s1[1]) + (s1[2] + s1[3]));
                const float rstd = frsq(tot * (1.0f / 128.0f) + EPS);
                const u32x2 rw = *(LAS const u32x2*)(lds + rro + i_ * PV + (16 * wid + 4 * fq) * 2);
                const f32x4 y = ao[ib] * rstd * gn4 * (f32x4){bf_lo(rw.x), bf_hi(rw.x), bf_lo(rw.y), bf_hi(rw.y)};
                *(GAS u32x2*)(Y + (r0 + i_) * YW + 1024 + 128 * h + 16 * wid + 4 * fq) = (u32x2){cvt_pk_bf16(y[0], y[1]), cvt_pk_bf16(y[2], y[3])}; }
        }
    }
    LDS_WAIT(); __builtin_amdgcn_s_barrier(); asm volatile("" ::: "memory");
}
}

constexpr int NWAVES = 8;
constexpr int RING_BYTES = 131072, MISC_OFF = RING_BYTES, LDS_BYTES = 147456;
static_assert(gla::L_END <= RING_BYTES && att::L_END <= RING_BYTES && att2::LDS_BYTES <= RING_BYTES, "LDS map");

struct Params { const float* in[20]; float* out; unsigned char* ws; double invf[32]; int ph_lo, ph_hi; };

__device__ __forceinline__ void norm_row(const float* xrow, const float* gain, bf16_t* orow, int lane) {
    const f32x4* xr = (const f32x4*)xrow + lane; const f32x4* gr = (const f32x4*)gain + lane;
    f32x4 v[4]; float s = 0.f;
#pragma unroll
    for (int j = 0; j < 4; ++j) { v[j] = xr[64 * j]; s += (v[j][0] * v[j][0] + v[j][1] * v[j][1]) + (v[j][2] * v[j][2] + v[j][3] * v[j][3]); }
    const float rstd = 1.0f / sqrtf(wave_sum(s) * (1.0f / D) + EPS);
    u32x2* o8 = (u32x2*)orow + lane;
#pragma unroll
    for (int j = 0; j < 4; ++j) { const f32x4 g = gr[64 * j]; u32x2 w; w.x = cvt_pk_bf16(v[j][0] * rstd * g[0], v[j][1] * rstd * g[1]); w.y = cvt_pk_bf16(v[j][2] * rstd * g[2], v[j][3] * rstd * g[3]); o8[64 * j] = w; }
}
__device__ __forceinline__ void norm_phase(const float* x, const float* gain, bf16_t* H, int gw, int ngw, int lane) {
    for (int m = gw; m < T; m += ngw) norm_row(x + (size_t)m * D, gain, H + (size_t)m * D, lane);
}

__device__ __forceinline__ void conv_item(const float* src, int pitch, int col, int K, bf16_t* dst, int prow, int k0, const float* kscale = nullptr) {
    const float* s = src + (size_t)k0 * pitch + col;
    bf16_t* d = dst + (size_t)prow * K + k0;
#pragma unroll 2
    for (int kk = 0; kk < 8; ++kk) {
        float v[8];
#pragma unroll
        for (int i = 0; i < 8; ++i) v[i] = s[(size_t)(kk * 8 + i) * pitch];
        if (kscale) {
#pragma unroll
            for (int i = 0; i < 8; ++i) v[i] *= kscale[k0 + kk * 8 + i]; }
        u32x4 w; w.x = cvt_pk_bf16(v[0], v[1]); w.y = cvt_pk_bf16(v[2], v[3]); w.z = cvt_pk_bf16(v[4], v[5]); w.w = cvt_pk_bf16(v[6], v[7]);
        *(GAS u32x4*)(d + kk * 8) = w;
    }
}
__device__ __forceinline__ void conv4_load(const float* src, int pitch, int k0, const float* kscale, float mul, f32x4 (&v)[16]) {
#pragma unroll
    for (int i = 0; i < 16; ++i) v[i] = *(const GAS f32x4*)(src + (size_t)(k0 + i) * pitch);
    if (kscale) {
#pragma unroll
        for (int i = 0; i < 16; ++i) v[i] *= kscale[k0 + i] * mul; }
}
__device__ __forceinline__ void conv4_store_bf16(const f32x4 (&v)[16], bf16_t* dst, int K) {
#pragma unroll
    for (int j = 0; j < 4; ++j) {
        *(GAS u32x4*)(dst + (size_t)j * K) = (u32x4){cvt_pk_bf16(v[0][j], v[1][j]), cvt_pk_bf16(v[2][j], v[3][j]), cvt_pk_bf16(v[4][j], v[5][j]), cvt_pk_bf16(v[6][j], v[7][j])};
        *(GAS u32x4*)(dst + (size_t)j * K + 8) = (u32x4){cvt_pk_bf16(v[8][j], v[9][j]), cvt_pk_bf16(v[10][j], v[11][j]), cvt_pk_bf16(v[12][j], v[13][j]), cvt_pk_bf16(v[14][j], v[15][j])}; }
}
__device__ __forceinline__ void conv4_store_fp8(const f32x4 (&v)[16], unsigned char* d8, int K) {
#pragma unroll
    for (int j = 0; j < 4; ++j)
        *(GAS u32x4*)(d8 + (size_t)j * K) = (u32x4){cvt4_fp8(v[0][j], v[1][j], v[2][j], v[3][j]), cvt4_fp8(v[4][j], v[5][j], v[6][j], v[7][j]), cvt4_fp8(v[8][j], v[9][j], v[10][j], v[11][j]), cvt4_fp8(v[12][j], v[13][j], v[14][j], v[15][j])};
}
constexpr int IT_WIN = (PW / 64) * (D / 64), IT_WG = (GW / 64) * (D / 64), IT_WB = 3 * (D / 64) * (512 / 64), IT_WO = (D / 64) * (D / 64), IT_F1 = (FFP / 64) * (D / 64), IT_F2 = (D / 64) * (FF / 64);
constexpr int IT_LAYER = IT_WIN + IT_WG + IT_WB + IT_WO + IT_F1 + IT_F2;

__device__ __forceinline__ void sincos_d(double a, float& c, float& s) {
    const double kq = rint(a * 0.63661977236758134308);
    double r = fma(-kq, 1.57079632679489655800e+00, a); r = fma(-kq, 6.12323399573676603587e-17, r);
    const double r2 = r * r;
    const double sp = r * (1.0 + r2 * (-1.0 / 6 + r2 * (1.0 / 120 + r2 * (-1.0 / 5040 + r2 * (1.0 / 362880 + r2 * (-1.0 / 39916800 + r2 * (1.0 / 6227020800.0)))))));
    const double cp = 1.0 + r2 * (-0.5 + r2 * (1.0 / 24 + r2 * (-1.0 / 720 + r2 * (1.0 / 40320 + r2 * (-1.0 / 3628800 + r2 * (1.0 / 479001600 + r2 * (-1.0 / 87178291200.0)))))));
    const int q = ((int)kq) & 3;
    const double ss = (q == 0) ? sp : (q == 1) ? cp : (q == 2) ? -sp : -cp;
    const double cc = (q == 0) ? cp : (q == 1) ? -sp : (q == 2) ? -cp : sp;
    c = (float)cc; s = (float)ss;
}

__device__ __forceinline__ void prologue(const Params& P, int gw, int ngw, int lane) {
    unsigned char* ws = P.ws;
    for (int rep = 0; rep < (DBG_DUP == 4 ? 2 : 1); ++rep)
    for (int it = gw; it < 2 * IT_LAYER; it += ngw) {
        const int l = it / IT_LAYER; int r = it - l * IT_LAYER;
        unsigned char* wl = ws + WS_W + (size_t)l * LW_BYTES;
        const int q4 = 4 * lane;
        if (r < IT_WIN) {
            const int pn = r / (D / 16), k0 = (r % (D / 16)) * 16, bj = (q4 >> 7) & 1, wc = (q4 >> 5) & 3, rem = q4 & 31, c = 256 * pn + 64 * wc + 32 * bj + rem, prow = 256 * pn + q4;
            const float* win = P.in[3] + (size_t)l * D * DIN; const float* ga = P.in[2] + (size_t)l * D;
            f32x4 v[16];
            if (pn < 2 || (pn >= 3 && pn < 7)) {
                conv4_load(win + c, DIN, k0, ga, WS8, v); conv4_store_fp8(v, wl + OFF_WIN8 + (size_t)prow * D + k0, D);
            } else if (pn == 13) {
                const float* wa = P.in[9] + (size_t)l * 16 * 256 + (c - 3328);
                f32x4 a[16];
#pragma unroll
                for (int q = 0; q < 16; ++q) a[q] = *(const GAS f32x4*)(wa + q * 256);
                const f32x4 wv = *(const GAS f32x4*)(win + (size_t)(k0 + (lane & 15)) * DIN + 3328 + 4 * (lane >> 4));
#pragma unroll
                for (int k = 0; k < 16; ++k) { f32x4 acc = {0.f, 0.f, 0.f, 0.f};
#pragma unroll
                    for (int q = 0; q < 16; ++q) acc += a[q] * __int_as_float(__builtin_amdgcn_readlane(__float_as_int(wv[q & 3]), k + 16 * (q >> 2)));
                    v[k] = acc * ga[k0 + k]; }
                conv4_store_bf16(v, (bf16_t*)(wl + OFF_WIN) + (size_t)prow * D + k0, D);
            } else { conv4_load(win + (pn >= 14 ? 3344 + (c - 3584) : c), DIN, k0, ga, 1.0f, v); conv4_store_bf16(v, (bf16_t*)(wl + OFF_WIN) + (size_t)prow * D + k0, D); }
            continue;
        }
        r -= IT_WIN;
        if (r < IT_WG) {
            const int prow = 256 * (r / (D / 16)) + q4, k0 = (r % (D / 16)) * 16; f32x4 v[16];
            conv4_load(P.in[3] + (size_t)l * D * DIN + 3856 + prow, DIN, k0, P.in[2] + (size_t)l * D, WS8, v); conv4_store_fp8(v, wl + OFF_WG + (size_t)prow * D + k0, D);
            continue; }
        r -= IT_WG;
        if (r < IT_WB) { const int j = r / (4 * 32), r2 = r % (4 * 32), prow = 256 * (r2 / 32) + q4, k0 = (r2 % 32) * 16; f32x4 v[16];
            conv4_load(P.in[12 + j] + (size_t)l * 512 * D + prow, D, k0, nullptr, 1.0f, v); conv4_store_bf16(v, (bf16_t*)(wl + OFF_WB) + (size_t)j * D * 512 + (size_t)prow * 512 + k0, 512); continue; }
        r -= IT_WB;
        if (r < IT_WO) { const int prow = 256 * (r / (D / 16)) + q4, k0 = (r % (D / 16)) * 16; f32x4 v[16];
            conv4_load(P.in[15] + (size_t)l * D * D + prow, D, k0, nullptr, 1.0f, v); conv4_store_bf16(v, (bf16_t*)(wl + OFF_WO) + (size_t)prow * D + k0, D); continue; }
        r -= IT_WO;
        if (r < IT_F1) { const int pn = r / (D / 16), k0 = (r % (D / 16)) * 16, prow = 256 * pn + q4, bj = (q4 >> 7) & 1, c = 128 * pn + (q4 & 127); f32x4 v[16];
            conv4_load(P.in[bj ? 18 : 17] + (size_t)l * D * FF + c, FF, k0, P.in[16] + (size_t)l * D, 1.0f, v); conv4_store_bf16(v, (bf16_t*)(wl + OFF_F1) + (size_t)prow * D + k0, D); continue; }
        r -= IT_F1;
        { const int prow = 256 * (r / (FF / 16)) + q4, k0 = (r % (FF / 16)) * 16; f32x4 v[16];
          conv4_load(P.in[19] + (size_t)l * FF * D + prow, D, k0, nullptr, 1.0f, v); conv4_store_bf16(v, (bf16_t*)(wl + OFF_F2) + (size_t)prow * FF + k0, FF); }
    }
    {
        bf16_t* rope = (bf16_t*)(ws + WS_ROPE); const int* pos = (const int*)P.in[1];
        for (int idx = gw * 64 + lane; idx < T * 32; idx += ngw * 64) { const int t = idx >> 5, i = idx & 31; float c, s; sincos_d((double)pos[t] * P.invf[i], c, s); rope[(size_t)t * 64 + i] = f2bf(c); rope[(size_t)t * 64 + 32 + i] = f2bf(s); }
    }
    {
        float* SS = (float*)(ws + WS_SS); bf16_t* XB = (bf16_t*)P.out;
        for (int m = gw; m < T; m += ngw) {
            const f32x4* xr = (const f32x4*)(P.in[0] + (size_t)m * D) + 4 * lane; float s2 = 0.f;
            f32x4 v[4];
#pragma unroll
            for (int j = 0; j < 4; ++j) { v[j] = xr[j]; s2 += (v[j][0] * v[j][0] + v[j][1] * v[j][1]) + (v[j][2] * v[j][2] + v[j][3] * v[j][3]); }
            u32x4* ob = (u32x4*)(XB + (size_t)(m / RPG) * XSH + (size_t)m * D) + 2 * lane;
            ob[0] = pg8::pack8(v[0], v[1]); ob[1] = pg8::pack8(v[2], v[3]);
            u32x4 w8;
            w8.x = cvt4_fp8(v[0][0] * XS8, v[0][1] * XS8, v[0][2] * XS8, v[0][3] * XS8); w8.y = cvt4_fp8(v[1][0] * XS8, v[1][1] * XS8, v[1][2] * XS8, v[1][3] * XS8);
            w8.z = cvt4_fp8(v[2][0] * XS8, v[2][1] * XS8, v[2][2] * XS8, v[2][3] * XS8); w8.w = cvt4_fp8(v[3][0] * XS8, v[3][1] * XS8, v[3][2] * XS8, v[3][3] * XS8);
            ((u32x4*)(ws + WS_XB8 + (size_t)m * D))[lane] = w8;
            s2 = wave_sum(s2);
            if (lane == 0) SS[m] = s2;
        }
        for (int idx = gw * 64 + lane; idx < 3 * T; idx += ngw * 64) SS[T + idx] = 0.f;
    }
}

constexpr int Q_GLA = 8, Q_MOBA = 128, Q_SWA = 128;

__global__ void __launch_bounds__(NWAVES * 64, 2) mk_fwd(Params P) {
    extern __shared__ __attribute__((aligned(16))) unsigned char lds_raw[];
    LAS unsigned char* lds = (LAS unsigned char*)lds_raw;
    volatile LAS unsigned* MISC = (volatile LAS unsigned*)(lds + MISC_OFF);
    const int tid = threadIdx.x, lane = tid & 63, wave = __builtin_amdgcn_readfirstlane(tid >> 6);
    const int G = gridDim.x, bx = blockIdx.x;
    const int vcu = (G % 8 == 0) ? (bx % 8) * (G / 8) + bx / 8 : bx;
    const int gw = vcu * NWAVES + wave, ngw = G * NWAVES;
    unsigned char* ws = P.ws;
    unsigned* ctl = (unsigned*)(ws + WS_CTL);
    for (int u = tid; u < 64; u += NWAVES * 64) MISC[u] = 0u;
    __syncthreads();
    XcdBarrier bar; bar.bar = ctl + CW_BAR; bar.x = 0; bar.st = nullptr;
    if (!MK_PER_PHASE) bar = xcd_barrier_post(ctl + CW_BAR, MISC + 8);
    if (!MK_PER_PHASE && tid == 0) (void)__hip_atomic_fetch_or(ctl + CW_GMASK + 64 * (bx & 7), 1u << xb_xcc_id(), __ATOMIC_RELAXED, __HIP_MEMORY_SCOPE_AGENT);
    const int lo = P.ph_lo, hi = P.ph_hi;
    int fastg = 0; unsigned gbn = 0u;
#define IN(k) (lo <= (k) && (k) < hi)
#define SEAM(k) do { if (IN(k) && IN((k) + 1)) xcd_barrier(bar); } while (0)
#define SEAMG(k) do { if (IN(k) && IN((k) + 1)) { if (fastg) { ++gbn; grp_barrier(ctl + CW_GRP + 64 * (bx & 7), gbn * (unsigned)(G / 8), ctl + CW_BAR); } else xcd_barrier(bar); } } while (0)

#define Hb ((bf16_t*)(ws + WS_H + (size_t)grp * SH_H))
#define PROJ ((bf16_t*)(ws + WS_PROJ))
#define XS ((bf16_t*)P.out + (size_t)grp * XSH)
#define GATES ((bf16_t*)(ws + WS_PROJ + (size_t)grp * SH_GATES))
#define MERGED ((bf16_t*)(ws + WS_PROJ + OFF_MERGED_IN_SLAB + (size_t)grp * SH_MERGED))
#define ACT ((bf16_t*)(ws + WS_PROJ + (size_t)grp * SH_ACT))
#define Yb ((bf16_t*)(ws + WS_Y))
#define rope ((bf16_t*)(ws + WS_ROPE))
#define kmp ((float*)(ws + WS_KM))
#define SS ((float*)(ws + WS_SS))

    #ifndef DBG_NO_PRO
    if (IN(1)) { prologue(P, gw, ngw, lane); }
#endif
    SEAM(1);
    if (!MK_PER_PHASE && IN(1) && IN(2)) {
        if (tid == 0) { unsigned ok = (G % 8 == 0) ? 1u : 0u;
            for (int j = 0; j < 8; ++j) { const unsigned m = xb_ld(ctl + CW_GMASK + 64 * j); ok &= (m != 0u && (m & (m - 1u)) == 0u) ? 1u : 0u; }
            MISC[20] = ok; }
        __syncthreads();
        fastg = __builtin_amdgcn_readfirstlane((int)MISC[20]);
#ifdef DBG_FORCE_GRID_BARRIERS
        fastg = 0;
#endif
    }
    for (int l = 0; l < DEPTH; ++l) {
        const int pb = 9 * l;
        unsigned char* ws = P.ws; asm volatile("" : "+s"(ws));
        int lane_l = lane; asm volatile("" : "+v"(lane_l));
        int bxl = blockIdx.x; asm volatile("" : "+s"(bxl));
        const int grp = bxl & 7;
        unsigned char* wl = ws + WS_W + (size_t)l * LW_BYTES;
        if (IN(2 + pb)) for (int rep = 0; rep < (DBG_DUP == 2 ? 2 : 1); ++rep) {
            if (rep) xcd_barrier(bar);
#ifndef DBG_NO_EPIINPROJ
            {
                pg8::Gemm g{(const bf16_t*)(ws + WS_XB8), (const bf16_t*)(wl + OFF_WIN8), D / 2, D / 2, D / 2, 0, 0, nullptr, nullptr, 0, 0, 0, 0, 0, 1 << 30};
                pg8::TileOrderSub S; S.init(T, 6 * 256, G, bxl, 1); S.mode = 1;
                pg8::EpiInProjT<FP8_LATE> E{PROJ, rope, P.in[4] + l * 64, P.in[5] + l * 64, P.in[7] + l * 64, P.in[8] + l * 64, P.in[10] + l * 256, kmp, SS + (size_t)(2 * l) * T, 1.0f / (XS8 * WS8)};
                pg8::gemm_phase<pg8::EpiInProjT<FP8_LATE>, false, pg8::TileOrderSub, true>(lds, g, S, E, 0); }
            {
                pg8::Gemm g{XS, (const bf16_t*)(wl + OFF_WIN), D, D, D, 0, 0, nullptr, nullptr, 0, 0, 0, 0, 0, 1 << 30};
                pg8::TileOrderSub S; S.init(T, 10 * 256, G, bxl, 1); S.mode = 2;
                pg8::EpiInProj E{PROJ, rope, P.in[4] + l * 64, P.in[5] + l * 64, P.in[7] + l * 64, P.in[8] + l * 64, P.in[10] + l * 256, kmp, SS + (size_t)(2 * l) * T, 1.0f};
                pg8::gemm_phase<pg8::EpiInProj, false, pg8::TileOrderSub, false>(lds, g, S, E, 0); }
#endif
        }
        SEAMG(2 + pb);
        if (IN(3 + pb)) {
            unsigned* qctr = ctl + CW_Q + 256 * (8 * l + grp);
            int it = 0;
            for (;; ++it) {
                if (tid == 0) MISC[16 + (it & 1)] = __hip_atomic_fetch_add(qctr, 1u, __ATOMIC_RELAXED, __HIP_MEMORY_SCOPE_AGENT);
                __syncthreads();
                const int id = (int)MISC[16 + (it & 1)];
                if (id >= Q_GLA) break;
                gla::gla_unit(PROJ, Yb, 2 * grp + (id >> 2), id & 3, P.in[11] + l * 128, lds);
            }
            ++it;
            for (;; ++it) {
                if (tid == 0) MISC[16 + (it & 1)] = __hip_atomic_fetch_add(qctr + 64, 1u, __ATOMIC_RELAXED, __HIP_MEMORY_SCOPE_AGENT);
                __syncthreads();
                const int m = (int)MISC[16 + (it & 1)];
                if (m >= Q_MOBA) break;
                att2::moba_unit<8>(2 * grp + ((m >> 3) & 1), m & 7, 7 - (m >> 4), PROJ, Yb, kmp, lds);
            }
            ++it;
            for (;; ++it) {
                if (tid == 0) MISC[16 + (it & 1)] = __hip_atomic_fetch_add(qctr + 128, 1u, __ATOMIC_RELAXED, __HIP_MEMORY_SCOPE_AGENT);
                __syncthreads();
                const int sidx = (int)MISC[16 + (it & 1)];
                if (sidx >= Q_SWA) break;
                att::attn_unit<0>(PROJ, Yb, 2 * grp + (sidx >> 6), (sidx >> 5) & 1, sidx & 31, P.in[6] + l * 8, nullptr, lds);
            }
        }
        SEAMG(3 + pb);
        if (IN(4 + pb)) for (int rep = 0; rep < ((DBG_DUP >= 18 && DBG_DUP <= 22) ? 2 : 1); ++rep) {
            if (rep) xcd_barrier(bar);
            pg8::TileOrder S0; S0.init(T, D, G, bxl, 1);
            for (int ti = 0;; ++ti) {
                pg8::Unit u0; if (!S0.next(ti, u0)) break;
                if (!((DBG_DUP == 21 || DBG_DUP == 22) && rep == 0))
                { pg8::Gemm g{(const bf16_t*)(ws + WS_XB8), (const bf16_t*)(wl + OFF_WG), D / 2, D / 2, D / 2, 0, 0, nullptr, nullptr, 0, 0, 0, 0, 0, 1 << 30}; pg8::GateTriple S{u0.pm, u0.pn};
                  pg8::EpiGatesT<false> E{GATES, ((DBG_DUP == 19 || DBG_DUP == 20) && rep == 0) ? 1 : 0, SS + (size_t)(2 * l) * T, 0, 1.0f / (XS8 * WS8)};
                  pg8::gemm_phase<pg8::EpiGatesT<false>, false, pg8::GateTriple, true>(lds, g, S, E, 0); }
                if (!(DBG_DUP == 20 && rep == 0))
                { pg8::Gemm g{Yb, (const bf16_t*)(wl + OFF_WB), 512, YW, 512, 512, (long)D * 512, nullptr, nullptr, 0, 0, 0, 0, 0, 1 << 30}; pg8::SubTriple S{u0.pm, u0.pn};
                  pg8::EpiMerge E{GATES, MERGED, (DBG_DUP == 22 && rep == 0) ? 1 : 0};
                  pg8::gemm_phase<pg8::EpiMerge, false, pg8::SubTriple>(lds, g, S, E, 0); }
            }
        }
        SEAMG(4 + pb);
        if (IN(6 + pb)) for (int rep = 0; rep < ((DBG_DUP == 13 && l == 0) ? 2 : 1); ++rep) {
            if (rep) xcd_barrier(bar);
            pg8::Gemm g{MERGED, (const bf16_t*)(wl + OFF_WO), D, D, D, 0, 0, nullptr, nullptr, 0, 0, 0, 0, 0, 1 << 30}; pg8::TileOrder S; S.init(T, D, G, bxl, 1);
            pg8::EpiResid E{XS, nullptr, Hb, SS + (size_t)(2 * l + 1) * T, nullptr};
#ifndef DBG_NO_RESID
            pg8::gemm_phase<pg8::EpiResid>(lds, g, S, E, ((bxl >> 3) & 3) * STG_F);
#endif
        }
        SEAMG(6 + pb);
        if (DBG_DUP == 5) { for (int rep = 0; rep < 8; ++rep) xcd_barrier(bar); }
        if (IN(8 + pb)) for (int rep = 0; rep < ((DBG_DUP == 6 || DBG_DUP == 14 || DBG_DUP == 15 || DBG_DUP == 16) ? 2 : 1); ++rep) {
            if (DBG_DUP == 15 && rep == 0 && grp != 0) continue;
            if (rep && DBG_DUP == 15) { if (grp == 0) { ++gbn; grp_barrier(ctl + CW_GRP + 64 * (bx & 7), gbn * (unsigned)(G / 8), ctl + CW_BAR); } }
            else if (rep) xcd_barrier(bar);
            pg8::Gemm g{Hb, (const bf16_t*)(wl + OFF_F1), D, D, D, 0, 0, nullptr, nullptr, 0, 0, 0, 0, 0, 1 << 30}; pg8::TileOrder S; S.init(T, FFP, G, bxl, 1);
            pg8::EpiFfn1 E{ACT, SS + (size_t)(2 * l + 1) * T, ((DBG_DUP == 14 || DBG_DUP == 15 || DBG_DUP == 16) && rep == 0) ? 1 : 0};
#if DBG_DUP == 16
            if (rep == 0) { pg8::TileOrderFix SF; SF.init(T, FFP, G, bxl, 1); pg8::gemm_phase<pg8::EpiFfn1, false, pg8::TileOrderFix>(lds, g, SF, E, 0); continue; }
#endif
#if DBG_DUP == 17
            unsigned long long c0_ = 0, r0_ = 0; if (l == 0) { c0_ = __builtin_readcyclecounter(); r0_ = __builtin_amdgcn_s_memrealtime(); }
#endif
#ifndef DBG_NO_EPIFFN1
            pg8::gemm_phase<pg8::EpiFfn1>(lds, g, S, E, ((bxl >> 3) & 3) * STG_B);
#endif
#if DBG_DUP == 17
            if (l == 0 && tid == 0) { const unsigned long long c1_ = __builtin_readcyclecounter(), r1_ = __builtin_amdgcn_s_memrealtime(); MISC[24] = (unsigned)(((c1_ - c0_) * 2000ull) / (r1_ - r0_)); }
#endif
        }
        SEAMG(8 + pb);
        if (IN(9 + pb)) {
            pg8::Gemm g{ACT, (const bf16_t*)(wl + OFF_F2), FF, FF, FF, 0, 0, nullptr, nullptr, 0, 0, 0, 0, 0, 1 << 30}; pg8::TileOrder S; S.init(T, D, G, bxl, 1);
            pg8::EpiResid E{(const bf16_t*)Hb, (l + 1 < DEPTH) ? nullptr : P.out, (l + 1 < DEPTH) ? XS : nullptr, (l + 1 < DEPTH) ? SS + (size_t)(2 * l + 2) * T : nullptr, (l + 1 < DEPTH) ? ws + WS_XB8 : nullptr};
#ifndef DBG_NO_RESID
            pg8::gemm_phase<pg8::EpiResid>(lds, g, S, E, ((bxl >> 3) & 3) * STG_F);
#endif
        }
        SEAMG(9 + pb);
    }
#if DBG_DUP == 17
    if (bx == 0) { __syncthreads(); if (tid == 0) { const unsigned long long e_ = __builtin_amdgcn_s_memrealtime() + (unsigned long long)MISC[24]; while (__builtin_amdgcn_s_memrealtime() < e_) __builtin_amdgcn_s_sleep(8); } __syncthreads(); }
#endif
#undef IN
#undef SEAM
#undef SEAMG
#undef Hb
#undef PROJ
#undef XS
#undef GATES
#undef MERGED
#undef ACT
#undef Yb
#undef rope
#undef kmp
#undef SS
}

extern "C" void kernel_launch(void* const* d_in, const int* in_sizes, int n_in, void* d_out, int out_size, void* d_ws, size_t ws_size, hipStream_t stream) {
    static int grid = 0;
    if (grid == 0) {
        if (n_in != 20 || out_size != T * D || ws_size < WS_END) { fprintf(stderr, "kernel_launch: unexpected problem (n_in %d, out %d, ws %zu < %zu)\n", n_in, out_size, ws_size, (size_t)WS_END); grid = -1; return; }
        int dev = 0, cus = 0;
        if (hipGetDevice(&dev) != hipSuccess || hipDeviceGetAttribute(&cus, hipDeviceAttributeMultiprocessorCount, dev) != hipSuccess) { grid = -1; return; }
        if (hipFuncSetAttribute((const void*)mk_fwd, hipFuncAttributeMaxDynamicSharedMemorySize, LDS_BYTES) != hipSuccess) { fprintf(stderr, "kernel_launch: hipFuncSetAttribute failed\n"); grid = -1; return; }
        int per_cu = 0;
        if (hipOccupancyMaxActiveBlocksPerMultiprocessor(&per_cu, (const void*)mk_fwd, NWAVES * 64, LDS_BYTES) != hipSuccess || per_cu < 1) fprintf(stderr, "kernel_launch: occupancy query says %d\n", per_cu);
        (void)hipGetLastError();
        grid = (cus / 8) * 8;
    }
    if (grid < 0) return;
    (void)hipMemsetAsync((char*)d_ws + WS_CTL, 0, CTL_ZERO_BYTES, stream);
    Params p{};
    for (int i = 0; i < 20; ++i) p.in[i] = (const float*)d_in[i];
    p.out = (float*)d_out; p.ws = (unsigned char*)d_ws;
    for (int i = 0; i < 32; ++i) p.invf[i] = std::pow(10000.0, -(double)i / 32.0);
#if MK_PER_PHASE
    for (int k = 1; k <= 18; ++k) { p.ph_lo = k; p.ph_hi = k + 1; hipLaunchKernelGGL(mk_fwd, dim3(grid), dim3(NWAVES * 64), LDS_BYTES, stream, p); }
#else
    p.ph_lo = 1; p.ph_hi = 19;
    hipLaunchKernelGGL(mk_fwd, dim3(grid), dim3(NWAVES * 64), LDS_BYTES, stream, p);
#endif
}
```

```cpp
#include <hip/hip_runtime.h>
#include <cstdint>
#include <cstdio>
#include <cmath>

#ifndef MK_PER_PHASE
#define MK_PER_PHASE 0
#endif

#ifndef DBG_DUP
#define DBG_DUP 0
#endif
#ifndef STG_B
#define STG_B 0
#endif
#ifndef FP8_LATE
#define FP8_LATE false
#endif
#ifndef STG_F
#define STG_F 0
#endif
#define GAS __attribute__((address_space(1)))
#define LAS __attribute__((address_space(3)))
typedef unsigned short bf16_t;
typedef short bf16x8 __attribute__((ext_vector_type(8)));
typedef short s16x4 __attribute__((ext_vector_type(4)));
typedef short v4i16_t __attribute__((ext_vector_type(4)));
typedef float f32x2 __attribute__((ext_vector_type(2)));
typedef float f32x4 __attribute__((ext_vector_type(4)));
typedef float f32x16 __attribute__((ext_vector_type(16)));
typedef unsigned u32x2 __attribute__((ext_vector_type(2)));
typedef unsigned u32x4 __attribute__((ext_vector_type(4)));
typedef __bf16 bf16x2_t __attribute__((ext_vector_type(2)));
typedef int v8i_t __attribute__((ext_vector_type(8)));

constexpr int T = 32768, SEQ = 2048, NBATCH = 16, D = 1024, DEPTH = 2;
constexpr int PP = 4096 + 64;
constexpr int PW = 4096;
constexpr int GW = 3072;
constexpr int YW = 1536;
constexpr int FF = 2816, FFP = 5632;
constexpr int DIN = 6928;
constexpr float EPS = 1e-6f;
constexpr float LOG2E = 1.4426950408889634f;
constexpr float C2 = 0.125f * LOG2E;

constexpr size_t MiB = 1u << 20;
constexpr size_t WS_CTL = 0, CTL_ZERO_BYTES = 128 * 1024;
constexpr size_t OFF_WIN = 0, OFF_WG = OFF_WIN + (size_t)PW * D * 2  , OFF_WB = OFF_WG + (size_t)GW * D, OFF_WO = OFF_WB + (size_t)3 * D * 512 * 2,
                 OFF_F1 = OFF_WO + (size_t)D * D * 2, OFF_F2 = OFF_F1 + (size_t)FFP * D * 2, OFF_WIN8 = OFF_F2 + (size_t)D * FF * 2  , LW_BYTES = OFF_WIN8 + (size_t)PW * D;
constexpr size_t WS_W = 1 * MiB;
constexpr size_t WS_ROPE = WS_W + 2 * LW_BYTES;
constexpr size_t WS_KM = WS_ROPE + (size_t)T * 64 * 4;
constexpr size_t WS_SS = WS_KM + 512 * 1024;
constexpr size_t WS_H = WS_KM + 1 * MiB;
constexpr size_t WS_PROJ = WS_H + (size_t)T * YW * 2;
constexpr size_t WS_MERGED = WS_PROJ + (size_t)T * GW * 2;
constexpr size_t WS_Y = WS_H;
constexpr size_t WS_XB8 = WS_PROJ + (size_t)T * PP * 2;
constexpr size_t WS_END = WS_XB8 + (size_t)T * D;
static_assert(WS_ROPE % 256 == 0 && WS_END <= 512 * MiB, "workspace map");
constexpr int CW_TMO = 0, CW_BAR = 4096, CW_Q = 16384;
constexpr int CW_GRP = 8192, CW_GMASK = 9216;
constexpr int RPG = T / 8;
constexpr size_t SLAB = (size_t)RPG * PP * 2;
constexpr size_t SH_H = (size_t)RPG * (YW - D) * 2, SH_GATES = SLAB - (size_t)RPG * GW, SH_MERGED = SLAB - (size_t)RPG * D * 2, SH_ACT = SLAB - (size_t)RPG * FF * 2;
constexpr size_t OFF_MERGED_IN_SLAB = (size_t)RPG * GW;
constexpr size_t XSH = (size_t)RPG * D;
static_assert(OFF_MERGED_IN_SLAB + (size_t)RPG * D * 2 <= SLAB && (size_t)RPG * FF * 2 <= SLAB, "group slabs");

__device__ __forceinline__ unsigned cvt_pk_bf16(float lo, float hi) { f32x2 v = {lo, hi}; bf16x2_t b = __builtin_convertvector(v, bf16x2_t); return __builtin_bit_cast(unsigned, b); }
__device__ __forceinline__ float bf_lo(unsigned w) { return __uint_as_float(w << 16); }
__device__ __forceinline__ float bf_hi(unsigned w) { return __uint_as_float(w & 0xffff0000u); }
__device__ __forceinline__ float bf1(bf16_t x) { return __uint_as_float(((unsigned)x) << 16); }
__device__ __forceinline__ bf16_t f2bf(float f) { return (bf16_t)(cvt_pk_bf16(f, 0.f) & 0xffffu); }
__device__ __forceinline__ unsigned cvt4_fp8(float a, float b, float c, float d) { unsigned w = 0; w = __builtin_amdgcn_cvt_pk_fp8_f32(a, b, w, false); w = __builtin_amdgcn_cvt_pk_fp8_f32(c, d, w, true); return w; }
constexpr float XS8 = 16.0f, WS8 = 64.0f;
__device__ __forceinline__ float fexp2(float x) { return __builtin_amdgcn_exp2f(x); }
__device__ __forceinline__ float fexp(float x) { return __builtin_amdgcn_exp2f(x * LOG2E); }
__device__ __forceinline__ float frcp(float x) { return __builtin_amdgcn_rcpf(x); }
__device__ __forceinline__ float frsq(float x) { return __builtin_amdgcn_rsqf(x); }
__device__ __forceinline__ float sigmoidf_(float x) { return frcp(1.f + fexp(-x)); }
template <int CTRL> __device__ __forceinline__ float dpp_f(float v) { return __builtin_bit_cast(float, __builtin_amdgcn_update_dpp(0, __builtin_bit_cast(int, v), CTRL, 0xf, 0xf, true)); }
__device__ __forceinline__ float sum16(float v) { v += dpp_f<0xB1>(v); v += dpp_f<0x4E>(v); v += dpp_f<0x141>(v); v += dpp_f<0x140>(v); return v; }
__device__ __forceinline__ float addx16(float v) { auto r = __builtin_amdgcn_permlane16_swap(__float_as_uint(v), __float_as_uint(v), false, false); return __uint_as_float(r[0]) + __uint_as_float(r[1]); }
__device__ __forceinline__ float addx32(float v) { auto r = __builtin_amdgcn_permlane32_swap(__float_as_uint(v), __float_as_uint(v), false, false); return __uint_as_float(r[0]) + __uint_as_float(r[1]); }
__device__ __forceinline__ float maxx32(float v) { auto r = __builtin_amdgcn_permlane32_swap(__float_as_uint(v), __float_as_uint(v), false, false); return fmaxf(__uint_as_float(r[0]), __uint_as_float(r[1])); }
__device__ __forceinline__ float wave_sum(float v) { return addx32(addx16(sum16(v))); }
#define LDS_WAIT() asm volatile("s_waitcnt lgkmcnt(0)" ::: "memory")
#define VM_WAIT() asm volatile("s_waitcnt vmcnt(0)" ::: "memory")

#define XB_TMO      128
#define XB_XCNT(j)  (256  + 64 * (j))
#define XB_XSUB(j)  (1280 + 64 * (j))
#define XB_XGEN(j)  (2304 + 64 * (j))
#define XB_TOP      3328
#define XB_TOPGEN   3392
#define XCD_BAR_WORDS 3456
#define XB_SPIN_CAP (1u << 18)
__device__ __forceinline__ unsigned xb_ld(unsigned* p)              { return __hip_atomic_load(p, __ATOMIC_RELAXED, __HIP_MEMORY_SCOPE_AGENT); }
__device__ __forceinline__ unsigned xb_add(unsigned* p, unsigned v) { return __hip_atomic_fetch_add(p, v, __ATOMIC_RELAXED, __HIP_MEMORY_SCOPE_AGENT); }
__device__ __forceinline__ unsigned xb_xcc_id() { return (unsigned)__builtin_amdgcn_s_getreg((3 << 11) | 20) & 0xFu; }
#define XB_SPIN(cond, bar) do { unsigned _sp = 0; while (cond) { __builtin_amdgcn_s_sleep(1); \
    if ((++_sp & 255u) == 0u) { if (xb_ld(&(bar)[XB_TMO])) break; if (_sp > XB_SPIN_CAP) { atomicAdd(&(bar)[XB_TMO], 1u); break; } } } } while (0)
struct XcdBarrier { unsigned* bar; unsigned x; volatile LAS unsigned* st; };
__device__ __forceinline__ XcdBarrier xcd_barrier_post(unsigned* bar, volatile LAS unsigned* st) {
    XcdBarrier b; b.bar = bar; b.x = xb_xcc_id(); b.st = st;
    if (threadIdx.x == 0) (void)xb_add(&bar[XB_XCNT(b.x)], 1u);
    return b;
}
__device__ __forceinline__ void xcd_barrier_complete(unsigned* bar, unsigned x, unsigned& nloc, unsigned& nx) {
    const unsigned G = gridDim.x * gridDim.y * gridDim.z;
    unsigned sum, cnt, mine, sp = 0u;
    for (;;) {
        sum = 0u; cnt = 0u; mine = 0u;
#pragma unroll
        for (unsigned j = 0; j < 16; ++j) { const unsigned c = xb_ld(&bar[XB_XCNT(j)]); sum += c; cnt += (c > 0u) ? 1u : 0u; mine = (j == x) ? c : mine; }
        if (sum == G) break;
        __builtin_amdgcn_s_sleep(1);
        if ((++sp & 255u) == 0u) { if (xb_ld(&bar[XB_TMO])) break; if (sp > XB_SPIN_CAP) { atomicAdd(&bar[XB_TMO], 1u); break; } }
    }
    nloc = mine > 0u ? mine : 1u; nx = cnt > 0u ? cnt : 1u;
}
__device__ __forceinline__ void xcd_barrier(const XcdBarrier& b) {
    asm volatile("s_waitcnt vmcnt(0)" ::: "memory");
    __syncthreads();
    if (threadIdx.x == 0) {
        unsigned* bar = b.bar;
        __builtin_amdgcn_s_waitcnt(0);
        unsigned nloc = b.st[0], nx = b.st[1];
        if (nloc == 0u) { xcd_barrier_complete(bar, b.x, nloc, nx); b.st[0] = nloc; b.st[1] = nx; }
        const unsigned old = xb_add(&bar[XB_XSUB(b.x)], 1u);
        const unsigned gen = old / nloc;
        if (old + 1u == (gen + 1u) * nloc) {
            __builtin_amdgcn_fence(__ATOMIC_RELEASE, "agent");
            asm volatile("s_waitcnt vmcnt(0)" ::: "memory");
            const unsigned og = xb_add(&bar[XB_TOP], 1u);
            const unsigned tg = og / nx;
            if (og + 1u == (tg + 1u) * nx) xb_add(&bar[XB_TOPGEN], 1u);
            else XB_SPIN(xb_ld(&bar[XB_TOPGEN]) == tg, bar);
            __builtin_amdgcn_fence(__ATOMIC_ACQUIRE, "agent");
            xb_add(&bar[XB_XGEN(b.x)], 1u);
            asm volatile("s_waitcnt vmcnt(0)" ::: "memory");
        } else {
            XB_SPIN(xb_ld(&bar[XB_XGEN(b.x)]) == gen, bar);
            __builtin_amdgcn_fence(__ATOMIC_ACQUIRE, "agent");
            asm volatile("s_waitcnt vmcnt(0)" ::: "memory");
        }
    }
    __syncthreads();
}

__device__ __forceinline__ void grp_barrier(unsigned* gword, unsigned target, unsigned* bar) {
    asm volatile("s_waitcnt vmcnt(0)" ::: "memory");
    __syncthreads();
    if (threadIdx.x == 0) {
        __builtin_amdgcn_s_waitcnt(0);
        (void)xb_add(gword, 1u);
        __builtin_amdgcn_fence(__ATOMIC_ACQUIRE, "agent");
        XB_SPIN(xb_ld(gword) < target, bar);
        asm volatile("s_waitcnt vmcnt(0)" ::: "memory");
    }
    __syncthreads();
}

namespace pg8 {
constexpr int BM = 256, BK = 64, HALF = 128, HTB = HALF * BK * 2, STAGE_BYTES = 8 * HTB, NXCD = 8, WGM = 8;
__host__ __device__ __forceinline__ int lds_byte(int r, int c) { const int st = (r >> 4) * 2 + (c >> 5), rr = r & 15, cc = c & 31, ob = rr * 64 + cc * 2; return st * 1024 + (ob ^ (((ob >> 9) & 1) << 5)); }
__host__ __device__ __forceinline__ void stage_rc(int b, int& R, int& C) { const int st = b / 1024, sb = b % 1024, swz = sb ^ (((sb >> 9) & 1) << 5); R = (st >> 1) * 16 + swz / 64; C = (st & 1) * 32 + (swz % 64) / 2; }
__host__ __device__ __forceinline__ int perm32(int rho) { const int n = rho >> 4, i = rho & 15; return 8 * (i >> 2) + 4 * n + (i & 3); }

struct Unit { int pm, pn, sub; };
struct Gemm { const bf16_t* A; const bf16_t* Bt; int K, lda, ldb; long a_sub, b_sub;
              const bf16_t* A1; const bf16_t* Bt1; int K1, lda1, ldb1; long a_sub1, b_sub1; int sub1; };

struct TileOrder {
    int nM, nN, nwg, G, c, nsub;
    __device__ __forceinline__ void init(int M, int N, int G_, int c_, int nsub_) { nM = M / BM; nN = N / BM; nwg = nM * nN; G = G_; c = c_; nsub = nsub_; }
    __device__ __forceinline__ bool next(int i, Unit& u) const {
        const int ti = i / nsub; u.sub = i - ti * nsub;
        const long L = (long)ti * G + c; if (L >= nwg) return false;
        int wgid = (int)L; { const int q = nwg / NXCD, r = nwg % NXCD, xcd = wgid % NXCD, off = wgid / NXCD; wgid = (xcd < r ? xcd * (q + 1) : r * (q + 1) + (xcd - r) * q) + off; }
        const int nig = WGM * nN, gid = wgid / nig, fm = gid * WGM, gsz = (nM - fm) < WGM ? (nM - fm) : WGM;
        u.pm = fm + ((wgid % nig) % gsz); u.pn = (wgid % nig) / gsz; return true;
    }
};

struct TileOrderBal : TileOrder {
    __device__ __forceinline__ bool next(int i, Unit& u) const { if (!TileOrder::next(i, u)) return false;
        const unsigned long long tab = 0xCBA8FD97E2654310ull;
        u.pn = (int)((tab >> (4 * u.pn)) & 15ull); return true; } };
struct TileOrderFix : TileOrder { __device__ __forceinline__ bool next(int i, Unit& u) const { if (!TileOrder::next(i, u)) return false; u.pm &= 1; u.pn &= 1; return true; } };
struct TileOrderSub : TileOrder { int mode;
    __device__ __forceinline__ bool next(int i, Unit& u) const { if (!TileOrder::next(i, u)) return false; u.pn = (mode == 1) ? u.pn + (u.pn >= 2 ? 1 : 0) : (u.pn == 0 ? 2 : u.pn + 6); return true; } };
struct GateTriple { int pm, pn; __device__ __forceinline__ bool next(int i, Unit& u) const { if (i >= 3) return false; u.pm = pm; u.pn = 4 * i + pn; u.sub = 0; return true; } };
struct SubTriple { int pm, pn; __device__ __forceinline__ bool next(int i, Unit& u) const { if (i >= 3) return false; u.pm = pm; u.pn = pn; u.sub = i; return true; } };

typedef f32x4 Acc[2][2][4][2];

template <class Epi, bool DUAL = false, class Sched = TileOrder, bool F8 = false>
__device__ __forceinline__ void gemm_phase(LAS unsigned char* lds, const Gemm g, const Sched& S, const Epi& E, int stagger = 0) {
    for (int i_ = 0; i_ < stagger; ++i_) __builtin_amdgcn_s_sleep(32);
    int tid_ = threadIdx.x; asm volatile("" : "+v"(tid_));
    const int tid = tid_, wid = __builtin_amdgcn_readfirstlane(tid >> 6), lane = tid & 63, wr = wid >> 2, wc = wid & 3, fr = lane & 15, fq = lane >> 4;
    const size_t kstep = (size_t)(BK * 2);
    const unsigned ldsw = (unsigned)wid * 1024u;
    const int aoff = F8 ? lds_byte(wr * 64 + fr, fq * 16) : lds_byte(wr * 64 + fr, fq * 8), boff = F8 ? lds_byte(wc * 32 + fr, fq * 16) : lds_byte(wc * 32 + fr, fq * 8);
#define PG8_SA(b, h) (((b) * 2 + (h)) * HTB)
#define PG8_SB(b, h) ((4 + (b) * 2 + (h)) * HTB)
#define PG8_STAGE(bufoff, gbase, voff, hs) do { _Pragma("unroll") for (int _i = 0; _i < 2; ++_i) \
        __builtin_amdgcn_global_load_lds((const unsigned*)((const char*)(gbase) + (size_t)_i * (hs) + (voff)), (LAS unsigned*)(lds + (bufoff) + ldsw + _i * 8192), 16, 0, 0); } while (0)
#define PG8_LD32(p) __builtin_bit_cast(v8i_t, __builtin_shufflevector(*(const LAS bf16x8*)(p), *(const LAS bf16x8*)((p) + 16), 0, 1, 2, 3, 4, 5, 6, 7, 8, 9, 10, 11, 12, 13, 14, 15))
#define PG8_LDA(dst, b, h) do { if constexpr (F8) { _Pragma("unroll") for (int m = 0; m < 4; ++m) dst##8[m] = PG8_LD32(lds + PG8_SA(b, h) + aoff + m * 2048); } \
        else { _Pragma("unroll") for (int m = 0; m < 4; ++m) _Pragma("unroll") for (int k = 0; k < 2; ++k) dst[m][k] = *(const LAS bf16x8*)(lds + PG8_SA(b, h) + aoff + m * 2048 + k * 1024); } } while (0)
#define PG8_LDB(dst, b, h) do { if constexpr (F8) { _Pragma("unroll") for (int n = 0; n < 2; ++n) dst##8[n] = PG8_LD32(lds + PG8_SB(b, h) + boff + n * 2048); } \
        else { _Pragma("unroll") for (int n = 0; n < 2; ++n) _Pragma("unroll") for (int k = 0; k < 2; ++k) dst[n][k] = *(const LAS bf16x8*)(lds + PG8_SB(b, h) + boff + n * 2048 + k * 1024); } } while (0)
#define PG8_MMA(ai, bj, At, Bt) do { __builtin_amdgcn_s_setprio(1); _Pragma("unroll") for (int m = 0; m < 4; ++m) _Pragma("unroll") for (int n = 0; n < 2; ++n) { \
        if constexpr (F8) asm volatile("v_mfma_scale_f32_16x16x128_f8f6f4 %0, %1, %2, %0, %3, %3 op_sel_hi:[0,0,0]" : "+v"(acc[ai][bj][m][n]) : "v"(Bt##8[n]), "v"(At##8[m]), "v"(sc8));   \
        else { _Pragma("unroll") for (int k = 0; k < 2; ++k) acc[ai][bj][m][n] = __builtin_amdgcn_mfma_f32_16x16x32_bf16(Bt[n][k], At[m][k], acc[ai][bj][m][n], 0, 0, 0); } } \
        __builtin_amdgcn_s_setprio(0); } while (0)
#define PG8_WAIT_V(n) asm volatile("s_waitcnt vmcnt(" #n ")" ::: "memory")
#define PG8_WAIT_L(n) asm volatile("s_waitcnt lgkmcnt(" #n ")" ::: "memory")
#define PG8_WAIT_VX(flag) do { if constexpr (Epi::NST == 8) asm volatile("s_cmp_eq_u32 %0, 0\n\ts_cbranch_scc1 1f\n\ts_waitcnt vmcnt(16)\n\ts_branch 2f\n1:\n\ts_waitcnt vmcnt(8)\n2:" :: "s"(flag) : "memory", "scc"); \
        else if constexpr (Epi::NST == 16) asm volatile("s_cmp_eq_u32 %0, 0\n\ts_cbranch_scc1 1f\n\ts_waitcnt vmcnt(24)\n\ts_branch 2f\n1:\n\ts_waitcnt vmcnt(8)\n2:" :: "s"(flag) : "memory", "scc"); \
        else if constexpr (Epi::NST == 32) asm volatile("s_cmp_eq_u32 %0, 0\n\ts_cbranch_scc1 1f\n\ts_waitcnt vmcnt(40)\n\ts_branch 2f\n1:\n\ts_waitcnt vmcnt(8)\n2:" :: "s"(flag) : "memory", "scc"); \
        else asm volatile("s_waitcnt vmcnt(8)" ::: "memory"); } while (0)
#define PG8_BAR __builtin_amdgcn_s_barrier()
#define PG8_SCHED __builtin_amdgcn_sched_barrier(0)
#define PG8_KIND(u) (DUAL && (u).sub >= g.sub1)
#define PG8_ABASE(u) (PG8_KIND(u) ? (const char*)g.A1 + ((size_t)(u).pm * BM * g.lda1 + (size_t)((u).sub - g.sub1) * g.a_sub1) * 2 : (const char*)g.A + ((size_t)(u).pm * BM * g.lda + (size_t)(u).sub * g.a_sub) * 2)
#define PG8_BBASE(u) (PG8_KIND(u) ? (const char*)g.Bt1 + ((size_t)(u).pn * BM * g.ldb1 + (size_t)((u).sub - g.sub1) * g.b_sub1) * 2 : (const char*)g.Bt + ((size_t)(u).pn * BM * g.ldb + (size_t)(u).sub * g.b_sub) * 2)
#define PG8_VOFF(kd, vA, vB) do { const bool k_ = (kd); const int la_ = k_ ? g.lda1 : g.lda, lb_ = k_ ? g.ldb1 : g.ldb; \
        vA = (unsigned)(sR * la_ + sC) * 2u; vB = (unsigned)(sRb * lb_ + sC) * 2u; } while (0)
#define PG8_SETCFG(kd, hA, hB, ntv) do { const bool k_ = (kd); hA = (size_t)HALF * (k_ ? g.lda1 : g.lda) * 2; hB = (size_t)HALF * (k_ ? g.ldb1 : g.ldb) * 2; ntv = (k_ ? g.K1 : g.K) / BK; } while (0)
    Unit cur, nxt; int ui = 0;
    if (!S.next(0, cur)) return;
    Acc acc;
#pragma unroll
    for (int a = 0; a < 2; ++a)
#pragma unroll
        for (int b = 0; b < 2; ++b)
#pragma unroll
            for (int m = 0; m < 4; ++m)
#pragma unroll
                for (int n = 0; n < 2; ++n) acc[a][b][m][n] = (f32x4){0.f, 0.f, 0.f, 0.f};
    bf16x8 At[4][2], B0[2][2], B1[2][2];
    v8i_t At8[4], B08[2], B18[2];
    const int sc8 = 0x7f7f7f7f;
    float pre[8];
#pragma unroll
    for (int i = 0; i < 8; ++i) pre[i] = 0.f;
    const char* cA = PG8_ABASE(cur); const char* cB = PG8_BBASE(cur);
    int sR, sC; stage_rc(tid * 16, sR, sC); const int sRb = Epi::PERM ? ((sR & ~31) + perm32(sR & 31)) : sR;
    unsigned voffA, voffB; size_t hstepA, hstepB, xhA, xhB; int nt, xnt; bool xkind;
    PG8_VOFF(PG8_KIND(cur), voffA, voffB); PG8_SETCFG(PG8_KIND(cur), hstepA, hstepB, nt);
    PG8_STAGE(PG8_SB(0, 0), cB, voffB, hstepB >> 1); PG8_STAGE(PG8_SB(0, 1), cB + hstepB, voffB, hstepB >> 1); PG8_STAGE(PG8_SA(0, 0), cA, voffA, hstepA >> 1); PG8_STAGE(PG8_SA(0, 1), cA + hstepA, voffA, hstepA >> 1);
    if (wr == 1) PG8_BAR;
    PG8_WAIT_V(2); PG8_BAR;
    PG8_STAGE(PG8_SB(1, 0), cB + kstep, voffB, hstepB >> 1); PG8_STAGE(PG8_SA(1, 0), cA + kstep, voffA, hstepA >> 1); PG8_STAGE(PG8_SB(1, 1), cB + hstepB + kstep, voffB, hstepB >> 1);
    PG8_WAIT_V(6); PG8_BAR;
    for (;;) {
        const bool has_next = S.next(ui + 1, nxt);
        const char* nA = has_next ? PG8_ABASE(nxt) : cA; const char* nB = has_next ? PG8_BBASE(nxt) : cB;
        xkind = has_next ? PG8_KIND(nxt) : PG8_KIND(cur); PG8_SETCFG(xkind, xhA, xhB, xnt);
        for (int t = 0; t < nt; t += 2) {
            const bool last = (t == nt - 2);
            const char* a1 = cA + (size_t)(t + 1) * kstep;
            const char* a2 = last ? nA : cA + (size_t)(t + 2) * kstep; const char* b2 = last ? nB : cB + (size_t)(t + 2) * kstep;
            const char* a3 = a2 + kstep; const char* b3 = b2 + kstep;
            unsigned vA2 = voffA, vB2 = voffB;
            if (DUAL && last) PG8_VOFF(xkind, vA2, vB2);
            const size_t hA2 = last ? xhA : hstepA, hB2 = last ? xhB : hstepB;
            if (last) E.prefetch(cur, pre);
            const int rxi = __builtin_amdgcn_readfirstlane(((Epi::NST > 0) && (t == 0) && (ui > 0)) ? 1 : 0);
            PG8_LDB(B0, 0, 0); PG8_LDB(B1, 0, 1); PG8_SCHED; PG8_LDA(At, 0, 0); PG8_STAGE(PG8_SA(1, 1), a1 + hstepA, voffA, hstepA >> 1);
            PG8_WAIT_VX(rxi);
            PG8_WAIT_L(0); PG8_BAR; PG8_MMA(0, 0, At, B0); PG8_MMA(0, 1, At, B1); PG8_BAR; PG8_SCHED;
            PG8_LDA(At, 0, 1); PG8_STAGE(PG8_SB(0, 0), b2, vB2, hB2 >> 1); PG8_STAGE(PG8_SB(0, 1), b2 + hB2, vB2, hB2 >> 1); PG8_STAGE(PG8_SA(0, 0), a2, vA2, hA2 >> 1);
            PG8_WAIT_VX(rxi);
            PG8_WAIT_L(0); PG8_BAR; PG8_MMA(1, 0, At, B0); PG8_MMA(1, 1, At, B1); PG8_BAR; PG8_SCHED;
            PG8_LDB(B0, 1, 0); PG8_LDB(B1, 1, 1); PG8_SCHED; PG8_LDA(At, 1, 0); PG8_STAGE(PG8_SA(0, 1), a2 + hA2, vA2, hA2 >> 1);
            PG8_WAIT_V(8); PG8_WAIT_L(0); PG8_BAR; PG8_MMA(0, 0, At, B0); PG8_MMA(0, 1, At, B1); PG8_BAR; PG8_SCHED;
            PG8_LDA(At, 1, 1); PG8_STAGE(PG8_SB(1, 0), b3, vB2, hB2 >> 1); PG8_STAGE(PG8_SB(1, 1), b3 + hB2, vB2, hB2 >> 1); PG8_STAGE(PG8_SA(1, 0), a3, vA2, hA2 >> 1);
            PG8_WAIT_V(8); PG8_WAIT_L(0); PG8_BAR; PG8_MMA(1, 0, At, B0); PG8_MMA(1, 1, At, B1); PG8_BAR; PG8_SCHED;
        }
        if (wr == 0) PG8_BAR;
        if constexpr (F8) asm volatile("s_nop 15\n\ts_nop 7" ::: "memory");
        const bool keep = E(acc, cur, pre);
        if (!has_next) break;
        if (!keep) {
#pragma unroll
            for (int a = 0; a < 2; ++a)
#pragma unroll
                for (int b = 0; b < 2; ++b)
#pragma unroll
                    for (int m = 0; m < 4; ++m)
#pragma unroll
                        for (int n = 0; n < 2; ++n) acc[a][b][m][n] = (f32x4){0.f, 0.f, 0.f, 0.f};
        }
        cur = nxt; cA = nA; cB = nB; ++ui;
        if (DUAL) PG8_VOFF(xkind, voffA, voffB);
        hstepA = xhA; hstepB = xhB; nt = xnt;
        if (wr == 1) PG8_BAR;
    }
    PG8_WAIT_V(0);
    PG8_BAR;
#undef PG8_SA
#undef PG8_SB
#undef PG8_STAGE
#undef PG8_LDA
#undef PG8_LD32
#undef PG8_LDB
#undef PG8_MMA
#undef PG8_WAIT_V
#undef PG8_WAIT_L
#undef PG8_WAIT_VX
#undef PG8_BAR
#undef PG8_SCHED
#undef PG8_ABASE
#undef PG8_BBASE
#undef PG8_KIND
#undef PG8_SETCFG
#undef PG8_VOFF
}

__device__ __forceinline__ void lane_ids(int& wr, int& wc, int& fr, int& fq) { int t = threadIdx.x; asm volatile("" : "+v"(t)); const int wid = __builtin_amdgcn_readfirstlane(t >> 6); wr = wid >> 2; wc = wid & 3; fr = t & 15; fq = (t >> 4) & 3; }
__device__ __forceinline__ u32x4 pack8(const f32x4 a, const f32x4 b) { u32x4 w; w.x = cvt_pk_bf16(a[0], a[1]); w.y = cvt_pk_bf16(a[2], a[3]); w.z = cvt_pk_bf16(b[0], b[1]); w.w = cvt_pk_bf16(b[2], b[3]); return w; }

template <bool LATE> struct EpiInProjT {
    static constexpr bool PERM = true; static constexpr int NST = 16;
    bf16_t* O;
    const bf16_t* rope;
    const float* g_qa; const float* g_ka; const float* g_qb; const float* g_kb;
    const float* b_alpha;
    float* kmp;
    const float* ssq;
    float oscale;
    __device__ __forceinline__ void prefetch(const Unit& u, float (&pre)[8]) const {
        if constexpr (LATE) return;
        int t = threadIdx.x; asm volatile("" : "+v"(t)); const int row0 = u.pm * BM + ((t >> 8) & 1) * 64 + (t & 15);
#pragma unroll
        for (int st = 0; st < 8; ++st) pre[st] = ((const GAS float*)ssq)[row0 + (st >> 2) * HALF + (st & 3) * 16];
    }
    __device__ __forceinline__ bool operator()(Acc& acc, const Unit& u, const float (&pre)[8]) const {
        int wr, wc, fr, fq; lane_ids(wr, wc, fr, fq);
        const int G = 4 * u.pn + wc;
        const int row0 = u.pm * BM + wr * 64 + fr;
        static_assert(!LATE, "the row sums come from the K-loop's prefetch (pre[])");
#define INP_MV(st_) (pre[st_] * (1.0f / D) + EPS)
        bf16_t* obase = O + (size_t)row0 * PP + 64 * G + 8 * fq;
        const float* gain = nullptr; float qs = 1.f; bool mean = false;
        if (G < 8) { gain = g_qa; qs = C2; } else if (G < 10) gain = g_ka; else if (G >= 12 && G < 20) { gain = g_qb; qs = C2; } else if (G >= 20 && G < 28) { gain = g_kb; mean = true; }
        if (gain) {
            const float ios2 = 1.0f / (oscale * oscale);
            f32x4 gn[2][2];
#pragma unroll
            for (int bj = 0; bj < 2; ++bj)
#pragma unroll
                for (int n = 0; n < 2; ++n) gn[bj][n] = *(const GAS f32x4*)(gain + 32 * bj + 8 * fq + 4 * n) * qs;
            f32x4 ks[2][2];
#pragma unroll
            for (int bj = 0; bj < 2; ++bj)
#pragma unroll
                for (int n = 0; n < 2; ++n) ks[bj][n] = (f32x4){0.f, 0.f, 0.f, 0.f};
            u32x4 cw[8], sw[8];
#define INP_ROPE_LD(g_) do { const int rn_ = ((g_) >> 2) * HALF + ((g_) & 3) * 16; const bf16_t* cs_ = rope + (size_t)(row0 + rn_) * 64 + 8 * fq; cw[g_] = *(const GAS u32x4*)cs_; sw[g_] = *(const GAS u32x4*)(cs_ + 32); } while (0)
            INP_ROPE_LD(0); INP_ROPE_LD(1);
#pragma unroll
            for (int st = 0; st < 8; ++st) {
                const int ai = st >> 2, m = st & 3, rr = ai * HALF + m * 16;
                if (st + 2 < 8) INP_ROPE_LD(st + 2);
                const u32x4 cq_ = cw[st], sq_ = sw[st];
                const f32x4 c0 = {bf_lo(cq_.x), bf_hi(cq_.x), bf_lo(cq_.y), bf_hi(cq_.y)}, c1 = {bf_lo(cq_.z), bf_hi(cq_.z), bf_lo(cq_.w), bf_hi(cq_.w)};
                const f32x4 s0 = {bf_lo(sq_.x), bf_hi(sq_.x), bf_lo(sq_.y), bf_hi(sq_.y)}, s1 = {bf_lo(sq_.z), bf_hi(sq_.z), bf_lo(sq_.w), bf_hi(sq_.w)};
                float ss = 0.f;
#pragma unroll
                for (int bj = 0; bj < 2; ++bj)
#pragma unroll
                    for (int n = 0; n < 2; ++n) { const f32x4 v = acc[ai][bj][m][n]; ss += (v[0] * v[0] + v[1] * v[1]) + (v[2] * v[2] + v[3] * v[3]); }
                ss = addx32(addx16(ss));
                const float rs = frsq(ss * (1.0f / 64.0f) + EPS * INP_MV(st) * ios2);
                f32x4 o0[2], o1[2];
#pragma unroll
                for (int n = 0; n < 2; ++n) {
                    const f32x4 c = n ? c1 : c0, sx = n ? s1 : s0;
                    const f32x4 y0 = acc[ai][0][m][n] * rs * gn[0][n], y1 = acc[ai][1][m][n] * rs * gn[1][n];
                    o0[n] = y0 * c - y1 * sx; o1[n] = y1 * c + y0 * sx;
                    ks[0][n] += o0[n]; ks[1][n] += o1[n];
                }
                *(GAS u32x4*)(obase + (size_t)rr * PP) = pack8(o0[0], o0[1]);
                *(GAS u32x4*)(obase + (size_t)rr * PP + 32) = pack8(o1[0], o1[1]);
                asm volatile("" : "+v"(ks[0][0]), "+v"(ks[0][1]), "+v"(ks[1][0]), "+v"(ks[1][1]) :: "memory");
            }
#undef INP_ROPE_LD
            if (mean) {
#pragma unroll
                for (int bj = 0; bj < 2; ++bj)
#pragma unroll
                    for (int n = 0; n < 2; ++n)
#pragma unroll
                        for (int j = 0; j < 4; ++j) ks[bj][n][j] = sum16(ks[bj][n][j]);
                if (fr == 0) {
                    float* kp = kmp + ((size_t)((u.pm * 8 + (G - 20)) * 2 + wr)) * 64 + 8 * fq;
#pragma unroll
                    for (int bj = 0; bj < 2; ++bj)
#pragma unroll
                        for (int n = 0; n < 2; ++n) *(GAS f32x4*)(kp + 32 * bj + 4 * n) = ks[bj][n];
                }
            }
        } else {
            const int mode = (G >= 36 && G < 40) ? 1 : (G >= 52 && G < 56) ? 2 : (G >= 56) ? 3 : 0;
            f32x4 bb[2][2];
#pragma unroll
            for (int bj = 0; bj < 2; ++bj)
#pragma unroll
                for (int n = 0; n < 2; ++n) bb[bj][n] = (mode == 2) ? *(const GAS f32x4*)(b_alpha + 64 * (G - 52) + 32 * bj + 8 * fq + 4 * n) : (f32x4){0.f, 0.f, 0.f, 0.f};
#pragma unroll
            for (int ai = 0; ai < 2; ++ai)
#pragma unroll
                for (int m = 0; m < 4; ++m) {
                    const int rr = ai * HALF + m * 16;
                    const float rs = frsq(INP_MV(ai * 4 + m)) * oscale * (mode == 1 ? 0.125f : 1.0f);
                    f32x4 o[2][2];
#pragma unroll
                    for (int bj = 0; bj < 2; ++bj)
#pragma unroll
                        for (int n = 0; n < 2; ++n) {
                            f32x4 v = acc[ai][bj][m][n] * rs;
                            if (mode == 1) {}
                            else if (mode == 2) {
#pragma unroll
                                for (int j = 0; j < 4; ++j) { const float z = v[j] + bb[bj][n][j]; v[j] = (fminf(z, 0.f) - __logf(1.f + fexp(-fabsf(z)))) * (1.0f / 16.0f); }
                            } else if (mode == 3) {
#pragma unroll
                                for (int j = 0; j < 4; ++j) v[j] = v[j] * sigmoidf_(v[j]);
                            }
                            o[bj][n] = v;
                        }
                    *(GAS u32x4*)(obase + (size_t)rr * PP) = pack8(o[0][0], o[0][1]);
                    *(GAS u32x4*)(obase + (size_t)rr * PP + 32) = pack8(o[1][0], o[1][1]);
                    asm volatile("" ::: "memory");
                }
        }
        return false;
    }
};

#undef INP_MV
typedef EpiInProjT<false> EpiInProj;

template <bool LATE> struct EpiGatesT {
    static constexpr bool PERM = true; static constexpr int NST = (DBG_DUP == 11 || (DBG_DUP >= 18 && DBG_DUP <= 22)) ? 0 : 8;
    bf16_t* O; int nostore; const float* ssq; int late; float oscale;
    __device__ __forceinline__ void prefetch(const Unit& u, float (&pre)[8]) const {
        if constexpr (LATE) return;
        int t = threadIdx.x; asm volatile("" : "+v"(t)); const int row0 = u.pm * BM + ((t >> 8) & 1) * 64 + (t & 15);
#pragma unroll
        for (int st = 0; st < 8; ++st) pre[st] = ((const GAS float*)ssq)[row0 + (st >> 2) * HALF + (st & 3) * 16];
    }
    __device__ __forceinline__ bool operator()(Acc& acc, const Unit& u, const float (&pre)[8]) const {
        int wr, wc, fr, fq; lane_ids(wr, wc, fr, fq);
        if (nostore) {
#pragma unroll
            for (int ai = 0; ai < 2; ++ai)
#pragma unroll
                for (int bj = 0; bj < 2; ++bj)
#pragma unroll
                    for (int m = 0; m < 4; ++m) asm volatile("" :: "v"(acc[ai][bj][m][0]), "v"(acc[ai][bj][m][1]));
            return false;
        }
        const int row0 = u.pm * BM + wr * 64 + fr, col0 = u.pn * BM + wc * 64 + 16 * fq;
        float rsv[8];
#pragma unroll
        for (int st = 0; st < 8; ++st) rsv[st] = LATE ? ((const GAS float*)ssq)[row0 + (st >> 2) * HALF + (st & 3) * 16] : pre[st];
#pragma unroll
        for (int ai = 0; ai < 2; ++ai)
#pragma unroll
            for (int m = 0; m < 4; ++m) { unsigned char* rowp = (unsigned char*)O + (size_t)(row0 + ai * HALF + m * 16) * GW + col0;
                const float rs = frsq(rsv[ai * 4 + m] * (1.0f / D) + EPS) * oscale * (-LOG2E);
                unsigned ww[4];
#pragma unroll
                for (int bj = 0; bj < 2; ++bj) { f32x4 v0 = acc[ai][bj][m][0] * rs, v1 = acc[ai][bj][m][1] * rs;
                    unsigned w0 = 0u, w1 = 0u;
#pragma unroll
                    for (int j = 0; j < 4; ++j) { w0 = __builtin_amdgcn_cvt_pk_u8_f32(fmaxf(frcp(fmaf(fexp2(v0[j]), 1.0f / 255.0f, 1.0f / 255.0f)), 1.0f), j, w0);
                                                  w1 = __builtin_amdgcn_cvt_pk_u8_f32(fmaxf(frcp(fmaf(fexp2(v1[j]), 1.0f / 255.0f, 1.0f / 255.0f)), 1.0f), j, w1); }
                    ww[2 * bj] = w0; ww[2 * bj + 1] = w1; }
                *(GAS u32x4*)rowp = (u32x4){ww[0], ww[1], ww[2], ww[3]}; }
        return false;
    }
};

typedef EpiGatesT<false> EpiGates;
struct EpiMerge {
    static constexpr bool PERM = true; static constexpr int NST = (DBG_DUP == 22) ? 0 : 16;
    const bf16_t* Gt;
    bf16_t* O;
    int probe;
    __device__ __forceinline__ void prefetch(const Unit&, float (&)[8]) const {}
    __device__ __forceinline__ bool operator()(Acc& acc, const Unit& u, const float (&pre)[8]) const {
        int wr, wc, fr, fq; lane_ids(wr, wc, fr, fq);
        const int row0 = u.pm * BM + wr * 64 + fr, col0 = u.pn * BM + wc * 32 + 8 * fq, gcol0 = u.pn * BM + wc * 64 + 16 * fq;
        const bool last = u.sub == 2;
        if (DBG_DUP == 22 && probe) {
#pragma unroll
            for (int ai = 0; ai < 2; ++ai)
#pragma unroll
                for (int bj = 0; bj < 2; ++bj)
#pragma unroll
                    for (int m = 0; m < 4; ++m) asm volatile("" :: "v"(acc[ai][bj][m][0]), "v"(acc[ai][bj][m][1]));
            return !last;
        }
        const unsigned char* G8 = (const unsigned char*)Gt;
        u32x2 ga[2][4][2], gb[2][4][2];
#pragma unroll
        for (int ai = 0; ai < 2; ++ai)
#pragma unroll
            for (int m = 0; m < 4; ++m) {
                const unsigned char* gp = G8 + (size_t)(row0 + ai * HALF + m * 16) * GW + (size_t)u.sub * D + gcol0;
                const u32x4 a4 = *(const GAS u32x4*)gp, b4 = last ? (u32x4){0x01010101u, 0x01010101u, 0x01010101u, 0x01010101u} : *(const GAS u32x4*)(gp + D);
                ga[ai][m][0] = (u32x2){a4.x, a4.y}; ga[ai][m][1] = (u32x2){a4.z, a4.w};
                gb[ai][m][0] = (u32x2){b4.x, b4.y}; gb[ai][m][1] = (u32x2){b4.z, b4.w};
            }
        asm volatile("" ::: "memory");
        const float fin = last ? (1.0f / 255.0f) : 1.0f;
#pragma unroll
        for (int ai = 0; ai < 2; ++ai)
#pragma unroll
            for (int m = 0; m < 4; ++m)
#pragma unroll
                for (int bj = 0; bj < 2; ++bj) {
                    const u32x2 a = ga[ai][m][bj], b = gb[ai][m][bj];
                    if (last) {
                        const f32x4 s0 = {(float)(a.x & 0xffu), (float)((a.x >> 8) & 0xffu), (float)((a.x >> 16) & 0xffu), (float)(a.x >> 24)};
                        const f32x4 s1 = {(float)(a.y & 0xffu), (float)((a.y >> 8) & 0xffu), (float)((a.y >> 16) & 0xffu), (float)(a.y >> 24)};
                        acc[ai][bj][m][0] *= s0 * fin; acc[ai][bj][m][1] *= s1 * fin;
                        *(GAS u32x4*)(O + (size_t)(row0 + ai * HALF + m * 16) * D + col0 + bj * HALF) = pack8(acc[ai][bj][m][0], acc[ai][bj][m][1]);
                    } else {
                        const f32x4 s0 = {(float)(a.x & 0xffu) * frcp((float)(b.x & 0xffu)), (float)((a.x >> 8) & 0xffu) * frcp((float)((b.x >> 8) & 0xffu)), (float)((a.x >> 16) & 0xffu) * frcp((float)((b.x >> 16) & 0xffu)), (float)(a.x >> 24) * frcp((float)(b.x >> 24))};
                        const f32x4 s1 = {(float)(a.y & 0xffu) * frcp((float)(b.y & 0xffu)), (float)((a.y >> 8) & 0xffu) * frcp((float)((b.y >> 8) & 0xffu)), (float)((a.y >> 16) & 0xffu) * frcp((float)((b.y >> 16) & 0xffu)), (float)(a.y >> 24) * frcp((float)(b.y >> 24))};
                        acc[ai][bj][m][0] *= s0; acc[ai][bj][m][1] *= s1;
                    }
                }
        asm volatile("" ::: "memory");
        return !last;
    }
};

struct EpiGBM {
    static constexpr bool PERM = true; static constexpr int NST = 16;
    EpiGates eg; EpiMerge em;
    __device__ __forceinline__ void prefetch(const Unit&, float (&)[8]) const {}
    __device__ __forceinline__ bool operator()(Acc& acc, const Unit& u, const float (&pre)[8]) const {
        if (u.sub < 3) { const Unit v = {u.pm, 4 * u.sub + u.pn, 0}; return eg(acc, v, pre); }
        const Unit v = {u.pm, u.pn, u.sub - 3}; return em(acc, v, pre);
    }
};

struct EpiResid {
    static constexpr bool PERM = true; static constexpr int NST = 32;
    const bf16_t* base; float* out; bf16_t* xb; float* ssq; unsigned char* xb8;
    __device__ __forceinline__ void prefetch(const Unit&, float (&)[8]) const {}
    __device__ __forceinline__ bool operator()(Acc& acc, const Unit& u, const float (&pre)[8]) const {
        int wr, wc, fr, fq; lane_ids(wr, wc, fr, fq);
        const int row0 = u.pm * BM + wr * 64 + fr, col0 = u.pn * BM + wc * 32 + 8 * fq;
        u32x4 bw[2][4][2];
#pragma unroll
        for (int ai = 0; ai < 2; ++ai)
#pragma unroll
            for (int m = 0; m < 4; ++m)
#pragma unroll
                for (int bj = 0; bj < 2; ++bj) bw[ai][m][bj] = *(const GAS u32x4*)(base + (size_t)(row0 + ai * HALF + m * 16) * D + col0 + bj * HALF);
        asm volatile("" ::: "memory");
#pragma unroll
        for (int ai = 0; ai < 2; ++ai) {
            float ssm[4];
#pragma unroll
            for (int m = 0; m < 4; ++m) { const size_t off = (size_t)(row0 + ai * HALF + m * 16) * D + col0; float ss = 0.f;
#pragma unroll
                for (int bj = 0; bj < 2; ++bj) {
                    const u32x4 w = bw[ai][m][bj];
                    const f32x4 o0 = (f32x4){bf_lo(w.x), bf_hi(w.x), bf_lo(w.y), bf_hi(w.y)} + acc[ai][bj][m][0], o1 = (f32x4){bf_lo(w.z), bf_hi(w.z), bf_lo(w.w), bf_hi(w.w)} + acc[ai][bj][m][1];
                    if (out) { *(GAS f32x4*)(out + off + bj * HALF) = o0; *(GAS f32x4*)(out + off + bj * HALF + 4) = o1; }
                    if (xb) { ss += ((o0[0] * o0[0] + o0[1] * o0[1]) + (o0[2] * o0[2] + o0[3] * o0[3])) + ((o1[0] * o1[0] + o1[1] * o1[1]) + (o1[2] * o1[2] + o1[3] * o1[3]));
                        *(GAS u32x4*)(xb + off + bj * HALF) = pack8(o0, o1);
                        if (xb8) *(GAS u32x2*)(xb8 + off + bj * HALF) = (u32x2){cvt4_fp8(o0[0] * XS8, o0[1] * XS8, o0[2] * XS8, o0[3] * XS8), cvt4_fp8(o1[0] * XS8, o1[1] * XS8, o1[2] * XS8, o1[3] * XS8)}; } }
                ssm[m] = xb ? addx32(addx16(ss)) : 0.f; }
            if (xb) { const float sv = fq == 0 ? ssm[0] : fq == 1 ? ssm[1] : fq == 2 ? ssm[2] : ssm[3];
                (void)__hip_atomic_fetch_add((GAS float*)ssq + (row0 + ai * HALF + fq * 16), sv, __ATOMIC_RELAXED, __HIP_MEMORY_SCOPE_AGENT); }
            asm volatile("" ::: "memory");
        }
        return false;
    }
};

struct EpiFfn1 {
    static constexpr bool PERM = true; static constexpr int NST = (DBG_DUP == 6 || DBG_DUP >= 14) ? 0 : 8;
    bf16_t* O; const float* ssq; int nostore;
    __device__ __forceinline__ void prefetch(const Unit& u, float (&pre)[8]) const {
        int t = threadIdx.x; asm volatile("" : "+v"(t)); const int row0 = u.pm * BM + ((t >> 8) & 1) * 64 + (t & 15);
#pragma unroll
        for (int st = 0; st < 8; ++st) pre[st] = ((const GAS float*)ssq)[row0 + (st >> 2) * HALF + (st & 3) * 16];
    }
    __device__ __forceinline__ bool operator()(Acc& acc, const Unit& u, const float (&pre)[8]) const {
        int wr, wc, fr, fq; lane_ids(wr, wc, fr, fq);
        const int row0 = u.pm * BM + wr * 64 + fr, col0 = u.pn * HALF + wc * 32 + 8 * fq;
        if (DBG_DUP >= 14 && nostore) {
#pragma unroll
            for (int ai = 0; ai < 2; ++ai)
#pragma unroll
                for (int bj = 0; bj < 2; ++bj)
#pragma unroll
                    for (int m = 0; m < 4; ++m) asm volatile("" :: "v"(acc[ai][bj][m][0]), "v"(acc[ai][bj][m][1]));
            return false;
        }
#pragma unroll
        for (int ai = 0; ai < 2; ++ai)
#pragma unroll
            for (int m = 0; m < 4; ++m) {
                const float rs = frsq(pre[ai * 4 + m] * (1.0f / D) + EPS), rsn = -rs * LOG2E, rs2 = rs * rs;
                f32x4 o[2];
#pragma unroll
                for (int n = 0; n < 2; ++n) { const f32x4 g = acc[ai][0][m][n], u = acc[ai][1][m][n]; const f32x4 t = g * rsn; f32x4 e, r;
#pragma unroll
                    for (int j = 0; j < 4; ++j) e[j] = fexp2(t[j]);
                    const f32x4 d = e + 1.0f;
#pragma unroll
                    for (int j = 0; j < 4; ++j) r[j] = frcp(d[j]);
                    o[n] = (g * u) * (r * rs2); }
                *(GAS u32x4*)(O + (size_t)(row0 + ai * HALF + m * 16) * FF + col0) = pack8(o[0], o[1]);
            }
        return false;
    }
};
}

namespace att {
constexpr int SLOTB = 8192;
constexpr int L_K = 0, L_V = 3 * SLOTB, L_WS = 6 * SLOTB, L_OST = L_WS + 8 * 256, L_KM = L_OST + 8 * 4096, L_END = L_KM + 7 * 64 * 4;
__device__ __forceinline__ int crow(int r, int hi) { return (r & 3) + 8 * (r >> 2) + 4 * hi; }
__device__ __forceinline__ void glds16(const void* gsrc, unsigned lds_dst) { unsigned keep;
    asm volatile("s_mov_b32 %0, m0\n\ts_mov_b32 m0, %2\n\ts_nop 0\n\tglobal_load_lds_dwordx4 %1, off\n\ts_mov_b32 m0, %0" : "=&s"(keep) : "v"(gsrc), "s"(lds_dst) : "memory"); }
#define ATT_WAIT_BAR0() asm volatile("s_waitcnt vmcnt(0) lgkmcnt(0)\n\ts_barrier" ::: "memory")
#define ATT_SBAR() __builtin_amdgcn_sched_barrier(0)

__device__ __forceinline__ void qkt(f32x16& p0, f32x16& p1, LAS const unsigned char* Kslot, const bf16x8* qr, int r32, int hi) {
    LAS const unsigned char* kb = Kslot + hi * 1024 + r32 * 16;
    p0 = f32x16{}; p1 = f32x16{};
#pragma unroll
    for (int d0 = 0; d0 < 4; ++d0) {
        const bf16x8 b0 = *(LAS const bf16x8*)(kb + d0 * 2048);
        const bf16x8 b1 = *(LAS const bf16x8*)(kb + d0 * 2048 + 512);
        p0 = __builtin_amdgcn_mfma_f32_32x32x16_bf16(b0, qr[d0], p0, 0, 0, 0);
        p1 = __builtin_amdgcn_mfma_f32_32x32x16_bf16(b1, qr[d0], p1, 0, 0, 0);
    }
}
__device__ __forceinline__ float rowmax(const f32x16& p0, const f32x16& p1) {
    float a = fmaxf(p0[0], p1[0]);
#pragma unroll
    for (int r = 1; r < 16; ++r) a = fmaxf(a, fmaxf(p0[r], p1[r]));
    return maxx32(a);
}
__device__ __forceinline__ void pv(f32x16* o, int vb, bf16x8 pa0, bf16x8 pa1, bf16x8 pa2, bf16x8 pa3) {
#pragma unroll
    for (int d0 = 0; d0 < 2; ++d0) { s16x4 lo[4], hi[4];
#pragma unroll
        for (int ks = 0; ks < 4; ++ks) {
            asm volatile("ds_read_b64_tr_b16 %0,%1 offset:%c2" : "=&v"(lo[ks]) : "v"(vb), "i"(d0 * 4096 + ks * 1024) : "memory");
            asm volatile("ds_read_b64_tr_b16 %0,%1 offset:%c2" : "=&v"(hi[ks]) : "v"(vb), "i"(d0 * 4096 + ks * 1024 + 512) : "memory"); }
        asm volatile("s_waitcnt lgkmcnt(0)" ::: "memory"); ATT_SBAR();
#define ATT_PK(k) (bf16x8){lo[k][0], lo[k][1], lo[k][2], lo[k][3], hi[k][0], hi[k][1], hi[k][2], hi[k][3]}
        o[d0] = __builtin_amdgcn_mfma_f32_32x32x16_bf16(pa0, ATT_PK(0), o[d0], 0, 0, 0);
        o[d0] = __builtin_amdgcn_mfma_f32_32x32x16_bf16(pa1, ATT_PK(1), o[d0], 0, 0, 0);
        o[d0] = __builtin_amdgcn_mfma_f32_32x32x16_bf16(pa2, ATT_PK(2), o[d0], 0, 0, 0);
        o[d0] = __builtin_amdgcn_mfma_f32_32x32x16_bf16(pa3, ATT_PK(3), o[d0], 0, 0, 0);
#undef ATT_PK
    }
}

template <int MODE>
__device__ __forceinline__ void attn_unit(const bf16_t* proj, bf16_t* Y, int b, int hh, int qb, const float* sinks, const float* kmp, LAS unsigned char* shm) {
    int tid_ = threadIdx.x; asm volatile("" : "+v"(tid_));
    const int tid = tid_, lane = tid & 63, r32 = lane & 31, hi = lane >> 5; const int wid = __builtin_amdgcn_readfirstlane(tid >> 6);
    const long rowbase = (long)b * SEQ;
    int qhead, qrow0, kcol, vcol, qcol, ycol, t_first, t_last;
    if (MODE == 0) { qhead = 4 * hh + (wid >> 1); qrow0 = 64 * qb + 32 * (wid & 1); qcol = 64 * qhead; kcol = 512 + 64 * hh; vcol = 640 + 64 * hh; ycol = 64 * qhead; t_first = qb >= 2 ? qb - 2 : 0; t_last = qb; }
    else { qhead = hh; qrow0 = 256 * qb + 32 * wid; qcol = 768 + 64 * hh; kcol = 1280 + 64 * hh; vcol = 1792 + 64 * hh; ycol = 512 + 64 * hh; t_first = 0; t_last = 4 * qb + 3; }
    const bf16_t* Qw = proj + (rowbase + qrow0) * PP + qcol;
    const bf16_t* Kh = proj + rowbase * PP + kcol; const bf16_t* Vh = proj + rowbase * PP + vcol;
    const unsigned lds0 = (unsigned)(uintptr_t)shm;
    LAS float* wsf = (LAS float*)(shm + L_WS) + wid * 64;
    const bf16_t* ksrc = Kh + (long)lane * PP + wid * 8;
    const bf16_t* vsrc = Vh + (long)(16 * (wid & 3) + (lane >> 2)) * PP + (wid >> 2) * 32 + (lane & 3) * 8;
    const unsigned kdst = lds0 + L_K + wid * 1024, vdst = lds0 + L_V + wid * 1024;
#define ATT_DMA(t, slot) do { glds16(ksrc + (long)(t) * 64 * PP, (unsigned)__builtin_amdgcn_readfirstlane(kdst + (slot))); glds16(vsrc + (long)(t) * 64 * PP, (unsigned)__builtin_amdgcn_readfirstlane(vdst + (slot))); } while (0)
    const int vb0 = (int)(lds0 + L_V) + ((lane >> 4) & 1) * 32 + (lane & 3) * 8 + (4 * hi + ((lane & 15) >> 2)) * 64;
    bf16x8 qr[4];
#pragma unroll
    for (int d0 = 0; d0 < 4; ++d0) qr[d0] = *(const GAS bf16x8*)(Qw + (long)r32 * PP + d0 * 16 + hi * 8);
    unsigned sel = 0u;
    if (MODE == 1) {
        LAS float* km = (LAS float*)(shm + L_KM);
        if (qb > 0) { for (int idx = tid; idx < qb * 64; idx += 512) { const int n = idx >> 6, d = idx & 63; const float* p = kmp + ((size_t)(((b * 8 + n) * 8 + hh) * 2)) * 64 + d; km[idx] = p[0] + p[64]; } }
        LDS_WAIT(); __syncthreads();
        if (qb <= 3) sel = (1u << qb) - 1u;
        else {
            float qf[32];
#pragma unroll
            for (int d0 = 0; d0 < 4; ++d0)
#pragma unroll
                for (int j = 0; j < 8; ++j) qf[d0 * 8 + j] = bf1((bf16_t)qr[d0][j]);
            float gsc[7];
#pragma unroll
            for (int n = 0; n < 7; ++n) {
                float a = 0.f;
                if (n < qb) {
#pragma unroll
                    for (int d0 = 0; d0 < 4; ++d0) { const f32x4 k0 = *(LAS const f32x4*)(km + n * 64 + d0 * 16 + hi * 8), k1 = *(LAS const f32x4*)(km + n * 64 + d0 * 16 + hi * 8 + 4);
                        a += qf[d0 * 8 + 0] * k0[0] + qf[d0 * 8 + 1] * k0[1] + qf[d0 * 8 + 2] * k0[2] + qf[d0 * 8 + 3] * k0[3] + qf[d0 * 8 + 4] * k1[0] + qf[d0 * 8 + 5] * k1[1] + qf[d0 * 8 + 6] * k1[2] + qf[d0 * 8 + 7] * k1[3]; }
                    a = addx32(a);
                } else a = -INFINITY;
                gsc[n] = a;
            }
#pragma unroll
            for (int n = 0; n < 7; ++n) { int cnt = 0;
#pragma unroll
                for (int m2 = 0; m2 < 7; ++m2) if (m2 != n) cnt += (gsc[m2] > gsc[n] || (gsc[m2] == gsc[n] && m2 < n)) ? 1 : 0;
                if (cnt < 3 && n < qb) sel |= 1u << n; }
        }
    }
    float mhat, l_reg; f32x16 o[2]; o[0] = f32x16{}; o[1] = f32x16{};
    if (MODE == 0) { mhat = sinks[qhead] * LOG2E; l_reg = hi == 0 ? 1.f : 0.f; } else { mhat = -1e30f; l_reg = 0.f; }
    const int qabs = qrow0 + r32;
    int slot = 0;
    if (MODE == 0) {
        for (int t = t_first; t <= t_last; ++t) ATT_DMA(t, (t - t_first) * SLOTB);
        ATT_WAIT_BAR0();
    } else ATT_DMA(t_first, 0);
    for (int t = t_first; t <= t_last; ++t) {
        if (MODE != 0) { ATT_WAIT_BAR0();
            if (t < t_last) ATT_DMA(t + 1, slot ^ SLOTB); }
        bool active = true;
        if (MODE == 1 && t < 4 * qb) active = __any((sel >> (t >> 2)) & 1u);
        if (active) {
            f32x16 p0, p1;
            qkt(p0, p1, shm + L_K + slot, qr, r32, hi);
            if (MODE == 0) {
                const int kb = 64 * t + 4 * hi;
#pragma unroll
                for (int r = 0; r < 16; ++r) { const int kv = kb + (r & 3) + 8 * (r >> 2);
                    if (!(kv <= qabs && kv > qabs - 128)) p0[r] = -INFINITY;
                    if (!(kv + 32 <= qabs && kv + 32 > qabs - 128)) p1[r] = -INFINITY; }
            } else {
                if (t >= 4 * qb) {
                    const int kb = 64 * t + 4 * hi;
#pragma unroll
                    for (int r = 0; r < 16; ++r) { const int kv = kb + (r & 3) + 8 * (r >> 2); if (kv > qabs) p0[r] = -INFINITY; if (kv + 32 > qabs) p1[r] = -INFINITY; }
                } else if (!((sel >> (t >> 2)) & 1u)) {
#pragma unroll
                    for (int r = 0; r < 16; ++r) { p0[r] = -INFINITY; p1[r] = -INFINITY; }
                }
            }
            const float rm = rowmax(p0, p1);
            const float mnew = fmaxf(mhat, rm);
            const float f = fexp2(mhat - mnew);
            mhat = mnew;
            float sacc = 0.f;
#pragma unroll
            for (int r = 0; r < 16; ++r) { p0[r] = fexp2(p0[r] - mnew); p1[r] = fexp2(p1[r] - mnew); sacc += p0[r] + p1[r]; }
            l_reg = l_reg * f + sacc;
            if (__any(f != 1.0f)) {
                if (hi == 0) wsf[r32] = f;
                LDS_WAIT();
#pragma unroll
                for (int r = 0; r < 16; ++r) { const float fr_ = wsf[crow(r, hi)]; o[0][r] *= fr_; o[1][r] *= fr_; }
            }
            u32x4 pw0, pw1, pw2, pw3;
#define ATT_PKW(P, B) cvt_pk_bf16(P[B], P[B + 1])
            pw0 = (u32x4){ATT_PKW(p0, 0), ATT_PKW(p0, 2), ATT_PKW(p0, 4), ATT_PKW(p0, 6)}; pw1 = (u32x4){ATT_PKW(p0, 8), ATT_PKW(p0, 10), ATT_PKW(p0, 12), ATT_PKW(p0, 14)};
            pw2 = (u32x4){ATT_PKW(p1, 0), ATT_PKW(p1, 2), ATT_PKW(p1, 4), ATT_PKW(p1, 6)}; pw3 = (u32x4){ATT_PKW(p1, 8), ATT_PKW(p1, 10), ATT_PKW(p1, 12), ATT_PKW(p1, 14)};
#undef ATT_PKW
            ATT_SBAR();
            pv(o, vb0 + slot, __builtin_bit_cast(bf16x8, pw0), __builtin_bit_cast(bf16x8, pw1), __builtin_bit_cast(bf16x8, pw2), __builtin_bit_cast(bf16x8, pw3));
        }
        if (MODE == 0) slot += SLOTB; else slot ^= SLOTB;
    }
    l_reg = addx32(l_reg);
    if (hi == 0) wsf[32 + r32] = l_reg;
    LDS_WAIT();
    float rli[16];
#pragma unroll
    for (int r = 0; r < 16; ++r) rli[r] = frcp(wsf[32 + crow(r, hi)]);
    bf16_t* Ow = Y + (rowbase + qrow0) * YW + ycol;
    { LAS bf16_t* stg = (LAS bf16_t*)(shm + L_OST) + wid * 2048;
#pragma unroll
        for (int r = 0; r < 16; ++r) { const int orow = crow(r, hi);
#pragma unroll
            for (int d0 = 0; d0 < 2; ++d0) stg[orow * 64 + d0 * 32 + r32] = f2bf(o[d0][r] * rli[r]); }
        LDS_WAIT();
#pragma unroll
        for (int i = 0; i < 4; ++i) { const int row = i * 8 + (lane >> 3), ch = lane & 7; const u32x4 v = *(LAS const u32x4*)(stg + row * 64 + ch * 8); *(GAS u32x4*)(Ow + (long)row * YW + ch * 8) = v; } }
    asm volatile("s_waitcnt lgkmcnt(0)\n\ts_barrier" ::: "memory");
#undef ATT_DMA
}
}

namespace att2 {
#define SBAR() __builtin_amdgcn_sched_barrier(0)
__device__ __forceinline__ int crow(int r,int hi){return (r&3)+8*(r>>2)+4*hi;}
#define SBAR() __builtin_amdgcn_sched_barrier(0)
__device__ __forceinline__ void cmask(f32x16&p0,f32x16&p1,int jb,int qrel,int hi){
  const float NEG=-INFINITY; int kb=64*jb+4*hi;
  #pragma unroll
  for(int r=0;r<16;++r){int kv=kb+(r&3)+8*(r>>2); if(kv>qrel)p0[r]=NEG; if(kv+32>qrel)p1[r]=NEG;}
}

constexpr int NW=8,QBLK=32,QB=256,KVBLK=64,DM=PP;
constexpr int NSLOT=3, SLOTB=8192;
constexpr int LDS_K=0, LDS_V=NSLOT*SLOTB, LDS_WS=2*NSLOT*SLOTB, LDS_OST=LDS_WS+NW*64*4, LDS_KM=LDS_OST+NW*4096, LDS_BYTES=LDS_KM+7*64*4;
__device__ __forceinline__ void glds16(const void*gsrc,unsigned lds_dst){unsigned keep;
  asm volatile("s_mov_b32 %0, m0\n\ts_mov_b32 m0, %2\n\ts_nop 0\n\tglobal_load_lds_dwordx4 %1, off\n\ts_mov_b32 m0, %0":"=&s"(keep):"v"(gsrc),"s"(lds_dst):"memory");}
__device__ __forceinline__ float max3f(float a,float b,float c){float r;asm("v_max3_f32 %0, %1, %2, %3":"=v"(r):"v"(a),"v"(b),"v"(c));return r;}
__device__ __forceinline__ float max2f(float a,float b){float r;asm("v_max_f32_e32 %0, %1, %2":"=v"(r):"v"(a),"v"(b));return r;}
__device__ __forceinline__ float fadd_s(float a,float b){float r;asm("v_add_f32_e32 %0, %1, %2":"=v"(r):"v"(a),"v"(b));return r;}
__device__ __forceinline__ float fsub_s(float a,float b){float r;asm("v_sub_f32_e32 %0, %1, %2":"=v"(r):"v"(a),"v"(b));return r;}
typedef float f32x2_t __attribute__((ext_vector_type(2))); typedef __bf16 bf16x2_t __attribute__((ext_vector_type(2)));
typedef int v8i_t __attribute__((ext_vector_type(8)));
__device__ __forceinline__ unsigned cvtpk_s(float lo,float hi){f32x2_t v={lo,hi};bf16x2_t b=__builtin_convertvector(v,bf16x2_t);return __builtin_bit_cast(unsigned,b);}
#define WAIT_BAR(N) asm volatile("s_waitcnt vmcnt(" #N ") lgkmcnt(0)\n\ts_barrier":::"memory")

typedef __attribute__((address_space(3))) const char* lds_cptr;
__device__ __forceinline__ void qkt(f32x16&p0,f32x16&p1,lds_cptr Kslot,const bf16x8*qr,const f32x16&negm,int r32,int hi){
  lds_cptr kb=Kslot+hi*1024+r32*16;
  #pragma unroll
  for(int d0=0;d0<4;++d0){
    const bf16x8 b0=*(const __attribute__((address_space(3))) bf16x8*)(kb+d0*2048);
    const bf16x8 b1=*(const __attribute__((address_space(3))) bf16x8*)(kb+d0*2048+512);
    if(d0==0){p0=__builtin_amdgcn_mfma_f32_32x32x16_bf16(b0,qr[0],negm,0,0,0);p1=__builtin_amdgcn_mfma_f32_32x32x16_bf16(b1,qr[0],negm,0,0,0);}
    else{p0=__builtin_amdgcn_mfma_f32_32x32x16_bf16(b0,qr[d0],p0,0,0,0);p1=__builtin_amdgcn_mfma_f32_32x32x16_bf16(b1,qr[d0],p1,0,0,0);}}
}
__device__ __forceinline__ void kload8(bf16x8*kf,lds_cptr kp){
  kf[0]=*(const __attribute__((address_space(3))) bf16x8*)(kp);      kf[1]=*(const __attribute__((address_space(3))) bf16x8*)(kp+512);
  kf[2]=*(const __attribute__((address_space(3))) bf16x8*)(kp+2048); kf[3]=*(const __attribute__((address_space(3))) bf16x8*)(kp+2560);
  kf[4]=*(const __attribute__((address_space(3))) bf16x8*)(kp+4096); kf[5]=*(const __attribute__((address_space(3))) bf16x8*)(kp+4608);
  kf[6]=*(const __attribute__((address_space(3))) bf16x8*)(kp+6144); kf[7]=*(const __attribute__((address_space(3))) bf16x8*)(kp+6656);
}
__device__ __forceinline__ void kload2(bf16x8*kf,lds_cptr kp,int j){ kf[2*j]=*(const __attribute__((address_space(3))) bf16x8*)(kp+j*2048); kf[2*j+1]=*(const __attribute__((address_space(3))) bf16x8*)(kp+j*2048+512); }
__device__ __forceinline__ s16x4 vtr(lds_cptr p){ return __builtin_bit_cast(s16x4,__builtin_amdgcn_ds_read_tr16_b64_v4i16((__attribute__((address_space(3))) v4i16_t*)p)); }
__device__ __forceinline__ float rowmax(const f32x16&p0,const f32x16&p1){
  float a=max3f(p0[0],p0[1],p1[0]),b=max3f(p0[2],p0[3],p1[1]);a=max3f(a,p1[2],p1[3]);
  #pragma unroll
  for(int r=4;r<16;r+=4){a=max3f(a,p0[r],p0[r+1]);b=max3f(b,p0[r+2],p0[r+3]);a=max3f(a,p1[r],p1[r+1]);b=max3f(b,p1[r+2],p1[r+3]);}
  const float m=max2f(a,b);
  auto rr=__builtin_amdgcn_permlane32_swap(__float_as_uint(m),__float_as_uint(m),false,false);
  return max2f(__uint_as_float(rr[0]),__uint_as_float(rr[1]));
}
__device__ __forceinline__ void pv(f32x16*o,int vb,bf16x8 pa0,bf16x8 pa1,bf16x8 pa2,bf16x8 pa3){
  #pragma unroll
  for(int d0=0;d0<2;++d0){s16x4 lo[4],hi[4];
    #pragma unroll
    for(int ks=0;ks<4;++ks){
      asm volatile("ds_read_b64_tr_b16 %0,%1 offset:%c2":"=&v"(lo[ks]):"v"(vb),"i"(d0*4096+ks*1024):"memory");
      asm volatile("ds_read_b64_tr_b16 %0,%1 offset:%c2":"=&v"(hi[ks]):"v"(vb),"i"(d0*4096+ks*1024+512):"memory");}
    asm volatile("s_waitcnt lgkmcnt(0)":::"memory");SBAR();
    #define PK(k) (bf16x8){lo[k][0],lo[k][1],lo[k][2],lo[k][3],hi[k][0],hi[k][1],hi[k][2],hi[k][3]}
    o[d0]=__builtin_amdgcn_mfma_f32_32x32x16_bf16(pa0,PK(0),o[d0],0,0,0);
    o[d0]=__builtin_amdgcn_mfma_f32_32x32x16_bf16(pa1,PK(1),o[d0],0,0,0);
    o[d0]=__builtin_amdgcn_mfma_f32_32x32x16_bf16(pa2,PK(2),o[d0],0,0,0);
    o[d0]=__builtin_amdgcn_mfma_f32_32x32x16_bf16(pa3,PK(3),o[d0],0,0,0);
    #undef PK
  }
}

template<int THRL> __device__ __forceinline__ void moba_unit(int b,int h,int qb,const bf16_t*proj,bf16_t*Y,const float*kmp,LAS unsigned char*shm){
  int tid_=threadIdx.x; asm volatile("":"+v"(tid_));
  const int tid=tid_,lane=tid&63,r32=lane&31,hi=lane>>5; const int wid=__builtin_amdgcn_readfirstlane(tid>>6);
  const long rowbase=(long)b*SEQ; const int q0=qb*QB;
  const bf16_t*Qw=proj+(rowbase+q0+wid*QBLK)*DM+768+h*64;
  const bf16_t*Kh=proj+rowbase*DM+1280+h*64,*Vh=proj+rowbase*DM+1792+h*64;
  const unsigned lds0=(unsigned)(uintptr_t)shm;
  LAS float*wsf=(LAS float*)(shm+LDS_WS)+wid*64;
  const bf16_t*ksrc=Kh+(long)lane*DM+wid*8;
  const bf16_t*vsrc=Vh+(long)(16*(wid&3)+(lane>>2))*DM+(wid>>2)*32+(lane&3)*8;
  const unsigned kdst=lds0+LDS_K+wid*1024, vdst=lds0+LDS_V+wid*1024;
  #define DMA_K(t,slot) glds16(ksrc+(long)(t)*KVBLK*DM,(unsigned)__builtin_amdgcn_readfirstlane(kdst+(slot)))
  #define DMA_V(t,slot) glds16(vsrc+(long)(t)*KVBLK*DM,(unsigned)__builtin_amdgcn_readfirstlane(vdst+(slot)))
  const int vb0=(int)(lds0+LDS_V)+((lane>>4)&1)*32+(lane&3)*8+(4*hi+((lane&15)>>2))*64;
  const lds_cptr Kbase=(lds_cptr)(shm+LDS_K); bf16x8 kf[8];
  const lds_cptr shm3=(lds_cptr)shm; const lds_cptr kp0=shm3+LDS_K+hi*1024+r32*16; const lds_cptr vp0=shm3+LDS_V+((lane>>4)&1)*32+(lane&3)*8+(4*hi+((lane&15)>>2))*64;
  const int NT=(q0+QB)/KVBLK;
  bf16x8 qr[4];
  #pragma unroll
  for(int d0=0;d0<4;++d0)qr[d0]=*(const GAS bf16x8*)(&Qw[(long)r32*DM+d0*16+hi*8]);
  LAS float*km=(LAS float*)(shm+LDS_KM);
  if(tid<qb*64){ const int n_=tid>>6,d_=tid&63; const float*p_=kmp+((size_t)(((b*8+n_)*8+h)*2))*64+d_; km[tid]=p_[0]+p_[64]; }
  DMA_K(0,0);DMA_V(0,0);DMA_K(1,SLOTB);
  asm volatile("s_waitcnt lgkmcnt(0)\n\ts_barrier":::"memory");
  unsigned sel=0u;
  if(qb<=3)sel=(1u<<qb)-1u;
  else{
    float qf[32];
    #pragma unroll
    for(int d0=0;d0<4;++d0)
      #pragma unroll
      for(int j=0;j<8;++j)qf[d0*8+j]=bf1((bf16_t)qr[d0][j]);
    float gsc[7];
    #pragma unroll
    for(int n=0;n<7;++n){
      float a=0.f;
      if(n<qb){
        #pragma unroll
        for(int d0=0;d0<4;++d0){ const f32x4 k0=*(LAS const f32x4*)(km+n*64+d0*16+hi*8),k1=*(LAS const f32x4*)(km+n*64+d0*16+hi*8+4);
          a+=qf[d0*8+0]*k0[0]+qf[d0*8+1]*k0[1]+qf[d0*8+2]*k0[2]+qf[d0*8+3]*k0[3]+qf[d0*8+4]*k1[0]+qf[d0*8+5]*k1[1]+qf[d0*8+6]*k1[2]+qf[d0*8+7]*k1[3]; }
        a=addx32(a);
      } else a=-INFINITY;
      gsc[n]=a;
    }
    #pragma unroll
    for(int n=0;n<7;++n){ int cnt=0;
      #pragma unroll
      for(int m2=0;m2<7;++m2) if(m2!=n) cnt+=(gsc[m2]>gsc[n]||(gsc[m2]==gsc[n]&&m2<n))?1:0;
      if(cnt<3&&n<qb)sel|=1u<<n; }
  }
  float mhat=0.f,l_reg=0.f;f32x16 o[2];o[0]=f32x16{};o[1]=f32x16{};f32x16 negm=f32x16{};asm volatile("":"+v"(negm));
  const int qrel=wid*QBLK+r32;
  #define BLKM(P0,P1,t) do{ const float mk_=((sel>>((t)>>2))&1u)?0.f:-INFINITY; _Pragma("unroll") for(int r=0;r<16;++r){P0[r]+=mk_;P1[r]+=mk_;} }while(0)
  #define CMASK(P0,P1,t) do{int jb_=(t)-(NT-4); if(jb_>=0)cmask(P0,P1,jb_,qrel,hi); else BLKM(P0,P1,t);}while(0)
  bool resc=false;
  #define START(P0,P1) do{ const float rm=rowmax(P0,P1); resc=false; \
    { const float dl=__builtin_fmaxf(rm,-60.f); mhat=fadd_s(mhat,dl); \
      _Pragma("unroll") for(int r=0;r<16;++r){P0[r]=fsub_s(P0[r],dl);P1[r]=fsub_s(P1[r],dl);} \
      _Pragma("unroll") for(int r=0;r<16;++r)negm[r]=-mhat; asm volatile("":"+v"(negm)); } \
    _Pragma("unroll") for(int r=0;r<16;++r)P0[r]=__builtin_amdgcn_exp2f(P0[r]); }while(0)
  #define RESC() do{ if(resc){ asm volatile("s_waitcnt lgkmcnt(0)":::"memory"); \
      _Pragma("unroll") for(int d_=0;d_<2;++d_) _Pragma("unroll") for(int r=0;r<16;++r)o[d_][r]*=wsf[crow(r,hi)]; } }while(0)
  f32x16 pA0,pA1,pB0,pB1;
  int sl_prev=0,sl_cur=0,sl_next=SLOTB;
  #define ROT() do{sl_prev=sl_cur;sl_cur=sl_next;sl_next=(sl_next==(NSLOT-1)*SLOTB)?0:sl_next+SLOTB;}while(0)
  DMA_K(2,2*SLOTB);
  WAIT_BAR(3);
  qkt(pA0,pA1,Kbase,qr,negm,r32,hi);asm volatile("s_nop 15\n\ts_nop 7":"+v"(pA0),"+v"(pA1));CMASK(pA0,pA1,0);
  START(pA0,pA1);
  _Pragma("unroll") for(int r=0;r<16;++r)pA1[r]=__builtin_amdgcn_exp2f(pA1[r]);
  WAIT_BAR(0);
  DMA_K(3,0);DMA_V(1,SLOTB);
  ROT();
  kload8(kf,kp0+sl_cur);
  WAIT_BAR(2);
  s16x4 vlo[8],vhi[8]; u32x4 pw0,pw1,pw2,pw3;
  #define PKW(P,B) cvtpk_s(P[B],P[B+1])
  #define PAF(k) __builtin_bit_cast(bf16x8,pw##k)
  #define VFR(i) (bf16x8){vlo[i][0],vlo[i][1],vlo[i][2],vlo[i][3],vhi[i][0],vhi[i][1],vhi[i][2],vhi[i][3]}
  #define PIN(x) asm volatile("":"+v"(x))
  #define MX3(a,b,c) __builtin_fmaxf(__builtin_fmaxf((a),(b)),(c))
  #define GAPA(MF,A0,A1,A2,A3,W0,W1,PW) do{ MF; sacc+=A0; sacc+=A1; sacc+=A2; sacc+=A3; PIN(sacc); W0; W1; PIN(PW); SBAR(); }while(0)
  #define EX(v) __builtin_amdgcn_exp2f(v)
  #define GAPB(MF,X,B) do{ MF; X[B]=EX(X[B]); X[B+1]=EX(X[B+1]); X[B+2]=EX(X[B+2]); X[B+3]=EX(X[B+3]); PIN(X); SBAR(); }while(0)
  #define VRD(i) do{ vlo[i]=vtr(vp_+(((i)>>2)*4096+((i)&3)*1024)); vhi[i]=vtr(vp_+(((i)>>2)*4096+((i)&3)*1024+512)); }while(0)
  #define KRD(G,j) do{ if(G){ kload2(kf,kp0+sl_next,j); SBAR(); } }while(0)
  #define STEP(C0,C1,P0,P1,t,GK,GV,GL) do{ SBAR(); \
    const lds_cptr vp_=vp0+sl_prev; \
    VRD(0); SBAR(); float sacc=(P0[0]+P0[1]); \
    GAPA(C0=__builtin_amdgcn_mfma_f32_32x32x16_bf16(kf[0],qr[0],negm,0,0,0), P0[2],P0[3],P0[4],P0[5],     pw0[0]=PKW(P0,0), pw0[1]=PKW(P0,2), pw0); \
    VRD(4); SBAR(); GAPA(C1=__builtin_amdgcn_mfma_f32_32x32x16_bf16(kf[1],qr[0],negm,0,0,0), P0[6],P0[7],P0[8],P0[9],     pw0[2]=PKW(P0,4), pw0[3]=PKW(P0,6), pw0); \
    VRD(1); SBAR(); GAPA(C0=__builtin_amdgcn_mfma_f32_32x32x16_bf16(kf[2],qr[1],C0,0,0,0),   P0[10],P0[11],P0[12],P0[13], pw1[0]=PKW(P0,8), pw1[1]=PKW(P0,10), pw1); \
    VRD(5); SBAR(); GAPA(C1=__builtin_amdgcn_mfma_f32_32x32x16_bf16(kf[3],qr[1],C1,0,0,0),   P0[14],P0[15],P1[0],P1[1],   pw1[2]=PKW(P0,12),pw1[3]=PKW(P0,14), pw1); \
    VRD(2); SBAR(); GAPA(C0=__builtin_amdgcn_mfma_f32_32x32x16_bf16(kf[4],qr[2],C0,0,0,0),   P1[2],P1[3],P1[4],P1[5],     pw2[0]=PKW(P1,0), pw2[1]=PKW(P1,2), pw2); \
    VRD(6); SBAR(); GAPA(C1=__builtin_amdgcn_mfma_f32_32x32x16_bf16(kf[5],qr[2],C1,0,0,0),   P1[6],P1[7],P1[8],P1[9],     pw2[2]=PKW(P1,4), pw2[3]=PKW(P1,6), pw2); \
    VRD(3); SBAR(); GAPA(C0=__builtin_amdgcn_mfma_f32_32x32x16_bf16(kf[6],qr[3],C0,0,0,0),   P1[10],P1[11],P1[12],P1[13], pw3[0]=PKW(P1,8), pw3[1]=PKW(P1,10), pw3); \
    VRD(7); SBAR(); GAPA(C1=__builtin_amdgcn_mfma_f32_32x32x16_bf16(kf[7],qr[3],C1,0,0,0),   P1[14],P1[15],0.f,0.f,       pw3[2]=PKW(P1,12),pw3[3]=PKW(P1,14), pw3); \
    l_reg+=sacc; \
    if(GK){DMA_K((t)+3,sl_cur);} if(GV){DMA_V((t)+1,sl_next);} \
    CMASK(C0,C1,t); \
    { float a=MX3(C0[0],C0[1],C1[0]),b=MX3(C0[2],C0[3],C1[1]); a=MX3(a,C1[2],C1[3]); \
      _Pragma("unroll") for(int r=4;r<16;r+=4){a=MX3(a,C0[r],C0[r+1]);b=MX3(b,C0[r+2],C0[r+3]);a=MX3(a,C1[r],C1[r+1]);b=MX3(b,C1[r+2],C1[r+3]);} \
      float rm=__builtin_fmaxf(a,b); { auto rr=__builtin_amdgcn_permlane32_swap(__float_as_uint(rm),__float_as_uint(rm),false,false); rm=__builtin_fmaxf(__uint_as_float(rr[0]),__uint_as_float(rr[1])); } \
      resc=false; \
      if(__builtin_expect(__any(rm>(float)THRL),0)){ const float dl=__builtin_fmaxf(rm,0.f); mhat+=dl; \
        _Pragma("unroll") for(int r=0;r<16;++r){C0[r]-=dl;C1[r]-=dl;} \
        _Pragma("unroll") for(int r=0;r<16;++r)negm[r]=-mhat; asm volatile("":"+v"(negm)); \
        const float f=__builtin_amdgcn_exp2f(-dl); l_reg*=f; if(hi==0)wsf[r32]=f; resc=true; } } \
    SBAR(); \
    GAPB(o[0]=__builtin_amdgcn_mfma_f32_32x32x16_bf16(PAF(0),VFR(0),o[0],0,0,0), C0,0); \
    GAPB(o[1]=__builtin_amdgcn_mfma_f32_32x32x16_bf16(PAF(0),VFR(4),o[1],0,0,0), C0,4); \
    KRD(GL,0); GAPB(o[0]=__builtin_amdgcn_mfma_f32_32x32x16_bf16(PAF(1),VFR(1),o[0],0,0,0), C0,8); \
    KRD(GL,1); GAPB(o[1]=__builtin_amdgcn_mfma_f32_32x32x16_bf16(PAF(1),VFR(5),o[1],0,0,0), C0,12); \
    KRD(GL,2); GAPB(o[0]=__builtin_amdgcn_mfma_f32_32x32x16_bf16(PAF(2),VFR(2),o[0],0,0,0), C1,0); \
    KRD(GL,3); GAPB(o[1]=__builtin_amdgcn_mfma_f32_32x32x16_bf16(PAF(2),VFR(6),o[1],0,0,0), C1,4); \
    GAPB(o[0]=__builtin_amdgcn_mfma_f32_32x32x16_bf16(PAF(3),VFR(3),o[0],0,0,0), C1,8); \
    GAPB(o[1]=__builtin_amdgcn_mfma_f32_32x32x16_bf16(PAF(3),VFR(7),o[1],0,0,0), C1,12); \
    }while(0)
  int t=1;
  #undef CMASK
  #define CMASK(P0,P1,t) BLKM(P0,P1,t)
  for(;t+5<NT;t+=2){
    STEP(pB0,pB1,pA0,pA1,t,true,true,true);     WAIT_BAR(2); RESC(); ROT();
    STEP(pA0,pA1,pB0,pB1,t+1,true,true,true);   WAIT_BAR(2); RESC(); ROT();
  }
  #undef CMASK
  #define CMASK(P0,P1,t) do{int jb_=(t)-(NT-4); if(jb_>=0)cmask(P0,P1,jb_,qrel,hi); else BLKM(P0,P1,t);}while(0)
  #define ENDW(tt) do{ if((tt)+3<NT){WAIT_BAR(2);} else if((tt)+2<NT){WAIT_BAR(1);} else {WAIT_BAR(0);} }while(0)
  for(;t+1<NT;t+=2){
    STEP(pB0,pB1,pA0,pA1,t,(t+3<NT),(t+1<NT),(t+1<NT));       ENDW(t);   RESC(); ROT();
    STEP(pA0,pA1,pB0,pB1,t+1,(t+4<NT),(t+2<NT),(t+2<NT));     ENDW(t+1); RESC(); ROT();
  }
  STEP(pB0,pB1,pA0,pA1,NT-1,false,false,false); RESC();
  { float sacc=pB0[0]+pB0[1]; _Pragma("unroll") for(int r=2;r<16;++r)sacc+=pB0[r]; _Pragma("unroll") for(int r=0;r<16;++r)sacc+=pB1[r]; l_reg+=sacc;
    pw0=(u32x4){PKW(pB0,0),PKW(pB0,2),PKW(pB0,4),PKW(pB0,6)};pw1=(u32x4){PKW(pB0,8),PKW(pB0,10),PKW(pB0,12),PKW(pB0,14)};pw2=(u32x4){PKW(pB1,0),PKW(pB1,2),PKW(pB1,4),PKW(pB1,6)};pw3=(u32x4){PKW(pB1,8),PKW(pB1,10),PKW(pB1,12),PKW(pB1,14)};
    SBAR(); pv(o,vb0+sl_cur,PAF(0),PAF(1),PAF(2),PAF(3)); }
  #undef PKW
  #undef PAF
  #undef VFR
  #undef PIN
  #undef MX3
  #undef GAPA
  #undef GAPB
  #undef EX
  #undef VRD
  #undef KRD
  #undef STEP
  #undef ENDW
  {auto rr=__builtin_amdgcn_permlane32_swap(__float_as_uint(l_reg),__float_as_uint(l_reg),false,false);l_reg=__uint_as_float(rr[0])+__uint_as_float(rr[1]);}
  if(hi==0)wsf[32+r32]=l_reg;asm volatile("s_waitcnt lgkmcnt(0)":::"memory");
  float rli[16];
  #pragma unroll
  for(int r=0;r<16;++r)rli[r]=__builtin_amdgcn_rcpf(wsf[32+crow(r,hi)]);
  bf16_t*Ow=Y+(rowbase+q0+wid*QBLK)*YW+512+h*64;
  { LAS bf16_t*stg=(LAS bf16_t*)(shm+LDS_OST)+wid*2048;
    #pragma unroll
    for(int r=0;r<16;++r){const int orow=crow(r,hi);
      #pragma unroll
      for(int d0=0;d0<2;++d0)stg[orow*64+d0*32+r32]=f2bf(o[d0][r]*rli[r]);}
    asm volatile("s_waitcnt lgkmcnt(0)":::"memory");
    #pragma unroll
    for(int i=0;i<4;++i){const int row=i*8+(lane>>3),ch=lane&7; const u32x4 v=*(LAS const u32x4*)(stg+row*64+ch*8); *(GAS u32x4*)(Ow+(long)row*YW+ch*8)=v;} }
  asm volatile("s_waitcnt lgkmcnt(0)\n\ts_barrier":::"memory");
  #undef DMA_K
  #undef DMA_V
  #undef CMASK
  #undef BLKM
  #undef START
  #undef RESC
  #undef ROT
}

#undef SBAR
#undef WAIT_BAR
}

namespace gla {
constexpr int PB = 144, PV = 272;
constexpr int L_LAR = 0, L_QR = 9216, L_KR = 18432, L_VR = 27648, L_RR = 45056, L_QD = 62464, L_KD = 71680, L_KTL = 80896, L_AM = 90112, L_DEC = 99328, L_SSQ = 99584, L_Y = 101632, L_END = 119040;
__device__ __forceinline__ f32x4 mfma16(bf16x8 a, bf16x8 b, f32x4 c) { return __builtin_amdgcn_mfma_f32_16x16x32_bf16(a, b, c, 0, 0, 0); }
__device__ __forceinline__ s16x4 trd(LAS const unsigned char* p) { return __builtin_bit_cast(s16x4, __builtin_amdgcn_ds_read_tr16_b64_v4i16((LAS v4i16_t*)p)); }
__device__ __forceinline__ bf16x8 tr_frag(LAS const unsigned char* img, int pitch, int k0, int c0, int lane) {
    const int g = lane >> 4, q = (lane & 15) >> 2, p = lane & 3;
    LAS const unsigned char* a = img + (k0 + 8 * g + q) * pitch + (c0 + 4 * p) * 2;
    const s16x4 lo = trd(a), hi = trd(a + 4 * pitch);
    return (bf16x8){lo[0], lo[1], lo[2], lo[3], hi[0], hi[1], hi[2], hi[3]};
}

template <int VAR = 0> __device__ __forceinline__ void gla_unit(const bf16_t* proj, bf16_t* Y, int b, int h, const float* gnorm, LAS unsigned char* lds) {
    int tid_ = threadIdx.x; asm volatile("" : "+v"(tid_));
    const int tid = tid_, lane = tid & 63, fr = lane & 15, fq = lane >> 4; const int wid = __builtin_amdgcn_readfirstlane(tid >> 6);
    const long rowbase = (long)b * SEQ;
    const int cq = 2304 + 64 * h, ck = 2560 + 64 * h, cv = 2816 + 128 * h, cla = 3328 + 64 * h, cr = 3584 + 128 * h;
    const int lt = tid >> 3, ldc = (tid & 7) * 8;
    const int vrow0 = tid >> 4, ve0 = (tid & 15) * 8;
    f32x4 sd[4];
#pragma unroll
    for (int i = 0; i < 4; ++i) sd[i] = (f32x4){0.f, 0.f, 0.f, 0.f};
    const f32x4 gn4 = *(const GAS f32x4*)(gnorm + 16 * wid + 4 * fq);
    u32x4 nq, nk, nla, nv0, nv1, nr0, nr1;
    {
        const bf16_t* base = proj + (rowbase + lt) * PP;
        nq = *(const GAS u32x4*)(base + cq + ldc); nk = *(const GAS u32x4*)(base + ck + ldc); nla = *(const GAS u32x4*)(base + cla + ldc);
        const bf16_t* bv = proj + (rowbase + vrow0) * PP;
        nv0 = *(const GAS u32x4*)(bv + cv + ve0); nv1 = *(const GAS u32x4*)(bv + (size_t)32 * PP + cv + ve0);
        nr0 = *(const GAS u32x4*)(bv + cr + ve0); nr1 = *(const GAS u32x4*)(bv + (size_t)32 * PP + cr + ve0);
    }
    LAS float* DEC = (LAS float*)(lds + L_DEC); LAS float* SSQ = (LAS float*)(lds + L_SSQ);
    const int db = wid & 3, ibp = wid >> 2;
    for (int n = 0; n < 32; ++n) {
        *(LAS u32x4*)(lds + L_LAR + lt * PB + ldc * 2) = nla; *(LAS u32x4*)(lds + L_QR + lt * PB + ldc * 2) = nq; *(LAS u32x4*)(lds + L_KR + lt * PB + ldc * 2) = nk;
        *(LAS u32x4*)(lds + L_VR + vrow0 * PV + ve0 * 2) = nv0; *(LAS u32x4*)(lds + L_VR + (vrow0 + 32) * PV + ve0 * 2) = nv1;
        const int rro = (n & 1) ? L_Y : L_RR;
        *(LAS u32x4*)(lds + rro + vrow0 * PV + ve0 * 2) = nr0; *(LAS u32x4*)(lds + rro + (vrow0 + 32) * PV + ve0 * 2) = nr1;
        if (n + 1 < 32) {
            const long r1 = rowbase + (long)(n + 1) * 64;
            const bf16_t* base = proj + (r1 + lt) * PP;
            nq = *(const GAS u32x4*)(base + cq + ldc); nk = *(const GAS u32x4*)(base + ck + ldc); nla = *(const GAS u32x4*)(base + cla + ldc);
            const bf16_t* bv = proj + (r1 + vrow0) * PP;
            nv0 = *(const GAS u32x4*)(bv + cv + ve0); nv1 = *(const GAS u32x4*)(bv + (size_t)32 * PP + cv + ve0);
            nr0 = *(const GAS u32x4*)(bv + cr + ve0); nr1 = *(const GAS u32x4*)(bv + (size_t)32 * PP + cr + ve0);
        }
        LDS_WAIT(); __builtin_amdgcn_s_barrier(); asm volatile("" ::: "memory");
        {
            bf16x8 af[2];
#pragma unroll
            for (int s = 0; s < 2; ++s) af[s] = tr_frag(lds + L_LAR, PB, 32 * s, 16 * db, lane);
            const u32x4 one4 = {0x3F803F80u, 0x3F803F80u, 0x3F803F80u, 0x3F803F80u};
            f32x4 bl = {0.f, 0.f, 0.f, 0.f};
            bl = mfma16(af[0], __builtin_bit_cast(bf16x8, one4), bl); bl = mfma16(af[1], __builtin_bit_cast(bf16x8, one4), bl);
#pragma unroll
            for (int rep = 0; rep < 2; ++rep) {
                const int ib = 2 * ibp + rep, i_ = 16 * ib + fr;
                f32x4 bc = {0.f, 0.f, 0.f, 0.f};
#pragma unroll
                for (int s = 0; s < 2; ++s) {
                    const int nones = i_ - (32 * s + 8 * fq) + 1;
                    u32x4 lw;
                    lw.x = (nones > 0 ? 0x3F80u : 0u) | (nones > 1 ? 0x3F800000u : 0u); lw.y = (nones > 2 ? 0x3F80u : 0u) | (nones > 3 ? 0x3F800000u : 0u);
                    lw.z = (nones > 4 ? 0x3F80u : 0u) | (nones > 5 ? 0x3F800000u : 0u); lw.w = (nones > 6 ? 0x3F80u : 0u) | (nones > 7 ? 0x3F800000u : 0u);
                    bc = mfma16(af[s], __builtin_bit_cast(bf16x8, lw), bc);
                }
                const int off = i_ * PB + (16 * db + 4 * fq) * 2;
                const u32x2 qw = *(LAS const u32x2*)(lds + L_QR + off), kw = *(LAS const u32x2*)(lds + L_KR + off);
                const float q4[4] = {bf_lo(qw.x), bf_hi(qw.x), bf_lo(qw.y), bf_hi(qw.y)}, k4[4] = {bf_lo(kw.x), bf_hi(kw.x), bf_lo(kw.y), bf_hi(kw.y)};
                float qd[4], kd[4], kt[4];
#pragma unroll
                for (int r = 0; r < 4; ++r) { qd[r] = q4[r] * fexp(bc[r]); kd[r] = k4[r] * fexp(-bc[r]); kt[r] = k4[r] * fexp(bl[r] - bc[r]); }
                *(LAS u32x2*)(lds + L_QD + off) = (u32x2){cvt_pk_bf16(qd[0], qd[1]), cvt_pk_bf16(qd[2], qd[3])};
                *(LAS u32x2*)(lds + L_KD + off) = (u32x2){cvt_pk_bf16(kd[0], kd[1]), cvt_pk_bf16(kd[2], kd[3])};
                *(LAS u32x2*)(lds + L_KTL + off) = (u32x2){cvt_pk_bf16(kt[0], kt[1]), cvt_pk_bf16(kt[2], kt[3])};
            }
            if (ibp == 0 && fr == 0) *(LAS f32x4*)(DEC + 16 * db + 4 * fq) = (f32x4){fexp(bl[0]), fexp(bl[1]), fexp(bl[2]), fexp(bl[3])};
        }
        LDS_WAIT(); __builtin_amdgcn_s_barrier(); asm volatile("" ::: "memory");
#pragma unroll
        for (int rep = 0; rep < 2; ++rep) {
            const int id = wid + 8 * rep, ib = id >> 2, jb = id & 3;
            u32x2 w = {0u, 0u};
            if (jb <= ib) {
                f32x4 a = {0.f, 0.f, 0.f, 0.f};
#pragma unroll
                for (int s = 0; s < 2; ++s) {
                    const bf16x8 ka = *(LAS const bf16x8*)(lds + L_KD + (16 * jb + fr) * PB + (32 * s + 8 * fq) * 2);
                    const bf16x8 qb_ = *(LAS const bf16x8*)(lds + L_QD + (16 * ib + fr) * PB + (32 * s + 8 * fq) * 2);
                    a = mfma16(ka, qb_, a);
                }
                const int i_ = 16 * ib + fr, j0 = 16 * jb + 4 * fq;
#pragma unroll
                for (int r = 0; r < 4; ++r) if (j0 + r > i_) a[r] = 0.f;
                w.x = cvt_pk_bf16(a[0], a[1]); w.y = cvt_pk_bf16(a[2], a[3]);
            }
            *(LAS u32x2*)(lds + L_AM + (16 * ib + fr) * PB + (16 * jb + 4 * fq) * 2) = w;
        }
        f32x4 ao[4];
        {
            bf16x8 sb[2];
#pragma unroll
            for (int s = 0; s < 2; ++s) { u32x4 w; w.x = cvt_pk_bf16(sd[2 * s][0], sd[2 * s][1]); w.y = cvt_pk_bf16(sd[2 * s][2], sd[2 * s][3]); w.z = cvt_pk_bf16(sd[2 * s + 1][0], sd[2 * s + 1][1]); w.w = cvt_pk_bf16(sd[2 * s + 1][2], sd[2 * s + 1][3]); sb[s] = __builtin_bit_cast(bf16x8, w); }
#pragma unroll
            for (int ib = 0; ib < 4; ++ib) {
                f32x4 a = {0.f, 0.f, 0.f, 0.f};
#pragma unroll
                for (int s = 0; s < 2; ++s) {
                    const u32x2 lo = *(LAS const u32x2*)(lds + L_QD + (16 * ib + fr) * PB + (32 * s + 4 * fq) * 2);
                    const u32x2 hi = *(LAS const u32x2*)(lds + L_QD + (16 * ib + fr) * PB + (32 * s + 16 + 4 * fq) * 2);
                    const u32x4 qa = {lo.x, lo.y, hi.x, hi.y};
                    a = mfma16(sb[s], __builtin_bit_cast(bf16x8, qa), a);
                }
                ao[ib] = a;
            }
        }
        LDS_WAIT(); __builtin_amdgcn_s_barrier(); asm volatile("" ::: "memory");
        {
            bf16x8 vf[2];
#pragma unroll
            for (int s = 0; s < 2; ++s) vf[s] = tr_frag(lds + L_VR, PV, 32 * s, 16 * wid, lane);
#pragma unroll
            for (int ib = 0; ib < 4; ++ib)
#pragma unroll
                for (int s = 0; s < 2; ++s) {
                    if (32 * s > 16 * ib + 15) continue;
                    const bf16x8 af = *(LAS const bf16x8*)(lds + L_AM + (16 * ib + fr) * PB + (32 * s + 8 * fq) * 2);
                    ao[ib] = mfma16(vf[s], af, ao[ib]);
                }
#pragma unroll
            for (int d4 = 0; d4 < 4; ++d4) {
                const f32x4 dc = *(LAS const f32x4*)(DEC + 16 * d4 + 4 * fq);
                f32x4 a = sd[d4] * dc;
#pragma unroll
                for (int s = 0; s < 2; ++s) { const bf16x8 kf = tr_frag(lds + L_KTL, PB, 32 * s, 16 * d4, lane); a = mfma16(kf, vf[s], a); }
                sd[d4] = a;
            }
        }
#pragma unroll
        for (int ib = 0; ib < 4; ++ib) { float v = (ao[ib][0] * ao[ib][0] + ao[ib][1] * ao[ib][1]) + (ao[ib][2] * ao[ib][2] + ao[ib][3] * ao[ib][3]); v = addx32(addx16(v));
            if (fq == 0) SSQ[(16 * ib + fr) * 8 + wid] = v; }
        LDS_WAIT(); __builtin_amdgcn_s_barrier(); asm volatile("" ::: "memory");
        {
            const long r0 = rowbase + (long)n * 64;
            u32x2 yw[4];
#pragma unroll
            for (int ib = 0; ib < 4; ++ib) { const int i_ = 16 * ib + fr;
                const f32x4 s0 = *(LAS const f32x4*)(SSQ + i_ * 8), s1 = *(LAS const f32x4*)(SSQ + i_ * 8 + 4);
                const float tot = ((s0[0] + s0[1]) + (s0[2] + s0[3])) + ((s1[0] + s1[1]) + (s1[2] + s1[3]));
                const float rstd = frsq(tot * (1.0f / 128.0f) + EPS);
                const u32x2 rw = *(LAS const u32x2*)(lds + rro + i_ * PV + (16 * wid + 4 * fq) * 2);
                const f32x4 y = ao[ib] * rstd * gn4 * (f32x4){bf_lo(rw.x), bf_hi(rw.x), bf_lo(rw.y), bf_hi(rw.y)};
                yw[ib] = (u32x2){cvt_pk_bf16(y[0], y[1]), cvt_pk_bf16(y[2], y[3])}; }
#pragma unroll
            for (int p2 = 0; p2 < 2; ++p2) {
                const auto rx = __builtin_amdgcn_permlane16_swap(yw[2 * p2].x, yw[2 * p2 + 1].x, false, false), ry = __builtin_amdgcn_permlane16_swap(yw[2 * p2].y, yw[2 * p2 + 1].y, false, false);
                *(GAS u32x4*)(Y + (r0 + 16 * (2 * p2 + (fq & 1)) + fr) * YW + 1024 + 128 * h + 16 * wid + 8 * (fq >> 1)) = (u32x4){rx[0], ry[0], rx[1], ry[1]}; }
        }
    }
    LDS_WAIT(); __builtin_amdgcn_s_barrier(); asm volatile("" ::: "memory");
}
}

constexpr int NWAVES = 8;
constexpr int RING_BYTES = 131072, MISC_OFF = RING_BYTES, LDS_BYTES = 147456;
static_assert(gla::L_END <= RING_BYTES && att::L_END <= RING_BYTES && att2::LDS_BYTES <= RING_BYTES, "LDS map");

struct Params { const float* in[20]; float* out; unsigned char* ws; double invf[32]; int ph_lo, ph_hi; };

__device__ __forceinline__ void norm_row(const float* xrow, const float* gain, bf16_t* orow, int lane) {
    const f32x4* xr = (const f32x4*)xrow + lane; const f32x4* gr = (const f32x4*)gain + lane;
    f32x4 v[4]; float s = 0.f;
#pragma unroll
    for (int j = 0; j < 4; ++j) { v[j] = xr[64 * j]; s += (v[j][0] * v[j][0] + v[j][1] * v[j][1]) + (v[j][2] * v[j][2] + v[j][3] * v[j][3]); }
    const float rstd = 1.0f / sqrtf(wave_sum(s) * (1.0f / D) + EPS);
    u32x2* o8 = (u32x2*)orow + lane;
#pragma unroll
    for (int j = 0; j < 4; ++j) { const f32x4 g = gr[64 * j]; u32x2 w; w.x = cvt_pk_bf16(v[j][0] * rstd * g[0], v[j][1] * rstd * g[1]); w.y = cvt_pk_bf16(v[j][2] * rstd * g[2], v[j][3] * rstd * g[3]); o8[64 * j] = w; }
}
__device__ __forceinline__ void norm_phase(const float* x, const float* gain, bf16_t* H, int gw, int ngw, int lane) {
    for (int m = gw; m < T; m += ngw) norm_row(x + (size_t)m * D, gain, H + (size_t)m * D, lane);
}

__device__ __forceinline__ void conv_item(const float* src, int pitch, int col, int K, bf16_t* dst, int prow, int k0, const float* kscale = nullptr) {
    const float* s = src + (size_t)k0 * pitch + col;
    bf16_t* d = dst + (size_t)prow * K + k0;
#pragma unroll 2
    for (int kk = 0; kk < 8; ++kk) {
        float v[8];
#pragma unroll
        for (int i = 0; i < 8; ++i) v[i] = s[(size_t)(kk * 8 + i) * pitch];
        if (kscale) {
#pragma unroll
            for (int i = 0; i < 8; ++i) v[i] *= kscale[k0 + kk * 8 + i]; }
        u32x4 w; w.x = cvt_pk_bf16(v[0], v[1]); w.y = cvt_pk_bf16(v[2], v[3]); w.z = cvt_pk_bf16(v[4], v[5]); w.w = cvt_pk_bf16(v[6], v[7]);
        *(GAS u32x4*)(d + kk * 8) = w;
    }
}
__device__ __forceinline__ void conv4_load(const float* src, int pitch, int k0, const float* kscale, float mul, f32x4 (&v)[16]) {
#pragma unroll
    for (int i = 0; i < 16; ++i) v[i] = *(const GAS f32x4*)(src + (size_t)(k0 + i) * pitch);
    if (kscale) {
#pragma unroll
        for (int i = 0; i < 16; ++i) v[i] *= kscale[k0 + i] * mul; }
}
__device__ __forceinline__ void conv4_store_bf16(const f32x4 (&v)[16], bf16_t* dst, int K) {
#pragma unroll
    for (int j = 0; j < 4; ++j) {
        *(GAS u32x4*)(dst + (size_t)j * K) = (u32x4){cvt_pk_bf16(v[0][j], v[1][j]), cvt_pk_bf16(v[2][j], v[3][j]), cvt_pk_bf16(v[4][j], v[5][j]), cvt_pk_bf16(v[6][j], v[7][j])};
        *(GAS u32x4*)(dst + (size_t)j * K + 8) = (u32x4){cvt_pk_bf16(v[8][j], v[9][j]), cvt_pk_bf16(v[10][j], v[11][j]), cvt_pk_bf16(v[12][j], v[13][j]), cvt_pk_bf16(v[14][j], v[15][j])}; }
}
__device__ __forceinline__ void conv4_store_fp8(const f32x4 (&v)[16], unsigned char* d8, int K) {
#pragma unroll
    for (int j = 0; j < 4; ++j)
        *(GAS u32x4*)(d8 + (size_t)j * K) = (u32x4){cvt4_fp8(v[0][j], v[1][j], v[2][j], v[3][j]), cvt4_fp8(v[4][j], v[5][j], v[6][j], v[7][j]), cvt4_fp8(v[8][j], v[9][j], v[10][j], v[11][j]), cvt4_fp8(v[12][j], v[13][j], v[14][j], v[15][j])};
}
constexpr int IT_WIN = (PW / 64) * (D / 64), IT_WG = (GW / 64) * (D / 64), IT_WB = 3 * (D / 64) * (512 / 64), IT_WO = (D / 64) * (D / 64), IT_F1 = (FFP / 64) * (D / 64), IT_F2 = (D / 64) * (FF / 64);
constexpr int IT_LAYER = IT_WIN + IT_WG + IT_WB + IT_WO + IT_F1 + IT_F2;

__device__ __forceinline__ void sincos_d(double a, float& c, float& s) {
    const double kq = rint(a * 0.63661977236758134308);
    double r = fma(-kq, 1.57079632679489655800e+00, a); r = fma(-kq, 6.12323399573676603587e-17, r);
    const double r2 = r * r;
    const double sp = r * (1.0 + r2 * (-1.0 / 6 + r2 * (1.0 / 120 + r2 * (-1.0 / 5040 + r2 * (1.0 / 362880 + r2 * (-1.0 / 39916800 + r2 * (1.0 / 6227020800.0)))))));
    const double cp = 1.0 + r2 * (-0.5 + r2 * (1.0 / 24 + r2 * (-1.0 / 720 + r2 * (1.0 / 40320 + r2 * (-1.0 / 3628800 + r2 * (1.0 / 479001600 + r2 * (-1.0 / 87178291200.0)))))));
    const int q = ((int)kq) & 3;
    const double ss = (q == 0) ? sp : (q == 1) ? cp : (q == 2) ? -sp : -cp;
    const double cc = (q == 0) ? cp : (q == 1) ? -sp : (q == 2) ? -cp : sp;
    c = (float)cc; s = (float)ss;
}

__device__ __forceinline__ void prologue(const Params& P, int gw, int ngw, int lane) {
    unsigned char* ws = P.ws;
    for (int rep = 0; rep < (DBG_DUP == 4 ? 2 : 1); ++rep)
    for (int it = gw; it < 2 * IT_LAYER; it += ngw) {
        const int l = it / IT_LAYER; int r = it - l * IT_LAYER;
        unsigned char* wl = ws + WS_W + (size_t)l * LW_BYTES;
        const int q4 = 4 * lane;
        if (r < IT_WIN) {
            const int pn = r / (D / 16), k0 = (r % (D / 16)) * 16, bj = (q4 >> 7) & 1, wc = (q4 >> 5) & 3, rem = q4 & 31, c = 256 * pn + 64 * wc + 32 * bj + rem, prow = 256 * pn + q4;
            const float* win = P.in[3] + (size_t)l * D * DIN; const float* ga = P.in[2] + (size_t)l * D;
            f32x4 v[16];
            if (pn < 2 || (pn >= 3 && pn < 7)) {
                conv4_load(win + c, DIN, k0, ga, WS8, v); conv4_store_fp8(v, wl + OFF_WIN8 + (size_t)prow * D + k0, D);
            } else if (pn == 13) {
                const float* wa = P.in[9] + (size_t)l * 16 * 256 + (c - 3328);
                f32x4 a[16];
#pragma unroll
                for (int q = 0; q < 16; ++q) a[q] = *(const GAS f32x4*)(wa + q * 256);
                const f32x4 wv = *(const GAS f32x4*)(win + (size_t)(k0 + (lane & 15)) * DIN + 3328 + 4 * (lane >> 4));
#pragma unroll
                for (int k = 0; k < 16; ++k) { f32x4 acc = {0.f, 0.f, 0.f, 0.f};
#pragma unroll
                    for (int q = 0; q < 16; ++q) acc += a[q] * __int_as_float(__builtin_amdgcn_readlane(__float_as_int(wv[q & 3]), k + 16 * (q >> 2)));
                    v[k] = acc * ga[k0 + k]; }
                conv4_store_bf16(v, (bf16_t*)(wl + OFF_WIN) + (size_t)prow * D + k0, D);
            } else { conv4_load(win + (pn >= 14 ? 3344 + (c - 3584) : c), DIN, k0, ga, 1.0f, v); conv4_store_bf16(v, (bf16_t*)(wl + OFF_WIN) + (size_t)prow * D + k0, D); }
            continue;
        }
        r -= IT_WIN;
        if (r < IT_WG) {
            const int prow = 256 * (r / (D / 16)) + q4, k0 = (r % (D / 16)) * 16; f32x4 v[16];
            conv4_load(P.in[3] + (size_t)l * D * DIN + 3856 + prow, DIN, k0, P.in[2] + (size_t)l * D, WS8, v); conv4_store_fp8(v, wl + OFF_WG + (size_t)prow * D + k0, D);
            continue; }
        r -= IT_WG;
        if (r < IT_WB) { const int j = r / (4 * 32), r2 = r % (4 * 32), prow = 256 * (r2 / 32) + q4, k0 = (r2 % 32) * 16; f32x4 v[16];
            conv4_load(P.in[12 + j] + (size_t)l * 512 * D + prow, D, k0, nullptr, 1.0f, v); conv4_store_bf16(v, (bf16_t*)(wl + OFF_WB) + (size_t)j * D * 512 + (size_t)prow * 512 + k0, 512); continue; }
        r -= IT_WB;
        if (r < IT_WO) { const int prow = 256 * (r / (D / 16)) + q4, k0 = (r % (D / 16)) * 16; f32x4 v[16];
            conv4_load(P.in[15] + (size_t)l * D * D + prow, D, k0, nullptr, 1.0f, v); conv4_store_bf16(v, (bf16_t*)(wl + OFF_WO) + (size_t)prow * D + k0, D); continue; }
        r -= IT_WO;
        if (r < IT_F1) { const int pn = r / (D / 16), k0 = (r % (D / 16)) * 16, prow = 256 * pn + q4, bj = (q4 >> 7) & 1, c = 128 * pn + (q4 & 127); f32x4 v[16];
            conv4_load(P.in[bj ? 18 : 17] + (size_t)l * D * FF + c, FF, k0, P.in[16] + (size_t)l * D, 1.0f, v); conv4_store_bf16(v, (bf16_t*)(wl + OFF_F1) + (size_t)prow * D + k0, D); continue; }
        r -= IT_F1;
        { const int prow = 256 * (r / (FF / 16)) + q4, k0 = (r % (FF / 16)) * 16; f32x4 v[16];
          conv4_load(P.in[19] + (size_t)l * FF * D + prow, D, k0, nullptr, 1.0f, v); conv4_store_bf16(v, (bf16_t*)(wl + OFF_F2) + (size_t)prow * FF + k0, FF); }
    }
    {
        bf16_t* rope = (bf16_t*)(ws + WS_ROPE); const int* pos = (const int*)P.in[1];
        for (int idx = gw * 64 + lane; idx < T * 4; idx += ngw * 64) {
            const int t = idx >> 2, i0 = (idx & 3) * 8; const double pt = (double)pos[t]; float c[8], sn[8];
#pragma unroll
            for (int j = 0; j < 8; ++j) sincos_d(pt * P.invf[i0 + j], c[j], sn[j]);
            *(GAS u32x4*)(rope + (size_t)t * 64 + i0) = (u32x4){cvt_pk_bf16(c[0], c[1]), cvt_pk_bf16(c[2], c[3]), cvt_pk_bf16(c[4], c[5]), cvt_pk_bf16(c[6], c[7])};
            *(GAS u32x4*)(rope + (size_t)t * 64 + 32 + i0) = (u32x4){cvt_pk_bf16(sn[0], sn[1]), cvt_pk_bf16(sn[2], sn[3]), cvt_pk_bf16(sn[4], sn[5]), cvt_pk_bf16(sn[6], sn[7])}; }
    }
    {
        float* SS = (float*)(ws + WS_SS); bf16_t* XB = (bf16_t*)P.out;
        for (int m = gw; m < T; m += ngw) {
            const f32x4* xr = (const f32x4*)(P.in[0] + (size_t)m * D) + 4 * lane; float s2 = 0.f;
            f32x4 v[4];
#pragma unroll
            for (int j = 0; j < 4; ++j) { v[j] = xr[j]; s2 += (v[j][0] * v[j][0] + v[j][1] * v[j][1]) + (v[j][2] * v[j][2] + v[j][3] * v[j][3]); }
            u32x4* ob = (u32x4*)(XB + (size_t)(m / RPG) * XSH + (size_t)m * D) + 2 * lane;
            ob[0] = pg8::pack8(v[0], v[1]); ob[1] = pg8::pack8(v[2], v[3]);
            u32x4 w8;
            w8.x = cvt4_fp8(v[0][0] * XS8, v[0][1] * XS8, v[0][2] * XS8, v[0][3] * XS8); w8.y = cvt4_fp8(v[1][0] * XS8, v[1][1] * XS8, v[1][2] * XS8, v[1][3] * XS8);
            w8.z = cvt4_fp8(v[2][0] * XS8, v[2][1] * XS8, v[2][2] * XS8, v[2][3] * XS8); w8.w = cvt4_fp8(v[3][0] * XS8, v[3][1] * XS8, v[3][2] * XS8, v[3][3] * XS8);
            ((u32x4*)(ws + WS_XB8 + (size_t)m * D))[lane] = w8;
            s2 = wave_sum(s2);
            if (lane == 0) SS[m] = s2;
        }
        for (int idx = gw * 64 + lane; idx < 3 * T; idx += ngw * 64) SS[T + idx] = 0.f;
    }
}

constexpr int Q_GLA = 8, Q_MOBA = 128, Q_SWA = 128;

__global__ void __launch_bounds__(NWAVES * 64, 2) mk_fwd(Params P) {
    extern __shared__ __attribute__((aligned(16))) unsigned char lds_raw[];
    LAS unsigned char* lds = (LAS unsigned char*)lds_raw;
    volatile LAS unsigned* MISC = (volatile LAS unsigned*)(lds + MISC_OFF);
    const int tid = threadIdx.x, lane = tid & 63, wave = __builtin_amdgcn_readfirstlane(tid >> 6);
    const int G = gridDim.x, bx = blockIdx.x;
    const int vcu = (G % 8 == 0) ? (bx % 8) * (G / 8) + bx / 8 : bx;
    const int gw = vcu * NWAVES + wave, ngw = G * NWAVES;
    unsigned char* ws = P.ws;
    unsigned* ctl = (unsigned*)(ws + WS_CTL);
    for (int u = tid; u < 64; u += NWAVES * 64) MISC[u] = 0u;
    __syncthreads();
    XcdBarrier bar; bar.bar = ctl + CW_BAR; bar.x = 0; bar.st = nullptr;
    if (!MK_PER_PHASE) bar = xcd_barrier_post(ctl + CW_BAR, MISC + 8);
    if (!MK_PER_PHASE && tid == 0) (void)__hip_atomic_fetch_or(ctl + CW_GMASK + 64 * (bx & 7), 1u << xb_xcc_id(), __ATOMIC_RELAXED, __HIP_MEMORY_SCOPE_AGENT);
    const int lo = P.ph_lo, hi = P.ph_hi;
    int fastg = 0; unsigned gbn = 0u;
#define IN(k) (lo <= (k) && (k) < hi)
#define SEAM(k) do { if (IN(k) && IN((k) + 1)) xcd_barrier(bar); } while (0)
#define SEAMG(k) do { if (IN(k) && IN((k) + 1)) { if (fastg) { ++gbn; grp_barrier(ctl + CW_GRP + 64 * (bx & 7), gbn * (unsigned)(G / 8), ctl + CW_BAR); } else xcd_barrier(bar); } } while (0)

#define Hb ((bf16_t*)(ws + WS_H + (size_t)grp * SH_H))
#define PROJ ((bf16_t*)(ws + WS_PROJ))
#define XS ((bf16_t*)P.out + (size_t)grp * XSH)
#define GATES ((bf16_t*)(ws + WS_PROJ + (size_t)grp * SH_GATES))
#define MERGED ((bf16_t*)(ws + WS_PROJ + OFF_MERGED_IN_SLAB + (size_t)grp * SH_MERGED))
#define ACT ((bf16_t*)(ws + WS_PROJ + (size_t)grp * SH_ACT))
#define Yb ((bf16_t*)(ws + WS_Y))
#define rope ((bf16_t*)(ws + WS_ROPE))
#define kmp ((float*)(ws + WS_KM))
#define SS ((float*)(ws + WS_SS))

    #ifndef DBG_NO_PRO
    if (IN(1)) { prologue(P, gw, ngw, lane); }
#endif
    SEAM(1);
    if (!MK_PER_PHASE && IN(1) && IN(2)) {
        if (tid == 0) { unsigned ok = (G % 8 == 0) ? 1u : 0u;
            for (int j = 0; j < 8; ++j) { const unsigned m = xb_ld(ctl + CW_GMASK + 64 * j); ok &= (m != 0u && (m & (m - 1u)) == 0u) ? 1u : 0u; }
            MISC[20] = ok; }
        __syncthreads();
        fastg = __builtin_amdgcn_readfirstlane((int)MISC[20]);
#ifdef DBG_FORCE_GRID_BARRIERS
        fastg = 0;
#endif
    }
    for (int l = 0; l < DEPTH; ++l) {
        const int pb = 9 * l;
        unsigned char* ws = P.ws; asm volatile("" : "+s"(ws));
        int lane_l = lane; asm volatile("" : "+v"(lane_l));
        int bxl = blockIdx.x; asm volatile("" : "+s"(bxl));
        const int grp = bxl & 7;
        unsigned char* wl = ws + WS_W + (size_t)l * LW_BYTES;
        if (IN(2 + pb)) for (int rep = 0; rep < (DBG_DUP == 2 ? 2 : 1); ++rep) {
            if (rep) xcd_barrier(bar);
#ifndef DBG_NO_EPIINPROJ
            {
                pg8::Gemm g{(const bf16_t*)(ws + WS_XB8), (const bf16_t*)(wl + OFF_WIN8), D / 2, D / 2, D / 2, 0, 0, nullptr, nullptr, 0, 0, 0, 0, 0, 1 << 30};
                pg8::TileOrderSub S; S.init(T, 6 * 256, G, bxl, 1); S.mode = 1;
                pg8::EpiInProjT<FP8_LATE> E{PROJ, rope, P.in[4] + l * 64, P.in[5] + l * 64, P.in[7] + l * 64, P.in[8] + l * 64, P.in[10] + l * 256, kmp, SS + (size_t)(2 * l) * T, 1.0f / (XS8 * WS8)};
                pg8::gemm_phase<pg8::EpiInProjT<FP8_LATE>, false, pg8::TileOrderSub, true>(lds, g, S, E, 0); }
            {
                pg8::Gemm g{XS, (const bf16_t*)(wl + OFF_WIN), D, D, D, 0, 0, nullptr, nullptr, 0, 0, 0, 0, 0, 1 << 30};
                pg8::TileOrderSub S; S.init(T, 10 * 256, G, bxl, 1); S.mode = 2;
                pg8::EpiInProj E{PROJ, rope, P.in[4] + l * 64, P.in[5] + l * 64, P.in[7] + l * 64, P.in[8] + l * 64, P.in[10] + l * 256, kmp, SS + (size_t)(2 * l) * T, 1.0f};
                pg8::gemm_phase<pg8::EpiInProj, false, pg8::TileOrderSub, false>(lds, g, S, E, 0); }
#endif
        }
        SEAMG(2 + pb);
        if (IN(3 + pb)) {
            unsigned* qctr = ctl + CW_Q + 256 * (8 * l + grp);
            int it = 0;
            for (;; ++it) {
                if (tid == 0) MISC[16 + (it & 1)] = __hip_atomic_fetch_add(qctr, 1u, __ATOMIC_RELAXED, __HIP_MEMORY_SCOPE_AGENT);
                __syncthreads();
                const int id = (int)MISC[16 + (it & 1)];
                if (id >= Q_GLA) break;
                gla::gla_unit(PROJ, Yb, 2 * grp + (id >> 2), id & 3, P.in[11] + l * 128, lds);
            }
            ++it;
            for (;; ++it) {
                if (tid == 0) MISC[16 + (it & 1)] = __hip_atomic_fetch_add(qctr + 64, 1u, __ATOMIC_RELAXED, __HIP_MEMORY_SCOPE_AGENT);
                __syncthreads();
                const int m = (int)MISC[16 + (it & 1)];
                if (m >= Q_MOBA) break;
                att2::moba_unit<8>(2 * grp + ((m >> 3) & 1), m & 7, 7 - (m >> 4), PROJ, Yb, kmp, lds);
            }
            ++it;
            for (;; ++it) {
                if (tid == 0) MISC[16 + (it & 1)] = __hip_atomic_fetch_add(qctr + 128, 1u, __ATOMIC_RELAXED, __HIP_MEMORY_SCOPE_AGENT);
                __syncthreads();
                const int sidx = (int)MISC[16 + (it & 1)];
                if (sidx >= Q_SWA) break;
                att::attn_unit<0>(PROJ, Yb, 2 * grp + (sidx >> 6), (sidx >> 5) & 1, sidx & 31, P.in[6] + l * 8, nullptr, lds);
            }
        }
        SEAMG(3 + pb);
        if (IN(4 + pb)) for (int rep = 0; rep < ((DBG_DUP >= 18 && DBG_DUP <= 22) ? 2 : 1); ++rep) {
            if (rep) xcd_barrier(bar);
            pg8::TileOrder S0; S0.init(T, D, G, bxl, 1);
            for (int ti = 0;; ++ti) {
                pg8::Unit u0; if (!S0.next(ti, u0)) break;
                if (!((DBG_DUP == 21 || DBG_DUP == 22) && rep == 0))
                { pg8::Gemm g{(const bf16_t*)(ws + WS_XB8), (const bf16_t*)(wl + OFF_WG), D / 2, D / 2, D / 2, 0, 0, nullptr, nullptr, 0, 0, 0, 0, 0, 1 << 30}; pg8::GateTriple S{u0.pm, u0.pn};
                  pg8::EpiGatesT<false> E{GATES, ((DBG_DUP == 19 || DBG_DUP == 20) && rep == 0) ? 1 : 0, SS + (size_t)(2 * l) * T, 0, 1.0f / (XS8 * WS8)};
                  pg8::gemm_phase<pg8::EpiGatesT<false>, false, pg8::GateTriple, true>(lds, g, S, E, 0); }
                if (!(DBG_DUP == 20 && rep == 0))
                { pg8::Gemm g{Yb, (const bf16_t*)(wl + OFF_WB), 512, YW, 512, 512, (long)D * 512, nullptr, nullptr, 0, 0, 0, 0, 0, 1 << 30}; pg8::SubTriple S{u0.pm, u0.pn};
                  pg8::EpiMerge E{GATES, MERGED, (DBG_DUP == 22 && rep == 0) ? 1 : 0};
                  pg8::gemm_phase<pg8::EpiMerge, false, pg8::SubTriple>(lds, g, S, E, 0); }
            }
        }
        SEAMG(4 + pb);
        if (IN(6 + pb)) for (int rep = 0; rep < ((DBG_DUP == 13 && l == 0) ? 2 : 1); ++rep) {
            if (rep) xcd_barrier(bar);
            pg8::Gemm g{MERGED, (const bf16_t*)(wl + OFF_WO), D, D, D, 0, 0, nullptr, nullptr, 0, 0, 0, 0, 0, 1 << 30}; pg8::TileOrder S; S.init(T, D, G, bxl, 1);
            pg8::EpiResid E{XS, nullptr, Hb, SS + (size_t)(2 * l + 1) * T, nullptr};
#ifndef DBG_NO_RESID
            pg8::gemm_phase<pg8::EpiResid>(lds, g, S, E, ((bxl >> 3) & 3) * STG_F);
#endif
        }
        SEAMG(6 + pb);
        if (DBG_DUP == 5) { for (int rep = 0; rep < 8; ++rep) xcd_barrier(bar); }
        if (IN(8 + pb)) for (int rep = 0; rep < ((DBG_DUP == 6 || DBG_DUP == 14 || DBG_DUP == 15 || DBG_DUP == 16) ? 2 : 1); ++rep) {
            if (DBG_DUP == 15 && rep == 0 && grp != 0) continue;
            if (rep && DBG_DUP == 15) { if (grp == 0) { ++gbn; grp_barrier(ctl + CW_GRP + 64 * (bx & 7), gbn * (unsigned)(G / 8), ctl + CW_BAR); } }
            else if (rep) xcd_barrier(bar);
            pg8::Gemm g{Hb, (const bf16_t*)(wl + OFF_F1), D, D, D, 0, 0, nullptr, nullptr, 0, 0, 0, 0, 0, 1 << 30}; pg8::TileOrder S; S.init(T, FFP, G, bxl, 1);
            pg8::EpiFfn1 E{ACT, SS + (size_t)(2 * l + 1) * T, ((DBG_DUP == 14 || DBG_DUP == 15 || DBG_DUP == 16) && rep == 0) ? 1 : 0};
#if DBG_DUP == 16
            if (rep == 0) { pg8::TileOrderFix SF; SF.init(T, FFP, G, bxl, 1); pg8::gemm_phase<pg8::EpiFfn1, false, pg8::TileOrderFix>(lds, g, SF, E, 0); continue; }
#endif
#if DBG_DUP == 17
            unsigned long long c0_ = 0, r0_ = 0; if (l == 0) { c0_ = __builtin_readcyclecounter(); r0_ = __builtin_amdgcn_s_memrealtime(); }
#endif
#ifndef DBG_NO_EPIFFN1
            pg8::gemm_phase<pg8::EpiFfn1>(lds, g, S, E, ((bxl >> 3) & 3) * STG_B);
#endif
#if DBG_DUP == 17
            if (l == 0 && tid == 0) { const unsigned long long c1_ = __builtin_readcyclecounter(), r1_ = __builtin_amdgcn_s_memrealtime(); MISC[24] = (unsigned)(((c1_ - c0_) * 2000ull) / (r1_ - r0_)); }
#endif
        }
        SEAMG(8 + pb);
        if (IN(9 + pb)) {
            pg8::Gemm g{ACT, (const bf16_t*)(wl + OFF_F2), FF, FF, FF, 0, 0, nullptr, nullptr, 0, 0, 0, 0, 0, 1 << 30}; pg8::TileOrder S; S.init(T, D, G, bxl, 1);
            pg8::EpiResid E{(const bf16_t*)Hb, (l + 1 < DEPTH) ? nullptr : P.out, (l + 1 < DEPTH) ? XS : nullptr, (l + 1 < DEPTH) ? SS + (size_t)(2 * l + 2) * T : nullptr, (l + 1 < DEPTH) ? ws + WS_XB8 : nullptr};
#ifndef DBG_NO_RESID
            pg8::gemm_phase<pg8::EpiResid>(lds, g, S, E, ((bxl >> 3) & 3) * STG_F);
#endif
        }
        SEAMG(9 + pb);
    }
#if DBG_DUP == 17
    if (bx == 0) { __syncthreads(); if (tid == 0) { const unsigned long long e_ = __builtin_amdgcn_s_memrealtime() + (unsigned long long)MISC[24]; while (__builtin_amdgcn_s_memrealtime() < e_) __builtin_amdgcn_s_sleep(8); } __syncthreads(); }
#endif
#undef IN
#undef SEAM
#undef SEAMG
#undef Hb
#undef PROJ
#undef XS
#undef GATES
#undef MERGED
#undef ACT
#undef Yb
#undef rope
#undef kmp
#undef SS
}

extern "C" void kernel_launch(void* const* d_in, const int* in_sizes, int n_in, void* d_out, int out_size, void* d_ws, size_t ws_size, hipStream_t stream) {
    static int grid = 0;
    if (grid == 0) {
        if (n_in != 20 || out_size != T * D || ws_size < WS_END) { fprintf(stderr, "kernel_launch: unexpected problem (n_in %d, out %d, ws %zu < %zu)\n", n_in, out_size, ws_size, (size_t)WS_END); grid = -1; return; }
        int dev = 0, cus = 0;
        if (hipGetDevice(&dev) != hipSuccess || hipDeviceGetAttribute(&cus, hipDeviceAttributeMultiprocessorCount, dev) != hipSuccess) { grid = -1; return; }
        if (hipFuncSetAttribute((const void*)mk_fwd, hipFuncAttributeMaxDynamicSharedMemorySize, LDS_BYTES) != hipSuccess) { fprintf(stderr, "kernel_launch: hipFuncSetAttribute failed\n"); grid = -1; return; }
        int per_cu = 0;
        if (hipOccupancyMaxActiveBlocksPerMultiprocessor(&per_cu, (const void*)mk_fwd, NWAVES * 64, LDS_BYTES) != hipSuccess || per_cu < 1) fprintf(stderr, "kernel_launch: occupancy query says %d\n", per_cu);
        (void)hipGetLastError();
        grid = (cus / 8) * 8;
    }
    if (grid < 0) return;
    (void)hipMemsetAsync((char*)d_ws + WS_CTL, 0, CTL_ZERO_BYTES, stream);
    Params p{};
    for (int i = 0; i < 20; ++i) p.in[i] = (const float*)d_in[i];
    p.out = (float*)d_out; p.ws = (unsigned char*)d_ws;
    for (int i = 0; i < 32; ++i) p.invf[i] = std::pow(10000.0, -(double)i / 32.0);
#if MK_PER_PHASE
    for (int k = 1; k <= 18; ++k) { p.ph_lo = k; p.ph_hi = k + 1; hipLaunchKernelGGL(mk_fwd, dim3(grid), dim3(NWAVES * 64), LDS_BYTES, stream, p); }
#else
    p.ph_lo = 1; p.ph_hi = 19;
    hipLaunchKernelGGL(mk_fwd, dim3(grid), dim3(NWAVES * 64), LDS_BYTES, stream, p);
#endif
}
```

```cpp
#include <hip/hip_runtime.h>
#include <cstdint>
#include <cstdio>
#include <cmath>

#ifndef MK_PER_PHASE
#define MK_PER_PHASE 0
#endif

#ifndef DBG_DUP
#define DBG_DUP 0
#endif
#ifndef STG_B
#define STG_B 0
#endif
#ifndef FP8_LATE
#define FP8_LATE false
#endif
#ifndef STG_F
#define STG_F 0
#endif
#define GAS __attribute__((address_space(1)))
#define LAS __attribute__((address_space(3)))
typedef unsigned short bf16_t;
typedef short bf16x8 __attribute__((ext_vector_type(8)));
typedef short s16x4 __attribute__((ext_vector_type(4)));
typedef short v4i16_t __attribute__((ext_vector_type(4)));
typedef float f32x2 __attribute__((ext_vector_type(2)));
typedef float f32x4 __attribute__((ext_vector_type(4)));
typedef float f32x16 __attribute__((ext_vector_type(16)));
typedef unsigned u32x2 __attribute__((ext_vector_type(2)));
typedef unsigned u32x4 __attribute__((ext_vector_type(4)));
typedef __bf16 bf16x2_t __attribute__((ext_vector_type(2)));
typedef int v8i_t __attribute__((ext_vector_type(8)));

constexpr int T = 32768, SEQ = 2048, NBATCH = 16, D = 1024, DEPTH = 2;
constexpr int PP = 4096 + 64;
constexpr int PW = 4096;
constexpr int GW = 3072;
constexpr int YW = 1536;
constexpr int FF = 2816, FFP = 5632;
constexpr int DIN = 6928;
constexpr float EPS = 1e-6f;
constexpr float LOG2E = 1.4426950408889634f;
constexpr float C2 = 0.125f * LOG2E;

constexpr size_t MiB = 1u << 20;
constexpr size_t WS_CTL = 0, CTL_ZERO_BYTES = 128 * 1024;
constexpr size_t OFF_WIN = 0, OFF_WG = OFF_WIN + (size_t)PW * D * 2  , OFF_WB = OFF_WG + (size_t)GW * D, OFF_WO = OFF_WB + (size_t)3 * D * 512 * 2,
                 OFF_F1 = OFF_WO + (size_t)D * D * 2, OFF_F2 = OFF_F1 + (size_t)FFP * D * 2, OFF_WIN8 = OFF_F2 + (size_t)D * FF * 2  , LW_BYTES = OFF_WIN8 + (size_t)PW * D;
constexpr size_t WS_W = 1 * MiB;
constexpr size_t WS_ROPE = WS_W + 2 * LW_BYTES;
constexpr size_t WS_KM = WS_ROPE + (size_t)T * 64 * 4;
constexpr size_t WS_SS = WS_KM + 512 * 1024;
constexpr size_t WS_H = WS_KM + 1 * MiB;
constexpr size_t WS_PROJ = WS_H + (size_t)T * YW * 2;
constexpr size_t WS_MERGED = WS_PROJ + (size_t)T * GW * 2;
constexpr size_t WS_Y = WS_H;
constexpr size_t WS_XB8 = WS_PROJ + (size_t)T * PP * 2;
constexpr size_t WS_END = WS_XB8 + (size_t)T * D;
static_assert(WS_ROPE % 256 == 0 && WS_END <= 512 * MiB, "workspace map");
constexpr int CW_TMO = 0, CW_BAR = 4096, CW_Q = 16384;
constexpr int CW_GRP = 8192, CW_GMASK = 9216;
constexpr int RPG = T / 8;
constexpr size_t SLAB = (size_t)RPG * PP * 2;
constexpr size_t SH_H = (size_t)RPG * (YW - D) * 2, SH_GATES = SLAB - (size_t)RPG * GW, SH_MERGED = SLAB - (size_t)RPG * D * 2, SH_ACT = SLAB - (size_t)RPG * FF * 2;
constexpr size_t OFF_MERGED_IN_SLAB = (size_t)RPG * GW;
constexpr size_t XSH = (size_t)RPG * D;
static_assert(OFF_MERGED_IN_SLAB + (size_t)RPG * D * 2 <= SLAB && (size_t)RPG * FF * 2 <= SLAB, "group slabs");

__device__ __forceinline__ unsigned cvt_pk_bf16(float lo, float hi) { f32x2 v = {lo, hi}; bf16x2_t b = __builtin_convertvector(v, bf16x2_t); return __builtin_bit_cast(unsigned, b); }
__device__ __forceinline__ float bf_lo(unsigned w) { return __uint_as_float(w << 16); }
__device__ __forceinline__ float bf_hi(unsigned w) { return __uint_as_float(w & 0xffff0000u); }
__device__ __forceinline__ float bf1(bf16_t x) { return __uint_as_float(((unsigned)x) << 16); }
__device__ __forceinline__ bf16_t f2bf(float f) { return (bf16_t)(cvt_pk_bf16(f, 0.f) & 0xffffu); }
__device__ __forceinline__ unsigned cvt4_fp8(float a, float b, float c, float d) { unsigned w = 0; w = __builtin_amdgcn_cvt_pk_fp8_f32(a, b, w, false); w = __builtin_amdgcn_cvt_pk_fp8_f32(c, d, w, true); return w; }
constexpr float XS8 = 16.0f, WS8 = 64.0f;
__device__ __forceinline__ float fexp2(float x) { return __builtin_amdgcn_exp2f(x); }
__device__ __forceinline__ float fexp(float x) { return __builtin_amdgcn_exp2f(x * LOG2E); }
__device__ __forceinline__ float frcp(float x) { return __builtin_amdgcn_rcpf(x); }
__device__ __forceinline__ float frsq(float x) { return __builtin_amdgcn_rsqf(x); }
__device__ __forceinline__ float sigmoidf_(float x) { return frcp(1.f + fexp(-x)); }
template <int CTRL> __device__ __forceinline__ float dpp_f(float v) { return __builtin_bit_cast(float, __builtin_amdgcn_update_dpp(0, __builtin_bit_cast(int, v), CTRL, 0xf, 0xf, true)); }
__device__ __forceinline__ float sum16(float v) { v += dpp_f<0xB1>(v); v += dpp_f<0x4E>(v); v += dpp_f<0x141>(v); v += dpp_f<0x140>(v); return v; }
__device__ __forceinline__ float addx16(float v) { auto r = __builtin_amdgcn_permlane16_swap(__float_as_uint(v), __float_as_uint(v), false, false); return __uint_as_float(r[0]) + __uint_as_float(r[1]); }
__device__ __forceinline__ float addx32(float v) { auto r = __builtin_amdgcn_permlane32_swap(__float_as_uint(v), __float_as_uint(v), false, false); return __uint_as_float(r[0]) + __uint_as_float(r[1]); }
__device__ __forceinline__ float maxx32(float v) { auto r = __builtin_amdgcn_permlane32_swap(__float_as_uint(v), __float_as_uint(v), false, false); return fmaxf(__uint_as_float(r[0]), __uint_as_float(r[1])); }
__device__ __forceinline__ float wave_sum(float v) { return addx32(addx16(sum16(v))); }
#define LDS_WAIT() asm volatile("s_waitcnt lgkmcnt(0)" ::: "memory")
#define VM_WAIT() asm volatile("s_waitcnt vmcnt(0)" ::: "memory")

#define XB_TMO      128
#define XB_XCNT(j)  (256  + 64 * (j))
#define XB_XSUB(j)  (1280 + 64 * (j))
#define XB_XGEN(j)  (2304 + 64 * (j))
#define XB_TOP      3328
#define XB_TOPGEN   3392
#define XCD_BAR_WORDS 3456
#define XB_SPIN_CAP (1u << 18)
__device__ __forceinline__ unsigned xb_ld(unsigned* p)              { return __hip_atomic_load(p, __ATOMIC_RELAXED, __HIP_MEMORY_SCOPE_AGENT); }
__device__ __forceinline__ unsigned xb_add(unsigned* p, unsigned v) { return __hip_atomic_fetch_add(p, v, __ATOMIC_RELAXED, __HIP_MEMORY_SCOPE_AGENT); }
__device__ __forceinline__ unsigned xb_xcc_id() { return (unsigned)__builtin_amdgcn_s_getreg((3 << 11) | 20) & 0xFu; }
#define XB_SPIN(cond, bar) do { unsigned _sp = 0; while (cond) { __builtin_amdgcn_s_sleep(1); \
    if ((++_sp & 255u) == 0u) { if (xb_ld(&(bar)[XB_TMO])) break; if (_sp > XB_SPIN_CAP) { atomicAdd(&(bar)[XB_TMO], 1u); break; } } } } while (0)
struct XcdBarrier { unsigned* bar; unsigned x; volatile LAS unsigned* st; };
__device__ __forceinline__ XcdBarrier xcd_barrier_post(unsigned* bar, volatile LAS unsigned* st) {
    XcdBarrier b; b.bar = bar; b.x = xb_xcc_id(); b.st = st;
    if (threadIdx.x == 0) (void)xb_add(&bar[XB_XCNT(b.x)], 1u);
    return b;
}
__device__ __forceinline__ void xcd_barrier_complete(unsigned* bar, unsigned x, unsigned& nloc, unsigned& nx) {
    const unsigned G = gridDim.x * gridDim.y * gridDim.z;
    unsigned sum, cnt, mine, sp = 0u;
    for (;;) {
        sum = 0u; cnt = 0u; mine = 0u;
#pragma unroll
        for (unsigned j = 0; j < 16; ++j) { const unsigned c = xb_ld(&bar[XB_XCNT(j)]); sum += c; cnt += (c > 0u) ? 1u : 0u; mine = (j == x) ? c : mine; }
        if (sum == G) break;
        __builtin_amdgcn_s_sleep(1);
        if ((++sp & 255u) == 0u) { if (xb_ld(&bar[XB_TMO])) break; if (sp > XB_SPIN_CAP) { atomicAdd(&bar[XB_TMO], 1u); break; } }
    }
    nloc = mine > 0u ? mine : 1u; nx = cnt > 0u ? cnt : 1u;
}
__device__ __forceinline__ void xcd_barrier(const XcdBarrier& b) {
    asm volatile("s_waitcnt vmcnt(0)" ::: "memory");
    __syncthreads();
    if (threadIdx.x == 0) {
        unsigned* bar = b.bar;
        __builtin_amdgcn_s_waitcnt(0);
        unsigned nloc = b.st[0], nx = b.st[1];
        if (nloc == 0u) { xcd_barrier_complete(bar, b.x, nloc, nx); b.st[0] = nloc; b.st[1] = nx; }
        const unsigned old = xb_add(&bar[XB_XSUB(b.x)], 1u);
        const unsigned gen = old / nloc;
        if (old + 1u == (gen + 1u) * nloc) {
            __builtin_amdgcn_fence(__ATOMIC_RELEASE, "agent");
            asm volatile("s_waitcnt vmcnt(0)" ::: "memory");
            const unsigned og = xb_add(&bar[XB_TOP], 1u);
            const unsigned tg = og / nx;
            if (og + 1u == (tg + 1u) * nx) xb_add(&bar[XB_TOPGEN], 1u);
            else XB_SPIN(xb_ld(&bar[XB_TOPGEN]) == tg, bar);
            __builtin_amdgcn_fence(__ATOMIC_ACQUIRE, "agent");
            xb_add(&bar[XB_XGEN(b.x)], 1u);
            asm volatile("s_waitcnt vmcnt(0)" ::: "memory");
        } else {
            XB_SPIN(xb_ld(&bar[XB_XGEN(b.x)]) == gen, bar);
            __builtin_amdgcn_fence(__ATOMIC_ACQUIRE, "agent");
            asm volatile("s_waitcnt vmcnt(0)" ::: "memory");
        }
    }
    __syncthreads();
}

__device__ __forceinline__ void grp_barrier(unsigned* gword, unsigned target, unsigned* bar) {
    asm volatile("s_waitcnt vmcnt(0)" ::: "memory");
    __syncthreads();
    if (threadIdx.x == 0) {
        __builtin_amdgcn_s_waitcnt(0);
        (void)xb_add(gword, 1u);
        __builtin_amdgcn_fence(__ATOMIC_ACQUIRE, "agent");
        XB_SPIN(xb_ld(gword) < target, bar);
        asm volatile("s_waitcnt vmcnt(0)" ::: "memory");
    }
    __syncthreads();
}

namespace pg8 {
constexpr int BM = 256, BK = 64, HALF = 128, HTB = HALF * BK * 2, STAGE_BYTES = 8 * HTB, NXCD = 8, WGM = 8;
__host__ __device__ __forceinline__ int lds_byte(int r, int c) { const int st = (r >> 4) * 2 + (c >> 5), rr = r & 15, cc = c & 31, ob = rr * 64 + cc * 2; return st * 1024 + (ob ^ (((ob >> 9) & 1) << 5)); }
__host__ __device__ __forceinline__ void stage_rc(int b, int& R, int& C) { const int st = b / 1024, sb = b % 1024, swz = sb ^ (((sb >> 9) & 1) << 5); R = (st >> 1) * 16 + swz / 64; C = (st & 1) * 32 + (swz % 64) / 2; }
__host__ __device__ __forceinline__ int perm32(int rho) { const int n = rho >> 4, i = rho & 15; return 8 * (i >> 2) + 4 * n + (i & 3); }

struct Unit { int pm, pn, sub; };
struct Gemm { const bf16_t* A; const bf16_t* Bt; int K, lda, ldb; long a_sub, b_sub;
              const bf16_t* A1; const bf16_t* Bt1; int K1, lda1, ldb1; long a_sub1, b_sub1; int sub1; };

struct TileOrder {
    int nM, nN, nwg, G, c, nsub;
    __device__ __forceinline__ void init(int M, int N, int G_, int c_, int nsub_) { nM = M / BM; nN = N / BM; nwg = nM * nN; G = G_; c = c_; nsub = nsub_; }
    __device__ __forceinline__ bool next(int i, Unit& u) const {
        const int ti = i / nsub; u.sub = i - ti * nsub;
        const long L = (long)ti * G + c; if (L >= nwg) return false;
        int wgid = (int)L; { const int q = nwg / NXCD, r = nwg % NXCD, xcd = wgid % NXCD, off = wgid / NXCD; wgid = (xcd < r ? xcd * (q + 1) : r * (q + 1) + (xcd - r) * q) + off; }
        const int nig = WGM * nN, gid = wgid / nig, fm = gid * WGM, gsz = (nM - fm) < WGM ? (nM - fm) : WGM;
        u.pm = fm + ((wgid % nig) % gsz); u.pn = (wgid % nig) / gsz; return true;
    }
};

struct TileOrderBal : TileOrder {
    __device__ __forceinline__ bool next(int i, Unit& u) const { if (!TileOrder::next(i, u)) return false;
        const unsigned long long tab = 0xCBA8FD97E2654310ull;
        u.pn = (int)((tab >> (4 * u.pn)) & 15ull); return true; } };
struct TileOrderFix : TileOrder { __device__ __forceinline__ bool next(int i, Unit& u) const { if (!TileOrder::next(i, u)) return false; u.pm &= 1; u.pn &= 1; return true; } };
struct TileOrderSub : TileOrder { int mode;
    __device__ __forceinline__ bool next(int i, Unit& u) const { if (!TileOrder::next(i, u)) return false; u.pn = (mode == 1) ? u.pn + (u.pn >= 2 ? 1 : 0) : (u.pn == 0 ? 2 : u.pn + 6); return true; } };
struct GateTriple { int pm, pn; __device__ __forceinline__ bool next(int i, Unit& u) const { if (i >= 3) return false; u.pm = pm; u.pn = 4 * i + pn; u.sub = 0; return true; } };
struct SubTriple { int pm, pn; __device__ __forceinline__ bool next(int i, Unit& u) const { if (i >= 3) return false; u.pm = pm; u.pn = pn; u.sub = i; return true; } };

typedef f32x4 Acc[2][2][4][2];

template <class Epi, bool DUAL = false, class Sched = TileOrder, bool F8 = false>
__device__ __forceinline__ void gemm_phase(LAS unsigned char* lds, const Gemm g, const Sched& S, const Epi& E, int stagger = 0) {
    for (int i_ = 0; i_ < stagger; ++i_) __builtin_amdgcn_s_sleep(32);
    int tid_ = threadIdx.x; asm volatile("" : "+v"(tid_));
    const int tid = tid_, wid = __builtin_amdgcn_readfirstlane(tid >> 6), lane = tid & 63, wr = wid >> 2, wc = wid & 3, fr = lane & 15, fq = lane >> 4;
    const size_t kstep = (size_t)(BK * 2);
    const unsigned ldsw = (unsigned)wid * 1024u;
    const int aoff = F8 ? lds_byte(wr * 64 + fr, fq * 16) : lds_byte(wr * 64 + fr, fq * 8), boff = F8 ? lds_byte(wc * 32 + fr, fq * 16) : lds_byte(wc * 32 + fr, fq * 8);
#define PG8_SA(b, h) (((b) * 2 + (h)) * HTB)
#define PG8_SB(b, h) ((4 + (b) * 2 + (h)) * HTB)
#define PG8_STAGE(bufoff, gbase, voff, hs) do { _Pragma("unroll") for (int _i = 0; _i < 2; ++_i) \
        __builtin_amdgcn_global_load_lds((const unsigned*)((const char*)(gbase) + (size_t)_i * (hs) + (voff)), (LAS unsigned*)(lds + (bufoff) + ldsw + _i * 8192), 16, 0, 0); } while (0)
#define PG8_LD32(p) __builtin_bit_cast(v8i_t, __builtin_shufflevector(*(const LAS bf16x8*)(p), *(const LAS bf16x8*)((p) + 16), 0, 1, 2, 3, 4, 5, 6, 7, 8, 9, 10, 11, 12, 13, 14, 15))
#define PG8_LDA(dst, b, h) do { if constexpr (F8) { _Pragma("unroll") for (int m = 0; m < 4; ++m) dst##8[m] = PG8_LD32(lds + PG8_SA(b, h) + aoff + m * 2048); } \
        else { _Pragma("unroll") for (int m = 0; m < 4; ++m) _Pragma("unroll") for (int k = 0; k < 2; ++k) dst[m][k] = *(const LAS bf16x8*)(lds + PG8_SA(b, h) + aoff + m * 2048 + k * 1024); } } while (0)
#define PG8_LDB(dst, b, h) do { if constexpr (F8) { _Pragma("unroll") for (int n = 0; n < 2; ++n) dst##8[n] = PG8_LD32(lds + PG8_SB(b, h) + boff + n * 2048); } \
        else { _Pragma("unroll") for (int n = 0; n < 2; ++n) _Pragma("unroll") for (int k = 0; k < 2; ++k) dst[n][k] = *(const LAS bf16x8*)(lds + PG8_SB(b, h) + boff + n * 2048 + k * 1024); } } while (0)
#define PG8_MMA(ai, bj, At, Bt) do { __builtin_amdgcn_s_setprio(1); _Pragma("unroll") for (int m = 0; m < 4; ++m) _Pragma("unroll") for (int n = 0; n < 2; ++n) { \
        if constexpr (F8) asm volatile("v_mfma_scale_f32_16x16x128_f8f6f4 %0, %1, %2, %0, %3, %3 op_sel_hi:[0,0,0]" : "+v"(acc[ai][bj][m][n]) : "v"(Bt##8[n]), "v"(At##8[m]), "v"(sc8));   \
        else { _Pragma("unroll") for (int k = 0; k < 2; ++k) acc[ai][bj][m][n] = __builtin_amdgcn_mfma_f32_16x16x32_bf16(Bt[n][k], At[m][k], acc[ai][bj][m][n], 0, 0, 0); } } \
        __builtin_amdgcn_s_setprio(0); } while (0)
#define PG8_WAIT_V(n) asm volatile("s_waitcnt vmcnt(" #n ")" ::: "memory")
#define PG8_WAIT_L(n) asm volatile("s_waitcnt lgkmcnt(" #n ")" ::: "memory")
#define PG8_WAIT_VX(flag) do { if constexpr (Epi::NST == 8) asm volatile("s_cmp_eq_u32 %0, 0\n\ts_cbranch_scc1 1f\n\ts_waitcnt vmcnt(16)\n\ts_branch 2f\n1:\n\ts_waitcnt vmcnt(8)\n2:" :: "s"(flag) : "memory", "scc"); \
        else if constexpr (Epi::NST == 16) asm volatile("s_cmp_eq_u32 %0, 0\n\ts_cbranch_scc1 1f\n\ts_waitcnt vmcnt(24)\n\ts_branch 2f\n1:\n\ts_waitcnt vmcnt(8)\n2:" :: "s"(flag) : "memory", "scc"); \
        else if constexpr (Epi::NST == 32) asm volatile("s_cmp_eq_u32 %0, 0\n\ts_cbranch_scc1 1f\n\ts_waitcnt vmcnt(40)\n\ts_branch 2f\n1:\n\ts_waitcnt vmcnt(8)\n2:" :: "s"(flag) : "memory", "scc"); \
        else asm volatile("s_waitcnt vmcnt(8)" ::: "memory"); } while (0)
#define PG8_BAR __builtin_amdgcn_s_barrier()
#define PG8_SCHED __builtin_amdgcn_sched_barrier(0)
#define PG8_KIND(u) (DUAL && (u).sub >= g.sub1)
#define PG8_ABASE(u) (PG8_KIND(u) ? (const char*)g.A1 + ((size_t)(u).pm * BM * g.lda1 + (size_t)((u).sub - g.sub1) * g.a_sub1) * 2 : (const char*)g.A + ((size_t)(u).pm * BM * g.lda + (size_t)(u).sub * g.a_sub) * 2)
#define PG8_BBASE(u) (PG8_KIND(u) ? (const char*)g.Bt1 + ((size_t)(u).pn * BM * g.ldb1 + (size_t)((u).sub - g.sub1) * g.b_sub1) * 2 : (const char*)g.Bt + ((size_t)(u).pn * BM * g.ldb + (size_t)(u).sub * g.b_sub) * 2)
#define PG8_VOFF(kd, vA, vB) do { const bool k_ = (kd); const int la_ = k_ ? g.lda1 : g.lda, lb_ = k_ ? g.ldb1 : g.ldb; \
        vA = (unsigned)(sR * la_ + sC) * 2u; vB = (unsigned)(sRb * lb_ + sC) * 2u; } while (0)
#define PG8_SETCFG(kd, hA, hB, ntv) do { const bool k_ = (kd); hA = (size_t)HALF * (k_ ? g.lda1 : g.lda) * 2; hB = (size_t)HALF * (k_ ? g.ldb1 : g.ldb) * 2; ntv = (k_ ? g.K1 : g.K) / BK; } while (0)
    Unit cur, nxt; int ui = 0;
    if (!S.next(0, cur)) return;
    Acc acc;
#pragma unroll
    for (int a = 0; a < 2; ++a)
#pragma unroll
        for (int b = 0; b < 2; ++b)
#pragma unroll
            for (int m = 0; m < 4; ++m)
#pragma unroll
                for (int n = 0; n < 2; ++n) acc[a][b][m][n] = (f32x4){0.f, 0.f, 0.f, 0.f};
    bf16x8 At[4][2], B0[2][2], B1[2][2];
    v8i_t At8[4], B08[2], B18[2];
    const int sc8 = 0x7f7f7f7f;
    float pre[8];
#pragma unroll
    for (int i = 0; i < 8; ++i) pre[i] = 0.f;
    const char* cA = PG8_ABASE(cur); const char* cB = PG8_BBASE(cur);
    int sR, sC; stage_rc(tid * 16, sR, sC); const int sRb = Epi::PERM ? ((sR & ~31) + perm32(sR & 31)) : sR;
    unsigned voffA, voffB; size_t hstepA, hstepB, xhA, xhB; int nt, xnt; bool xkind;
    PG8_VOFF(PG8_KIND(cur), voffA, voffB); PG8_SETCFG(PG8_KIND(cur), hstepA, hstepB, nt);
    PG8_STAGE(PG8_SB(0, 0), cB, voffB, hstepB >> 1); PG8_STAGE(PG8_SB(0, 1), cB + hstepB, voffB, hstepB >> 1); PG8_STAGE(PG8_SA(0, 0), cA, voffA, hstepA >> 1); PG8_STAGE(PG8_SA(0, 1), cA + hstepA, voffA, hstepA >> 1);
    if (wr == 1) PG8_BAR;
    PG8_WAIT_V(2); PG8_BAR;
    PG8_STAGE(PG8_SB(1, 0), cB + kstep, voffB, hstepB >> 1); PG8_STAGE(PG8_SA(1, 0), cA + kstep, voffA, hstepA >> 1); PG8_STAGE(PG8_SB(1, 1), cB + hstepB + kstep, voffB, hstepB >> 1);
    PG8_WAIT_V(6); PG8_BAR;
    for (;;) {
        const bool has_next = S.next(ui + 1, nxt);
        const char* nA = has_next ? PG8_ABASE(nxt) : cA; const char* nB = has_next ? PG8_BBASE(nxt) : cB;
        xkind = has_next ? PG8_KIND(nxt) : PG8_KIND(cur); PG8_SETCFG(xkind, xhA, xhB, xnt);
        for (int t = 0; t < nt; t += 2) {
            const bool last = (t == nt - 2);
            const char* a1 = cA + (size_t)(t + 1) * kstep;
            const char* a2 = last ? nA : cA + (size_t)(t + 2) * kstep; const char* b2 = last ? nB : cB + (size_t)(t + 2) * kstep;
            const char* a3 = a2 + kstep; const char* b3 = b2 + kstep;
            unsigned vA2 = voffA, vB2 = voffB;
            if (DUAL && last) PG8_VOFF(xkind, vA2, vB2);
            const size_t hA2 = last ? xhA : hstepA, hB2 = last ? xhB : hstepB;
            if (last) E.prefetch(cur, pre);
            const int rxi = __builtin_amdgcn_readfirstlane(((Epi::NST > 0) && (t == 0) && (ui > 0)) ? 1 : 0);
            PG8_LDB(B0, 0, 0); PG8_LDB(B1, 0, 1); PG8_SCHED; PG8_LDA(At, 0, 0); PG8_STAGE(PG8_SA(1, 1), a1 + hstepA, voffA, hstepA >> 1);
            PG8_WAIT_VX(rxi);
            PG8_WAIT_L(0); PG8_BAR; PG8_MMA(0, 0, At, B0); PG8_MMA(0, 1, At, B1); PG8_BAR; PG8_SCHED;
            PG8_LDA(At, 0, 1); PG8_STAGE(PG8_SB(0, 0), b2, vB2, hB2 >> 1); PG8_STAGE(PG8_SB(0, 1), b2 + hB2, vB2, hB2 >> 1); PG8_STAGE(PG8_SA(0, 0), a2, vA2, hA2 >> 1);
            PG8_WAIT_VX(rxi);
            PG8_WAIT_L(0); PG8_BAR; PG8_MMA(1, 0, At, B0); PG8_MMA(1, 1, At, B1); PG8_BAR; PG8_SCHED;
            PG8_LDB(B0, 1, 0); PG8_LDB(B1, 1, 1); PG8_SCHED; PG8_LDA(At, 1, 0); PG8_STAGE(PG8_SA(0, 1), a2 + hA2, vA2, hA2 >> 1);
            PG8_WAIT_V(8); PG8_WAIT_L(0); PG8_BAR; PG8_MMA(0, 0, At, B0); PG8_MMA(0, 1, At, B1); PG8_BAR; PG8_SCHED;
            PG8_LDA(At, 1, 1); PG8_STAGE(PG8_SB(1, 0), b3, vB2, hB2 >> 1); PG8_STAGE(PG8_SB(1, 1), b3 + hB2, vB2, hB2 >> 1); PG8_STAGE(PG8_SA(1, 0), a3, vA2, hA2 >> 1);
            PG8_WAIT_V(8); PG8_WAIT_L(0); PG8_BAR; PG8_MMA(1, 0, At, B0); PG8_MMA(1, 1, At, B1); PG8_BAR; PG8_SCHED;
        }
        if (wr == 0) PG8_BAR;
        if constexpr (F8) asm volatile("s_nop 15\n\ts_nop 7" ::: "memory");
        const bool keep = E(acc, cur, pre);
        if (!has_next) break;
        if (!keep) {
#pragma unroll
            for (int a = 0; a < 2; ++a)
#pragma unroll
                for (int b = 0; b < 2; ++b)
#pragma unroll
                    for (int m = 0; m < 4; ++m)
#pragma unroll
                        for (int n = 0; n < 2; ++n) acc[a][b][m][n] = (f32x4){0.f, 0.f, 0.f, 0.f};
        }
        cur = nxt; cA = nA; cB = nB; ++ui;
        if (DUAL) PG8_VOFF(xkind, voffA, voffB);
        hstepA = xhA; hstepB = xhB; nt = xnt;
        if (wr == 1) PG8_BAR;
    }
    PG8_WAIT_V(0);
    PG8_BAR;
#undef PG8_SA
#undef PG8_SB
#undef PG8_STAGE
#undef PG8_LDA
#undef PG8_LD32
#undef PG8_LDB
#undef PG8_MMA
#undef PG8_WAIT_V
#undef PG8_WAIT_L
#undef PG8_WAIT_VX
#undef PG8_BAR
#undef PG8_SCHED
#undef PG8_ABASE
#undef PG8_BBASE
#undef PG8_KIND
#undef PG8_SETCFG
#undef PG8_VOFF
}

__device__ __forceinline__ void lane_ids(int& wr, int& wc, int& fr, int& fq) { int t = threadIdx.x; asm volatile("" : "+v"(t)); const int wid = __builtin_amdgcn_readfirstlane(t >> 6); wr = wid >> 2; wc = wid & 3; fr = t & 15; fq = (t >> 4) & 3; }
__device__ __forceinline__ u32x4 pack8(const f32x4 a, const f32x4 b) { u32x4 w; w.x = cvt_pk_bf16(a[0], a[1]); w.y = cvt_pk_bf16(a[2], a[3]); w.z = cvt_pk_bf16(b[0], b[1]); w.w = cvt_pk_bf16(b[2], b[3]); return w; }

template <bool LATE> struct EpiInProjT {
    static constexpr bool PERM = true; static constexpr int NST = 16;
    bf16_t* O;
    const bf16_t* rope;
    const float* g_qa; const float* g_ka; const float* g_qb; const float* g_kb;
    const float* b_alpha;
    float* kmp;
    const float* ssq;
    float oscale;
    __device__ __forceinline__ void prefetch(const Unit& u, float (&pre)[8]) const {
        if constexpr (LATE) return;
        int t = threadIdx.x; asm volatile("" : "+v"(t)); const int row0 = u.pm * BM + ((t >> 8) & 1) * 64 + (t & 15);
#pragma unroll
        for (int st = 0; st < 8; ++st) pre[st] = ((const GAS float*)ssq)[row0 + (st >> 2) * HALF + (st & 3) * 16];
    }
    __device__ __forceinline__ bool operator()(Acc& acc, const Unit& u, const float (&pre)[8]) const {
        int wr, wc, fr, fq; lane_ids(wr, wc, fr, fq);
        const int G = 4 * u.pn + wc;
        const int row0 = u.pm * BM + wr * 64 + fr;
        static_assert(!LATE, "the row sums come from the K-loop's prefetch (pre[])");
#define INP_MV(st_) (pre[st_] * (1.0f / D) + EPS)
        bf16_t* obase = O + (size_t)row0 * PP + 64 * G + 8 * fq;
        const float* gain = nullptr; float qs = 1.f; bool mean = false;
        if (G < 8) { gain = g_qa; qs = C2; } else if (G < 10) gain = g_ka; else if (G >= 12 && G < 20) { gain = g_qb; qs = C2; } else if (G >= 20 && G < 28) { gain = g_kb; mean = true; }
        if (gain) {
            const float ios2 = 1.0f / (oscale * oscale);
            f32x4 gn[2][2];
#pragma unroll
            for (int bj = 0; bj < 2; ++bj)
#pragma unroll
                for (int n = 0; n < 2; ++n) gn[bj][n] = *(const GAS f32x4*)(gain + 32 * bj + 8 * fq + 4 * n) * qs;
            f32x4 ks[2][2];
#pragma unroll
            for (int bj = 0; bj < 2; ++bj)
#pragma unroll
                for (int n = 0; n < 2; ++n) ks[bj][n] = (f32x4){0.f, 0.f, 0.f, 0.f};
            u32x4 cw[8], sw[8];
#define INP_ROPE_LD(g_) do { const int rn_ = ((g_) >> 2) * HALF + ((g_) & 3) * 16; const bf16_t* cs_ = rope + (size_t)(row0 + rn_) * 64 + 8 * fq; cw[g_] = *(const GAS u32x4*)cs_; sw[g_] = *(const GAS u32x4*)(cs_ + 32); } while (0)
            INP_ROPE_LD(0); INP_ROPE_LD(1);
#pragma unroll
            for (int st = 0; st < 8; ++st) {
                const int ai = st >> 2, m = st & 3, rr = ai * HALF + m * 16;
                if (st + 2 < 8) INP_ROPE_LD(st + 2);
                const u32x4 cq_ = cw[st], sq_ = sw[st];
                const f32x4 c0 = {bf_lo(cq_.x), bf_hi(cq_.x), bf_lo(cq_.y), bf_hi(cq_.y)}, c1 = {bf_lo(cq_.z), bf_hi(cq_.z), bf_lo(cq_.w), bf_hi(cq_.w)};
                const f32x4 s0 = {bf_lo(sq_.x), bf_hi(sq_.x), bf_lo(sq_.y), bf_hi(sq_.y)}, s1 = {bf_lo(sq_.z), bf_hi(sq_.z), bf_lo(sq_.w), bf_hi(sq_.w)};
                float ss = 0.f;
#pragma unroll
                for (int bj = 0; bj < 2; ++bj)
#pragma unroll
                    for (int n = 0; n < 2; ++n) { const f32x4 v = acc[ai][bj][m][n]; ss += (v[0] * v[0] + v[1] * v[1]) + (v[2] * v[2] + v[3] * v[3]); }
                ss = addx32(addx16(ss));
                const float rs = frsq(ss * (1.0f / 64.0f) + EPS * INP_MV(st) * ios2);
                f32x4 o0[2], o1[2];
#pragma unroll
                for (int n = 0; n < 2; ++n) {
                    const f32x4 c = n ? c1 : c0, sx = n ? s1 : s0;
                    const f32x4 y0 = acc[ai][0][m][n] * rs * gn[0][n], y1 = acc[ai][1][m][n] * rs * gn[1][n];
                    o0[n] = y0 * c - y1 * sx; o1[n] = y1 * c + y0 * sx;
                    ks[0][n] += o0[n]; ks[1][n] += o1[n];
                }
                *(GAS u32x4*)(obase + (size_t)rr * PP) = pack8(o0[0], o0[1]);
                *(GAS u32x4*)(obase + (size_t)rr * PP + 32) = pack8(o1[0], o1[1]);
                asm volatile("" : "+v"(ks[0][0]), "+v"(ks[0][1]), "+v"(ks[1][0]), "+v"(ks[1][1]) :: "memory");
            }
#undef INP_ROPE_LD
            if (mean) {
#pragma unroll
                for (int bj = 0; bj < 2; ++bj)
#pragma unroll
                    for (int n = 0; n < 2; ++n)
#pragma unroll
                        for (int j = 0; j < 4; ++j) ks[bj][n][j] = sum16(ks[bj][n][j]);
                if (fr == 0) {
                    float* kp = kmp + ((size_t)((u.pm * 8 + (G - 20)) * 2 + wr)) * 64 + 8 * fq;
#pragma unroll
                    for (int bj = 0; bj < 2; ++bj)
#pragma unroll
                        for (int n = 0; n < 2; ++n) *(GAS f32x4*)(kp + 32 * bj + 4 * n) = ks[bj][n];
                }
            }
        } else {
            const int mode = (G >= 36 && G < 40) ? 1 : (G >= 52 && G < 56) ? 2 : (G >= 56) ? 3 : 0;
            f32x4 bb[2][2];
#pragma unroll
            for (int bj = 0; bj < 2; ++bj)
#pragma unroll
                for (int n = 0; n < 2; ++n) bb[bj][n] = (mode == 2) ? *(const GAS f32x4*)(b_alpha + 64 * (G - 52) + 32 * bj + 8 * fq + 4 * n) : (f32x4){0.f, 0.f, 0.f, 0.f};
#pragma unroll
            for (int ai = 0; ai < 2; ++ai)
#pragma unroll
                for (int m = 0; m < 4; ++m) {
                    const int rr = ai * HALF + m * 16;
                    const float rs = frsq(INP_MV(ai * 4 + m)) * oscale * (mode == 1 ? 0.125f : 1.0f);
                    f32x4 o[2][2];
#pragma unroll
                    for (int bj = 0; bj < 2; ++bj)
#pragma unroll
                        for (int n = 0; n < 2; ++n) {
                            f32x4 v = acc[ai][bj][m][n] * rs;
                            if (mode == 1) {}
                            else if (mode == 2) {
#pragma unroll
                                for (int j = 0; j < 4; ++j) { const float z = v[j] + bb[bj][n][j]; v[j] = (fminf(z, 0.f) - __logf(1.f + fexp(-fabsf(z)))) * (1.0f / 16.0f); }
                            } else if (mode == 3) {
#pragma unroll
                                for (int j = 0; j < 4; ++j) v[j] = v[j] * sigmoidf_(v[j]);
                            }
                            o[bj][n] = v;
                        }
                    *(GAS u32x4*)(obase + (size_t)rr * PP) = pack8(o[0][0], o[0][1]);
                    *(GAS u32x4*)(obase + (size_t)rr * PP + 32) = pack8(o[1][0], o[1][1]);
                    asm volatile("" ::: "memory");
                }
        }
        return false;
    }
};

#undef INP_MV
typedef EpiInProjT<false> EpiInProj;

template <bool LATE> struct EpiGatesT {
    static constexpr bool PERM = true; static constexpr int NST = (DBG_DUP == 11 || (DBG_DUP >= 18 && DBG_DUP <= 22)) ? 0 : 8;
    bf16_t* O; int nostore; const float* ssq; int late; float oscale;
    __device__ __forceinline__ void prefetch(const Unit& u, float (&pre)[8]) const {
        if constexpr (LATE) return;
        int t = threadIdx.x; asm volatile("" : "+v"(t)); const int row0 = u.pm * BM + ((t >> 8) & 1) * 64 + (t & 15);
#pragma unroll
        for (int st = 0; st < 8; ++st) pre[st] = ((const GAS float*)ssq)[row0 + (st >> 2) * HALF + (st & 3) * 16];
    }
    __device__ __forceinline__ bool operator()(Acc& acc, const Unit& u, const float (&pre)[8]) const {
        int wr, wc, fr, fq; lane_ids(wr, wc, fr, fq);
        if (nostore) {
#pragma unroll
            for (int ai = 0; ai < 2; ++ai)
#pragma unroll
                for (int bj = 0; bj < 2; ++bj)
#pragma unroll
                    for (int m = 0; m < 4; ++m) asm volatile("" :: "v"(acc[ai][bj][m][0]), "v"(acc[ai][bj][m][1]));
            return false;
        }
        const int row0 = u.pm * BM + wr * 64 + fr, col0 = u.pn * BM + wc * 64 + 16 * fq;
        float rsv[8];
#pragma unroll
        for (int st = 0; st < 8; ++st) rsv[st] = LATE ? ((const GAS float*)ssq)[row0 + (st >> 2) * HALF + (st & 3) * 16] : pre[st];
#pragma unroll
        for (int ai = 0; ai < 2; ++ai)
#pragma unroll
            for (int m = 0; m < 4; ++m) { unsigned char* rowp = (unsigned char*)O + (size_t)(row0 + ai * HALF + m * 16) * GW + col0;
                const float rs = frsq(rsv[ai * 4 + m] * (1.0f / D) + EPS) * oscale * (-LOG2E);
                unsigned ww[4];
#pragma unroll
                for (int bj = 0; bj < 2; ++bj) { f32x4 v0 = acc[ai][bj][m][0] * rs, v1 = acc[ai][bj][m][1] * rs;
                    unsigned w0 = 0u, w1 = 0u;
#pragma unroll
                    for (int j = 0; j < 4; ++j) { w0 = __builtin_amdgcn_cvt_pk_u8_f32(fmaxf(frcp(fmaf(fexp2(v0[j]), 1.0f / 255.0f, 1.0f / 255.0f)), 1.0f), j, w0);
                                                  w1 = __builtin_amdgcn_cvt_pk_u8_f32(fmaxf(frcp(fmaf(fexp2(v1[j]), 1.0f / 255.0f, 1.0f / 255.0f)), 1.0f), j, w1); }
                    ww[2 * bj] = w0; ww[2 * bj + 1] = w1; }
                *(GAS u32x4*)rowp = (u32x4){ww[0], ww[1], ww[2], ww[3]}; }
        return false;
    }
};

typedef EpiGatesT<false> EpiGates;
struct EpiMerge {
    static constexpr bool PERM = true; static constexpr int NST = (DBG_DUP == 22) ? 0 : 16;
    const bf16_t* Gt;
    bf16_t* O;
    int probe;
    __device__ __forceinline__ void prefetch(const Unit&, float (&)[8]) const {}
    __device__ __forceinline__ bool operator()(Acc& acc, const Unit& u, const float (&pre)[8]) const {
        int wr, wc, fr, fq; lane_ids(wr, wc, fr, fq);
        const int row0 = u.pm * BM + wr * 64 + fr, col0 = u.pn * BM + wc * 32 + 8 * fq, gcol0 = u.pn * BM + wc * 64 + 16 * fq;
        const bool last = u.sub == 2;
        if (DBG_DUP == 22 && probe) {
#pragma unroll
            for (int ai = 0; ai < 2; ++ai)
#pragma unroll
                for (int bj = 0; bj < 2; ++bj)
#pragma unroll
                    for (int m = 0; m < 4; ++m) asm volatile("" :: "v"(acc[ai][bj][m][0]), "v"(acc[ai][bj][m][1]));
            return !last;
        }
        const unsigned char* G8 = (const unsigned char*)Gt;
        u32x2 ga[2][4][2], gb[2][4][2];
#pragma unroll
        for (int ai = 0; ai < 2; ++ai)
#pragma unroll
            for (int m = 0; m < 4; ++m) {
                const unsigned char* gp = G8 + (size_t)(row0 + ai * HALF + m * 16) * GW + (size_t)u.sub * D + gcol0;
                const u32x4 a4 = *(const GAS u32x4*)gp, b4 = last ? (u32x4){0x01010101u, 0x01010101u, 0x01010101u, 0x01010101u} : *(const GAS u32x4*)(gp + D);
                ga[ai][m][0] = (u32x2){a4.x, a4.y}; ga[ai][m][1] = (u32x2){a4.z, a4.w};
                gb[ai][m][0] = (u32x2){b4.x, b4.y}; gb[ai][m][1] = (u32x2){b4.z, b4.w};
            }
        asm volatile("" ::: "memory");
        const float fin = last ? (1.0f / 255.0f) : 1.0f;
#pragma unroll
        for (int ai = 0; ai < 2; ++ai)
#pragma unroll
            for (int m = 0; m < 4; ++m)
#pragma unroll
                for (int bj = 0; bj < 2; ++bj) {
                    const u32x2 a = ga[ai][m][bj], b = gb[ai][m][bj];
                    if (last) {
                        const f32x4 s0 = {(float)(a.x & 0xffu), (float)((a.x >> 8) & 0xffu), (float)((a.x >> 16) & 0xffu), (float)(a.x >> 24)};
                        const f32x4 s1 = {(float)(a.y & 0xffu), (float)((a.y >> 8) & 0xffu), (float)((a.y >> 16) & 0xffu), (float)(a.y >> 24)};
                        acc[ai][bj][m][0] *= s0 * fin; acc[ai][bj][m][1] *= s1 * fin;
                        *(GAS u32x4*)(O + (size_t)(row0 + ai * HALF + m * 16) * D + col0 + bj * HALF) = pack8(acc[ai][bj][m][0], acc[ai][bj][m][1]);
                    } else {
                        const f32x4 s0 = {(float)(a.x & 0xffu) * frcp((float)(b.x & 0xffu)), (float)((a.x >> 8) & 0xffu) * frcp((float)((b.x >> 8) & 0xffu)), (float)((a.x >> 16) & 0xffu) * frcp((float)((b.x >> 16) & 0xffu)), (float)(a.x >> 24) * frcp((float)(b.x >> 24))};
                        const f32x4 s1 = {(float)(a.y & 0xffu) * frcp((float)(b.y & 0xffu)), (float)((a.y >> 8) & 0xffu) * frcp((float)((b.y >> 8) & 0xffu)), (float)((a.y >> 16) & 0xffu) * frcp((float)((b.y >> 16) & 0xffu)), (float)(a.y >> 24) * frcp((float)(b.y >> 24))};
                        acc[ai][bj][m][0] *= s0; acc[ai][bj][m][1] *= s1;
                    }
                }
        asm volatile("" ::: "memory");
        return !last;
    }
};

struct EpiGBM {
    static constexpr bool PERM = true; static constexpr int NST = 16;
    EpiGates eg; EpiMerge em;
    __device__ __forceinline__ void prefetch(const Unit&, float (&)[8]) const {}
    __device__ __forceinline__ bool operator()(Acc& acc, const Unit& u, const float (&pre)[8]) const {
        if (u.sub < 3) { const Unit v = {u.pm, 4 * u.sub + u.pn, 0}; return eg(acc, v, pre); }
        const Unit v = {u.pm, u.pn, u.sub - 3}; return em(acc, v, pre);
    }
};

struct EpiResid {
    static constexpr bool PERM = true; static constexpr int NST = 32;
    const bf16_t* base; float* out; bf16_t* xb; float* ssq; unsigned char* xb8;
    __device__ __forceinline__ void prefetch(const Unit&, float (&)[8]) const {}
    __device__ __forceinline__ bool operator()(Acc& acc, const Unit& u, const float (&pre)[8]) const {
        int wr, wc, fr, fq; lane_ids(wr, wc, fr, fq);
        const int row0 = u.pm * BM + wr * 64 + fr, col0 = u.pn * BM + wc * 32 + 8 * fq;
        u32x4 bw[2][4][2];
#pragma unroll
        for (int ai = 0; ai < 2; ++ai)
#pragma unroll
            for (int m = 0; m < 4; ++m)
#pragma unroll
                for (int bj = 0; bj < 2; ++bj) bw[ai][m][bj] = *(const GAS u32x4*)(base + (size_t)(row0 + ai * HALF + m * 16) * D + col0 + bj * HALF);
        asm volatile("" ::: "memory");
#pragma unroll
        for (int ai = 0; ai < 2; ++ai) {
            float ssm[4];
#pragma unroll
            for (int m = 0; m < 4; ++m) { const size_t off = (size_t)(row0 + ai * HALF + m * 16) * D + col0; float ss = 0.f;
#pragma unroll
                for (int bj = 0; bj < 2; ++bj) {
                    const u32x4 w = bw[ai][m][bj];
                    const f32x4 o0 = (f32x4){bf_lo(w.x), bf_hi(w.x), bf_lo(w.y), bf_hi(w.y)} + acc[ai][bj][m][0], o1 = (f32x4){bf_lo(w.z), bf_hi(w.z), bf_lo(w.w), bf_hi(w.w)} + acc[ai][bj][m][1];
                    if (out) { *(GAS f32x4*)(out + off + bj * HALF) = o0; *(GAS f32x4*)(out + off + bj * HALF + 4) = o1; }
                    if (xb) { ss += ((o0[0] * o0[0] + o0[1] * o0[1]) + (o0[2] * o0[2] + o0[3] * o0[3])) + ((o1[0] * o1[0] + o1[1] * o1[1]) + (o1[2] * o1[2] + o1[3] * o1[3]));
                        *(GAS u32x4*)(xb + off + bj * HALF) = pack8(o0, o1);
                        if (xb8) *(GAS u32x2*)(xb8 + off + bj * HALF) = (u32x2){cvt4_fp8(o0[0] * XS8, o0[1] * XS8, o0[2] * XS8, o0[3] * XS8), cvt4_fp8(o1[0] * XS8, o1[1] * XS8, o1[2] * XS8, o1[3] * XS8)}; } }
                ssm[m] = xb ? addx32(addx16(ss)) : 0.f; }
            if (xb) { const float sv = fq == 0 ? ssm[0] : fq == 1 ? ssm[1] : fq == 2 ? ssm[2] : ssm[3];
                (void)__hip_atomic_fetch_add((GAS float*)ssq + (row0 + ai * HALF + fq * 16), sv, __ATOMIC_RELAXED, __HIP_MEMORY_SCOPE_AGENT); }
            asm volatile("" ::: "memory");
        }
        return false;
    }
};

struct EpiFfn1 {
    static constexpr bool PERM = true; static constexpr int NST = (DBG_DUP == 6 || DBG_DUP >= 14) ? 0 : 8;
    bf16_t* O; const float* ssq; int nostore;
    __device__ __forceinline__ void prefetch(const Unit& u, float (&pre)[8]) const {
        int t = threadIdx.x; asm volatile("" : "+v"(t)); const int row0 = u.pm * BM + ((t >> 8) & 1) * 64 + (t & 15);
#pragma unroll
        for (int st = 0; st < 8; ++st) pre[st] = ((const GAS float*)ssq)[row0 + (st >> 2) * HALF + (st & 3) * 16];
    }
    __device__ __forceinline__ bool operator()(Acc& acc, const Unit& u, const float (&pre)[8]) const {
        int wr, wc, fr, fq; lane_ids(wr, wc, fr, fq);
        const int row0 = u.pm * BM + wr * 64 + fr, col0 = u.pn * HALF + wc * 32 + 8 * fq;
        if (DBG_DUP >= 14 && nostore) {
#pragma unroll
            for (int ai = 0; ai < 2; ++ai)
#pragma unroll
                for (int bj = 0; bj < 2; ++bj)
#pragma unroll
                    for (int m = 0; m < 4; ++m) asm volatile("" :: "v"(acc[ai][bj][m][0]), "v"(acc[ai][bj][m][1]));
            return false;
        }
#pragma unroll
        for (int ai = 0; ai < 2; ++ai)
#pragma unroll
            for (int m = 0; m < 4; ++m) {
                const float rs = frsq(pre[ai * 4 + m] * (1.0f / D) + EPS), rsn = -rs * LOG2E, rs2 = rs * rs;
                f32x4 o[2];
#pragma unroll
                for (int n = 0; n < 2; ++n) { const f32x4 g = acc[ai][0][m][n], u = acc[ai][1][m][n]; const f32x4 t = g * rsn; f32x4 e, r;
#pragma unroll
                    for (int j = 0; j < 4; ++j) e[j] = fexp2(t[j]);
                    const f32x4 d = e + 1.0f;
#pragma unroll
                    for (int j = 0; j < 4; ++j) r[j] = frcp(d[j]);
                    o[n] = (g * u) * (r * rs2); }
                *(GAS u32x4*)(O + (size_t)(row0 + ai * HALF + m * 16) * FF + col0) = pack8(o[0], o[1]);
            }
        return false;
    }
};
}

namespace att {
constexpr int SLOTB = 8192;
constexpr int L_K = 0, L_V = 3 * SLOTB, L_WS = 6 * SLOTB, L_OST = L_WS + 8 * 256, L_KM = L_OST + 8 * 4096, L_END = L_KM + 7 * 64 * 4;
__device__ __forceinline__ int crow(int r, int hi) { return (r & 3) + 8 * (r >> 2) + 4 * hi; }
__device__ __forceinline__ void glds16(const void* gsrc, unsigned lds_dst) { unsigned keep;
    asm volatile("s_mov_b32 %0, m0\n\ts_mov_b32 m0, %2\n\ts_nop 0\n\tglobal_load_lds_dwordx4 %1, off\n\ts_mov_b32 m0, %0" : "=&s"(keep) : "v"(gsrc), "s"(lds_dst) : "memory"); }
#define ATT_WAIT_BAR0() asm volatile("s_waitcnt vmcnt(0) lgkmcnt(0)\n\ts_barrier" ::: "memory")
#define ATT_SBAR() __builtin_amdgcn_sched_barrier(0)

__device__ __forceinline__ void qkt(f32x16& p0, f32x16& p1, LAS const unsigned char* Kslot, const bf16x8* qr, int r32, int hi) {
    LAS const unsigned char* kb = Kslot + hi * 1024 + r32 * 16;
    p0 = f32x16{}; p1 = f32x16{};
#pragma unroll
    for (int d0 = 0; d0 < 4; ++d0) {
        const bf16x8 b0 = *(LAS const bf16x8*)(kb + d0 * 2048);
        const bf16x8 b1 = *(LAS const bf16x8*)(kb + d0 * 2048 + 512);
        p0 = __builtin_amdgcn_mfma_f32_32x32x16_bf16(b0, qr[d0], p0, 0, 0, 0);
        p1 = __builtin_amdgcn_mfma_f32_32x32x16_bf16(b1, qr[d0], p1, 0, 0, 0);
    }
}
__device__ __forceinline__ void qkt_c(f32x16& p0, f32x16& p1, LAS const unsigned char* Kslot, const bf16x8* qr, const f32x16& c, int r32, int hi) {
    LAS const unsigned char* kb = Kslot + hi * 1024 + r32 * 16;
#pragma unroll
    for (int d0 = 0; d0 < 4; ++d0) {
        const bf16x8 b0 = *(LAS const bf16x8*)(kb + d0 * 2048);
        const bf16x8 b1 = *(LAS const bf16x8*)(kb + d0 * 2048 + 512);
        if (d0 == 0) { p0 = __builtin_amdgcn_mfma_f32_32x32x16_bf16(b0, qr[0], c, 0, 0, 0); p1 = __builtin_amdgcn_mfma_f32_32x32x16_bf16(b1, qr[0], c, 0, 0, 0); }
        else { p0 = __builtin_amdgcn_mfma_f32_32x32x16_bf16(b0, qr[d0], p0, 0, 0, 0); p1 = __builtin_amdgcn_mfma_f32_32x32x16_bf16(b1, qr[d0], p1, 0, 0, 0); }
    }
}
__device__ __forceinline__ float max3_asm(float a, float b, float c) { float r; asm("v_max3_f32 %0, %1, %2, %3" : "=v"(r) : "v"(a), "v"(b), "v"(c)); return r; }
__device__ __forceinline__ float rowmax(const f32x16& p0, const f32x16& p1) {
    float a = max3_asm(p0[0], p1[0], p0[1]), b = max3_asm(p1[1], p0[2], p1[2]);
#pragma unroll
    for (int r = 3; r < 15; r += 2) { a = max3_asm(a, p0[r], p1[r]); b = max3_asm(b, p0[r + 1], p1[r + 1]); }
    a = max3_asm(a, p0[15], p1[15]);
    return maxx32(fmaxf(a, b));
}
__device__ __forceinline__ void pv(f32x16* o, int vb, bf16x8 pa0, bf16x8 pa1, bf16x8 pa2, bf16x8 pa3) {
#pragma unroll
    for (int d0 = 0; d0 < 2; ++d0) { s16x4 lo[4], hi[4];
#pragma unroll
        for (int ks = 0; ks < 4; ++ks) {
            asm volatile("ds_read_b64_tr_b16 %0,%1 offset:%c2" : "=&v"(lo[ks]) : "v"(vb), "i"(d0 * 4096 + ks * 1024) : "memory");
            asm volatile("ds_read_b64_tr_b16 %0,%1 offset:%c2" : "=&v"(hi[ks]) : "v"(vb), "i"(d0 * 4096 + ks * 1024 + 512) : "memory"); }
        asm volatile("s_waitcnt lgkmcnt(0)" ::: "memory"); ATT_SBAR();
#define ATT_PK(k) (bf16x8){lo[k][0], lo[k][1], lo[k][2], lo[k][3], hi[k][0], hi[k][1], hi[k][2], hi[k][3]}
        o[d0] = __builtin_amdgcn_mfma_f32_32x32x16_bf16(pa0, ATT_PK(0), o[d0], 0, 0, 0);
        o[d0] = __builtin_amdgcn_mfma_f32_32x32x16_bf16(pa1, ATT_PK(1), o[d0], 0, 0, 0);
        o[d0] = __builtin_amdgcn_mfma_f32_32x32x16_bf16(pa2, ATT_PK(2), o[d0], 0, 0, 0);
        o[d0] = __builtin_amdgcn_mfma_f32_32x32x16_bf16(pa3, ATT_PK(3), o[d0], 0, 0, 0);
#undef ATT_PK
    }
}

template <int MODE>
__device__ __forceinline__ void attn_unit(const bf16_t* proj, bf16_t* Y, int b, int hh, int qb, const float* sinks, const float* kmp, LAS unsigned char* shm) {
    int tid_ = threadIdx.x; asm volatile("" : "+v"(tid_));
    const int tid = tid_, lane = tid & 63, r32 = lane & 31, hi = lane >> 5; const int wid = __builtin_amdgcn_readfirstlane(tid >> 6);
    const long rowbase = (long)b * SEQ;
    int qhead, qrow0, kcol, vcol, qcol, ycol, t_first, t_last;
    if (MODE == 0) { qhead = 4 * hh + (wid >> 1); qrow0 = 64 * qb + 32 * (wid & 1); qcol = 64 * qhead; kcol = 512 + 64 * hh; vcol = 640 + 64 * hh; ycol = 64 * qhead; t_first = qb >= 2 ? qb - 2 : 0; t_last = qb; }
    else { qhead = hh; qrow0 = 256 * qb + 32 * wid; qcol = 768 + 64 * hh; kcol = 1280 + 64 * hh; vcol = 1792 + 64 * hh; ycol = 512 + 64 * hh; t_first = 0; t_last = 4 * qb + 3; }
    const bf16_t* Qw = proj + (rowbase + qrow0) * PP + qcol;
    const bf16_t* Kh = proj + rowbase * PP + kcol; const bf16_t* Vh = proj + rowbase * PP + vcol;
    const unsigned lds0 = (unsigned)(uintptr_t)shm;
    LAS float* wsf = (LAS float*)(shm + L_WS) + wid * 64;
    const bf16_t* ksrc = Kh + (long)lane * PP + wid * 8;
    const bf16_t* vsrc = Vh + (long)(16 * (wid & 3) + (lane >> 2)) * PP + (wid >> 2) * 32 + (lane & 3) * 8;
    const unsigned kdst = lds0 + L_K + wid * 1024, vdst = lds0 + L_V + wid * 1024;
#define ATT_DMA(t, slot) do { glds16(ksrc + (long)(t) * 64 * PP, (unsigned)__builtin_amdgcn_readfirstlane(kdst + (slot))); glds16(vsrc + (long)(t) * 64 * PP, (unsigned)__builtin_amdgcn_readfirstlane(vdst + (slot))); } while (0)
    const int vb0 = (int)(lds0 + L_V) + ((lane >> 4) & 1) * 32 + (lane & 3) * 8 + (4 * hi + ((lane & 15) >> 2)) * 64;
    bf16x8 qr[4];
#pragma unroll
    for (int d0 = 0; d0 < 4; ++d0) qr[d0] = *(const GAS bf16x8*)(Qw + (long)r32 * PP + d0 * 16 + hi * 8);
    unsigned sel = 0u;
    if (MODE == 1) {
        LAS float* km = (LAS float*)(shm + L_KM);
        if (qb > 0) { for (int idx = tid; idx < qb * 64; idx += 512) { const int n = idx >> 6, d = idx & 63; const float* p = kmp + ((size_t)(((b * 8 + n) * 8 + hh) * 2)) * 64 + d; km[idx] = p[0] + p[64]; } }
        LDS_WAIT(); __syncthreads();
        if (qb <= 3) sel = (1u << qb) - 1u;
        else {
            float qf[32];
#pragma unroll
            for (int d0 = 0; d0 < 4; ++d0)
#pragma unroll
                for (int j = 0; j < 8; ++j) qf[d0 * 8 + j] = bf1((bf16_t)qr[d0][j]);
            float gsc[7];
#pragma unroll
            for (int n = 0; n < 7; ++n) {
                float a = 0.f;
                if (n < qb) {
#pragma unroll
                    for (int d0 = 0; d0 < 4; ++d0) { const f32x4 k0 = *(LAS const f32x4*)(km + n * 64 + d0 * 16 + hi * 8), k1 = *(LAS const f32x4*)(km + n * 64 + d0 * 16 + hi * 8 + 4);
                        a += qf[d0 * 8 + 0] * k0[0] + qf[d0 * 8 + 1] * k0[1] + qf[d0 * 8 + 2] * k0[2] + qf[d0 * 8 + 3] * k0[3] + qf[d0 * 8 + 4] * k1[0] + qf[d0 * 8 + 5] * k1[1] + qf[d0 * 8 + 6] * k1[2] + qf[d0 * 8 + 7] * k1[3]; }
                    a = addx32(a);
                } else a = -INFINITY;
                gsc[n] = a;
            }
#pragma unroll
            for (int n = 0; n < 7; ++n) { int cnt = 0;
#pragma unroll
                for (int m2 = 0; m2 < 7; ++m2) if (m2 != n) cnt += (gsc[m2] > gsc[n] || (gsc[m2] == gsc[n] && m2 < n)) ? 1 : 0;
                if (cnt < 3 && n < qb) sel |= 1u << n; }
        }
    }
    float mhat, l_reg; f32x16 o[2]; o[0] = f32x16{}; o[1] = f32x16{};
    if (MODE == 0) { mhat = sinks[qhead] * LOG2E; l_reg = hi == 0 ? 1.f : 0.f; } else { mhat = -1e30f; l_reg = 0.f; }
    f32x16 negm;
#pragma unroll
    for (int r = 0; r < 16; ++r) negm[r] = -mhat;
    asm volatile("" : "+v"(negm));
    const int qabs = qrow0 + r32;
    int slot = 0;
    if (MODE == 0) {
        for (int t = t_first; t <= t_last; ++t) ATT_DMA(t, (t - t_first) * SLOTB);
        ATT_WAIT_BAR0();
    } else ATT_DMA(t_first, 0);
    for (int t = t_first; t <= t_last; ++t) {
        if (MODE != 0) { ATT_WAIT_BAR0();
            if (t < t_last) ATT_DMA(t + 1, slot ^ SLOTB); }
        bool active = true;
        if (MODE == 1 && t < 4 * qb) active = __any((sel >> (t >> 2)) & 1u);
        if (active) {
            f32x16 p0, p1;
            if (MODE == 0) qkt_c(p0, p1, shm + L_K + slot, qr, negm, r32, hi); else qkt(p0, p1, shm + L_K + slot, qr, r32, hi);
            if (MODE == 0) {
                const int kb = 64 * t + 4 * hi;
                const bool needC = 64 * t + 63 > qrow0, needW = 64 * t <= qrow0 + 31 - 128;
                int dq = qabs - kb; asm volatile("" : "+v"(dq));
                if (needC && needW) {
                    int dw = dq - 128; asm volatile("" : "+v"(dw));
#pragma unroll
                    for (int r = 0; r < 16; ++r) { const int c = (r & 3) + 8 * (r >> 2);
                        if (c > dq || c <= dw) p0[r] = -INFINITY;
                        if (c + 32 > dq || c + 32 <= dw) p1[r] = -INFINITY; }
                } else if (needC) {
#pragma unroll
                    for (int r = 0; r < 16; ++r) { const int c = (r & 3) + 8 * (r >> 2); if (c > dq) p0[r] = -INFINITY; if (c + 32 > dq) p1[r] = -INFINITY; }
                } else if (needW) {
                    int dw = dq - 128; asm volatile("" : "+v"(dw));
#pragma unroll
                    for (int r = 0; r < 16; ++r) { const int c = (r & 3) + 8 * (r >> 2); if (c <= dw) p0[r] = -INFINITY; if (c + 32 <= dw) p1[r] = -INFINITY; }
                }
            } else {
                if (t >= 4 * qb) {
                    const int kb = 64 * t + 4 * hi;
#pragma unroll
                    for (int r = 0; r < 16; ++r) { const int kv = kb + (r & 3) + 8 * (r >> 2); if (kv > qabs) p0[r] = -INFINITY; if (kv + 32 > qabs) p1[r] = -INFINITY; }
                } else if (!((sel >> (t >> 2)) & 1u)) {
#pragma unroll
                    for (int r = 0; r < 16; ++r) { p0[r] = -INFINITY; p1[r] = -INFINITY; }
                }
            }
            const float rm = rowmax(p0, p1);
            float sacc = 0.f;
            if (MODE == 0) {
                if (__any(rm > 8.0f)) {
                    const float dl = fmaxf(rm, 0.f);
                    const float f = fexp2(-dl);
                    mhat += dl; l_reg *= f;
#pragma unroll
                    for (int r = 0; r < 16; ++r) { p0[r] -= dl; p1[r] -= dl; negm[r] = -mhat; }
                    asm volatile("" : "+v"(negm));
                    if (hi == 0) wsf[r32] = f;
                    LDS_WAIT();
#pragma unroll
                    for (int r = 0; r < 16; ++r) { const float fr_ = wsf[crow(r, hi)]; o[0][r] *= fr_; o[1][r] *= fr_; }
                }
#pragma unroll
                for (int r = 0; r < 16; ++r) { p0[r] = fexp2(p0[r]); p1[r] = fexp2(p1[r]); sacc += p0[r] + p1[r]; }
            } else {
                const float mnew = fmaxf(mhat, rm);
                const float f = fexp2(mhat - mnew);
                mhat = mnew; l_reg *= f;
                if (__any(f != 1.0f)) {
                    if (hi == 0) wsf[r32] = f;
                    LDS_WAIT();
#pragma unroll
                    for (int r = 0; r < 16; ++r) { const float fr_ = wsf[crow(r, hi)]; o[0][r] *= fr_; o[1][r] *= fr_; }
                }
#pragma unroll
                for (int r = 0; r < 16; ++r) { p0[r] = fexp2(p0[r] - mhat); p1[r] = fexp2(p1[r] - mhat); sacc += p0[r] + p1[r]; }
            }
            l_reg += sacc;
            u32x4 pw0, pw1, pw2, pw3;
#define ATT_PKW(P, B) cvt_pk_bf16(P[B], P[B + 1])
            pw0 = (u32x4){ATT_PKW(p0, 0), ATT_PKW(p0, 2), ATT_PKW(p0, 4), ATT_PKW(p0, 6)}; pw1 = (u32x4){ATT_PKW(p0, 8), ATT_PKW(p0, 10), ATT_PKW(p0, 12), ATT_PKW(p0, 14)};
            pw2 = (u32x4){ATT_PKW(p1, 0), ATT_PKW(p1, 2), ATT_PKW(p1, 4), ATT_PKW(p1, 6)}; pw3 = (u32x4){ATT_PKW(p1, 8), ATT_PKW(p1, 10), ATT_PKW(p1, 12), ATT_PKW(p1, 14)};
#undef ATT_PKW
            ATT_SBAR();
            pv(o, vb0 + slot, __builtin_bit_cast(bf16x8, pw0), __builtin_bit_cast(bf16x8, pw1), __builtin_bit_cast(bf16x8, pw2), __builtin_bit_cast(bf16x8, pw3));
        }
        if (MODE == 0) slot += SLOTB; else slot ^= SLOTB;
    }
    l_reg = addx32(l_reg);
    if (hi == 0) wsf[32 + r32] = l_reg;
    LDS_WAIT();
    float rli[16];
#pragma unroll
    for (int r = 0; r < 16; ++r) rli[r] = frcp(wsf[32 + crow(r, hi)]);
    bf16_t* Ow = Y + (rowbase + qrow0) * YW + ycol;
    { LAS bf16_t* stg = (LAS bf16_t*)(shm + L_OST) + wid * 2048;
#pragma unroll
        for (int r = 0; r < 16; ++r) { const int orow = crow(r, hi);
#pragma unroll
            for (int d0 = 0; d0 < 2; ++d0) stg[orow * 64 + d0 * 32 + r32] = f2bf(o[d0][r] * rli[r]); }
        LDS_WAIT();
#pragma unroll
        for (int i = 0; i < 4; ++i) { const int row = i * 8 + (lane >> 3), ch = lane & 7; const u32x4 v = *(LAS const u32x4*)(stg + row * 64 + ch * 8); *(GAS u32x4*)(Ow + (long)row * YW + ch * 8) = v; } }
    asm volatile("s_waitcnt lgkmcnt(0)\n\ts_barrier" ::: "memory");
#undef ATT_DMA
}
}

namespace att2 {
#define SBAR() __builtin_amdgcn_sched_barrier(0)
__device__ __forceinline__ int crow(int r,int hi){return (r&3)+8*(r>>2)+4*hi;}
#define SBAR() __builtin_amdgcn_sched_barrier(0)
__device__ __forceinline__ void cmask(f32x16&p0,f32x16&p1,int jb,int qrel,int hi){
  const float NEG=-INFINITY; int kb=64*jb+4*hi;
  #pragma unroll
  for(int r=0;r<16;++r){int kv=kb+(r&3)+8*(r>>2); if(kv>qrel)p0[r]=NEG; if(kv+32>qrel)p1[r]=NEG;}
}

constexpr int NW=8,QBLK=32,QB=256,KVBLK=64,DM=PP;
constexpr int NSLOT=3, SLOTB=8192;
constexpr int LDS_K=0, LDS_V=NSLOT*SLOTB, LDS_WS=2*NSLOT*SLOTB, LDS_OST=LDS_WS+NW*64*4, LDS_KM=LDS_OST+NW*4096, LDS_BYTES=LDS_KM+7*64*4;
__device__ __forceinline__ void glds16(const void*gsrc,unsigned lds_dst){unsigned keep;
  asm volatile("s_mov_b32 %0, m0\n\ts_mov_b32 m0, %2\n\ts_nop 0\n\tglobal_load_lds_dwordx4 %1, off\n\ts_mov_b32 m0, %0":"=&s"(keep):"v"(gsrc),"s"(lds_dst):"memory");}
__device__ __forceinline__ float max3f(float a,float b,float c){float r;asm("v_max3_f32 %0, %1, %2, %3":"=v"(r):"v"(a),"v"(b),"v"(c));return r;}
__device__ __forceinline__ float max2f(float a,float b){float r;asm("v_max_f32_e32 %0, %1, %2":"=v"(r):"v"(a),"v"(b));return r;}
__device__ __forceinline__ float fadd_s(float a,float b){float r;asm("v_add_f32_e32 %0, %1, %2":"=v"(r):"v"(a),"v"(b));return r;}
__device__ __forceinline__ float fsub_s(float a,float b){float r;asm("v_sub_f32_e32 %0, %1, %2":"=v"(r):"v"(a),"v"(b));return r;}
typedef float f32x2_t __attribute__((ext_vector_type(2))); typedef __bf16 bf16x2_t __attribute__((ext_vector_type(2)));
typedef int v8i_t __attribute__((ext_vector_type(8)));
__device__ __forceinline__ unsigned cvtpk_s(float lo,float hi){f32x2_t v={lo,hi};bf16x2_t b=__builtin_convertvector(v,bf16x2_t);return __builtin_bit_cast(unsigned,b);}
#define WAIT_BAR(N) asm volatile("s_waitcnt vmcnt(" #N ") lgkmcnt(0)\n\ts_barrier":::"memory")

typedef __attribute__((address_space(3))) const char* lds_cptr;
__device__ __forceinline__ void qkt(f32x16&p0,f32x16&p1,lds_cptr Kslot,const bf16x8*qr,const f32x16&negm,int r32,int hi){
  lds_cptr kb=Kslot+hi*1024+r32*16;
  #pragma unroll
  for(int d0=0;d0<4;++d0){
    const bf16x8 b0=*(const __attribute__((address_space(3))) bf16x8*)(kb+d0*2048);
    const bf16x8 b1=*(const __attribute__((address_space(3))) bf16x8*)(kb+d0*2048+512);
    if(d0==0){p0=__builtin_amdgcn_mfma_f32_32x32x16_bf16(b0,qr[0],negm,0,0,0);p1=__builtin_amdgcn_mfma_f32_32x32x16_bf16(b1,qr[0],negm,0,0,0);}
    else{p0=__builtin_amdgcn_mfma_f32_32x32x16_bf16(b0,qr[d0],p0,0,0,0);p1=__builtin_amdgcn_mfma_f32_32x32x16_bf16(b1,qr[d0],p1,0,0,0);}}
}
__device__ __forceinline__ void kload8(bf16x8*kf,lds_cptr kp){
  kf[0]=*(const __attribute__((address_space(3))) bf16x8*)(kp);      kf[1]=*(const __attribute__((address_space(3))) bf16x8*)(kp+512);
  kf[2]=*(const __attribute__((address_space(3))) bf16x8*)(kp+2048); kf[3]=*(const __attribute__((address_space(3))) bf16x8*)(kp+2560);
  kf[4]=*(const __attribute__((address_space(3))) bf16x8*)(kp+4096); kf[5]=*(const __attribute__((address_space(3))) bf16x8*)(kp+4608);
  kf[6]=*(const __attribute__((address_space(3))) bf16x8*)(kp+6144); kf[7]=*(const __attribute__((address_space(3))) bf16x8*)(kp+6656);
}
__device__ __forceinline__ void kload2(bf16x8*kf,lds_cptr kp,int j){ kf[2*j]=*(const __attribute__((address_space(3))) bf16x8*)(kp+j*2048); kf[2*j+1]=*(const __attribute__((address_space(3))) bf16x8*)(kp+j*2048+512); }
__device__ __forceinline__ s16x4 vtr(lds_cptr p){ return __builtin_bit_cast(s16x4,__builtin_amdgcn_ds_read_tr16_b64_v4i16((__attribute__((address_space(3))) v4i16_t*)p)); }
__device__ __forceinline__ float rowmax(const f32x16&p0,const f32x16&p1){
  float a=max3f(p0[0],p0[1],p1[0]),b=max3f(p0[2],p0[3],p1[1]);a=max3f(a,p1[2],p1[3]);
  #pragma unroll
  for(int r=4;r<16;r+=4){a=max3f(a,p0[r],p0[r+1]);b=max3f(b,p0[r+2],p0[r+3]);a=max3f(a,p1[r],p1[r+1]);b=max3f(b,p1[r+2],p1[r+3]);}
  const float m=max2f(a,b);
  auto rr=__builtin_amdgcn_permlane32_swap(__float_as_uint(m),__float_as_uint(m),false,false);
  return max2f(__uint_as_float(rr[0]),__uint_as_float(rr[1]));
}
__device__ __forceinline__ void pv(f32x16*o,int vb,bf16x8 pa0,bf16x8 pa1,bf16x8 pa2,bf16x8 pa3){
  #pragma unroll
  for(int d0=0;d0<2;++d0){s16x4 lo[4],hi[4];
    #pragma unroll
    for(int ks=0;ks<4;++ks){
      asm volatile("ds_read_b64_tr_b16 %0,%1 offset:%c2":"=&v"(lo[ks]):"v"(vb),"i"(d0*4096+ks*1024):"memory");
      asm volatile("ds_read_b64_tr_b16 %0,%1 offset:%c2":"=&v"(hi[ks]):"v"(vb),"i"(d0*4096+ks*1024+512):"memory");}
    asm volatile("s_waitcnt lgkmcnt(0)":::"memory");SBAR();
    #define PK(k) (bf16x8){lo[k][0],lo[k][1],lo[k][2],lo[k][3],hi[k][0],hi[k][1],hi[k][2],hi[k][3]}
    o[d0]=__builtin_amdgcn_mfma_f32_32x32x16_bf16(pa0,PK(0),o[d0],0,0,0);
    o[d0]=__builtin_amdgcn_mfma_f32_32x32x16_bf16(pa1,PK(1),o[d0],0,0,0);
    o[d0]=__builtin_amdgcn_mfma_f32_32x32x16_bf16(pa2,PK(2),o[d0],0,0,0);
    o[d0]=__builtin_amdgcn_mfma_f32_32x32x16_bf16(pa3,PK(3),o[d0],0,0,0);
    #undef PK
  }
}

template<int THRL> __device__ __forceinline__ void moba_unit(int b,int h,int qb,const bf16_t*proj,bf16_t*Y,const float*kmp,LAS unsigned char*shm){
  int tid_=threadIdx.x; asm volatile("":"+v"(tid_));
  const int tid=tid_,lane=tid&63,r32=lane&31,hi=lane>>5; const int wid=__builtin_amdgcn_readfirstlane(tid>>6);
  const long rowbase=(long)b*SEQ; const int q0=qb*QB;
  const bf16_t*Qw=proj+(rowbase+q0+wid*QBLK)*DM+768+h*64;
  const bf16_t*Kh=proj+rowbase*DM+1280+h*64,*Vh=proj+rowbase*DM+1792+h*64;
  const unsigned lds0=(unsigned)(uintptr_t)shm;
  LAS float*wsf=(LAS float*)(shm+LDS_WS)+wid*64;
  const bf16_t*ksrc=Kh+(long)lane*DM+wid*8;
  const bf16_t*vsrc=Vh+(long)(16*(wid&3)+(lane>>2))*DM+(wid>>2)*32+(lane&3)*8;
  const unsigned kdst=lds0+LDS_K+wid*1024, vdst=lds0+LDS_V+wid*1024;
  #define DMA_K(t,slot) glds16(ksrc+(long)(t)*KVBLK*DM,(unsigned)__builtin_amdgcn_readfirstlane(kdst+(slot)))
  #define DMA_V(t,slot) glds16(vsrc+(long)(t)*KVBLK*DM,(unsigned)__builtin_amdgcn_readfirstlane(vdst+(slot)))
  const int vb0=(int)(lds0+LDS_V)+((lane>>4)&1)*32+(lane&3)*8+(4*hi+((lane&15)>>2))*64;
  const lds_cptr Kbase=(lds_cptr)(shm+LDS_K); bf16x8 kf[8];
  const lds_cptr shm3=(lds_cptr)shm; const lds_cptr kp0=shm3+LDS_K+hi*1024+r32*16; const lds_cptr vp0=shm3+LDS_V+((lane>>4)&1)*32+(lane&3)*8+(4*hi+((lane&15)>>2))*64;
  const int NT=(q0+QB)/KVBLK;
  bf16x8 qr[4];
  #pragma unroll
  for(int d0=0;d0<4;++d0)qr[d0]=*(const GAS bf16x8*)(&Qw[(long)r32*DM+d0*16+hi*8]);
  LAS float*km=(LAS float*)(shm+LDS_KM);
  if(tid<qb*64){ const int n_=tid>>6,d_=tid&63; const float*p_=kmp+((size_t)(((b*8+n_)*8+h)*2))*64+d_; km[tid]=p_[0]+p_[64]; }
  DMA_K(0,0);DMA_V(0,0);DMA_K(1,SLOTB);
  asm volatile("s_waitcnt lgkmcnt(0)\n\ts_barrier":::"memory");
  unsigned sel=0u;
  if(qb<=3)sel=(1u<<qb)-1u;
  else{
    float qf[32];
    #pragma unroll
    for(int d0=0;d0<4;++d0)
      #pragma unroll
      for(int j=0;j<8;++j)qf[d0*8+j]=bf1((bf16_t)qr[d0][j]);
    float gsc[7];
    #pragma unroll
    for(int n=0;n<7;++n){
      float a=0.f;
      if(n<qb){
        #pragma unroll
        for(int d0=0;d0<4;++d0){ const f32x4 k0=*(LAS const f32x4*)(km+n*64+d0*16+hi*8),k1=*(LAS const f32x4*)(km+n*64+d0*16+hi*8+4);
          a+=qf[d0*8+0]*k0[0]+qf[d0*8+1]*k0[1]+qf[d0*8+2]*k0[2]+qf[d0*8+3]*k0[3]+qf[d0*8+4]*k1[0]+qf[d0*8+5]*k1[1]+qf[d0*8+6]*k1[2]+qf[d0*8+7]*k1[3]; }
        a=addx32(a);
      } else a=-INFINITY;
      gsc[n]=a;
    }
    #pragma unroll
    for(int n=0;n<7;++n){ int cnt=0;
      #pragma unroll
      for(int m2=0;m2<7;++m2) if(m2!=n) cnt+=(gsc[m2]>gsc[n]||(gsc[m2]==gsc[n]&&m2<n))?1:0;
      if(cnt<3&&n<qb)sel|=1u<<n; }
  }
  float mhat=0.f,l_reg=0.f;f32x16 o[2];o[0]=f32x16{};o[1]=f32x16{};f32x16 negm=f32x16{};asm volatile("":"+v"(negm));
  const int qrel=wid*QBLK+r32;
  #define NEGM_UPD(tn) do{ const bool on_=((tn)>=NT-4)||((sel>>((tn)>>2))&1u); const float nv_=on_?-mhat:-INFINITY; _Pragma("unroll") for(int r=0;r<16;++r)negm[r]=nv_; asm volatile("":"+v"(negm)); }while(0)
  #define CMASK(P0,P1,t) do{int jb_=(t)-(NT-4); if(jb_>=0&&64*jb_+63>QBLK*wid)cmask(P0,P1,jb_,qrel,hi);}while(0)
  bool resc=false;
  #define START(P0,P1) do{ const float rm=rowmax(P0,P1); resc=false; \
    { const float dl=__builtin_fmaxf(rm,-60.f); mhat=fadd_s(mhat,dl); \
      _Pragma("unroll") for(int r=0;r<16;++r){P0[r]=fsub_s(P0[r],dl);P1[r]=fsub_s(P1[r],dl);} \
      NEGM_UPD(1); } \
    _Pragma("unroll") for(int r=0;r<16;++r)P0[r]=__builtin_amdgcn_exp2f(P0[r]); }while(0)
  #define RESC() do{ if(resc){ asm volatile("s_waitcnt lgkmcnt(0)":::"memory"); \
      _Pragma("unroll") for(int d_=0;d_<2;++d_) _Pragma("unroll") for(int r=0;r<16;++r)o[d_][r]*=wsf[crow(r,hi)]; } }while(0)
  f32x16 pA0,pA1,pB0,pB1;
  int sl_prev=0,sl_cur=0,sl_next=SLOTB;
  #define ROT() do{sl_prev=sl_cur;sl_cur=sl_next;sl_next=(sl_next==(NSLOT-1)*SLOTB)?0:sl_next+SLOTB;}while(0)
  DMA_K(2,2*SLOTB);
  WAIT_BAR(3);
  NEGM_UPD(0);
  qkt(pA0,pA1,Kbase,qr,negm,r32,hi);asm volatile("s_nop 15\n\ts_nop 7":"+v"(pA0),"+v"(pA1));CMASK(pA0,pA1,0);
  START(pA0,pA1);
  _Pragma("unroll") for(int r=0;r<16;++r)pA1[r]=__builtin_amdgcn_exp2f(pA1[r]);
  WAIT_BAR(0);
  DMA_K(3,0);DMA_V(1,SLOTB);
  ROT();
  kload8(kf,kp0+sl_cur);
  WAIT_BAR(2);
  s16x4 vlo[8],vhi[8]; u32x4 pw0,pw1,pw2,pw3;
  #define PKW(P,B) cvtpk_s(P[B],P[B+1])
  #define PAF(k) __builtin_bit_cast(bf16x8,pw##k)
  #define VFR(i) (bf16x8){vlo[i][0],vlo[i][1],vlo[i][2],vlo[i][3],vhi[i][0],vhi[i][1],vhi[i][2],vhi[i][3]}
  #define PIN(x) asm volatile("":"+v"(x))
  #define MX3(a,b,c) __builtin_fmaxf(__builtin_fmaxf((a),(b)),(c))
  #define GAPA(MF,A0,A1,A2,A3,W0,W1,PW) do{ MF; sacc+=A0; sacc+=A1; sacc+=A2; sacc+=A3; PIN(sacc); W0; W1; PIN(PW); SBAR(); }while(0)
  #define EX(v) __builtin_amdgcn_exp2f(v)
  #define GAPB(MF,X,B) do{ MF; X[B]=EX(X[B]); X[B+1]=EX(X[B+1]); X[B+2]=EX(X[B+2]); X[B+3]=EX(X[B+3]); PIN(X); SBAR(); }while(0)
  #define VRD(i) do{ vlo[i]=vtr(vp_+(((i)>>2)*4096+((i)&3)*1024)); vhi[i]=vtr(vp_+(((i)>>2)*4096+((i)&3)*1024+512)); }while(0)
  #define KRD(G,j) do{ if(G){ kload2(kf,kp0+sl_next,j); SBAR(); } }while(0)
  #define STEP(C0,C1,P0,P1,t,GK,GV,GL) do{ SBAR(); \
    const lds_cptr vp_=vp0+sl_prev; \
    VRD(0); SBAR(); float sacc=(P0[0]+P0[1]); \
    GAPA(C0=__builtin_amdgcn_mfma_f32_32x32x16_bf16(kf[0],qr[0],negm,0,0,0), P0[2],P0[3],P0[4],P0[5],     pw0[0]=PKW(P0,0), pw0[1]=PKW(P0,2), pw0); \
    VRD(4); SBAR(); GAPA(C1=__builtin_amdgcn_mfma_f32_32x32x16_bf16(kf[1],qr[0],negm,0,0,0), P0[6],P0[7],P0[8],P0[9],     pw0[2]=PKW(P0,4), pw0[3]=PKW(P0,6), pw0); \
    VRD(1); SBAR(); GAPA(C0=__builtin_amdgcn_mfma_f32_32x32x16_bf16(kf[2],qr[1],C0,0,0,0),   P0[10],P0[11],P0[12],P0[13], pw1[0]=PKW(P0,8), pw1[1]=PKW(P0,10), pw1); \
    VRD(5); SBAR(); GAPA(C1=__builtin_amdgcn_mfma_f32_32x32x16_bf16(kf[3],qr[1],C1,0,0,0),   P0[14],P0[15],P1[0],P1[1],   pw1[2]=PKW(P0,12),pw1[3]=PKW(P0,14), pw1); \
    VRD(2); SBAR(); GAPA(C0=__builtin_amdgcn_mfma_f32_32x32x16_bf16(kf[4],qr[2],C0,0,0,0),   P1[2],P1[3],P1[4],P1[5],     pw2[0]=PKW(P1,0), pw2[1]=PKW(P1,2), pw2); \
    VRD(6); SBAR(); GAPA(C1=__builtin_amdgcn_mfma_f32_32x32x16_bf16(kf[5],qr[2],C1,0,0,0),   P1[6],P1[7],P1[8],P1[9],     pw2[2]=PKW(P1,4), pw2[3]=PKW(P1,6), pw2); \
    VRD(3); SBAR(); GAPA(C0=__builtin_amdgcn_mfma_f32_32x32x16_bf16(kf[6],qr[3],C0,0,0,0),   P1[10],P1[11],P1[12],P1[13], pw3[0]=PKW(P1,8), pw3[1]=PKW(P1,10), pw3); \
    VRD(7); SBAR(); GAPA(C1=__builtin_amdgcn_mfma_f32_32x32x16_bf16(kf[7],qr[3],C1,0,0,0),   P1[14],P1[15],0.f,0.f,       pw3[2]=PKW(P1,12),pw3[3]=PKW(P1,14), pw3); \
    l_reg+=sacc; \
    if(GK){DMA_K((t)+3,sl_cur);} if(GV){DMA_V((t)+1,sl_next);} \
    CMASK(C0,C1,t); \
    { float a=MX3(C0[0],C0[1],C1[0]),b=MX3(C0[2],C0[3],C1[1]); a=MX3(a,C1[2],C1[3]); \
      _Pragma("unroll") for(int r=4;r<16;r+=4){a=MX3(a,C0[r],C0[r+1]);b=MX3(b,C0[r+2],C0[r+3]);a=MX3(a,C1[r],C1[r+1]);b=MX3(b,C1[r+2],C1[r+3]);} \
      float rm=__builtin_fmaxf(a,b); { auto rr=__builtin_amdgcn_permlane32_swap(__float_as_uint(rm),__float_as_uint(rm),false,false); rm=__builtin_fmaxf(__uint_as_float(rr[0]),__uint_as_float(rr[1])); } \
      resc=false; \
      if(__builtin_expect(__any(rm>(float)THRL),0)){ const float dl=__builtin_fmaxf(rm,0.f); mhat+=dl; \
        _Pragma("unroll") for(int r=0;r<16;++r){C0[r]-=dl;C1[r]-=dl;} \
        const float f=__builtin_amdgcn_exp2f(-dl); l_reg*=f; if(hi==0)wsf[r32]=f; resc=true; } \
      if(resc||((((t)+1)&3)==0)) NEGM_UPD((t)+1); } \
    SBAR(); \
    GAPB(o[0]=__builtin_amdgcn_mfma_f32_32x32x16_bf16(PAF(0),VFR(0),o[0],0,0,0), C0,0); \
    GAPB(o[1]=__builtin_amdgcn_mfma_f32_32x32x16_bf16(PAF(0),VFR(4),o[1],0,0,0), C0,4); \
    KRD(GL,0); GAPB(o[0]=__builtin_amdgcn_mfma_f32_32x32x16_bf16(PAF(1),VFR(1),o[0],0,0,0), C0,8); \
    KRD(GL,1); GAPB(o[1]=__builtin_amdgcn_mfma_f32_32x32x16_bf16(PAF(1),VFR(5),o[1],0,0,0), C0,12); \
    KRD(GL,2); GAPB(o[0]=__builtin_amdgcn_mfma_f32_32x32x16_bf16(PAF(2),VFR(2),o[0],0,0,0), C1,0); \
    KRD(GL,3); GAPB(o[1]=__builtin_amdgcn_mfma_f32_32x32x16_bf16(PAF(2),VFR(6),o[1],0,0,0), C1,4); \
    GAPB(o[0]=__builtin_amdgcn_mfma_f32_32x32x16_bf16(PAF(3),VFR(3),o[0],0,0,0), C1,8); \
    GAPB(o[1]=__builtin_amdgcn_mfma_f32_32x32x16_bf16(PAF(3),VFR(7),o[1],0,0,0), C1,12); \
    }while(0)
  int t=1;
  #undef CMASK
  #define CMASK(P0,P1,t) do{}while(0)
  for(;t+5<NT;t+=2){
    STEP(pB0,pB1,pA0,pA1,t,true,true,true);     WAIT_BAR(2); RESC(); ROT();
    STEP(pA0,pA1,pB0,pB1,t+1,true,true,true);   WAIT_BAR(2); RESC(); ROT();
  }
  #undef CMASK
  #define CMASK(P0,P1,t) do{int jb_=(t)-(NT-4); if(jb_>=0&&64*jb_+63>QBLK*wid)cmask(P0,P1,jb_,qrel,hi);}while(0)
  #define ENDW(tt) do{ if((tt)+3<NT){WAIT_BAR(2);} else if((tt)+2<NT){WAIT_BAR(1);} else {WAIT_BAR(0);} }while(0)
  for(;t+1<NT;t+=2){
    STEP(pB0,pB1,pA0,pA1,t,(t+3<NT),(t+1<NT),(t+1<NT));       ENDW(t);   RESC(); ROT();
    STEP(pA0,pA1,pB0,pB1,t+1,(t+4<NT),(t+2<NT),(t+2<NT));     ENDW(t+1); RESC(); ROT();
  }
  STEP(pB0,pB1,pA0,pA1,NT-1,false,false,false); RESC();
  { float sacc=pB0[0]+pB0[1]; _Pragma("unroll") for(int r=2;r<16;++r)sacc+=pB0[r]; _Pragma("unroll") for(int r=0;r<16;++r)sacc+=pB1[r]; l_reg+=sacc;
    pw0=(u32x4){PKW(pB0,0),PKW(pB0,2),PKW(pB0,4),PKW(pB0,6)};pw1=(u32x4){PKW(pB0,8),PKW(pB0,10),PKW(pB0,12),PKW(pB0,14)};pw2=(u32x4){PKW(pB1,0),PKW(pB1,2),PKW(pB1,4),PKW(pB1,6)};pw3=(u32x4){PKW(pB1,8),PKW(pB1,10),PKW(pB1,12),PKW(pB1,14)};
    SBAR(); pv(o,vb0+sl_cur,PAF(0),PAF(1),PAF(2),PAF(3)); }
  #undef PKW
  #undef PAF
  #undef VFR
  #undef PIN
  #undef MX3
  #undef GAPA
  #undef GAPB
  #undef EX
  #undef VRD
  #undef KRD
  #undef STEP
  #undef ENDW
  {auto rr=__builtin_amdgcn_permlane32_swap(__float_as_uint(l_reg),__float_as_uint(l_reg),false,false);l_reg=__uint_as_float(rr[0])+__uint_as_float(rr[1]);}
  if(hi==0)wsf[32+r32]=l_reg;asm volatile("s_waitcnt lgkmcnt(0)":::"memory");
  float rli[16];
  #pragma unroll
  for(int r=0;r<16;++r)rli[r]=__builtin_amdgcn_rcpf(wsf[32+crow(r,hi)]);
  bf16_t*Ow=Y+(rowbase+q0+wid*QBLK)*YW+512+h*64;
  { LAS bf16_t*stg=(LAS bf16_t*)(shm+LDS_OST)+wid*2048;
    #pragma unroll
    for(int r=0;r<16;++r){const int orow=crow(r,hi);
      #pragma unroll
      for(int d0=0;d0<2;++d0)stg[orow*64+d0*32+r32]=f2bf(o[d0][r]*rli[r]);}
    asm volatile("s_waitcnt lgkmcnt(0)":::"memory");
    #pragma unroll
    for(int i=0;i<4;++i){const int row=i*8+(lane>>3),ch=lane&7; const u32x4 v=*(LAS const u32x4*)(stg+row*64+ch*8); *(GAS u32x4*)(Ow+(long)row*YW+ch*8)=v;} }
  asm volatile("s_waitcnt lgkmcnt(0)\n\ts_barrier":::"memory");
  #undef DMA_K
  #undef DMA_V
  #undef CMASK
  #undef NEGM_UPD
  #undef START
  #undef RESC
  #undef ROT
}

#undef SBAR
#undef WAIT_BAR
}

namespace gla {
constexpr int PB = 144, PV = 272;
constexpr int L_LAR = 0, L_QR = 9216, L_KR = 18432, L_VR = 27648, L_RR = 45056, L_QD = 62464, L_KD = 71680, L_KTL = 80896, L_AM = 90112, L_DEC = 99328, L_SSQ = 99584, L_Y = 101632, L_END = 119040;
__device__ __forceinline__ f32x4 mfma16(bf16x8 a, bf16x8 b, f32x4 c) { return __builtin_amdgcn_mfma_f32_16x16x32_bf16(a, b, c, 0, 0, 0); }
__device__ __forceinline__ s16x4 trd(LAS const unsigned char* p) { return __builtin_bit_cast(s16x4, __builtin_amdgcn_ds_read_tr16_b64_v4i16((LAS v4i16_t*)p)); }
__device__ __forceinline__ bf16x8 tr_frag(LAS const unsigned char* img, int pitch, int k0, int c0, int lane) {
    const int g = lane >> 4, q = (lane & 15) >> 2, p = lane & 3;
    LAS const unsigned char* a = img + (k0 + 8 * g + q) * pitch + (c0 + 4 * p) * 2;
    const s16x4 lo = trd(a), hi = trd(a + 4 * pitch);
    return (bf16x8){lo[0], lo[1], lo[2], lo[3], hi[0], hi[1], hi[2], hi[3]};
}

template <int VAR = 0> __device__ __forceinline__ void gla_unit(const bf16_t* proj, bf16_t* Y, int b, int h, const float* gnorm, LAS unsigned char* lds) {
    int tid_ = threadIdx.x; asm volatile("" : "+v"(tid_));
    const int tid = tid_, lane = tid & 63, fr = lane & 15, fq = lane >> 4; const int wid = __builtin_amdgcn_readfirstlane(tid >> 6);
    const long rowbase = (long)b * SEQ;
    const int cq = 2304 + 64 * h, ck = 2560 + 64 * h, cv = 2816 + 128 * h, cla = 3328 + 64 * h, cr = 3584 + 128 * h;
    const int lt = tid >> 3, ldc = (tid & 7) * 8;
    const int vrow0 = tid >> 4, ve0 = (tid & 15) * 8;
    f32x4 sd[4];
#pragma unroll
    for (int i = 0; i < 4; ++i) sd[i] = (f32x4){0.f, 0.f, 0.f, 0.f};
    const f32x4 gn4 = *(const GAS f32x4*)(gnorm + 16 * wid + 4 * fq);
    u32x4 nq, nk, nla, nv0, nv1, nr0, nr1;
    {
        const bf16_t* base = proj + (rowbase + lt) * PP;
        nq = *(const GAS u32x4*)(base + cq + ldc); nk = *(const GAS u32x4*)(base + ck + ldc); nla = *(const GAS u32x4*)(base + cla + ldc);
        const bf16_t* bv = proj + (rowbase + vrow0) * PP;
        nv0 = *(const GAS u32x4*)(bv + cv + ve0); nv1 = *(const GAS u32x4*)(bv + (size_t)32 * PP + cv + ve0);
        nr0 = *(const GAS u32x4*)(bv + cr + ve0); nr1 = *(const GAS u32x4*)(bv + (size_t)32 * PP + cr + ve0);
    }
    LAS float* DEC = (LAS float*)(lds + L_DEC); LAS float* SSQ = (LAS float*)(lds + L_SSQ);
    const int db = wid & 3, ibp = wid >> 2;
    f32x4 aop[4];
#pragma unroll
    for (int i = 0; i < 4; ++i) aop[i] = (f32x4){0.f, 0.f, 0.f, 0.f};
    auto epi2 = [&](int m) {
        const int rro_ = (m & 1) ? L_Y : L_RR;
        const long r0 = rowbase + (long)m * 64;
        u32x2 yw[4];
#pragma unroll
        for (int ib = 0; ib < 4; ++ib) { const int i_ = 16 * ib + fr;
            const f32x4 s0 = *(LAS const f32x4*)(SSQ + i_ * 8), s1 = *(LAS const f32x4*)(SSQ + i_ * 8 + 4);
            const float tot = ((s0[0] + s0[1]) + (s0[2] + s0[3])) + ((s1[0] + s1[1]) + (s1[2] + s1[3]));
            const float rstd = frsq(tot * (1.0f / 128.0f) + EPS);
            const u32x2 rw = *(LAS const u32x2*)(lds + rro_ + i_ * PV + (16 * wid + 4 * fq) * 2);
            const f32x4 y = aop[ib] * rstd * gn4 * (f32x4){bf_lo(rw.x), bf_hi(rw.x), bf_lo(rw.y), bf_hi(rw.y)};
            yw[ib] = (u32x2){cvt_pk_bf16(y[0], y[1]), cvt_pk_bf16(y[2], y[3])}; }
#pragma unroll
        for (int p2 = 0; p2 < 2; ++p2) {
            const auto rx = __builtin_amdgcn_permlane16_swap(yw[2 * p2].x, yw[2 * p2 + 1].x, false, false), ry = __builtin_amdgcn_permlane16_swap(yw[2 * p2].y, yw[2 * p2 + 1].y, false, false);
            *(GAS u32x4*)(Y + (r0 + 16 * (2 * p2 + (fq & 1)) + fr) * YW + 1024 + 128 * h + 16 * wid + 8 * (fq >> 1)) = (u32x4){rx[0], ry[0], rx[1], ry[1]}; }
    };
    for (int n = 0; n < 32; ++n) {
        *(LAS u32x4*)(lds + L_LAR + lt * PB + ldc * 2) = nla; *(LAS u32x4*)(lds + L_QR + lt * PB + ldc * 2) = nq; *(LAS u32x4*)(lds + L_KR + lt * PB + ldc * 2) = nk;
        const int rro = (n & 1) ? L_Y : L_RR;
        *(LAS u32x4*)(lds + rro + vrow0 * PV + ve0 * 2) = nr0; *(LAS u32x4*)(lds + rro + (vrow0 + 32) * PV + ve0 * 2) = nr1;
        LDS_WAIT(); __builtin_amdgcn_s_barrier(); asm volatile("" ::: "memory");
        *(LAS u32x4*)(lds + L_VR + vrow0 * PV + ve0 * 2) = nv0; *(LAS u32x4*)(lds + L_VR + (vrow0 + 32) * PV + ve0 * 2) = nv1;
        if (n + 1 < 32) {
            const long r1 = rowbase + (long)(n + 1) * 64;
            const bf16_t* base = proj + (r1 + lt) * PP;
            nq = *(const GAS u32x4*)(base + cq + ldc); nk = *(const GAS u32x4*)(base + ck + ldc); nla = *(const GAS u32x4*)(base + cla + ldc);
            const bf16_t* bv = proj + (r1 + vrow0) * PP;
            nv0 = *(const GAS u32x4*)(bv + cv + ve0); nv1 = *(const GAS u32x4*)(bv + (size_t)32 * PP + cv + ve0);
            nr0 = *(const GAS u32x4*)(bv + cr + ve0); nr1 = *(const GAS u32x4*)(bv + (size_t)32 * PP + cr + ve0);
        }
        if (n > 0) epi2(n - 1);
        {
            bf16x8 af[2];
#pragma unroll
            for (int s = 0; s < 2; ++s) af[s] = tr_frag(lds + L_LAR, PB, 32 * s, 16 * db, lane);
            const u32x4 one4 = {0x3F803F80u, 0x3F803F80u, 0x3F803F80u, 0x3F803F80u};
            f32x4 bl = {0.f, 0.f, 0.f, 0.f};
            bl = mfma16(af[0], __builtin_bit_cast(bf16x8, one4), bl); bl = mfma16(af[1], __builtin_bit_cast(bf16x8, one4), bl);
#pragma unroll
            for (int rep = 0; rep < 2; ++rep) {
                const int ib = 2 * ibp + rep, i_ = 16 * ib + fr;
                f32x4 bc = {0.f, 0.f, 0.f, 0.f};
#pragma unroll
                for (int s = 0; s < 2; ++s) {
                    const int nones = i_ - (32 * s + 8 * fq) + 1;
                    u32x4 lw;
                    lw.x = (nones > 0 ? 0x3F80u : 0u) | (nones > 1 ? 0x3F800000u : 0u); lw.y = (nones > 2 ? 0x3F80u : 0u) | (nones > 3 ? 0x3F800000u : 0u);
                    lw.z = (nones > 4 ? 0x3F80u : 0u) | (nones > 5 ? 0x3F800000u : 0u); lw.w = (nones > 6 ? 0x3F80u : 0u) | (nones > 7 ? 0x3F800000u : 0u);
                    bc = mfma16(af[s], __builtin_bit_cast(bf16x8, lw), bc);
                }
                const int off = i_ * PB + (16 * db + 4 * fq) * 2;
                const u32x2 qw = *(LAS const u32x2*)(lds + L_QR + off), kw = *(LAS const u32x2*)(lds + L_KR + off);
                const float q4[4] = {bf_lo(qw.x), bf_hi(qw.x), bf_lo(qw.y), bf_hi(qw.y)}, k4[4] = {bf_lo(kw.x), bf_hi(kw.x), bf_lo(kw.y), bf_hi(kw.y)};
                float qd[4], kd[4], kt[4];
#pragma unroll
                for (int r = 0; r < 4; ++r) { qd[r] = q4[r] * fexp(bc[r]); kd[r] = k4[r] * fexp(-bc[r]); kt[r] = k4[r] * fexp(bl[r] - bc[r]); }
                *(LAS u32x2*)(lds + L_QD + off) = (u32x2){cvt_pk_bf16(qd[0], qd[1]), cvt_pk_bf16(qd[2], qd[3])};
                *(LAS u32x2*)(lds + L_KD + off) = (u32x2){cvt_pk_bf16(kd[0], kd[1]), cvt_pk_bf16(kd[2], kd[3])};
                *(LAS u32x2*)(lds + L_KTL + off) = (u32x2){cvt_pk_bf16(kt[0], kt[1]), cvt_pk_bf16(kt[2], kt[3])};
            }
            if (ibp == 0 && fr == 0) *(LAS f32x4*)(DEC + 16 * db + 4 * fq) = (f32x4){fexp(bl[0]), fexp(bl[1]), fexp(bl[2]), fexp(bl[3])};
        }
        LDS_WAIT(); __builtin_amdgcn_s_barrier(); asm volatile("" ::: "memory");
#pragma unroll
        for (int rep = 0; rep < 2; ++rep) {
            const int id = wid + 8 * rep, ib = id >> 2, jb = id & 3;
            u32x2 w = {0u, 0u};
            if (jb <= ib) {
                f32x4 a = {0.f, 0.f, 0.f, 0.f};
#pragma unroll
                for (int s = 0; s < 2; ++s) {
                    const bf16x8 ka = *(LAS const bf16x8*)(lds + L_KD + (16 * jb + fr) * PB + (32 * s + 8 * fq) * 2);
                    const bf16x8 qb_ = *(LAS const bf16x8*)(lds + L_QD + (16 * ib + fr) * PB + (32 * s + 8 * fq) * 2);
                    a = mfma16(ka, qb_, a);
                }
                const int i_ = 16 * ib + fr, j0 = 16 * jb + 4 * fq;
#pragma unroll
                for (int r = 0; r < 4; ++r) if (j0 + r > i_) a[r] = 0.f;
                w.x = cvt_pk_bf16(a[0], a[1]); w.y = cvt_pk_bf16(a[2], a[3]);
            }
            *(LAS u32x2*)(lds + L_AM + (16 * ib + fr) * PB + (16 * jb + 4 * fq) * 2) = w;
        }
        f32x4 ao[4];
        {
            bf16x8 sb[2];
#pragma unroll
            for (int s = 0; s < 2; ++s) { u32x4 w; w.x = cvt_pk_bf16(sd[2 * s][0], sd[2 * s][1]); w.y = cvt_pk_bf16(sd[2 * s][2], sd[2 * s][3]); w.z = cvt_pk_bf16(sd[2 * s + 1][0], sd[2 * s + 1][1]); w.w = cvt_pk_bf16(sd[2 * s + 1][2], sd[2 * s + 1][3]); sb[s] = __builtin_bit_cast(bf16x8, w); }
#pragma unroll
            for (int ib = 0; ib < 4; ++ib) {
                f32x4 a = {0.f, 0.f, 0.f, 0.f};
#pragma unroll
                for (int s = 0; s < 2; ++s) {
                    const u32x2 lo = *(LAS const u32x2*)(lds + L_QD + (16 * ib + fr) * PB + (32 * s + 4 * fq) * 2);
                    const u32x2 hi = *(LAS const u32x2*)(lds + L_QD + (16 * ib + fr) * PB + (32 * s + 16 + 4 * fq) * 2);
                    const u32x4 qa = {lo.x, lo.y, hi.x, hi.y};
                    a = mfma16(sb[s], __builtin_bit_cast(bf16x8, qa), a);
                }
                ao[ib] = a;
            }
        }
        bf16x8 vf[2];
#pragma unroll
        for (int s = 0; s < 2; ++s) vf[s] = tr_frag(lds + L_VR, PV, 32 * s, 16 * wid, lane);
#pragma unroll
        for (int d4 = 0; d4 < 4; ++d4) {
            const f32x4 dc = *(LAS const f32x4*)(DEC + 16 * d4 + 4 * fq);
            f32x4 a = sd[d4] * dc;
#pragma unroll
            for (int s = 0; s < 2; ++s) { const bf16x8 kf = tr_frag(lds + L_KTL, PB, 32 * s, 16 * d4, lane); a = mfma16(kf, vf[s], a); }
            sd[d4] = a;
        }
        LDS_WAIT(); __builtin_amdgcn_s_barrier(); asm volatile("" ::: "memory");
#pragma unroll
        for (int ib = 0; ib < 4; ++ib)
#pragma unroll
            for (int s = 0; s < 2; ++s) {
                if (32 * s > 16 * ib + 15) continue;
                const bf16x8 af = *(LAS const bf16x8*)(lds + L_AM + (16 * ib + fr) * PB + (32 * s + 8 * fq) * 2);
                ao[ib] = mfma16(vf[s], af, ao[ib]);
            }
#pragma unroll
        for (int ib = 0; ib < 4; ++ib) { float v = (ao[ib][0] * ao[ib][0] + ao[ib][1] * ao[ib][1]) + (ao[ib][2] * ao[ib][2] + ao[ib][3] * ao[ib][3]); v = addx32(addx16(v));
            if (fq == 0) SSQ[(16 * ib + fr) * 8 + wid] = v; }
#pragma unroll
        for (int ib = 0; ib < 4; ++ib) aop[ib] = ao[ib];
    }
    LDS_WAIT(); __builtin_amdgcn_s_barrier(); asm volatile("" ::: "memory");
    epi2(31);
    LDS_WAIT(); __builtin_amdgcn_s_barrier(); asm volatile("" ::: "memory");
}
}

constexpr int NWAVES = 8;
constexpr int RING_BYTES = 131072, MISC_OFF = RING_BYTES, LDS_BYTES = 147456;
static_assert(gla::L_END <= RING_BYTES && att::L_END <= RING_BYTES && att2::LDS_BYTES <= RING_BYTES, "LDS map");

struct Params { const float* in[20]; float* out; unsigned char* ws; double invf[32]; int ph_lo, ph_hi; };

__device__ __forceinline__ void norm_row(const float* xrow, const float* gain, bf16_t* orow, int lane) {
    const f32x4* xr = (const f32x4*)xrow + lane; const f32x4* gr = (const f32x4*)gain + lane;
    f32x4 v[4]; float s = 0.f;
#pragma unroll
    for (int j = 0; j < 4; ++j) { v[j] = xr[64 * j]; s += (v[j][0] * v[j][0] + v[j][1] * v[j][1]) + (v[j][2] * v[j][2] + v[j][3] * v[j][3]); }
    const float rstd = 1.0f / sqrtf(wave_sum(s) * (1.0f / D) + EPS);
    u32x2* o8 = (u32x2*)orow + lane;
#pragma unroll
    for (int j = 0; j < 4; ++j) { const f32x4 g = gr[64 * j]; u32x2 w; w.x = cvt_pk_bf16(v[j][0] * rstd * g[0], v[j][1] * rstd * g[1]); w.y = cvt_pk_bf16(v[j][2] * rstd * g[2], v[j][3] * rstd * g[3]); o8[64 * j] = w; }
}
__device__ __forceinline__ void norm_phase(const float* x, const float* gain, bf16_t* H, int gw, int ngw, int lane) {
    for (int m = gw; m < T; m += ngw) norm_row(x + (size_t)m * D, gain, H + (size_t)m * D, lane);
}

__device__ __forceinline__ void conv_item(const float* src, int pitch, int col, int K, bf16_t* dst, int prow, int k0, const float* kscale = nullptr) {
    const float* s = src + (size_t)k0 * pitch + col;
    bf16_t* d = dst + (size_t)prow * K + k0;
#pragma unroll 2
    for (int kk = 0; kk < 8; ++kk) {
        float v[8];
#pragma unroll
        for (int i = 0; i < 8; ++i) v[i] = s[(size_t)(kk * 8 + i) * pitch];
        if (kscale) {
#pragma unroll
            for (int i = 0; i < 8; ++i) v[i] *= kscale[k0 + kk * 8 + i]; }
        u32x4 w; w.x = cvt_pk_bf16(v[0], v[1]); w.y = cvt_pk_bf16(v[2], v[3]); w.z = cvt_pk_bf16(v[4], v[5]); w.w = cvt_pk_bf16(v[6], v[7]);
        *(GAS u32x4*)(d + kk * 8) = w;
    }
}
__device__ __forceinline__ void conv4_load(const float* src, int pitch, int k0, const float* kscale, float mul, f32x4 (&v)[16]) {
#pragma unroll
    for (int i = 0; i < 16; ++i) v[i] = *(const GAS f32x4*)(src + (size_t)(k0 + i) * pitch);
    if (kscale) {
#pragma unroll
        for (int i = 0; i < 16; ++i) v[i] *= kscale[k0 + i] * mul; }
}
__device__ __forceinline__ void conv4_store_bf16(const f32x4 (&v)[16], bf16_t* dst, int K) {
#pragma unroll
    for (int j = 0; j < 4; ++j) {
        *(GAS u32x4*)(dst + (size_t)j * K) = (u32x4){cvt_pk_bf16(v[0][j], v[1][j]), cvt_pk_bf16(v[2][j], v[3][j]), cvt_pk_bf16(v[4][j], v[5][j]), cvt_pk_bf16(v[6][j], v[7][j])};
        *(GAS u32x4*)(dst + (size_t)j * K + 8) = (u32x4){cvt_pk_bf16(v[8][j], v[9][j]), cvt_pk_bf16(v[10][j], v[11][j]), cvt_pk_bf16(v[12][j], v[13][j]), cvt_pk_bf16(v[14][j], v[15][j])}; }
}
__device__ __forceinline__ void conv4_store_fp8(const f32x4 (&v)[16], unsigned char* d8, int K) {
#pragma unroll
    for (int j = 0; j < 4; ++j)
        *(GAS u32x4*)(d8 + (size_t)j * K) = (u32x4){cvt4_fp8(v[0][j], v[1][j], v[2][j], v[3][j]), cvt4_fp8(v[4][j], v[5][j], v[6][j], v[7][j]), cvt4_fp8(v[8][j], v[9][j], v[10][j], v[11][j]), cvt4_fp8(v[12][j], v[13][j], v[14][j], v[15][j])};
}
constexpr int IT_WIN = (PW / 64) * (D / 64), IT_WG = (GW / 64) * (D / 64), IT_WB = 3 * (D / 64) * (512 / 64), IT_WO = (D / 64) * (D / 64), IT_F1 = (FFP / 64) * (D / 64), IT_F2 = (D / 64) * (FF / 64);
constexpr int IT_LAYER = IT_WIN + IT_WG + IT_WB + IT_WO + IT_F1 + IT_F2;

__device__ __forceinline__ void sincos_d(double a, float& c, float& s) {
    const double kq = rint(a * 0.63661977236758134308);
    double r = fma(-kq, 1.57079632679489655800e+00, a); r = fma(-kq, 6.12323399573676603587e-17, r);
    const double r2 = r * r;
    const double sp = r * (1.0 + r2 * (-1.0 / 6 + r2 * (1.0 / 120 + r2 * (-1.0 / 5040 + r2 * (1.0 / 362880 + r2 * (-1.0 / 39916800 + r2 * (1.0 / 6227020800.0)))))));
    const double cp = 1.0 + r2 * (-0.5 + r2 * (1.0 / 24 + r2 * (-1.0 / 720 + r2 * (1.0 / 40320 + r2 * (-1.0 / 3628800 + r2 * (1.0 / 479001600 + r2 * (-1.0 / 87178291200.0)))))));
    const int q = ((int)kq) & 3;
    const double ss = (q == 0) ? sp : (q == 1) ? cp : (q == 2) ? -sp : -cp;
    const double cc = (q == 0) ? cp : (q == 1) ? -sp : (q == 2) ? -cp : sp;
    c = (float)cc; s = (float)ss;
}

__device__ __forceinline__ void prologue(const Params& P, int gw, int ngw, int lane) {
    unsigned char* ws = P.ws;
    for (int rep = 0; rep < (DBG_DUP == 4 ? 2 : 1); ++rep)
    for (int it = gw; it < 2 * IT_LAYER; it += ngw) {
        const int l = it / IT_LAYER; int r = it - l * IT_LAYER;
        unsigned char* wl = ws + WS_W + (size_t)l * LW_BYTES;
        const int q4 = 4 * lane;
        if (r < IT_WIN) {
            const int pn = r / (D / 16), k0 = (r % (D / 16)) * 16, bj = (q4 >> 7) & 1, wc = (q4 >> 5) & 3, rem = q4 & 31, c = 256 * pn + 64 * wc + 32 * bj + rem, prow = 256 * pn + q4;
            const float* win = P.in[3] + (size_t)l * D * DIN; const float* ga = P.in[2] + (size_t)l * D;
            f32x4 v[16];
            if (pn < 2 || (pn >= 3 && pn < 7)) {
                conv4_load(win + c, DIN, k0, ga, WS8, v); conv4_store_fp8(v, wl + OFF_WIN8 + (size_t)prow * D + k0, D);
            } else if (pn == 13) {
                const float* wa = P.in[9] + (size_t)l * 16 * 256 + (c - 3328);
                f32x4 a[16];
#pragma unroll
                for (int q = 0; q < 16; ++q) a[q] = *(const GAS f32x4*)(wa + q * 256);
                const f32x4 wv = *(const GAS f32x4*)(win + (size_t)(k0 + (lane & 15)) * DIN + 3328 + 4 * (lane >> 4));
#pragma unroll
                for (int k = 0; k < 16; ++k) { f32x4 acc = {0.f, 0.f, 0.f, 0.f};
#pragma unroll
                    for (int q = 0; q < 16; ++q) acc += a[q] * __int_as_float(__builtin_amdgcn_readlane(__float_as_int(wv[q & 3]), k + 16 * (q >> 2)));
                    v[k] = acc * ga[k0 + k]; }
                conv4_store_bf16(v, (bf16_t*)(wl + OFF_WIN) + (size_t)prow * D + k0, D);
            } else { conv4_load(win + (pn >= 14 ? 3344 + (c - 3584) : c), DIN, k0, ga, 1.0f, v); conv4_store_bf16(v, (bf16_t*)(wl + OFF_WIN) + (size_t)prow * D + k0, D); }
            continue;
        }
        r -= IT_WIN;
        if (r < IT_WG) {
            const int prow = 256 * (r / (D / 16)) + q4, k0 = (r % (D / 16)) * 16; f32x4 v[16];
            conv4_load(P.in[3] + (size_t)l * D * DIN + 3856 + prow, DIN, k0, P.in[2] + (size_t)l * D, WS8, v); conv4_store_fp8(v, wl + OFF_WG + (size_t)prow * D + k0, D);
            continue; }
        r -= IT_WG;
        if (r < IT_WB) { const int j = r / (4 * 32), r2 = r % (4 * 32), prow = 256 * (r2 / 32) + q4, k0 = (r2 % 32) * 16; f32x4 v[16];
            conv4_load(P.in[12 + j] + (size_t)l * 512 * D + prow, D, k0, nullptr, 1.0f, v); conv4_store_bf16(v, (bf16_t*)(wl + OFF_WB) + (size_t)j * D * 512 + (size_t)prow * 512 + k0, 512); continue; }
        r -= IT_WB;
        if (r < IT_WO) { const int prow = 256 * (r / (D / 16)) + q4, k0 = (r % (D / 16)) * 16; f32x4 v[16];
            conv4_load(P.in[15] + (size_t)l * D * D + prow, D, k0, nullptr, 1.0f, v); conv4_store_bf16(v, (bf16_t*)(wl + OFF_WO) + (size_t)prow * D + k0, D); continue; }
        r -= IT_WO;
        if (r < IT_F1) { const int pn = r / (D / 16), k0 = (r % (D / 16)) * 16, prow = 256 * pn + q4, bj = (q4 >> 7) & 1, c = 128 * pn + (q4 & 127); f32x4 v[16];
            conv4_load(P.in[bj ? 18 : 17] + (size_t)l * D * FF + c, FF, k0, P.in[16] + (size_t)l * D, 1.0f, v); conv4_store_bf16(v, (bf16_t*)(wl + OFF_F1) + (size_t)prow * D + k0, D); continue; }
        r -= IT_F1;
        { const int prow = 256 * (r / (FF / 16)) + q4, k0 = (r % (FF / 16)) * 16; f32x4 v[16];
          conv4_load(P.in[19] + (size_t)l * FF * D + prow, D, k0, nullptr, 1.0f, v); conv4_store_bf16(v, (bf16_t*)(wl + OFF_F2) + (size_t)prow * FF + k0, FF); }
    }
    {
        bf16_t* rope = (bf16_t*)(ws + WS_ROPE); const int* pos = (const int*)P.in[1];
        for (int idx = gw * 64 + lane; idx < T * 4; idx += ngw * 64) {
            const int t = idx >> 2, i0 = (idx & 3) * 8; const double pt = (double)pos[t]; float c[8], sn[8];
#pragma unroll
            for (int j = 0; j < 8; ++j) sincos_d(pt * P.invf[i0 + j], c[j], sn[j]);
            *(GAS u32x4*)(rope + (size_t)t * 64 + i0) = (u32x4){cvt_pk_bf16(c[0], c[1]), cvt_pk_bf16(c[2], c[3]), cvt_pk_bf16(c[4], c[5]), cvt_pk_bf16(c[6], c[7])};
            *(GAS u32x4*)(rope + (size_t)t * 64 + 32 + i0) = (u32x4){cvt_pk_bf16(sn[0], sn[1]), cvt_pk_bf16(sn[2], sn[3]), cvt_pk_bf16(sn[4], sn[5]), cvt_pk_bf16(sn[6], sn[7])}; }
    }
    {
        float* SS = (float*)(ws + WS_SS); bf16_t* XB = (bf16_t*)P.out;
        for (int m = gw; m < T; m += ngw) {
            const f32x4* xr = (const f32x4*)(P.in[0] + (size_t)m * D) + 4 * lane; float s2 = 0.f;
            f32x4 v[4];
#pragma unroll
            for (int j = 0; j < 4; ++j) { v[j] = xr[j]; s2 += (v[j][0] * v[j][0] + v[j][1] * v[j][1]) + (v[j][2] * v[j][2] + v[j][3] * v[j][3]); }
            u32x4* ob = (u32x4*)(XB + (size_t)(m / RPG) * XSH + (size_t)m * D) + 2 * lane;
            ob[0] = pg8::pack8(v[0], v[1]); ob[1] = pg8::pack8(v[2], v[3]);
            u32x4 w8;
            w8.x = cvt4_fp8(v[0][0] * XS8, v[0][1] * XS8, v[0][2] * XS8, v[0][3] * XS8); w8.y = cvt4_fp8(v[1][0] * XS8, v[1][1] * XS8, v[1][2] * XS8, v[1][3] * XS8);
            w8.z = cvt4_fp8(v[2][0] * XS8, v[2][1] * XS8, v[2][2] * XS8, v[2][3] * XS8); w8.w = cvt4_fp8(v[3][0] * XS8, v[3][1] * XS8, v[3][2] * XS8, v[3][3] * XS8);
            ((u32x4*)(ws + WS_XB8 + (size_t)m * D))[lane] = w8;
            s2 = wave_sum(s2);
            if (lane == 0) SS[m] = s2;
        }
        for (int idx = gw * 64 + lane; idx < 3 * T; idx += ngw * 64) SS[T + idx] = 0.f;
    }
}

constexpr int Q_GLA = 8, Q_MOBA = 128, Q_SWA = 128;

__global__ void __launch_bounds__(NWAVES * 64, 2) mk_fwd(Params P) {
    extern __shared__ __attribute__((aligned(16))) unsigned char lds_raw[];
    LAS unsigned char* lds = (LAS unsigned char*)lds_raw;
    volatile LAS unsigned* MISC = (volatile LAS unsigned*)(lds + MISC_OFF);
    const int tid = threadIdx.x, lane = tid & 63, wave = __builtin_amdgcn_readfirstlane(tid >> 6);
    const int G = gridDim.x, bx = blockIdx.x;
    const int vcu = (G % 8 == 0) ? (bx % 8) * (G / 8) + bx / 8 : bx;
    const int gw = vcu * NWAVES + wave, ngw = G * NWAVES;
    unsigned char* ws = P.ws;
    unsigned* ctl = (unsigned*)(ws + WS_CTL);
    for (int u = tid; u < 64; u += NWAVES * 64) MISC[u] = 0u;
    __syncthreads();
    XcdBarrier bar; bar.bar = ctl + CW_BAR; bar.x = 0; bar.st = nullptr;
    if (!MK_PER_PHASE) bar = xcd_barrier_post(ctl + CW_BAR, MISC + 8);
    if (!MK_PER_PHASE && tid == 0) (void)__hip_atomic_fetch_or(ctl + CW_GMASK + 64 * (bx & 7), 1u << xb_xcc_id(), __ATOMIC_RELAXED, __HIP_MEMORY_SCOPE_AGENT);
    const int lo = P.ph_lo, hi = P.ph_hi;
    int fastg = 0; unsigned gbn = 0u;
#define IN(k) (lo <= (k) && (k) < hi)
#define SEAM(k) do { if (IN(k) && IN((k) + 1)) xcd_barrier(bar); } while (0)
#define SEAMG(k) do { if (IN(k) && IN((k) + 1)) { if (fastg) { ++gbn; grp_barrier(ctl + CW_GRP + 64 * (bx & 7), gbn * (unsigned)(G / 8), ctl + CW_BAR); } else xcd_barrier(bar); } } while (0)

#define Hb ((bf16_t*)(ws + WS_H + (size_t)grp * SH_H))
#define PROJ ((bf16_t*)(ws + WS_PROJ))
#define XS ((bf16_t*)P.out + (size_t)grp * XSH)
#define GATES ((bf16_t*)(ws + WS_PROJ + (size_t)grp * SH_GATES))
#define MERGED ((bf16_t*)(ws + WS_PROJ + OFF_MERGED_IN_SLAB + (size_t)grp * SH_MERGED))
#define ACT ((bf16_t*)(ws + WS_PROJ + (size_t)grp * SH_ACT))
#define Yb ((bf16_t*)(ws + WS_Y))
#define rope ((bf16_t*)(ws + WS_ROPE))
#define kmp ((float*)(ws + WS_KM))
#define SS ((float*)(ws + WS_SS))

    #ifndef DBG_NO_PRO
    if (IN(1)) { prologue(P, gw, ngw, lane); }
#endif
    SEAM(1);
    if (!MK_PER_PHASE && IN(1) && IN(2)) {
        if (tid == 0) { unsigned ok = (G % 8 == 0) ? 1u : 0u;
            for (int j = 0; j < 8; ++j) { const unsigned m = xb_ld(ctl + CW_GMASK + 64 * j); ok &= (m != 0u && (m & (m - 1u)) == 0u) ? 1u : 0u; }
            MISC[20] = ok; }
        __syncthreads();
        fastg = __builtin_amdgcn_readfirstlane((int)MISC[20]);
#ifdef DBG_FORCE_GRID_BARRIERS
        fastg = 0;
#endif
    }
    for (int l = 0; l < DEPTH; ++l) {
        const int pb = 9 * l;
        unsigned char* ws = P.ws; asm volatile("" : "+s"(ws));
        int lane_l = lane; asm volatile("" : "+v"(lane_l));
        int bxl = blockIdx.x; asm volatile("" : "+s"(bxl));
        const int grp = bxl & 7;
        unsigned char* wl = ws + WS_W + (size_t)l * LW_BYTES;
        if (IN(2 + pb)) for (int rep = 0; rep < (DBG_DUP == 2 ? 2 : 1); ++rep) {
            if (rep) xcd_barrier(bar);
#ifndef DBG_NO_EPIINPROJ
            {
                pg8::Gemm g{(const bf16_t*)(ws + WS_XB8), (const bf16_t*)(wl + OFF_WIN8), D / 2, D / 2, D / 2, 0, 0, nullptr, nullptr, 0, 0, 0, 0, 0, 1 << 30};
                pg8::TileOrderSub S; S.init(T, 6 * 256, G, bxl, 1); S.mode = 1;
                pg8::EpiInProjT<FP8_LATE> E{PROJ, rope, P.in[4] + l * 64, P.in[5] + l * 64, P.in[7] + l * 64, P.in[8] + l * 64, P.in[10] + l * 256, kmp, SS + (size_t)(2 * l) * T, 1.0f / (XS8 * WS8)};
                pg8::gemm_phase<pg8::EpiInProjT<FP8_LATE>, false, pg8::TileOrderSub, true>(lds, g, S, E, 0); }
            {
                pg8::Gemm g{XS, (const bf16_t*)(wl + OFF_WIN), D, D, D, 0, 0, nullptr, nullptr, 0, 0, 0, 0, 0, 1 << 30};
                pg8::TileOrderSub S; S.init(T, 10 * 256, G, bxl, 1); S.mode = 2;
                pg8::EpiInProj E{PROJ, rope, P.in[4] + l * 64, P.in[5] + l * 64, P.in[7] + l * 64, P.in[8] + l * 64, P.in[10] + l * 256, kmp, SS + (size_t)(2 * l) * T, 1.0f};
                pg8::gemm_phase<pg8::EpiInProj, false, pg8::TileOrderSub, false>(lds, g, S, E, 0); }
#endif
        }
        SEAMG(2 + pb);
        if (IN(3 + pb)) {
            unsigned* qctr = ctl + CW_Q + 256 * (8 * l + grp);
            int it = 0;
            for (;; ++it) {
                if (tid == 0) MISC[16 + (it & 1)] = __hip_atomic_fetch_add(qctr, 1u, __ATOMIC_RELAXED, __HIP_MEMORY_SCOPE_AGENT);
                __syncthreads();
                const int id = (int)MISC[16 + (it & 1)];
                if (id >= Q_GLA) break;
                gla::gla_unit(PROJ, Yb, 2 * grp + (id >> 2), id & 3, P.in[11] + l * 128, lds);
            }
            ++it;
            for (;; ++it) {
                if (tid == 0) MISC[16 + (it & 1)] = __hip_atomic_fetch_add(qctr + 64, 1u, __ATOMIC_RELAXED, __HIP_MEMORY_SCOPE_AGENT);
                __syncthreads();
                const int m = (int)MISC[16 + (it & 1)];
                if (m >= Q_MOBA) break;
                att2::moba_unit<8>(2 * grp + ((m >> 3) & 1), m & 7, 7 - (m >> 4), PROJ, Yb, kmp, lds);
            }
            ++it;
            for (;; ++it) {
                if (tid == 0) MISC[16 + (it & 1)] = __hip_atomic_fetch_add(qctr + 128, 1u, __ATOMIC_RELAXED, __HIP_MEMORY_SCOPE_AGENT);
                __syncthreads();
                const int sidx = (int)MISC[16 + (it & 1)];
                if (sidx >= Q_SWA) break;
                att::attn_unit<0>(PROJ, Yb, 2 * grp + (sidx >> 6), (sidx >> 5) & 1, sidx & 31, P.in[6] + l * 8, nullptr, lds);
            }
        }
        SEAMG(3 + pb);
        if (IN(4 + pb)) for (int rep = 0; rep < ((DBG_DUP >= 18 && DBG_DUP <= 22) ? 2 : 1); ++rep) {
            if (rep) xcd_barrier(bar);
            pg8::TileOrder S0; S0.init(T, D, G, bxl, 1);
            for (int ti = 0;; ++ti) {
                pg8::Unit u0; if (!S0.next(ti, u0)) break;
                if (!((DBG_DUP == 21 || DBG_DUP == 22) && rep == 0))
                { pg8::Gemm g{(const bf16_t*)(ws + WS_XB8), (const bf16_t*)(wl + OFF_WG), D / 2, D / 2, D / 2, 0, 0, nullptr, nullptr, 0, 0, 0, 0, 0, 1 << 30}; pg8::GateTriple S{u0.pm, u0.pn};
                  pg8::EpiGatesT<false> E{GATES, ((DBG_DUP == 19 || DBG_DUP == 20) && rep == 0) ? 1 : 0, SS + (size_t)(2 * l) * T, 0, 1.0f / (XS8 * WS8)};
                  pg8::gemm_phase<pg8::EpiGatesT<false>, false, pg8::GateTriple, true>(lds, g, S, E, 0); }
                if (!(DBG_DUP == 20 && rep == 0))
                { pg8::Gemm g{Yb, (const bf16_t*)(wl + OFF_WB), 512, YW, 512, 512, (long)D * 512, nullptr, nullptr, 0, 0, 0, 0, 0, 1 << 30}; pg8::SubTriple S{u0.pm, u0.pn};
                  pg8::EpiMerge E{GATES, MERGED, (DBG_DUP == 22 && rep == 0) ? 1 : 0};
                  pg8::gemm_phase<pg8::EpiMerge, false, pg8::SubTriple>(lds, g, S, E, 0); }
            }
        }
        SEAMG(4 + pb);
        if (IN(6 + pb)) for (int rep = 0; rep < ((DBG_DUP == 13 && l == 0) ? 2 : 1); ++rep) {
            if (rep) xcd_barrier(bar);
            pg8::Gemm g{MERGED, (const bf16_t*)(wl + OFF_WO), D, D, D, 0, 0, nullptr, nullptr, 0, 0, 0, 0, 0, 1 << 30}; pg8::TileOrder S; S.init(T, D, G, bxl, 1);
            pg8::EpiResid E{XS, nullptr, Hb, SS + (size_t)(2 * l + 1) * T, nullptr};
#ifndef DBG_NO_RESID
            pg8::gemm_phase<pg8::EpiResid>(lds, g, S, E, ((bxl >> 3) & 3) * STG_F);
#endif
        }
        SEAMG(6 + pb);
        if (DBG_DUP == 5) { for (int rep = 0; rep < 8; ++rep) xcd_barrier(bar); }
        if (IN(8 + pb)) for (int rep = 0; rep < ((DBG_DUP == 6 || DBG_DUP == 14 || DBG_DUP == 15 || DBG_DUP == 16) ? 2 : 1); ++rep) {
            if (DBG_DUP == 15 && rep == 0 && grp != 0) continue;
            if (rep && DBG_DUP == 15) { if (grp == 0) { ++gbn; grp_barrier(ctl + CW_GRP + 64 * (bx & 7), gbn * (unsigned)(G / 8), ctl + CW_BAR); } }
            else if (rep) xcd_barrier(bar);
            pg8::Gemm g{Hb, (const bf16_t*)(wl + OFF_F1), D, D, D, 0, 0, nullptr, nullptr, 0, 0, 0, 0, 0, 1 << 30}; pg8::TileOrder S; S.init(T, FFP, G, bxl, 1);
            pg8::EpiFfn1 E{ACT, SS + (size_t)(2 * l + 1) * T, ((DBG_DUP == 14 || DBG_DUP == 15 || DBG_DUP == 16) && rep == 0) ? 1 : 0};
#if DBG_DUP == 16
            if (rep == 0) { pg8::TileOrderFix SF; SF.init(T, FFP, G, bxl, 1); pg8::gemm_phase<pg8::EpiFfn1, false, pg8::TileOrderFix>(lds, g, SF, E, 0); continue; }
#endif
#if DBG_DUP == 17
            unsigned long long c0_ = 0, r0_ = 0; if (l == 0) { c0_ = __builtin_readcyclecounter(); r0_ = __builtin_amdgcn_s_memrealtime(); }
#endif
#ifndef DBG_NO_EPIFFN1
            pg8::gemm_phase<pg8::EpiFfn1>(lds, g, S, E, ((bxl >> 3) & 3) * STG_B);
#endif
#if DBG_DUP == 17
            if (l == 0 && tid == 0) { const unsigned long long c1_ = __builtin_readcyclecounter(), r1_ = __builtin_amdgcn_s_memrealtime(); MISC[24] = (unsigned)(((c1_ - c0_) * 2000ull) / (r1_ - r0_)); }
#endif
        }
        SEAMG(8 + pb);
        if (IN(9 + pb)) {
            pg8::Gemm g{ACT, (const bf16_t*)(wl + OFF_F2), FF, FF, FF, 0, 0, nullptr, nullptr, 0, 0, 0, 0, 0, 1 << 30}; pg8::TileOrder S; S.init(T, D, G, bxl, 1);
            pg8::EpiResid E{(const bf16_t*)Hb, (l + 1 < DEPTH) ? nullptr : P.out, (l + 1 < DEPTH) ? XS : nullptr, (l + 1 < DEPTH) ? SS + (size_t)(2 * l + 2) * T : nullptr, (l + 1 < DEPTH) ? ws + WS_XB8 : nullptr};
#ifndef DBG_NO_RESID
            pg8::gemm_phase<pg8::EpiResid>(lds, g, S, E, ((bxl >> 3) & 3) * STG_F);
#endif
        }
        SEAMG(9 + pb);
    }
#if DBG_DUP == 17
    if (bx == 0) { __syncthreads(); if (tid == 0) { const unsigned long long e_ = __builtin_amdgcn_s_memrealtime() + (unsigned long long)MISC[24]; while (__builtin_amdgcn_s_memrealtime() < e_) __builtin_amdgcn_s_sleep(8); } __syncthreads(); }
#endif
#undef IN
#undef SEAM
#undef SEAMG
#undef Hb
#undef PROJ
#undef XS
#undef GATES
#undef MERGED
#undef ACT
#undef Yb
#undef rope
#undef kmp
#undef SS
}

extern "C" void kernel_launch(void* const* d_in, const int* in_sizes, int n_in, void* d_out, int out_size, void* d_ws, size_t ws_size, hipStream_t stream) {
    static int grid = 0;
    if (grid == 0) {
        if (n_in != 20 || out_size != T * D || ws_size < WS_END) { fprintf(stderr, "kernel_launch: unexpected problem (n_in %d, out %d, ws %zu < %zu)\n", n_in, out_size, ws_size, (size_t)WS_END); grid = -1; return; }
        int dev = 0, cus = 0;
        if (hipGetDevice(&dev) != hipSuccess || hipDeviceGetAttribute(&cus, hipDeviceAttributeMultiprocessorCount, dev) != hipSuccess) { grid = -1; return; }
        if (hipFuncSetAttribute((const void*)mk_fwd, hipFuncAttributeMaxDynamicSharedMemorySize, LDS_BYTES) != hipSuccess) { fprintf(stderr, "kernel_launch: hipFuncSetAttribute failed\n"); grid = -1; return; }
        int per_cu = 0;
        if (hipOccupancyMaxActiveBlocksPerMultiprocessor(&per_cu, (const void*)mk_fwd, NWAVES * 64, LDS_BYTES) != hipSuccess || per_cu < 1) fprintf(stderr, "kernel_launch: occupancy query says %d\n", per_cu);
        (void)hipGetLastError();
        grid = (cus / 8) * 8;
    }
    if (grid < 0) return;
    (void)hipMemsetAsync((char*)d_ws + WS_CTL, 0, CTL_ZERO_BYTES, stream);
    Params p{};
    for (int i = 0; i < 20; ++i) p.in[i] = (const float*)d_in[i];
    p.out = (float*)d_out; p.ws = (unsigned char*)d_ws;
    for (int i = 0; i < 32; ++i) p.invf[i] = std::pow(10000.0, -(double)i / 32.0);
#if MK_PER_PHASE
    for (int k = 1; k <= 18; ++k) { p.ph_lo = k; p.ph_hi = k + 1; hipLaunchKernelGGL(mk_fwd, dim3(grid), dim3(NWAVES * 64), LDS_BYTES, stream, p); }
#else
    p.ph_lo = 1; p.ph_hi = 19;
    hipLaunchKernelGGL(mk_fwd, dim3(grid), dim3(NWAVES * 64), LDS_BYTES, stream, p);
#endif
}
```
